# Optimizing an MI355X kernel written in HIP

```python
import math
import jax, jax.numpy as jnp
from jax import lax
import numpy as np

D_MODEL = 1024
BATCH = 2
SEQ = 8192
DEPTH = 2

GRID_W = 64
D_MIX = D_MODEL
EPS = 1e-6
CONV_W = 256
CONV_K = 3
NA_HEADS = 4
NA_DH = 64
NA_W = NA_HEADS * NA_DH
NA_KH = 8
NA_KW = 16
GDN_HEADS = 4
GDN_DK = 128
GDN_DV = 128
GDN_W = GDN_HEADS * GDN_DV
GDN_CONV_K = 3
GDN_CHUNK = 64
GDN_QKV = 2 * GDN_HEADS * GDN_DK + GDN_W
IN_SPLITS = (CONV_W, CONV_W, CONV_W, NA_W, NA_W, NA_W, GDN_QKV, GDN_W, 2 * GDN_HEADS, 2 * GDN_HEADS)
D_IN = 3 * CONV_W + 3 * NA_W + GDN_QKV + GDN_W + 4 * GDN_HEADS
N_GROUPS = 4
EXPERTS_PER_GROUP = 8
N_EXPERTS = N_GROUPS * EXPERTS_PER_GROUP
TOP_K = 2
D_EXPERT = 512
MOE_BLOCK = 256

kernel_name = "hybrid_parallel_conv_na_gdn_hmoe_encoder"


def _rmsnorm(x, w):
    xf = x.astype(jnp.float32)
    y = xf * lax.rsqrt(jnp.mean(xf * xf, axis=-1, keepdims=True) + EPS)
    return (y * w.astype(jnp.float32)).astype(x.dtype)


def _l2norm(x):
    xf = x.astype(jnp.float32)
    return xf * lax.rsqrt(jnp.sum(xf * xf, axis=-1, keepdims=True) + EPS)


def _dwconv(x, w):
    ch = x.shape[-1]
    return lax.conv_general_dilated(x, w[:, None, :].astype(x.dtype), window_strides=(1,), padding='SAME',
                                    dimension_numbers=('NWC', 'WIO', 'NWC'), feature_group_count=ch)


def _neighbourhood_attention(q, k, v, rpb):
    bsz, t, h, dh = q.shape
    rows = t // GRID_W
    kh = min(NA_KH, rows)
    qg = q.reshape(bsz, rows, GRID_W, h, dh)
    kg = k.reshape(bsz, rows, GRID_W, h, dh)
    vg = v.reshape(bsz, rows, GRID_W, h, dh)
    col = jnp.arange(GRID_W)
    col_idx = jnp.clip(col - NA_KW // 2, 0, GRID_W - NA_KW)[:, None] + jnp.arange(NA_KW)[None, :]
    dc = col_idx - col[:, None] + (NA_KW - 1)
    row_start = jnp.clip(jnp.arange(rows) - kh // 2, 0, rows - kh)
    scale = dh ** -0.5

    def one_row(r):
        rs = row_start[r]
        q_r = lax.dynamic_index_in_dim(qg, r, axis=1, keepdims=False)
        k_rows = lax.dynamic_slice_in_dim(kg, rs, kh, axis=1)
        v_rows = lax.dynamic_slice_in_dim(vg, rs, kh, axis=1)
        k_win = k_rows[:, :, col_idx]
        v_win = v_rows[:, :, col_idx]
        dr = rs + jnp.arange(kh) - r + (NA_KH - 1)
        bias = rpb[:, dr][:, :, dc]
        s = jnp.einsum('bchd,brckhd->bhcrk', q_r, k_win).astype(jnp.float32) * scale
        s = s + jnp.transpose(bias, (0, 2, 1, 3)).astype(jnp.float32)[None]
        p = jax.nn.softmax(s.reshape(bsz, h, GRID_W, kh * NA_KW), axis=-1).reshape(s.shape).astype(v.dtype)
        return jnp.einsum('bhcrk,brckhd->bchd', p, v_win)

    out = lax.map(one_row, jnp.arange(rows))
    return jnp.transpose(out, (1, 0, 2, 3, 4)).reshape(bsz, t, h * dh)


def _gated_delta_chunked(q, k, v, g, beta):
    bsz, h, t, dk = q.shape
    dv = v.shape[-1]
    n = t // GDN_CHUNK
    cs = lambda a: a.reshape((bsz, h, n, GDN_CHUNK) + a.shape[3:])
    q, k, v, g, beta = cs(q), cs(k), cs(v), cs(g), cs(beta)
    g = jnp.cumsum(g, axis=-1)
    idx = jnp.arange(GDN_CHUNK)
    strict = idx[:, None] > idx[None, :]
    incl = idx[:, None] >= idx[None, :]
    diff = g[..., :, None] - g[..., None, :]
    dec_strict = jnp.exp(jnp.where(strict, diff, -jnp.inf))
    dec_incl = jnp.exp(jnp.where(incl, diff, -jnp.inf))
    kb = k * beta[..., None]
    lower = jnp.einsum('bhncd,bhnsd->bhncs', kb, k) * dec_strict
    rhs = jnp.concatenate([v * beta[..., None], kb * jnp.exp(g)[..., None]], axis=-1)
    sol = lax.linalg.triangular_solve(lower, rhs, left_side=True, lower=True, unit_diagonal=True)
    u, w = sol[..., :dv], sol[..., dv:]
    intra = jnp.einsum('bhncd,bhnsd->bhncs', q, k) * dec_incl
    q_dec = q * jnp.exp(g)[..., None]
    g_last = g[..., -1]
    k_dec = k * jnp.exp(g_last[..., None] - g)[..., None]

    def step(state, xs):
        u_c, w_c, intra_c, q_c, k_c, gl_c = xs
        v_new = u_c - jnp.einsum('bhcd,bhde->bhce', w_c, state)
        o_c = jnp.einsum('bhcd,bhde->bhce', q_c, state) + jnp.einsum('bhcs,bhse->bhce', intra_c, v_new)
        state = state * jnp.exp(gl_c)[..., None, None] + jnp.einsum('bhcd,bhce->bhde', k_c, v_new)
        return state, o_c

    xs = tuple(jnp.moveaxis(a, 2, 0) for a in (u, w, intra, q_dec, k_dec, g_last))
    s0 = jnp.zeros((bsz, h, dk, dv), jnp.float32)
    _, o = lax.scan(step, s0, xs)
    return jnp.moveaxis(o, 0, 2).reshape(bsz, h, t, dv)


def _gdn_mixer(qkv, z, a, b, conv_w, a_log, dt_bias, norm_w):
    bsz, t, _ = qkv.shape
    qkv = jax.nn.silu(_dwconv(qkv, conv_w))
    q = qkv[..., :GDN_HEADS * GDN_DK].reshape(bsz, t, GDN_HEADS, GDN_DK)
    k = qkv[..., GDN_HEADS * GDN_DK:2 * GDN_HEADS * GDN_DK].reshape(bsz, t, GDN_HEADS, GDN_DK)
    v = qkv[..., 2 * GDN_HEADS * GDN_DK:].reshape(bsz, t, GDN_HEADS, GDN_DV)
    q = jnp.transpose(_l2norm(q) * (GDN_DK ** -0.5), (0, 2, 1, 3))
    k = jnp.transpose(_l2norm(k), (0, 2, 1, 3))
    v = jnp.transpose(v.astype(jnp.float32), (0, 2, 1, 3))
    a = a.astype(jnp.float32).reshape(bsz, t, 2, GDN_HEADS)
    b = b.astype(jnp.float32).reshape(bsz, t, 2, GDN_HEADS)
    g = -jnp.exp(a_log.astype(jnp.float32)) * jax.nn.softplus(a + dt_bias.astype(jnp.float32))
    beta = jax.nn.sigmoid(b)
    g = jnp.transpose(g, (2, 0, 3, 1))
    beta = jnp.transpose(beta, (2, 0, 3, 1))
    flip = lambda a_: jnp.flip(a_, axis=2)
    o_fwd = _gated_delta_chunked(q, k, v, g[0], beta[0])
    o_bwd = flip(_gated_delta_chunked(flip(q), flip(k), flip(v), flip(g[1]), flip(beta[1])))
    o = jnp.transpose(o_fwd + o_bwd, (0, 2, 1, 3))
    o = o * lax.rsqrt(jnp.mean(o * o, axis=-1, keepdims=True) + EPS) * norm_w.astype(jnp.float32)
    o = o * jax.nn.silu(z.astype(jnp.float32).reshape(bsz, t, GDN_HEADS, GDN_DV))
    return o.reshape(bsz, t, GDN_W).astype(qkv.dtype)


def _hier_moe(h, wg, bg, we, be, w1, w3, w2):
    bsz, t, d = h.shape
    xt = h.reshape(bsz * t, d)
    n = xt.shape[0]
    pg = jax.nn.softmax((xt @ wg + bg).astype(jnp.float32), axis=-1)
    grp = jnp.argmax(pg, axis=-1)
    pg_top = jnp.take_along_axis(pg, grp[:, None], axis=-1)
    el = (xt @ we + be).astype(jnp.float32).reshape(n, N_GROUPS, EXPERTS_PER_GROUP)
    el_grp = jnp.take_along_axis(el, grp[:, None, None], axis=1)[:, 0]
    top_logit, top_e = lax.top_k(el_grp, TOP_K)
    gate = pg_top * jax.nn.softmax(top_logit, axis=-1)
    expert = (grp[:, None] * EXPERTS_PER_GROUP + top_e).reshape(-1)
    n_slots = n * TOP_K
    order = jnp.argsort(expert)
    sorted_e = expert[order]
    tok = order // TOP_K
    sizes = jnp.bincount(expert, length=N_EXPERTS)
    padded = (sizes + MOE_BLOCK - 1) // MOE_BLOCK * MOE_BLOCK
    pad_end = jnp.cumsum(padded)
    pad_start = pad_end - padded
    seg_start = jnp.cumsum(sizes) - sizes
    dest = pad_start[sorted_e] + jnp.arange(n_slots) - seg_start[sorted_e]
    padded_rows = (n_slots + N_EXPERTS * (MOE_BLOCK - 1) + MOE_BLOCK - 1) // MOE_BLOCK * MOE_BLOCK
    n_blocks = padded_rows // MOE_BLOCK
    buf = jnp.zeros((padded_rows, d), xt.dtype).at[dest].set(xt[tok])
    block_e = jnp.minimum(jnp.searchsorted(pad_end, jnp.arange(n_blocks) * MOE_BLOCK, side='right'), N_EXPERTS - 1)

    def expert_block(args):
        xb, e = args
        return (jax.nn.silu(xb @ w1[e]) * (xb @ w3[e])) @ w2[e]

    ys = lax.map(expert_block, (buf.reshape(n_blocks, MOE_BLOCK, d), block_e)).reshape(padded_rows, d)[dest]
    ys = ys * gate.reshape(-1)[order][:, None].astype(ys.dtype)
    return jnp.zeros_like(xt).at[tok].add(ys).reshape(bsz, t, d)


def setup_inputs(seed: int = 0) -> dict:
    key = jax.random.key(seed)
    ks = jax.random.split(key, 22)
    f32 = jnp.float32
    nrm = lambda k_, shape, s: jax.random.normal(k_, shape, f32) * s
    x = nrm(ks[0], (BATCH, SEQ, D_MODEL), 1.0)
    c = nrm(ks[1], (BATCH, D_MODEL), 1.0)
    norm_mix_w = 1.0 + nrm(ks[2], (DEPTH, D_MODEL), 0.02)
    norm_ffn_w = 1.0 + nrm(ks[3], (DEPTH, D_MODEL), 0.02)
    w_ada = nrm(ks[4], (DEPTH, D_MODEL, 6 * D_MODEL), 0.5 * D_MODEL ** -0.5)
    b_ada = nrm(ks[5], (DEPTH, 6 * D_MODEL), 0.02)
    w_in = nrm(ks[6], (DEPTH, D_MODEL, D_IN), D_MODEL ** -0.5)
    conv_a_w = nrm(ks[7], (DEPTH, CONV_K, CONV_W), CONV_K ** -0.5)
    na_rpb = nrm(ks[8], (DEPTH, NA_HEADS, 2 * NA_KH - 1, 2 * NA_KW - 1), 0.1)
    gdn_conv_w = nrm(ks[9], (DEPTH, GDN_CONV_K, GDN_QKV), GDN_CONV_K ** -0.5)
    gdn_a_log = jnp.log(jax.random.uniform(ks[10], (DEPTH, 2, GDN_HEADS), f32, 1.0, 16.0))
    dt = jnp.exp(jax.random.uniform(ks[11], (DEPTH, 2, GDN_HEADS), f32, math.log(1e-3), math.log(1e-1)))
    gdn_dt_bias = dt + jnp.log(-jnp.expm1(-dt))
    gdn_norm_w = 1.0 + nrm(ks[12], (DEPTH, GDN_DV), 0.02)
    w_out = nrm(ks[13], (DEPTH, D_MIX, D_MODEL), D_MIX ** -0.5)
    router_group_w = nrm(ks[14], (DEPTH, D_MODEL, N_GROUPS), D_MODEL ** -0.5)
    router_group_b = nrm(ks[15], (DEPTH, N_GROUPS), 0.01)
    router_expert_w = nrm(ks[16], (DEPTH, D_MODEL, N_EXPERTS), D_MODEL ** -0.5)
    router_expert_b = nrm(ks[17], (DEPTH, N_EXPERTS), 0.01)
    expert_w1 = nrm(ks[18], (DEPTH, N_EXPERTS, D_MODEL, D_EXPERT), D_MODEL ** -0.5)
    expert_w3 = nrm(ks[19], (DEPTH, N_EXPERTS, D_MODEL, D_EXPERT), D_MODEL ** -0.5)
    expert_w2 = nrm(ks[20], (DEPTH, N_EXPERTS, D_EXPERT, D_MODEL), D_EXPERT ** -0.5)
    final_norm_w = 1.0 + nrm(ks[21], (D_MODEL,), 0.02)
    return {"x": x, "c": c, "norm_mix_w": norm_mix_w, "norm_ffn_w": norm_ffn_w, "w_ada": w_ada, "b_ada": b_ada,
            "w_in": w_in, "conv_a_w": conv_a_w, "na_rpb": na_rpb, "gdn_conv_w": gdn_conv_w,
            "gdn_a_log": gdn_a_log, "gdn_dt_bias": gdn_dt_bias, "gdn_norm_w": gdn_norm_w, "w_out": w_out,
            "router_group_w": router_group_w, "router_group_b": router_group_b,
            "router_expert_w": router_expert_w, "router_expert_b": router_expert_b,
            "expert_w1": expert_w1, "expert_w3": expert_w3, "expert_w2": expert_w2, "final_norm_w": final_norm_w}


def reference(x, c, norm_mix_w, norm_ffn_w, w_ada, b_ada, w_in, conv_a_w, na_rpb, gdn_conv_w, gdn_a_log,
              gdn_dt_bias, gdn_norm_w, w_out, router_group_w, router_group_b, router_expert_w, router_expert_b,
              expert_w1, expert_w3, expert_w2, final_norm_w):
    bsz, t, _ = x.shape
    cond = jax.nn.silu(c)
    split_at = np.cumsum(IN_SPLITS)[:-1].tolist()
    for l in range(DEPTH):
        mod = cond @ w_ada[l] + b_ada[l]
        shift1, scale1, gate1, shift2, scale2, gate2 = [m[:, None, :] for m in jnp.split(mod, 6, axis=-1)]
        hmix = _rmsnorm(x, norm_mix_w[l]) * (1.0 + scale1) + shift1
        proj = hmix @ w_in[l]
        cb, cc, cx, nq, nk, nv, gqkv, gz, ga, gb = jnp.split(proj, split_at, axis=-1)
        y_conv = cb * _dwconv(cc * cx, conv_a_w[l])
        y_na = _neighbourhood_attention(nq.reshape(bsz, t, NA_HEADS, NA_DH), nk.reshape(bsz, t, NA_HEADS, NA_DH),
                                        nv.reshape(bsz, t, NA_HEADS, NA_DH), na_rpb[l])
        y_gdn = _gdn_mixer(gqkv, gz, ga, gb, gdn_conv_w[l], gdn_a_log[l], gdn_dt_bias[l], gdn_norm_w[l])
        mixed = jnp.concatenate([y_conv, y_na, y_gdn], axis=-1) @ w_out[l]
        x = x + gate1 * mixed
        hffn = _rmsnorm(x, norm_ffn_w[l]) * (1.0 + scale2) + shift2
        y_moe = _hier_moe(hffn, router_group_w[l], router_group_b[l], router_expert_w[l], router_expert_b[l],
                          expert_w1[l], expert_w3[l], expert_w2[l])
        x = x + gate2 * y_moe
    return _rmsnorm(x, final_norm_w)
```

```cpp
#include <hip/hip_runtime.h>
#include <stdint.h>
#include <stdio.h>

#define DEV __device__ __forceinline__

typedef __attribute__((ext_vector_type(8))) short bf16x8;
typedef __attribute__((ext_vector_type(4))) float f32x4;
typedef unsigned short bf16_t;

constexpr int DM = 1024;
constexpr int NB = 2;
constexpr int T = 8192;
constexpr int NTOK = NB * T;
constexpr int DEPTH = 2;
constexpr int DIN = 3600;
constexpr int PROJW = 3584;
constexpr int NEXP = 32;
constexpr int DEXP = 512;
constexpr int CAP = 16384;
constexpr float EPS = 1e-6f;
constexpr int OFF_CB = 0, OFF_CC = 256, OFF_CX = 512, OFF_NQ = 768, OFF_NK = 1024, OFF_NV = 1280,
              OFF_GQKV = 1536, OFF_GZ = 3072;
constexpr int MOD_SHIFT1 = 0, MOD_SCALE1 = 1024, MOD_GATE1 = 2048, MOD_SHIFT2 = 3072, MOD_SCALE2 = 4096,
              MOD_GATE2 = 5120;

constexpr int SMEM_BYTES = 40960;

struct Params {
  const float *x, *c, *norm_mix_w, *norm_ffn_w, *w_ada, *b_ada, *w_in, *conv_a_w, *na_rpb, *gdn_conv_w,
      *gdn_a_log, *gdn_dt_bias, *gdn_norm_w, *w_out, *rg_w, *rg_b, *re_w, *re_b, *ew1, *ew3, *ew2, *final_w;
  float* out;
  float* mod;
  int* cnt;
  float* xbuf;
  bf16_t* act;
  bf16_t* proj;
  float* gates;
  float* gb;
  bf16_t* y;
  float* obuf;
  float* qkvn;
  bf16_t* hbuf;
  bf16_t* ybuf;
  int* list;
  float* sgate;
};

DEV bf16_t f2bf(float f) {
  unsigned u = __float_as_uint(f);
  u += 0x7fffu + ((u >> 16) & 1u);
  return (bf16_t)(u >> 16);
}
DEV float bf2f(bf16_t h) { return __uint_as_float(((unsigned)h) << 16); }
DEV unsigned pack2(float a, float b) { return (unsigned)f2bf(a) | ((unsigned)f2bf(b) << 16); }
DEV float silu_f(float x) { return x / (1.f + __expf(-x)); }
DEV float sigmoid_f(float x) { return 1.f / (1.f + __expf(-x)); }
DEV float softplus_f(float x) { return fmaxf(x, 0.f) + log1pf(__expf(-fabsf(x))); }
DEV float wave_sum(float v) {
#pragma unroll
  for (int o = 32; o > 0; o >>= 1) v += __shfl_xor(v, o, 64);
  return v;
}
DEV float wave_max(float v) {
#pragma unroll
  for (int o = 32; o > 0; o >>= 1) v = fmaxf(v, __shfl_xor(v, o, 64));
  return v;
}

constexpr int GBK = 32;
constexpr int LDSROW = GBK + 8;

template <class AF, class BF>
DEV void gemm_tile_128(int K, AF arow, BF bload, f32x4 (&acc)[4][4], char* smem) {
  bf16_t* sA = (bf16_t*)smem;
  bf16_t* sB = sA + 2 * 128 * LDSROW;
  const int tid = threadIdx.x, lane = tid & 63, wid = tid >> 6, wr = wid >> 1, wc = wid & 1, fr = lane & 15,
            fq = lane >> 4;
  const int ar0 = tid >> 2, ach = tid & 3;
  const bf16_t* ap0 = arow(ar0) + ach * 8;
  const bf16_t* ap1 = arow(ar0 + 64) + ach * 8;
  const int bn = tid & 127, bkg0 = tid >> 7;
  uint4 ra0, ra1;
  float rb[2][8];
#pragma unroll
  for (int mi = 0; mi < 4; ++mi)
#pragma unroll
    for (int ni = 0; ni < 4; ++ni) acc[mi][ni] = f32x4{0.f, 0.f, 0.f, 0.f};

  auto gload = [&](int k0) {
    ra0 = *(const uint4*)(ap0 + k0);
    ra1 = *(const uint4*)(ap1 + k0);
#pragma unroll
    for (int u = 0; u < 2; ++u)
#pragma unroll
      for (int j = 0; j < 8; ++j) rb[u][j] = bload(k0 + (bkg0 + 2 * u) * 8 + j, bn);
  };
  auto sstore = [&](int buf) {
    bf16_t* a = sA + buf * 128 * LDSROW;
    bf16_t* b = sB + buf * 128 * LDSROW;
    *(uint4*)(a + ar0 * LDSROW + ach * 8) = ra0;
    *(uint4*)(a + (ar0 + 64) * LDSROW + ach * 8) = ra1;
#pragma unroll
    for (int u = 0; u < 2; ++u) {
      uint4 pk;
      pk.x = pack2(rb[u][0], rb[u][1]);
      pk.y = pack2(rb[u][2], rb[u][3]);
      pk.z = pack2(rb[u][4], rb[u][5]);
      pk.w = pack2(rb[u][6], rb[u][7]);
      *(uint4*)(b + bn * LDSROW + (bkg0 + 2 * u) * 8) = pk;
    }
  };
  const int nt = K / GBK;
  gload(0);
  sstore(0);
  __syncthreads();
  for (int t = 0; t < nt; ++t) {
    const int buf = t & 1;
    if (t + 1 < nt) gload((t + 1) * GBK);
    const bf16_t* a = sA + buf * 128 * LDSROW;
    const bf16_t* b = sB + buf * 128 * LDSROW;
    bf16x8 af[4], bfr[4];
#pragma unroll
    for (int mi = 0; mi < 4; ++mi) af[mi] = *(const bf16x8*)(a + (wr * 64 + mi * 16 + fr) * LDSROW + fq * 8);
#pragma unroll
    for (int ni = 0; ni < 4; ++ni) bfr[ni] = *(const bf16x8*)(b + (wc * 64 + ni * 16 + fr) * LDSROW + fq * 8);
#pragma unroll
    for (int mi = 0; mi < 4; ++mi)
#pragma unroll
      for (int ni = 0; ni < 4; ++ni)
        acc[mi][ni] = __builtin_amdgcn_mfma_f32_16x16x32_bf16(af[mi], bfr[ni], acc[mi][ni], 0, 0, 0);
    if (t + 1 < nt) sstore(buf ^ 1);
    __syncthreads();
  }
}

__device__ void phase_ada(const Params& p, int bid, int nb, char* smem) {
  float* cond = (float*)smem;
  for (int i = threadIdx.x; i < 2 * DM; i += 256) cond[i] = silu_f(p.c[i]);
  __syncthreads();
  for (int g = bid * 256 + threadIdx.x; g < DEPTH * 6144; g += nb * 256) {
    const int l = g / 6144, j = g - l * 6144;
    float a0 = p.b_ada[g], a1 = a0;
    const float* w = p.w_ada + (size_t)l * DM * 6144 + j;
#pragma unroll 8
    for (int k = 0; k < DM; ++k) {
      const float wv = w[(size_t)k * 6144];
      a0 += cond[k] * wv;
      a1 += cond[DM + k] * wv;
    }
    p.mod[(l * 2 + 0) * 6144 + j] = a0;
    p.mod[(l * 2 + 1) * 6144 + j] = a1;
  }
  if (bid == 0 && threadIdx.x < DEPTH * NEXP) p.cnt[threadIdx.x] = 0;
  __syncthreads();
}

DEV void norm_mod_store(const float4 (&v)[4], float rstd, const float* nw, const float* sc, const float* sh,
                        bf16_t* dst, int lane) {
#pragma unroll
  for (int i = 0; i < 4; ++i) {
    const int idx = (lane + 64 * i) * 4;
    const float4 w = *(const float4*)(nw + idx);
    const float4 s = *(const float4*)(sc + idx);
    const float4 h = *(const float4*)(sh + idx);
    const float r0 = v[i].x * rstd * w.x * (1.f + s.x) + h.x;
    const float r1 = v[i].y * rstd * w.y * (1.f + s.y) + h.y;
    const float r2 = v[i].z * rstd * w.z * (1.f + s.z) + h.z;
    const float r3 = v[i].w * rstd * w.w * (1.f + s.w) + h.w;
    uint2 pk;
    pk.x = pack2(r0, r1);
    pk.y = pack2(r2, r3);
    *(uint2*)(dst + idx) = pk;
  }
}

__device__ void phase_hmix(const Params& p, int l, const float* xin, int bid, int nb) {
  const int lane = threadIdx.x & 63, wid = threadIdx.x >> 6;
  for (int t = bid * 4 + wid; t < NTOK; t += nb * 4) {
    const float4* xr = (const float4*)(xin + (size_t)t * DM);
    float4 v[4];
    float ss = 0.f;
#pragma unroll
    for (int i = 0; i < 4; ++i) {
      v[i] = xr[lane + 64 * i];
      ss += v[i].x * v[i].x + v[i].y * v[i].y + v[i].z * v[i].z + v[i].w * v[i].w;
    }
    ss = wave_sum(ss);
    const float rstd = rsqrtf(ss * (1.f / DM) + EPS);
    const int b = t / T;
    const float* md = p.mod + (l * 2 + b) * 6144;
    norm_mod_store(v, rstd, p.norm_mix_w + l * DM, md + MOD_SCALE1, md + MOD_SHIFT1, p.act + (size_t)t * DM, lane);
  }
}

__device__ void phase_gemm_proj(const Params& p, int l, int bid, int nb, char* smem) {
  const int NCT = 29;
  const int tid = threadIdx.x, lane = tid & 63, wid = tid >> 6, wr = wid >> 1, wc = wid & 1, fr = lane & 15,
            fq = lane >> 4;
  const float* W = p.w_in + (size_t)l * DM * DIN;
  for (int tile = bid; tile < 128 * NCT; tile += nb) {
    const int rt = tile / NCT, ct = tile - rt * NCT;
    const int m0 = rt * 128, n0 = ct * 128;
    f32x4 acc[4][4];
    gemm_tile_128(
        DM, [&](int m) { return p.act + (size_t)(m0 + m) * DM; },
        [&](int k, int n) { return (n0 + n < DIN) ? W[(size_t)k * DIN + n0 + n] : 0.f; }, acc, smem);
#pragma unroll
    for (int mi = 0; mi < 4; ++mi)
#pragma unroll
      for (int ni = 0; ni < 4; ++ni)
#pragma unroll
        for (int j = 0; j < 4; ++j) {
          const int m = m0 + wr * 64 + mi * 16 + fq * 4 + j;
          const int n = n0 + wc * 64 + ni * 16 + fr;
          const float v = acc[mi][ni][j];
          if (n < PROJW)
            p.proj[(size_t)m * PROJW + n] = f2bf(v);
          else if (n < DIN)
            p.gates[(size_t)m * 16 + (n - PROJW)] = v;
        }
  }
}

__device__ void phase_conv(const Params& p, int l, int bid, int nb) {
  const float* w = p.conv_a_w + l * 768;
  for (int g = bid * 256 + threadIdx.x; g < NTOK * 256; g += nb * 256) {
    const int t = g >> 8, c = g & 255;
    const int tl = t & (T - 1);
    const bf16_t* r = p.proj + (size_t)t * PROJW;
    const float cb = bf2f(r[OFF_CB + c]);
    const float mid = bf2f(r[OFF_CC + c]) * bf2f(r[OFF_CX + c]);
    float prev = 0.f, next = 0.f;
    if (tl > 0) prev = bf2f(r[OFF_CC + c - PROJW]) * bf2f(r[OFF_CX + c - PROJW]);
    if (tl < T - 1) next = bf2f(r[OFF_CC + c + PROJW]) * bf2f(r[OFF_CX + c + PROJW]);
    const float s = w[c] * prev + w[256 + c] * mid + w[512 + c] * next;
    p.y[(size_t)t * DM + c] = f2bf(cb * s);
  }
}

DEV void unpack8(uint4 u, float* f) {
  f[0] = __uint_as_float(u.x << 16);
  f[1] = __uint_as_float(u.x & 0xffff0000u);
  f[2] = __uint_as_float(u.y << 16);
  f[3] = __uint_as_float(u.y & 0xffff0000u);
  f[4] = __uint_as_float(u.z << 16);
  f[5] = __uint_as_float(u.z & 0xffff0000u);
  f[6] = __uint_as_float(u.w << 16);
  f[7] = __uint_as_float(u.w & 0xffff0000u);
}

__device__ void phase_na_naive(const Params& p, int l, int bid, int nb) {
  const int lane = threadIdx.x & 63, wid = threadIdx.x >> 6;
  for (int item = bid * 4 + wid; item < NTOK * 4; item += nb * 4) {
    const int t = item >> 2, h = item & 3;
    const int b = t / T, tl = t & (T - 1), r = tl >> 6, c = tl & 63;
    const int rs = min(max(r - 4, 0), 120), cs = min(max(c - 8, 0), 48);
    float q[64];
    {
      const uint4* qp = (const uint4*)(p.proj + (size_t)t * PROJW + OFF_NQ + h * 64);
#pragma unroll
      for (int i = 0; i < 8; ++i) unpack8(qp[i], q + i * 8);
    }
    const float* rpb = p.na_rpb + (size_t)(l * 4 + h) * 15 * 31;
    float s[2];
#pragma unroll
    for (int u = 0; u < 2; ++u) {
      const int kidx = lane + 64 * u, i = kidx >> 4, j = kidx & 15;
      const int kt = b * T + (rs + i) * 64 + cs + j;
      const uint4* kp = (const uint4*)(p.proj + (size_t)kt * PROJW + OFF_NK + h * 64);
      float d = 0.f;
#pragma unroll
      for (int i8 = 0; i8 < 8; ++i8) {
        float kf[8];
        unpack8(kp[i8], kf);
#pragma unroll
        for (int e = 0; e < 8; ++e) d += q[i8 * 8 + e] * kf[e];
      }
      s[u] = d * 0.125f + rpb[(rs + i - r + 7) * 31 + (cs + j - c + 15)];
    }
    const float m = wave_max(fmaxf(s[0], s[1]));
    const float e0 = __expf(s[0] - m), e1 = __expf(s[1] - m);
    const float sum = wave_sum(e0 + e1);
    const float p0 = e0 / sum, p1 = e1 / sum;
    float o = 0.f;
    for (int kidx = 0; kidx < 128; ++kidx) {
      const float pk = __shfl((kidx < 64) ? p0 : p1, kidx & 63, 64);
      const int i = kidx >> 4, j = kidx & 15;
      const int kt = b * T + (rs + i) * 64 + cs + j;
      o += pk * bf2f(p.proj[(size_t)kt * PROJW + OFF_NV + h * 64 + lane]);
    }
    p.y[(size_t)t * DM + 256 + h * 64 + lane] = f2bf(o);
  }
}

__device__ void phase_gdn_prep_naive(const Params& p, int l, int bid, int nb) {
  const int lane = threadIdx.x & 63, wid = threadIdx.x >> 6;
  const float* cw = p.gdn_conv_w + l * 4608;
  for (int t = bid * 4 + wid; t < NTOK; t += nb * 4) {
    const int tl = t & (T - 1);
    const bf16_t* r = p.proj + (size_t)t * PROJW + OFF_GQKV;
    float val[24];
#pragma unroll
    for (int i = 0; i < 24; ++i) {
      const int ch = lane + 64 * i;
      const float x1 = bf2f(r[ch]);
      const float x0 = (tl > 0) ? bf2f(r[ch - PROJW]) : 0.f;
      const float x2 = (tl < T - 1) ? bf2f(r[ch + PROJW]) : 0.f;
      val[i] = silu_f(cw[ch] * x0 + cw[1536 + ch] * x1 + cw[3072 + ch] * x2);
    }
#pragma unroll
    for (int hh = 0; hh < 8; ++hh) {
      float ss = val[2 * hh] * val[2 * hh] + val[2 * hh + 1] * val[2 * hh + 1];
      ss = wave_sum(ss);
      float sc = rsqrtf(ss + EPS);
      if (hh < 4) sc *= 0.08838834764831845f;
      val[2 * hh] *= sc;
      val[2 * hh + 1] *= sc;
    }
#pragma unroll
    for (int i = 0; i < 24; ++i) p.qkvn[(size_t)t * 1536 + lane + 64 * i] = val[i];
    if (lane < 8) {
      const float a = p.gates[(size_t)t * 16 + lane];
      const float bb = p.gates[(size_t)t * 16 + 8 + lane];
      const float g = -__expf(p.gdn_a_log[l * 8 + lane]) * softplus_f(a + p.gdn_dt_bias[l * 8 + lane]);
      p.gb[(size_t)t * 16 + lane] = g;
      p.gb[(size_t)t * 16 + 8 + lane] = sigmoid_f(bb);
    }
  }
}

__device__ void phase_gdn_seq_naive(const Params& p, int bid, int nb, char* smem) {
  float* lk = (float*)smem;
  float* lq = lk + 2 * 2 * 128;
  const int tid = threadIdx.x, dir = tid >> 7, e = tid & 127;
  for (int item = bid; item < 8; item += nb) {
    const int b = item >> 2, h = item & 3;
    float S[128];
#pragma unroll
    for (int d = 0; d < 128; ++d) S[d] = 0.f;
    auto tok_of = [&](int s) { return b * T + (dir ? (T - 1 - s) : s); };
    float nk, nq, nv, ng, nbeta, cv, cg, cbeta;
    {
      const int tk = tok_of(0);
      nk = p.qkvn[(size_t)tk * 1536 + 512 + h * 128 + e];
      nq = p.qkvn[(size_t)tk * 1536 + h * 128 + e];
      cv = p.qkvn[(size_t)tk * 1536 + 1024 + h * 128 + e];
      cg = p.gb[(size_t)tk * 16 + dir * 4 + h];
      cbeta = p.gb[(size_t)tk * 16 + 8 + dir * 4 + h];
      lk[(0 * 2 + dir) * 128 + e] = nk;
      lq[(0 * 2 + dir) * 128 + e] = nq;
    }
    __syncthreads();
    for (int s = 0; s < T; ++s) {
      const int cur = s & 1;
      const int tk = tok_of(s);
      if (s + 1 < T) {
        const int tn = tok_of(s + 1);
        nk = p.qkvn[(size_t)tn * 1536 + 512 + h * 128 + e];
        nq = p.qkvn[(size_t)tn * 1536 + h * 128 + e];
        nv = p.qkvn[(size_t)tn * 1536 + 1024 + h * 128 + e];
        ng = p.gb[(size_t)tn * 16 + dir * 4 + h];
        nbeta = p.gb[(size_t)tn * 16 + 8 + dir * 4 + h];
      }
      const float decay = __expf(cg);
      const float4* k4 = (const float4*)(lk + (cur * 2 + dir) * 128);
      const float4* q4 = (const float4*)(lq + (cur * 2 + dir) * 128);
      float dot = 0.f;
#pragma unroll
      for (int d4 = 0; d4 < 32; ++d4) {
        const float4 kk = k4[d4];
        S[d4 * 4 + 0] *= decay; dot += S[d4 * 4 + 0] * kk.x;
        S[d4 * 4 + 1] *= decay; dot += S[d4 * 4 + 1] * kk.y;
        S[d4 * 4 + 2] *= decay; dot += S[d4 * 4 + 2] * kk.z;
        S[d4 * 4 + 3] *= decay; dot += S[d4 * 4 + 3] * kk.w;
      }
      const float vn = (cv - dot) * cbeta;
      float o = 0.f;
#pragma unroll
      for (int d4 = 0; d4 < 32; ++d4) {
        const float4 kk = k4[d4];
        const float4 qq = q4[d4];
        S[d4 * 4 + 0] += kk.x * vn; o += S[d4 * 4 + 0] * qq.x;
        S[d4 * 4 + 1] += kk.y * vn; o += S[d4 * 4 + 1] * qq.y;
        S[d4 * 4 + 2] += kk.z * vn; o += S[d4 * 4 + 2] * qq.z;
        S[d4 * 4 + 3] += kk.w * vn; o += S[d4 * 4 + 3] * qq.w;
      }
      p.obuf[((size_t)dir * NTOK + tk) * 512 + h * 128 + e] = o;
      if (s + 1 < T) {
        lk[((cur ^ 1) * 2 + dir) * 128 + e] = nk;
        lq[((cur ^ 1) * 2 + dir) * 128 + e] = nq;
        cv = nv; cg = ng; cbeta = nbeta;
      }
      __syncthreads();
    }
  }
}

__device__ void phase_gdn_fin(const Params& p, int l, int bid, int nb) {
  const int lane = threadIdx.x & 63, wid = threadIdx.x >> 6;
  const float* gnw = p.gdn_norm_w + l * 128;
  for (int t = bid * 4 + wid; t < NTOK; t += nb * 4) {
    float o[8];
#pragma unroll
    for (int i = 0; i < 8; ++i) {
      const int idx = lane + 64 * i;
      o[i] = p.obuf[(size_t)t * 512 + idx] + p.obuf[((size_t)NTOK + t) * 512 + idx];
    }
#pragma unroll
    for (int hh = 0; hh < 4; ++hh) {
      float ss = o[2 * hh] * o[2 * hh] + o[2 * hh + 1] * o[2 * hh + 1];
      ss = wave_sum(ss);
      const float rr = rsqrtf(ss * (1.f / 128.f) + EPS);
#pragma unroll
      for (int u = 0; u < 2; ++u) {
        const int i = 2 * hh + u, idx = lane + 64 * i, e = idx & 127;
        const float z = bf2f(p.proj[(size_t)t * PROJW + OFF_GZ + idx]);
        p.y[(size_t)t * DM + 512 + idx] = f2bf(o[i] * rr * gnw[e] * silu_f(z));
      }
    }
  }
}

__device__ void phase_gemm_wout(const Params& p, int l, const float* xin, int bid, int nb, char* smem) {
  const int tid = threadIdx.x, lane = tid & 63, wid = tid >> 6, wr = wid >> 1, wc = wid & 1, fr = lane & 15,
            fq = lane >> 4;
  const float* W = p.w_out + (size_t)l * DM * DM;
  for (int tile = bid; tile < 128 * 8; tile += nb) {
    const int rt = tile >> 3, ct = tile & 7;
    const int m0 = rt * 128, n0 = ct * 128;
    f32x4 acc[4][4];
    gemm_tile_128(
        DM, [&](int m) { return p.y + (size_t)(m0 + m) * DM; },
        [&](int k, int n) { return W[(size_t)k * DM + n0 + n]; }, acc, smem);
    const int b = m0 / T;
    const float* gate = p.mod + (l * 2 + b) * 6144 + MOD_GATE1;
#pragma unroll
    for (int mi = 0; mi < 4; ++mi)
#pragma unroll
      for (int ni = 0; ni < 4; ++ni)
#pragma unroll
        for (int j = 0; j < 4; ++j) {
          const int m = m0 + wr * 64 + mi * 16 + fq * 4 + j;
          const int n = n0 + wc * 64 + ni * 16 + fr;
          p.xbuf[(size_t)m * DM + n] = xin[(size_t)m * DM + n] + gate[n] * acc[mi][ni][j];
        }
  }
}

__device__ void phase_router(const Params& p, int l, int bid, int nb) {
  const int lane = threadIdx.x & 63, wid = threadIdx.x >> 6;
  for (int t = bid * 4 + wid; t < NTOK; t += nb * 4) {
    const float4* xr = (const float4*)(p.xbuf + (size_t)t * DM);
    float4 v[4];
    float ss = 0.f;
#pragma unroll
    for (int i = 0; i < 4; ++i) {
      v[i] = xr[lane + 64 * i];
      ss += v[i].x * v[i].x + v[i].y * v[i].y + v[i].z * v[i].z + v[i].w * v[i].w;
    }
    ss = wave_sum(ss);
    const float rstd = rsqrtf(ss * (1.f / DM) + EPS);
    const int b = t / T;
    const float* md = p.mod + (l * 2 + b) * 6144;
    const float* nw = p.norm_ffn_w + l * DM;
    float acc[36];
#pragma unroll
    for (int o = 0; o < 36; ++o) acc[o] = 0.f;
#pragma unroll
    for (int i = 0; i < 4; ++i) {
      const int idx = (lane + 64 * i) * 4;
      const float4 w = *(const float4*)(nw + idx);
      const float4 s = *(const float4*)(md + MOD_SCALE2 + idx);
      const float4 hsh = *(const float4*)(md + MOD_SHIFT2 + idx);
      float hf[4];
      hf[0] = v[i].x * rstd * w.x * (1.f + s.x) + hsh.x;
      hf[1] = v[i].y * rstd * w.y * (1.f + s.y) + hsh.y;
      hf[2] = v[i].z * rstd * w.z * (1.f + s.z) + hsh.z;
      hf[3] = v[i].w * rstd * w.w * (1.f + s.w) + hsh.w;
      uint2 pk;
      pk.x = pack2(hf[0], hf[1]);
      pk.y = pack2(hf[2], hf[3]);
      *(uint2*)(p.act + (size_t)t * DM + idx) = pk;
#pragma unroll
      for (int c4 = 0; c4 < 4; ++c4) {
        const int k = idx + c4;
        const float hv = hf[c4];
        const float4 wg = *(const float4*)(p.rg_w + ((size_t)l * DM + k) * 4);
        acc[0] += hv * wg.x; acc[1] += hv * wg.y; acc[2] += hv * wg.z; acc[3] += hv * wg.w;
        const float4* we = (const float4*)(p.re_w + ((size_t)l * DM + k) * 32);
#pragma unroll
        for (int e4 = 0; e4 < 8; ++e4) {
          const float4 ww = we[e4];
          acc[4 + e4 * 4 + 0] += hv * ww.x;
          acc[4 + e4 * 4 + 1] += hv * ww.y;
          acc[4 + e4 * 4 + 2] += hv * ww.z;
          acc[4 + e4 * 4 + 3] += hv * ww.w;
        }
      }
    }
#pragma unroll
    for (int o = 0; o < 36; ++o) acc[o] = wave_sum(acc[o]);
    float lg[4];
#pragma unroll
    for (int g = 0; g < 4; ++g) lg[g] = acc[g] + p.rg_b[l * 4 + g];
    int grp = 0;
    float mx = lg[0];
#pragma unroll
    for (int g = 1; g < 4; ++g)
      if (lg[g] > mx) { mx = lg[g]; grp = g; }
    float den = 0.f;
#pragma unroll
    for (int g = 0; g < 4; ++g) den += __expf(lg[g] - mx);
    const float pg_top = 1.f / den;
    float el[8];
#pragma unroll
    for (int j = 0; j < 8; ++j) {
      const float a0 = acc[4 + j], a1 = acc[12 + j], a2 = acc[20 + j], a3 = acc[28 + j];
      const float sel = (grp == 0) ? a0 : (grp == 1) ? a1 : (grp == 2) ? a2 : a3;
      el[j] = sel + p.re_b[l * 32 + grp * 8 + j];
    }
    float b0 = -3.0e38f, b1 = -3.0e38f;
    int i0 = 0, i1 = 0;
#pragma unroll
    for (int j = 0; j < 8; ++j)
      if (el[j] > b0) { b0 = el[j]; i0 = j; }
#pragma unroll
    for (int j = 0; j < 8; ++j)
      if (j != i0 && el[j] > b1) { b1 = el[j]; i1 = j; }
    const float ex = __expf(b1 - b0);
    const float g0 = pg_top / (1.f + ex), g1 = pg_top * ex / (1.f + ex);
    if (lane == 0) {
      const int e0 = grp * 8 + i0, e1 = grp * 8 + i1;
      const int pos0 = atomicAdd(&p.cnt[l * NEXP + e0], 1);
      p.list[e0 * CAP + pos0] = 2 * t;
      p.sgate[2 * t] = g0;
      const int pos1 = atomicAdd(&p.cnt[l * NEXP + e1], 1);
      p.list[e1 * CAP + pos1] = 2 * t + 1;
      p.sgate[2 * t + 1] = g1;
    }
  }
}

DEV bool moe_tile(const int* cnt, int tile, int& e, int& rt, int& ct, int& valid) {
  for (e = 0; e < NEXP; ++e) {
    const int c = cnt[e];
    const int ntl = ((c + 127) >> 7) * 8;
    if (tile < ntl) {
      rt = tile >> 3;
      ct = tile & 7;
      valid = min(128, c - rt * 128);
      return true;
    }
    tile -= ntl;
  }
  return false;
}

__device__ void phase_moe1(const Params& p, int l, int bid, int nb, char* smem) {
  const int tid = threadIdx.x, lane = tid & 63, wid = tid >> 6, wr = wid >> 1, wc = wid & 1, fr = lane & 15,
            fq = lane >> 4;
  const int* cnt = p.cnt + l * NEXP;
  for (int tile = bid;; tile += nb) {
    int e, rt, ct, valid;
    if (!moe_tile(cnt, tile, e, rt, ct, valid)) break;
    const int* lst = p.list + e * CAP + rt * 128;
    const float* W1 = p.ew1 + (size_t)(l * NEXP + e) * DM * DEXP;
    const float* W3 = p.ew3 + (size_t)(l * NEXP + e) * DM * DEXP;
    f32x4 acc[4][4];
    gemm_tile_128(
        DM,
        [&](int m) {
          const int slot = lst[(m < valid) ? m : 0];
          return p.act + (size_t)(slot >> 1) * DM;
        },
        [&](int k, int n) {
          const int r = n & 63;
          const int col = ct * 64 + (n >> 6) * 32 + (r & 31);
          const float* W = (r >> 5) ? W3 : W1;
          return W[(size_t)k * DEXP + col];
        },
        acc, smem);
#pragma unroll
    for (int mi = 0; mi < 4; ++mi)
#pragma unroll
      for (int j = 0; j < 4; ++j) {
        const int ml = wr * 64 + mi * 16 + fq * 4 + j;
        if (ml < valid) {
          const int slot = lst[ml];
#pragma unroll
          for (int ni = 0; ni < 2; ++ni) {
            const float a = acc[mi][ni][j], g = acc[mi][ni + 2][j];
            p.hbuf[(size_t)slot * DEXP + ct * 64 + wc * 32 + ni * 16 + fr] = f2bf(silu_f(a) * g);
          }
        }
      }
  }
}

__device__ void phase_moe2(const Params& p, int l, int bid, int nb, char* smem) {
  const int tid = threadIdx.x, lane = tid & 63, wid = tid >> 6, wr = wid >> 1, wc = wid & 1, fr = lane & 15,
            fq = lane >> 4;
  const int* cnt = p.cnt + l * NEXP;
  for (int tile = bid;; tile += nb) {
    int e, rt, ct, valid;
    if (!moe_tile(cnt, tile, e, rt, ct, valid)) break;
    const int* lst = p.list + e * CAP + rt * 128;
    const float* W2 = p.ew2 + (size_t)(l * NEXP + e) * DEXP * DM;
    f32x4 acc[4][4];
    gemm_tile_128(
        DEXP,
        [&](int m) {
          const int slot = lst[(m < valid) ? m : 0];
          return p.hbuf + (size_t)slot * DEXP;
        },
        [&](int k, int n) { return W2[(size_t)k * DM + ct * 128 + n]; }, acc, smem);
#pragma unroll
    for (int mi = 0; mi < 4; ++mi)
#pragma unroll
      for (int j = 0; j < 4; ++j) {
        const int ml = wr * 64 + mi * 16 + fq * 4 + j;
        if (ml < valid) {
          const int slot = lst[ml];
          const float g = p.sgate[slot];
#pragma unroll
          for (int ni = 0; ni < 4; ++ni)
            p.ybuf[(size_t)slot * DM + ct * 128 + wc * 64 + ni * 16 + fr] = f2bf(g * acc[mi][ni][j]);
        }
      }
  }
}

__device__ void phase_combine(const Params& p, int l, int bid, int nb) {
  const int lane = threadIdx.x & 63, wid = threadIdx.x >> 6;
  for (int t = bid * 4 + wid; t < NTOK; t += nb * 4) {
    float4* xr = (float4*)(p.xbuf + (size_t)t * DM);
    const int b = t / T;
    const float* md = p.mod + (l * 2 + b) * 6144;
    float4 v[4];
    float ss = 0.f;
#pragma unroll
    for (int i = 0; i < 4; ++i) {
      const int idx = (lane + 64 * i) * 4;
      v[i] = xr[lane + 64 * i];
      const float4 g = *(const float4*)(md + MOD_GATE2 + idx);
      const uint2 ya = *(const uint2*)(p.ybuf + (size_t)(2 * t) * DM + idx);
      const uint2 yb = *(const uint2*)(p.ybuf + (size_t)(2 * t + 1) * DM + idx);
      v[i].x += g.x * (__uint_as_float(ya.x << 16) + __uint_as_float(yb.x << 16));
      v[i].y += g.y * (__uint_as_float(ya.x & 0xffff0000u) + __uint_as_float(yb.x & 0xffff0000u));
      v[i].z += g.z * (__uint_as_float(ya.y << 16) + __uint_as_float(yb.y << 16));
      v[i].w += g.w * (__uint_as_float(ya.y & 0xffff0000u) + __uint_as_float(yb.y & 0xffff0000u));
      ss += v[i].x * v[i].x + v[i].y * v[i].y + v[i].z * v[i].z + v[i].w * v[i].w;
    }
    ss = wave_sum(ss);
    const float rstd = rsqrtf(ss * (1.f / DM) + EPS);
    if (l + 1 < DEPTH) {
#pragma unroll
      for (int i = 0; i < 4; ++i) xr[lane + 64 * i] = v[i];
      const float* md2 = p.mod + ((l + 1) * 2 + b) * 6144;
      norm_mod_store(v, rstd, p.norm_mix_w + (l + 1) * DM, md2 + MOD_SCALE1, md2 + MOD_SHIFT1,
                     p.act + (size_t)t * DM, lane);
    } else {
      float4* orow = (float4*)(p.out + (size_t)t * DM);
#pragma unroll
      for (int i = 0; i < 4; ++i) {
        const float4 w = *(const float4*)(p.final_w + (lane + 64 * i) * 4);
        float4 r;
        r.x = v[i].x * rstd * w.x;
        r.y = v[i].y * rstd * w.y;
        r.z = v[i].z * rstd * w.z;
        r.w = v[i].w * rstd * w.w;
        orow[lane + 64 * i] = r;
      }
    }
  }
}

#define SMEM_DECL __shared__ __attribute__((aligned(16))) char smem[SMEM_BYTES]

__global__ void __launch_bounds__(256) k_ada(Params p) { SMEM_DECL; phase_ada(p, blockIdx.x, gridDim.x, smem); }
__global__ void __launch_bounds__(256) k_hmix(Params p, int l) { phase_hmix(p, l, p.x, blockIdx.x, gridDim.x); }
__global__ void __launch_bounds__(256) k_proj(Params p, int l) { SMEM_DECL; phase_gemm_proj(p, l, blockIdx.x, gridDim.x, smem); }
__global__ void __launch_bounds__(256) k_conv(Params p, int l) { phase_conv(p, l, blockIdx.x, gridDim.x); }
__global__ void __launch_bounds__(256) k_na(Params p, int l) { phase_na_naive(p, l, blockIdx.x, gridDim.x); }
__global__ void __launch_bounds__(256) k_gprep(Params p, int l) { phase_gdn_prep_naive(p, l, blockIdx.x, gridDim.x); }
__global__ void __launch_bounds__(256) k_gseq(Params p) { SMEM_DECL; phase_gdn_seq_naive(p, blockIdx.x, gridDim.x, smem); }
__global__ void __launch_bounds__(256) k_gfin(Params p, int l) { phase_gdn_fin(p, l, blockIdx.x, gridDim.x); }
__global__ void __launch_bounds__(256) k_wout(Params p, int l) {
  SMEM_DECL;
  phase_gemm_wout(p, l, l == 0 ? p.x : p.xbuf, blockIdx.x, gridDim.x, smem);
}
__global__ void __launch_bounds__(256) k_router(Params p, int l) { phase_router(p, l, blockIdx.x, gridDim.x); }
__global__ void __launch_bounds__(256) k_moe1(Params p, int l) { SMEM_DECL; phase_moe1(p, l, blockIdx.x, gridDim.x, smem); }
__global__ void __launch_bounds__(256) k_moe2(Params p, int l) { SMEM_DECL; phase_moe2(p, l, blockIdx.x, gridDim.x, smem); }
__global__ void __launch_bounds__(256) k_combine(Params p, int l) { phase_combine(p, l, blockIdx.x, gridDim.x); }

extern "C" void kernel_launch(void* const* d_in, const int* in_sizes, int n_in, void* d_out, int out_size,
                              void* d_ws, size_t ws_size, hipStream_t stream) {
  Params p{};
  p.x = (const float*)d_in[0];
  p.c = (const float*)d_in[1];
  p.norm_mix_w = (const float*)d_in[2];
  p.norm_ffn_w = (const float*)d_in[3];
  p.w_ada = (const float*)d_in[4];
  p.b_ada = (const float*)d_in[5];
  p.w_in = (const float*)d_in[6];
  p.conv_a_w = (const float*)d_in[7];
  p.na_rpb = (const float*)d_in[8];
  p.gdn_conv_w = (const float*)d_in[9];
  p.gdn_a_log = (const float*)d_in[10];
  p.gdn_dt_bias = (const float*)d_in[11];
  p.gdn_norm_w = (const float*)d_in[12];
  p.w_out = (const float*)d_in[13];
  p.rg_w = (const float*)d_in[14];
  p.rg_b = (const float*)d_in[15];
  p.re_w = (const float*)d_in[16];
  p.re_b = (const float*)d_in[17];
  p.ew1 = (const float*)d_in[18];
  p.ew3 = (const float*)d_in[19];
  p.ew2 = (const float*)d_in[20];
  p.final_w = (const float*)d_in[21];
  p.out = (float*)d_out;
  char* ws = (char*)d_ws;
  size_t off = 0;
  auto take = [&](size_t bytes) {
    char* r = ws + off;
    off += (bytes + 255) & ~(size_t)255;
    return r;
  };
  p.mod = (float*)take(sizeof(float) * DEPTH * NB * 6144);
  p.cnt = (int*)take(sizeof(int) * DEPTH * NEXP);
  p.xbuf = (float*)take(sizeof(float) * (size_t)NTOK * DM);
  p.act = (bf16_t*)take(2 * (size_t)NTOK * DM);
  p.proj = (bf16_t*)take(2 * (size_t)NTOK * PROJW);
  p.gates = (float*)take(sizeof(float) * (size_t)NTOK * 16);
  p.gb = (float*)take(sizeof(float) * (size_t)NTOK * 16);
  p.y = (bf16_t*)take(2 * (size_t)NTOK * DM);
  p.list = (int*)take(sizeof(int) * NEXP * CAP);
  p.sgate = (float*)take(sizeof(float) * 2 * NTOK);
  p.obuf = (float*)take(sizeof(float) * 2 * (size_t)NTOK * 512);
  p.qkvn = (float*)take(sizeof(float) * (size_t)NTOK * 1536);
  p.hbuf = (bf16_t*)p.obuf;
  p.ybuf = (bf16_t*)p.qkvn;
  if (off > ws_size) fprintf(stderr, "workspace too small: need %zu have %zu\n", off, ws_size);

  const int G = 2048;
  k_ada<<<48, 256, 0, stream>>>(p);
  k_hmix<<<G, 256, 0, stream>>>(p, 0);
  for (int l = 0; l < DEPTH; ++l) {
    k_proj<<<G, 256, 0, stream>>>(p, l);
    k_conv<<<G, 256, 0, stream>>>(p, l);
    k_na<<<G, 256, 0, stream>>>(p, l);
    k_gprep<<<G, 256, 0, stream>>>(p, l);
    k_gseq<<<8, 256, 0, stream>>>(p);
    k_gfin<<<G, 256, 0, stream>>>(p, l);
    k_wout<<<1024, 256, 0, stream>>>(p, l);
    k_router<<<G, 256, 0, stream>>>(p, l);
    k_moe1<<<G, 256, 0, stream>>>(p, l);
    k_moe2<<<G, 256, 0, stream>>>(p, l);
    k_combine<<<G, 256, 0, stream>>>(p, l);
  }
}
```

```cpp
#include <hip/hip_runtime.h>
#include <hip/hip_cooperative_groups.h>
#include <stdint.h>
#include <stdio.h>

#define DEV __device__ __forceinline__
namespace cg = cooperative_groups;

typedef __attribute__((ext_vector_type(8))) short bf16x8;
typedef __attribute__((ext_vector_type(4))) float f32x4;
typedef unsigned short bf16_t;

constexpr int DM = 1024;
constexpr int NB = 2;
constexpr int T = 8192;
constexpr int NTOK = NB * T;
constexpr int DEPTH = 2;
constexpr int DIN = 3600;
constexpr int PROJW = 3584;
constexpr int NEXP = 32;
constexpr int DEXP = 512;
constexpr int CAP = 16384;
constexpr float EPS = 1e-6f;
constexpr int OFF_CB = 0, OFF_CC = 256, OFF_CX = 512, OFF_NQ = 768, OFF_NK = 1024, OFF_NV = 1280,
              OFF_GQKV = 1536, OFF_GZ = 3072;
constexpr int MOD_SHIFT1 = 0, MOD_SCALE1 = 1024, MOD_GATE1 = 2048, MOD_SHIFT2 = 3072, MOD_SCALE2 = 4096,
              MOD_GATE2 = 5120;

constexpr int SMEM_BYTES = 40960;

struct Params {
  const float *x, *c, *norm_mix_w, *norm_ffn_w, *w_ada, *b_ada, *w_in, *conv_a_w, *na_rpb, *gdn_conv_w,
      *gdn_a_log, *gdn_dt_bias, *gdn_norm_w, *w_out, *rg_w, *rg_b, *re_w, *re_b, *ew1, *ew3, *ew2, *final_w;
  float* out;
  float* mod;
  int* cnt;
  float* xbuf;
  bf16_t* act;
  bf16_t* proj;
  float* gates;
  float* gb;
  bf16_t* y;
  float* obuf;
  float* qkvn;
  bf16_t* hbuf;
  bf16_t* ybuf;
  int* list;
  float* sgate;
};

DEV bf16_t f2bf(float f) {
  unsigned u = __float_as_uint(f);
  u += 0x7fffu + ((u >> 16) & 1u);
  return (bf16_t)(u >> 16);
}
DEV float bf2f(bf16_t h) { return __uint_as_float(((unsigned)h) << 16); }
DEV unsigned pack2(float a, float b) { return (unsigned)f2bf(a) | ((unsigned)f2bf(b) << 16); }
DEV float silu_f(float x) { return x / (1.f + __expf(-x)); }
DEV float sigmoid_f(float x) { return 1.f / (1.f + __expf(-x)); }
DEV float softplus_f(float x) { return fmaxf(x, 0.f) + log1pf(__expf(-fabsf(x))); }
DEV float wave_sum(float v) {
#pragma unroll
  for (int o = 32; o > 0; o >>= 1) v += __shfl_xor(v, o, 64);
  return v;
}
DEV float wave_max(float v) {
#pragma unroll
  for (int o = 32; o > 0; o >>= 1) v = fmaxf(v, __shfl_xor(v, o, 64));
  return v;
}

constexpr int GBK = 32;
constexpr int LDSROW = GBK + 8;

template <class AF, class BF>
DEV void gemm_tile_128(int K, AF arow, BF bload, f32x4 (&acc)[4][4], char* smem) {
  bf16_t* sA = (bf16_t*)smem;
  bf16_t* sB = sA + 2 * 128 * LDSROW;
  const int tid = threadIdx.x, lane = tid & 63, wid = tid >> 6, wr = wid >> 1, wc = wid & 1, fr = lane & 15,
            fq = lane >> 4;
  const int ar0 = tid >> 2, ach = tid & 3;
  const bf16_t* ap0 = arow(ar0) + ach * 8;
  const bf16_t* ap1 = arow(ar0 + 64) + ach * 8;
  const int bn = tid & 127, bkg0 = tid >> 7;
  uint4 ra0, ra1;
  float rb[2][8];
#pragma unroll
  for (int mi = 0; mi < 4; ++mi)
#pragma unroll
    for (int ni = 0; ni < 4; ++ni) acc[mi][ni] = f32x4{0.f, 0.f, 0.f, 0.f};

  auto gload = [&](int k0) {
    ra0 = *(const uint4*)(ap0 + k0);
    ra1 = *(const uint4*)(ap1 + k0);
#pragma unroll
    for (int u = 0; u < 2; ++u)
#pragma unroll
      for (int j = 0; j < 8; ++j) rb[u][j] = bload(k0 + (bkg0 + 2 * u) * 8 + j, bn);
  };
  auto sstore = [&](int buf) {
    bf16_t* a = sA + buf * 128 * LDSROW;
    bf16_t* b = sB + buf * 128 * LDSROW;
    *(uint4*)(a + ar0 * LDSROW + ach * 8) = ra0;
    *(uint4*)(a + (ar0 + 64) * LDSROW + ach * 8) = ra1;
#pragma unroll
    for (int u = 0; u < 2; ++u) {
      uint4 pk;
      pk.x = pack2(rb[u][0], rb[u][1]);
      pk.y = pack2(rb[u][2], rb[u][3]);
      pk.z = pack2(rb[u][4], rb[u][5]);
      pk.w = pack2(rb[u][6], rb[u][7]);
      *(uint4*)(b + bn * LDSROW + (bkg0 + 2 * u) * 8) = pk;
    }
  };
  const int nt = K / GBK;
  gload(0);
  sstore(0);
  __syncthreads();
  for (int t = 0; t < nt; ++t) {
    const int buf = t & 1;
    if (t + 1 < nt) gload((t + 1) * GBK);
    const bf16_t* a = sA + buf * 128 * LDSROW;
    const bf16_t* b = sB + buf * 128 * LDSROW;
    bf16x8 af[4], bfr[4];
#pragma unroll
    for (int mi = 0; mi < 4; ++mi) af[mi] = *(const bf16x8*)(a + (wr * 64 + mi * 16 + fr) * LDSROW + fq * 8);
#pragma unroll
    for (int ni = 0; ni < 4; ++ni) bfr[ni] = *(const bf16x8*)(b + (wc * 64 + ni * 16 + fr) * LDSROW + fq * 8);
#pragma unroll
    for (int mi = 0; mi < 4; ++mi)
#pragma unroll
      for (int ni = 0; ni < 4; ++ni)
        acc[mi][ni] = __builtin_amdgcn_mfma_f32_16x16x32_bf16(af[mi], bfr[ni], acc[mi][ni], 0, 0, 0);
    if (t + 1 < nt) sstore(buf ^ 1);
    __syncthreads();
  }
}

DEV void phase_ada(const Params& p, int bid, int nb, char* smem) {
  float* cond = (float*)smem;
  for (int i = threadIdx.x; i < 2 * DM; i += 256) cond[i] = silu_f(p.c[i]);
  __syncthreads();
  for (int g = bid * 256 + threadIdx.x; g < DEPTH * 6144; g += nb * 256) {
    const int l = g / 6144, j = g - l * 6144;
    float a0 = p.b_ada[g], a1 = a0;
    const float* w = p.w_ada + (size_t)l * DM * 6144 + j;
#pragma unroll 8
    for (int k = 0; k < DM; ++k) {
      const float wv = w[(size_t)k * 6144];
      a0 += cond[k] * wv;
      a1 += cond[DM + k] * wv;
    }
    p.mod[(l * 2 + 0) * 6144 + j] = a0;
    p.mod[(l * 2 + 1) * 6144 + j] = a1;
  }
  if (bid == 0 && threadIdx.x < DEPTH * NEXP) p.cnt[threadIdx.x] = 0;
  __syncthreads();
}

DEV void norm_mod_store(const float4 (&v)[4], float rstd, const float* nw, const float* sc, const float* sh,
                        bf16_t* dst, int lane) {
#pragma unroll
  for (int i = 0; i < 4; ++i) {
    const int idx = (lane + 64 * i) * 4;
    const float4 w = *(const float4*)(nw + idx);
    const float4 s = *(const float4*)(sc + idx);
    const float4 h = *(const float4*)(sh + idx);
    const float r0 = v[i].x * rstd * w.x * (1.f + s.x) + h.x;
    const float r1 = v[i].y * rstd * w.y * (1.f + s.y) + h.y;
    const float r2 = v[i].z * rstd * w.z * (1.f + s.z) + h.z;
    const float r3 = v[i].w * rstd * w.w * (1.f + s.w) + h.w;
    uint2 pk;
    pk.x = pack2(r0, r1);
    pk.y = pack2(r2, r3);
    *(uint2*)(dst + idx) = pk;
  }
}

DEV void phase_hmix(const Params& p, int l, const float* xin, int bid, int nb) {
  const int lane = threadIdx.x & 63, wid = threadIdx.x >> 6;
  for (int t = bid * 4 + wid; t < NTOK; t += nb * 4) {
    const float4* xr = (const float4*)(xin + (size_t)t * DM);
    float4 v[4];
    float ss = 0.f;
#pragma unroll
    for (int i = 0; i < 4; ++i) {
      v[i] = xr[lane + 64 * i];
      ss += v[i].x * v[i].x + v[i].y * v[i].y + v[i].z * v[i].z + v[i].w * v[i].w;
    }
    ss = wave_sum(ss);
    const float rstd = rsqrtf(ss * (1.f / DM) + EPS);
    const int b = t / T;
    const float* md = p.mod + (l * 2 + b) * 6144;
    norm_mod_store(v, rstd, p.norm_mix_w + l * DM, md + MOD_SCALE1, md + MOD_SHIFT1, p.act + (size_t)t * DM, lane);
  }
}

DEV void phase_gemm_proj(const Params& p, int l, int bid, int nb, char* smem) {
  const int NCT = 29;
  const int tid = threadIdx.x, lane = tid & 63, wid = tid >> 6, wr = wid >> 1, wc = wid & 1, fr = lane & 15,
            fq = lane >> 4;
  const float* W = p.w_in + (size_t)l * DM * DIN;
  for (int tile = bid; tile < 128 * NCT; tile += nb) {
    const int rt = tile / NCT, ct = tile - rt * NCT;
    const int m0 = rt * 128, n0 = ct * 128;
    f32x4 acc[4][4];
    gemm_tile_128(
        DM, [&](int m) { return p.act + (size_t)(m0 + m) * DM; },
        [&](int k, int n) { return (n0 + n < DIN) ? W[(size_t)k * DIN + n0 + n] : 0.f; }, acc, smem);
#pragma unroll
    for (int mi = 0; mi < 4; ++mi)
#pragma unroll
      for (int ni = 0; ni < 4; ++ni)
#pragma unroll
        for (int j = 0; j < 4; ++j) {
          const int m = m0 + wr * 64 + mi * 16 + fq * 4 + j;
          const int n = n0 + wc * 64 + ni * 16 + fr;
          const float v = acc[mi][ni][j];
          if (n < PROJW)
            p.proj[(size_t)m * PROJW + n] = f2bf(v);
          else if (n < DIN)
            p.gates[(size_t)m * 16 + (n - PROJW)] = v;
        }
  }
}

DEV void phase_conv(const Params& p, int l, int bid, int nb) {
  const float* w = p.conv_a_w + l * 768;
  for (int g = bid * 256 + threadIdx.x; g < NTOK * 256; g += nb * 256) {
    const int t = g >> 8, c = g & 255;
    const int tl = t & (T - 1);
    const bf16_t* r = p.proj + (size_t)t * PROJW;
    const float cb = bf2f(r[OFF_CB + c]);
    const float mid = bf2f(r[OFF_CC + c]) * bf2f(r[OFF_CX + c]);
    float prev = 0.f, next = 0.f;
    if (tl > 0) prev = bf2f(r[OFF_CC + c - PROJW]) * bf2f(r[OFF_CX + c - PROJW]);
    if (tl < T - 1) next = bf2f(r[OFF_CC + c + PROJW]) * bf2f(r[OFF_CX + c + PROJW]);
    const float s = w[c] * prev + w[256 + c] * mid + w[512 + c] * next;
    p.y[(size_t)t * DM + c] = f2bf(cb * s);
  }
}

DEV void unpack8(uint4 u, float* f) {
  f[0] = __uint_as_float(u.x << 16);
  f[1] = __uint_as_float(u.x & 0xffff0000u);
  f[2] = __uint_as_float(u.y << 16);
  f[3] = __uint_as_float(u.y & 0xffff0000u);
  f[4] = __uint_as_float(u.z << 16);
  f[5] = __uint_as_float(u.z & 0xffff0000u);
  f[6] = __uint_as_float(u.w << 16);
  f[7] = __uint_as_float(u.w & 0xffff0000u);
}

DEV void phase_na_naive(const Params& p, int l, int bid, int nb) {
  const int lane = threadIdx.x & 63, wid = threadIdx.x >> 6;
  for (int item = bid * 4 + wid; item < NTOK * 4; item += nb * 4) {
    const int t = item >> 2, h = item & 3;
    const int b = t / T, tl = t & (T - 1), r = tl >> 6, c = tl & 63;
    const int rs = min(max(r - 4, 0), 120), cs = min(max(c - 8, 0), 48);
    float q[64];
    {
      const uint4* qp = (const uint4*)(p.proj + (size_t)t * PROJW + OFF_NQ + h * 64);
#pragma unroll
      for (int i = 0; i < 8; ++i) unpack8(qp[i], q + i * 8);
    }
    const float* rpb = p.na_rpb + (size_t)(l * 4 + h) * 15 * 31;
    float s[2];
#pragma unroll
    for (int u = 0; u < 2; ++u) {
      const int kidx = lane + 64 * u, i = kidx >> 4, j = kidx & 15;
      const int kt = b * T + (rs + i) * 64 + cs + j;
      const uint4* kp = (const uint4*)(p.proj + (size_t)kt * PROJW + OFF_NK + h * 64);
      float d = 0.f;
#pragma unroll
      for (int i8 = 0; i8 < 8; ++i8) {
        float kf[8];
        unpack8(kp[i8], kf);
#pragma unroll
        for (int e = 0; e < 8; ++e) d += q[i8 * 8 + e] * kf[e];
      }
      s[u] = d * 0.125f + rpb[(rs + i - r + 7) * 31 + (cs + j - c + 15)];
    }
    const float m = wave_max(fmaxf(s[0], s[1]));
    const float e0 = __expf(s[0] - m), e1 = __expf(s[1] - m);
    const float sum = wave_sum(e0 + e1);
    const float p0 = e0 / sum, p1 = e1 / sum;
    float o = 0.f;
    for (int kidx = 0; kidx < 128; ++kidx) {
      const float pk = __shfl((kidx < 64) ? p0 : p1, kidx & 63, 64);
      const int i = kidx >> 4, j = kidx & 15;
      const int kt = b * T + (rs + i) * 64 + cs + j;
      o += pk * bf2f(p.proj[(size_t)kt * PROJW + OFF_NV + h * 64 + lane]);
    }
    p.y[(size_t)t * DM + 256 + h * 64 + lane] = f2bf(o);
  }
}

DEV void phase_gdn_prep_naive(const Params& p, int l, int bid, int nb) {
  const int lane = threadIdx.x & 63, wid = threadIdx.x >> 6;
  const float* cw = p.gdn_conv_w + l * 4608;
  for (int t = bid * 4 + wid; t < NTOK; t += nb * 4) {
    const int tl = t & (T - 1);
    const bf16_t* r = p.proj + (size_t)t * PROJW + OFF_GQKV;
#pragma unroll 1
    for (int hh = 0; hh < 12; ++hh) {
      float val[2];
#pragma unroll
      for (int u = 0; u < 2; ++u) {
        const int ch = lane + 64 * (2 * hh + u);
        const float x1 = bf2f(r[ch]);
        const float x0 = (tl > 0) ? bf2f(r[ch - PROJW]) : 0.f;
        const float x2 = (tl < T - 1) ? bf2f(r[ch + PROJW]) : 0.f;
        val[u] = silu_f(cw[ch] * x0 + cw[1536 + ch] * x1 + cw[3072 + ch] * x2);
      }
      if (hh < 8) {
        float ss = val[0] * val[0] + val[1] * val[1];
        ss = wave_sum(ss);
        float sc = rsqrtf(ss + EPS);
        if (hh < 4) sc *= 0.08838834764831845f;
        val[0] *= sc;
        val[1] *= sc;
      }
      p.qkvn[(size_t)t * 1536 + lane + 64 * (2 * hh)] = val[0];
      p.qkvn[(size_t)t * 1536 + lane + 64 * (2 * hh + 1)] = val[1];
    }
    if (lane < 8) {
      const float a = p.gates[(size_t)t * 16 + lane];
      const float bb = p.gates[(size_t)t * 16 + 8 + lane];
      const float g = -__expf(p.gdn_a_log[l * 8 + lane]) * softplus_f(a + p.gdn_dt_bias[l * 8 + lane]);
      p.gb[(size_t)t * 16 + lane] = g;
      p.gb[(size_t)t * 16 + 8 + lane] = sigmoid_f(bb);
    }
  }
}

DEV void phase_gdn_seq_naive(const Params& p, int bid, int nb, char* smem) {
  float* lk = (float*)smem;
  float* lq = lk + 2 * 2 * 128;
  const int tid = threadIdx.x, dir = tid >> 7, e = tid & 127;
  for (int item = bid; item < 8; item += nb) {
    const int b = item >> 2, h = item & 3;
    float S[128];
#pragma unroll
    for (int d = 0; d < 128; ++d) S[d] = 0.f;
    auto tok_of = [&](int s) { return b * T + (dir ? (T - 1 - s) : s); };
    float nk, nq, nv, ng, nbeta, cv, cg, cbeta;
    {
      const int tk = tok_of(0);
      nk = p.qkvn[(size_t)tk * 1536 + 512 + h * 128 + e];
      nq = p.qkvn[(size_t)tk * 1536 + h * 128 + e];
      cv = p.qkvn[(size_t)tk * 1536 + 1024 + h * 128 + e];
      cg = p.gb[(size_t)tk * 16 + dir * 4 + h];
      cbeta = p.gb[(size_t)tk * 16 + 8 + dir * 4 + h];
      lk[(0 * 2 + dir) * 128 + e] = nk;
      lq[(0 * 2 + dir) * 128 + e] = nq;
    }
    __syncthreads();
    for (int s = 0; s < T; ++s) {
      const int cur = s & 1;
      const int tk = tok_of(s);
      if (s + 1 < T) {
        const int tn = tok_of(s + 1);
        nk = p.qkvn[(size_t)tn * 1536 + 512 + h * 128 + e];
        nq = p.qkvn[(size_t)tn * 1536 + h * 128 + e];
        nv = p.qkvn[(size_t)tn * 1536 + 1024 + h * 128 + e];
        ng = p.gb[(size_t)tn * 16 + dir * 4 + h];
        nbeta = p.gb[(size_t)tn * 16 + 8 + dir * 4 + h];
      }
      const float decay = __expf(cg);
      const float4* k4 = (const float4*)(lk + (cur * 2 + dir) * 128);
      const float4* q4 = (const float4*)(lq + (cur * 2 + dir) * 128);
      float dot = 0.f;
#pragma unroll
      for (int d4 = 0; d4 < 32; ++d4) {
        const float4 kk = k4[d4];
        S[d4 * 4 + 0] *= decay; dot += S[d4 * 4 + 0] * kk.x;
        S[d4 * 4 + 1] *= decay; dot += S[d4 * 4 + 1] * kk.y;
        S[d4 * 4 + 2] *= decay; dot += S[d4 * 4 + 2] * kk.z;
        S[d4 * 4 + 3] *= decay; dot += S[d4 * 4 + 3] * kk.w;
        if ((d4 & 7) == 7) asm volatile("" ::: "memory");
      }
      const float vn = (cv - dot) * cbeta;
      float o = 0.f;
#pragma unroll
      for (int d4 = 0; d4 < 32; ++d4) {
        const float4 kk = k4[d4];
        const float4 qq = q4[d4];
        S[d4 * 4 + 0] += kk.x * vn; o += S[d4 * 4 + 0] * qq.x;
        S[d4 * 4 + 1] += kk.y * vn; o += S[d4 * 4 + 1] * qq.y;
        S[d4 * 4 + 2] += kk.z * vn; o += S[d4 * 4 + 2] * qq.z;
        S[d4 * 4 + 3] += kk.w * vn; o += S[d4 * 4 + 3] * qq.w;
        if ((d4 & 7) == 7) asm volatile("" ::: "memory");
      }
      p.obuf[((size_t)dir * NTOK + tk) * 512 + h * 128 + e] = o;
      if (s + 1 < T) {
        lk[((cur ^ 1) * 2 + dir) * 128 + e] = nk;
        lq[((cur ^ 1) * 2 + dir) * 128 + e] = nq;
        cv = nv; cg = ng; cbeta = nbeta;
      }
      __syncthreads();
    }
  }
}

DEV void phase_gdn_fin(const Params& p, int l, int bid, int nb) {
  const int lane = threadIdx.x & 63, wid = threadIdx.x >> 6;
  const float* gnw = p.gdn_norm_w + l * 128;
  for (int t = bid * 4 + wid; t < NTOK; t += nb * 4) {
    float o[8];
#pragma unroll
    for (int i = 0; i < 8; ++i) {
      const int idx = lane + 64 * i;
      o[i] = p.obuf[(size_t)t * 512 + idx] + p.obuf[((size_t)NTOK + t) * 512 + idx];
    }
#pragma unroll
    for (int hh = 0; hh < 4; ++hh) {
      float ss = o[2 * hh] * o[2 * hh] + o[2 * hh + 1] * o[2 * hh + 1];
      ss = wave_sum(ss);
      const float rr = rsqrtf(ss * (1.f / 128.f) + EPS);
#pragma unroll
      for (int u = 0; u < 2; ++u) {
        const int i = 2 * hh + u, idx = lane + 64 * i, e = idx & 127;
        const float z = bf2f(p.proj[(size_t)t * PROJW + OFF_GZ + idx]);
        p.y[(size_t)t * DM + 512 + idx] = f2bf(o[i] * rr * gnw[e] * silu_f(z));
      }
    }
  }
}

DEV void phase_gemm_wout(const Params& p, int l, const float* xin, int bid, int nb, char* smem) {
  const int tid = threadIdx.x, lane = tid & 63, wid = tid >> 6, wr = wid >> 1, wc = wid & 1, fr = lane & 15,
            fq = lane >> 4;
  const float* W = p.w_out + (size_t)l * DM * DM;
  for (int tile = bid; tile < 128 * 8; tile += nb) {
    const int rt = tile >> 3, ct = tile & 7;
    const int m0 = rt * 128, n0 = ct * 128;
    f32x4 acc[4][4];
    gemm_tile_128(
        DM, [&](int m) { return p.y + (size_t)(m0 + m) * DM; },
        [&](int k, int n) { return W[(size_t)k * DM + n0 + n]; }, acc, smem);
    const int b = m0 / T;
    const float* gate = p.mod + (l * 2 + b) * 6144 + MOD_GATE1;
#pragma unroll
    for (int mi = 0; mi < 4; ++mi)
#pragma unroll
      for (int ni = 0; ni < 4; ++ni)
#pragma unroll
        for (int j = 0; j < 4; ++j) {
          const int m = m0 + wr * 64 + mi * 16 + fq * 4 + j;
          const int n = n0 + wc * 64 + ni * 16 + fr;
          p.xbuf[(size_t)m * DM + n] = xin[(size_t)m * DM + n] + gate[n] * acc[mi][ni][j];
        }
  }
}

DEV void phase_router(const Params& p, int l, int bid, int nb) {
  const int lane = threadIdx.x & 63, wid = threadIdx.x >> 6;
  for (int t = bid * 4 + wid; t < NTOK; t += nb * 4) {
    const float4* xr = (const float4*)(p.xbuf + (size_t)t * DM);
    float4 v[4];
    float ss = 0.f;
#pragma unroll
    for (int i = 0; i < 4; ++i) {
      v[i] = xr[lane + 64 * i];
      ss += v[i].x * v[i].x + v[i].y * v[i].y + v[i].z * v[i].z + v[i].w * v[i].w;
    }
    ss = wave_sum(ss);
    const float rstd = rsqrtf(ss * (1.f / DM) + EPS);
    const int b = t / T;
    const float* md = p.mod + (l * 2 + b) * 6144;
    const float* nw = p.norm_ffn_w + l * DM;
    float acc[36];
#pragma unroll
    for (int o = 0; o < 36; ++o) acc[o] = 0.f;
#pragma unroll
    for (int i = 0; i < 4; ++i) {
      const int idx = (lane + 64 * i) * 4;
      const float4 w = *(const float4*)(nw + idx);
      const float4 s = *(const float4*)(md + MOD_SCALE2 + idx);
      const float4 hsh = *(const float4*)(md + MOD_SHIFT2 + idx);
      float hf[4];
      hf[0] = v[i].x * rstd * w.x * (1.f + s.x) + hsh.x;
      hf[1] = v[i].y * rstd * w.y * (1.f + s.y) + hsh.y;
      hf[2] = v[i].z * rstd * w.z * (1.f + s.z) + hsh.z;
      hf[3] = v[i].w * rstd * w.w * (1.f + s.w) + hsh.w;
      uint2 pk;
      pk.x = pack2(hf[0], hf[1]);
      pk.y = pack2(hf[2], hf[3]);
      *(uint2*)(p.act + (size_t)t * DM + idx) = pk;
#pragma unroll
      for (int c4 = 0; c4 < 4; ++c4) {
        const int k = idx + c4;
        const float hv = hf[c4];
        const float4 wg = *(const float4*)(p.rg_w + ((size_t)l * DM + k) * 4);
        acc[0] += hv * wg.x; acc[1] += hv * wg.y; acc[2] += hv * wg.z; acc[3] += hv * wg.w;
        const float4* we = (const float4*)(p.re_w + ((size_t)l * DM + k) * 32);
#pragma unroll
        for (int e4 = 0; e4 < 8; ++e4) {
          const float4 ww = we[e4];
          acc[4 + e4 * 4 + 0] += hv * ww.x;
          acc[4 + e4 * 4 + 1] += hv * ww.y;
          acc[4 + e4 * 4 + 2] += hv * ww.z;
          acc[4 + e4 * 4 + 3] += hv * ww.w;
        }
      }
    }
#pragma unroll
    for (int o = 0; o < 36; ++o) acc[o] = wave_sum(acc[o]);
    float lg[4];
#pragma unroll
    for (int g = 0; g < 4; ++g) lg[g] = acc[g] + p.rg_b[l * 4 + g];
    int grp = 0;
    float mx = lg[0];
#pragma unroll
    for (int g = 1; g < 4; ++g)
      if (lg[g] > mx) { mx = lg[g]; grp = g; }
    float den = 0.f;
#pragma unroll
    for (int g = 0; g < 4; ++g) den += __expf(lg[g] - mx);
    const float pg_top = 1.f / den;
    float el[8];
#pragma unroll
    for (int j = 0; j < 8; ++j) {
      const float a0 = acc[4 + j], a1 = acc[12 + j], a2 = acc[20 + j], a3 = acc[28 + j];
      const float sel = (grp == 0) ? a0 : (grp == 1) ? a1 : (grp == 2) ? a2 : a3;
      el[j] = sel + p.re_b[l * 32 + grp * 8 + j];
    }
    float b0 = -3.0e38f, b1 = -3.0e38f;
    int i0 = 0, i1 = 0;
#pragma unroll
    for (int j = 0; j < 8; ++j)
      if (el[j] > b0) { b0 = el[j]; i0 = j; }
#pragma unroll
    for (int j = 0; j < 8; ++j)
      if (j != i0 && el[j] > b1) { b1 = el[j]; i1 = j; }
    const float ex = __expf(b1 - b0);
    const float g0 = pg_top / (1.f + ex), g1 = pg_top * ex / (1.f + ex);
    if (lane == 0) {
      const int e0 = grp * 8 + i0, e1 = grp * 8 + i1;
      const int pos0 = atomicAdd(&p.cnt[l * NEXP + e0], 1);
      p.list[e0 * CAP + pos0] = 2 * t;
      p.sgate[2 * t] = g0;
      const int pos1 = atomicAdd(&p.cnt[l * NEXP + e1], 1);
      p.list[e1 * CAP + pos1] = 2 * t + 1;
      p.sgate[2 * t + 1] = g1;
    }
  }
}

DEV bool moe_tile(const int* cnt, int tile, int& e, int& rt, int& ct, int& valid) {
  for (e = 0; e < NEXP; ++e) {
    const int c = cnt[e];
    const int ntl = ((c + 127) >> 7) * 8;
    if (tile < ntl) {
      rt = tile >> 3;
      ct = tile & 7;
      valid = min(128, c - rt * 128);
      return true;
    }
    tile -= ntl;
  }
  return false;
}

DEV void phase_moe1(const Params& p, int l, int bid, int nb, char* smem) {
  const int tid = threadIdx.x, lane = tid & 63, wid = tid >> 6, wr = wid >> 1, wc = wid & 1, fr = lane & 15,
            fq = lane >> 4;
  const int* cnt = p.cnt + l * NEXP;
  for (int tile = bid;; tile += nb) {
    int e, rt, ct, valid;
    if (!moe_tile(cnt, tile, e, rt, ct, valid)) break;
    const int* lst = p.list + e * CAP + rt * 128;
    const float* W1 = p.ew1 + (size_t)(l * NEXP + e) * DM * DEXP;
    const float* W3 = p.ew3 + (size_t)(l * NEXP + e) * DM * DEXP;
    f32x4 acc[4][4];
    gemm_tile_128(
        DM,
        [&](int m) {
          const int slot = lst[(m < valid) ? m : 0];
          return p.act + (size_t)(slot >> 1) * DM;
        },
        [&](int k, int n) {
          const int r = n & 63;
          const int col = ct * 64 + (n >> 6) * 32 + (r & 31);
          const float* W = (r >> 5) ? W3 : W1;
          return W[(size_t)k * DEXP + col];
        },
        acc, smem);
#pragma unroll
    for (int mi = 0; mi < 4; ++mi)
#pragma unroll
      for (int j = 0; j < 4; ++j) {
        const int ml = wr * 64 + mi * 16 + fq * 4 + j;
        if (ml < valid) {
          const int slot = lst[ml];
#pragma unroll
          for (int ni = 0; ni < 2; ++ni) {
            const float a = acc[mi][ni][j], g = acc[mi][ni + 2][j];
            p.hbuf[(size_t)slot * DEXP + ct * 64 + wc * 32 + ni * 16 + fr] = f2bf(silu_f(a) * g);
          }
        }
      }
  }
}

DEV void phase_moe2(const Params& p, int l, int bid, int nb, char* smem) {
  const int tid = threadIdx.x, lane = tid & 63, wid = tid >> 6, wr = wid >> 1, wc = wid & 1, fr = lane & 15,
            fq = lane >> 4;
  const int* cnt = p.cnt + l * NEXP;
  for (int tile = bid;; tile += nb) {
    int e, rt, ct, valid;
    if (!moe_tile(cnt, tile, e, rt, ct, valid)) break;
    const int* lst = p.list + e * CAP + rt * 128;
    const float* W2 = p.ew2 + (size_t)(l * NEXP + e) * DEXP * DM;
    f32x4 acc[4][4];
    gemm_tile_128(
        DEXP,
        [&](int m) {
          const int slot = lst[(m < valid) ? m : 0];
          return p.hbuf + (size_t)slot * DEXP;
        },
        [&](int k, int n) { return W2[(size_t)k * DM + ct * 128 + n]; }, acc, smem);
#pragma unroll
    for (int mi = 0; mi < 4; ++mi)
#pragma unroll
      for (int j = 0; j < 4; ++j) {
        const int ml = wr * 64 + mi * 16 + fq * 4 + j;
        if (ml < valid) {
          const int slot = lst[ml];
          const float g = p.sgate[slot];
#pragma unroll
          for (int ni = 0; ni < 4; ++ni)
            p.ybuf[(size_t)slot * DM + ct * 128 + wc * 64 + ni * 16 + fr] = f2bf(g * acc[mi][ni][j]);
        }
      }
  }
}

DEV void phase_combine(const Params& p, int l, int bid, int nb) {
  const int lane = threadIdx.x & 63, wid = threadIdx.x >> 6;
  for (int t = bid * 4 + wid; t < NTOK; t += nb * 4) {
    float4* xr = (float4*)(p.xbuf + (size_t)t * DM);
    const int b = t / T;
    const float* md = p.mod + (l * 2 + b) * 6144;
    float4 v[4];
    float ss = 0.f;
#pragma unroll
    for (int i = 0; i < 4; ++i) {
      const int idx = (lane + 64 * i) * 4;
      v[i] = xr[lane + 64 * i];
      const float4 g = *(const float4*)(md + MOD_GATE2 + idx);
      const uint2 ya = *(const uint2*)(p.ybuf + (size_t)(2 * t) * DM + idx);
      const uint2 yb = *(const uint2*)(p.ybuf + (size_t)(2 * t + 1) * DM + idx);
      v[i].x += g.x * (__uint_as_float(ya.x << 16) + __uint_as_float(yb.x << 16));
      v[i].y += g.y * (__uint_as_float(ya.x & 0xffff0000u) + __uint_as_float(yb.x & 0xffff0000u));
      v[i].z += g.z * (__uint_as_float(ya.y << 16) + __uint_as_float(yb.y << 16));
      v[i].w += g.w * (__uint_as_float(ya.y & 0xffff0000u) + __uint_as_float(yb.y & 0xffff0000u));
      ss += v[i].x * v[i].x + v[i].y * v[i].y + v[i].z * v[i].z + v[i].w * v[i].w;
    }
    ss = wave_sum(ss);
    const float rstd = rsqrtf(ss * (1.f / DM) + EPS);
    if (l + 1 < DEPTH) {
#pragma unroll
      for (int i = 0; i < 4; ++i) xr[lane + 64 * i] = v[i];
      const float* md2 = p.mod + ((l + 1) * 2 + b) * 6144;
      norm_mod_store(v, rstd, p.norm_mix_w + (l + 1) * DM, md2 + MOD_SCALE1, md2 + MOD_SHIFT1,
                     p.act + (size_t)t * DM, lane);
    } else {
      float4* orow = (float4*)(p.out + (size_t)t * DM);
#pragma unroll
      for (int i = 0; i < 4; ++i) {
        const float4 w = *(const float4*)(p.final_w + (lane + 64 * i) * 4);
        float4 r;
        r.x = v[i].x * rstd * w.x;
        r.y = v[i].y * rstd * w.y;
        r.z = v[i].z * rstd * w.z;
        r.w = v[i].w * rstd * w.w;
        orow[lane + 64 * i] = r;
      }
    }
  }
}

__global__ void __launch_bounds__(256) mega_kernel(Params p) {
  __shared__ __attribute__((aligned(16))) char smem[SMEM_BYTES];
  cg::grid_group grid = cg::this_grid();
  const int bid = blockIdx.x, nb = gridDim.x;
  phase_ada(p, bid, nb, smem);
  grid.sync();
  phase_hmix(p, 0, p.x, bid, nb);
  grid.sync();
#pragma unroll 1
  for (int l = 0; l < DEPTH; ++l) {
    phase_gemm_proj(p, l, bid, nb, smem);
    grid.sync();
    phase_gdn_prep_naive(p, l, bid, nb);
    grid.sync();
    if (bid < 8) {
      phase_gdn_seq_naive(p, bid, 8, smem);
    } else {
      phase_conv(p, l, bid - 8, nb - 8);
      phase_na_naive(p, l, bid - 8, nb - 8);
    }
    grid.sync();
    phase_gdn_fin(p, l, bid, nb);
    grid.sync();
    phase_gemm_wout(p, l, l == 0 ? p.x : p.xbuf, bid, nb, smem);
    grid.sync();
    phase_router(p, l, bid, nb);
    grid.sync();
    phase_moe1(p, l, bid, nb, smem);
    grid.sync();
    phase_moe2(p, l, bid, nb, smem);
    grid.sync();
    phase_combine(p, l, bid, nb);
    if (l + 1 < DEPTH) grid.sync();
  }
}

extern "C" void kernel_launch(void* const* d_in, const int* in_sizes, int n_in, void* d_out, int out_size,
                              void* d_ws, size_t ws_size, hipStream_t stream) {
  Params p{};
  p.x = (const float*)d_in[0];
  p.c = (const float*)d_in[1];
  p.norm_mix_w = (const float*)d_in[2];
  p.norm_ffn_w = (const float*)d_in[3];
  p.w_ada = (const float*)d_in[4];
  p.b_ada = (const float*)d_in[5];
  p.w_in = (const float*)d_in[6];
  p.conv_a_w = (const float*)d_in[7];
  p.na_rpb = (const float*)d_in[8];
  p.gdn_conv_w = (const float*)d_in[9];
  p.gdn_a_log = (const float*)d_in[10];
  p.gdn_dt_bias = (const float*)d_in[11];
  p.gdn_norm_w = (const float*)d_in[12];
  p.w_out = (const float*)d_in[13];
  p.rg_w = (const float*)d_in[14];
  p.rg_b = (const float*)d_in[15];
  p.re_w = (const float*)d_in[16];
  p.re_b = (const float*)d_in[17];
  p.ew1 = (const float*)d_in[18];
  p.ew3 = (const float*)d_in[19];
  p.ew2 = (const float*)d_in[20];
  p.final_w = (const float*)d_in[21];
  p.out = (float*)d_out;
  char* ws = (char*)d_ws;
  size_t off = 0;
  auto take = [&](size_t bytes) {
    char* r = ws + off;
    off += (bytes + 255) & ~(size_t)255;
    return r;
  };
  p.mod = (float*)take(sizeof(float) * DEPTH * NB * 6144);
  p.cnt = (int*)take(sizeof(int) * DEPTH * NEXP);
  p.xbuf = (float*)take(sizeof(float) * (size_t)NTOK * DM);
  p.act = (bf16_t*)take(2 * (size_t)NTOK * DM);
  p.proj = (bf16_t*)take(2 * (size_t)NTOK * PROJW);
  p.gates = (float*)take(sizeof(float) * (size_t)NTOK * 16);
  p.gb = (float*)take(sizeof(float) * (size_t)NTOK * 16);
  p.y = (bf16_t*)take(2 * (size_t)NTOK * DM);
  p.list = (int*)take(sizeof(int) * NEXP * CAP);
  p.sgate = (float*)take(sizeof(float) * 2 * NTOK);
  p.obuf = (float*)take(sizeof(float) * 2 * (size_t)NTOK * 512);
  p.qkvn = (float*)take(sizeof(float) * (size_t)NTOK * 1536);
  p.hbuf = (bf16_t*)p.obuf;
  p.ybuf = (bf16_t*)p.qkvn;
  if (off > ws_size) fprintf(stderr, "workspace too small: need %zu have %zu\n", off, ws_size);

  static int grid_blocks = 0;
  if (!grid_blocks) {
    int dev = 0, cus = 0, per_cu = 0;
    (void)hipGetDevice(&dev);
    (void)hipDeviceGetAttribute(&cus, hipDeviceAttributeMultiprocessorCount, dev);
    (void)hipOccupancyMaxActiveBlocksPerMultiprocessor(&per_cu, mega_kernel, 256, 0);
    if (per_cu > 2) per_cu = 2;
    if (per_cu < 1) per_cu = 1;
    grid_blocks = cus * per_cu;
  }
  void* args[] = {&p};
  hipError_t e = hipLaunchCooperativeKernel((void*)mega_kernel, dim3(grid_blocks), dim3(256), args, 0, stream);
  if (e != hipSuccess) fprintf(stderr, "cooperative launch failed: %s (grid %d)\n", hipGetErrorString(e), grid_blocks);
}
```

```cpp
#include <hip/hip_runtime.h>
#include <hip/hip_cooperative_groups.h>
#include <stdint.h>
#include <stdio.h>

#define DEV __device__ __forceinline__
namespace cg = cooperative_groups;

typedef __attribute__((ext_vector_type(8))) short bf16x8;
typedef __attribute__((ext_vector_type(4))) float f32x4;
typedef __attribute__((ext_vector_type(16))) float f32x16;
typedef float f32x2_t __attribute__((ext_vector_type(2)));
typedef __bf16 bf16x2_t __attribute__((ext_vector_type(2)));
typedef unsigned short bf16_t;

constexpr int NTHR = 512;
constexpr int NWAVE = 8;
constexpr int DM = 1024;
constexpr int NB = 2;
constexpr int T = 8192;
constexpr int NTOK = NB * T;
constexpr int DEPTH = 2;
constexpr int DIN = 3600;
constexpr int PROJW = 3584;
constexpr int NEXP = 32;
constexpr int DEXP = 512;
constexpr int CAP = 16384;
constexpr float EPS = 1e-6f;
constexpr int OFF_CB = 0, OFF_CC = 256, OFF_CX = 512, OFF_NQ = 768, OFF_NK = 1024, OFF_NV = 1280,
              OFF_GQKV = 1536, OFF_GZ = 3072;
constexpr int MOD_SHIFT1 = 0, MOD_SCALE1 = 1024, MOD_GATE1 = 2048, MOD_SHIFT2 = 3072, MOD_SCALE2 = 4096,
              MOD_GATE2 = 5120;

constexpr int REC_WN = 0, REC_QD = 16384, REC_IN = 32768, REC_KT = 40960, REC_BYTES = 57344;
constexpr int SC_WN = 0, SC_QD = 16896, SC_IN = 33792, SC_KT = 42496, SC_BUF = 59904;
constexpr int PL_Q = 0, PL_K = 17408, PL_V = 34816, PL_L = 52224, PL_GC = 87040, PL_BETA = 87552, PL_BG = 88064,
              PL_GL = 88576;
constexpr int SMEM_BYTES = 2 * SC_BUF;

struct Params {
  const float *x, *c, *norm_mix_w, *norm_ffn_w, *w_ada, *b_ada, *w_in, *conv_a_w, *na_rpb, *gdn_conv_w,
      *gdn_a_log, *gdn_dt_bias, *gdn_norm_w, *w_out, *rg_w, *rg_b, *re_w, *re_b, *ew1, *ew3, *ew2, *final_w;
  float* out;
  float* mod;
  int* cnt;
  float* xbuf;
  bf16_t* act;
  bf16_t* proj;
  float* gates;
  bf16_t* y;
  float* obuf;
  char* gdn_rec;
  unsigned* gdn_u;
  float* egl;
  bf16_t* hbuf;
  bf16_t* ybuf;
  int* list;
  float* sgate;
};

DEV unsigned pack2(float a, float b) {
  f32x2_t v = {a, b};
  return __builtin_bit_cast(unsigned, __builtin_convertvector(v, bf16x2_t));
}
DEV bf16_t f2bf(float f) { return (bf16_t)(pack2(f, 0.f) & 0xffffu); }
DEV float bf2f(bf16_t h) { return __uint_as_float(((unsigned)h) << 16); }
DEV float silu_f(float x) { return x / (1.f + __expf(-x)); }
DEV float sigmoid_f(float x) { return 1.f / (1.f + __expf(-x)); }
DEV float softplus_f(float x) { return fmaxf(x, 0.f) + log1pf(__expf(-fabsf(x))); }
DEV float wave_sum(float v) {
#pragma unroll
  for (int o = 32; o > 0; o >>= 1) v += __shfl_xor(v, o, 64);
  return v;
}
DEV int fresh_tid() {
  int t = threadIdx.x;
  asm volatile("" : "+v"(t));
  return t;
}
DEV void unpack8(uint4 u, float* f) {
  f[0] = __uint_as_float(u.x << 16);
  f[1] = __uint_as_float(u.x & 0xffff0000u);
  f[2] = __uint_as_float(u.y << 16);
  f[3] = __uint_as_float(u.y & 0xffff0000u);
  f[4] = __uint_as_float(u.z << 16);
  f[5] = __uint_as_float(u.z & 0xffff0000u);
  f[6] = __uint_as_float(u.w << 16);
  f[7] = __uint_as_float(u.w & 0xffff0000u);
}
DEV uint4 pack8(const float* f) {
  uint4 r;
  r.x = pack2(f[0], f[1]);
  r.y = pack2(f[2], f[3]);
  r.z = pack2(f[4], f[5]);
  r.w = pack2(f[6], f[7]);
  return r;
}
#define MFMA16(a, b, c) __builtin_amdgcn_mfma_f32_16x16x32_bf16((a), (b), (c), 0, 0, 0)
#define MFMA32(a, b, c) __builtin_amdgcn_mfma_f32_32x32x16_bf16((a), (b), (c), 0, 0, 0)

constexpr int GBK = 32;
constexpr int LDSROW = GBK + 8;

template <class AF, class BF>
DEV void gemm_tile(int K, AF arow, BF bload, f32x4 (&acc)[4][4], char* smem) {
  bf16_t* sA = (bf16_t*)smem;
  bf16_t* sB = sA + 2 * 256 * LDSROW;
  const int tid = fresh_tid(), lane = tid & 63, wid = tid >> 6, wr = wid >> 1, wc = wid & 1, fr = lane & 15,
            fq = lane >> 4;
  const int ar0 = tid >> 2, ach = tid & 3;
  const bf16_t* ap0 = arow(ar0) + ach * 8;
  const bf16_t* ap1 = arow(ar0 + 128) + ach * 8;
  const int bn = tid & 127, bkg = tid >> 7;
  uint4 ra0, ra1;
  float rb[8];
#pragma unroll
  for (int mi = 0; mi < 4; ++mi)
#pragma unroll
    for (int ni = 0; ni < 4; ++ni) acc[mi][ni] = f32x4{0.f, 0.f, 0.f, 0.f};

  auto gload = [&](int k0) {
    ra0 = *(const uint4*)(ap0 + k0);
    ra1 = *(const uint4*)(ap1 + k0);
#pragma unroll
    for (int j = 0; j < 8; ++j) rb[j] = bload(k0 + bkg * 8 + j, bn);
  };
  auto sstore = [&](int buf) {
    bf16_t* a = sA + buf * 256 * LDSROW;
    bf16_t* b = sB + buf * 128 * LDSROW;
    *(uint4*)(a + ar0 * LDSROW + ach * 8) = ra0;
    *(uint4*)(a + (ar0 + 128) * LDSROW + ach * 8) = ra1;
    *(uint4*)(b + bn * LDSROW + bkg * 8) = pack8(rb);
  };
  const int nt = K / GBK;
  gload(0);
  sstore(0);
  __syncthreads();
  for (int t = 0; t < nt; ++t) {
    const int buf = t & 1;
    if (t + 1 < nt) gload((t + 1) * GBK);
    const bf16_t* a = sA + buf * 256 * LDSROW;
    const bf16_t* b = sB + buf * 128 * LDSROW;
    bf16x8 af[4], bfr[4];
#pragma unroll
    for (int mi = 0; mi < 4; ++mi) af[mi] = *(const bf16x8*)(a + (wr * 64 + mi * 16 + fr) * LDSROW + fq * 8);
#pragma unroll
    for (int ni = 0; ni < 4; ++ni) bfr[ni] = *(const bf16x8*)(b + (wc * 64 + ni * 16 + fr) * LDSROW + fq * 8);
#pragma unroll
    for (int mi = 0; mi < 4; ++mi)
#pragma unroll
      for (int ni = 0; ni < 4; ++ni) acc[mi][ni] = MFMA16(af[mi], bfr[ni], acc[mi][ni]);
    if (t + 1 < nt) sstore(buf ^ 1);
    __syncthreads();
  }
}

DEV void phase_ada(const Params& p, int bid, int nb, char* smem) {
  float* cond = (float*)smem;
  float* red = cond + 2 * DM;
  const int tid = fresh_tid(), lane = tid & 63, wid = tid >> 6;
  for (int i = tid; i < 2 * DM; i += NTHR) cond[i] = silu_f(p.c[i]);
  __syncthreads();
  for (int item = bid; item < DEPTH * 96; item += nb) {
    const int l = item / 96, j = (item - l * 96) * 64 + lane;
    const float* w = p.w_ada + ((size_t)l * DM + wid * 128) * 6144 + j;
    float a0 = 0.f, a1 = 0.f;
#pragma unroll 16
    for (int k = 0; k < 128; ++k) {
      const float wv = w[(size_t)k * 6144];
      a0 += cond[wid * 128 + k] * wv;
      a1 += cond[DM + wid * 128 + k] * wv;
    }
    red[(wid * 2 + 0) * 64 + lane] = a0;
    red[(wid * 2 + 1) * 64 + lane] = a1;
    __syncthreads();
    if (wid < 2) {
      float s = p.b_ada[l * 6144 + j];
#pragma unroll
      for (int w8 = 0; w8 < 8; ++w8) s += red[(w8 * 2 + wid) * 64 + lane];
      p.mod[(l * 2 + wid) * 6144 + j] = s;
    }
    __syncthreads();
  }
  if (bid == 0 && tid < DEPTH * NEXP) p.cnt[tid] = 0;
}

DEV void norm_mod_store(const float4 (&v)[4], float rstd, const float* nw, const float* sc, const float* sh,
                        bf16_t* dst, int lane) {
#pragma unroll
  for (int i = 0; i < 4; ++i) {
    const int idx = (lane + 64 * i) * 4;
    const float4 w = *(const float4*)(nw + idx);
    const float4 s = *(const float4*)(sc + idx);
    const float4 h = *(const float4*)(sh + idx);
    const float r0 = v[i].x * rstd * w.x * (1.f + s.x) + h.x;
    const float r1 = v[i].y * rstd * w.y * (1.f + s.y) + h.y;
    const float r2 = v[i].z * rstd * w.z * (1.f + s.z) + h.z;
    const float r3 = v[i].w * rstd * w.w * (1.f + s.w) + h.w;
    uint2 pk;
    pk.x = pack2(r0, r1);
    pk.y = pack2(r2, r3);
    *(uint2*)(dst + idx) = pk;
  }
}

DEV void phase_hmix(const Params& p, int l, const float* xin, int bid, int nb) {
  const int tid_ = fresh_tid(), lane = tid_ & 63, wid = tid_ >> 6;
  for (int t = bid * NWAVE + wid; t < NTOK; t += nb * NWAVE) {
    const float4* xr = (const float4*)(xin + (size_t)t * DM);
    float4 v[4];
    float ss = 0.f;
#pragma unroll
    for (int i = 0; i < 4; ++i) {
      v[i] = xr[lane + 64 * i];
      ss += v[i].x * v[i].x + v[i].y * v[i].y + v[i].z * v[i].z + v[i].w * v[i].w;
    }
    ss = wave_sum(ss);
    const float rstd = rsqrtf(ss * (1.f / DM) + EPS);
    const int b = t / T;
    const float* md = p.mod + (l * 2 + b) * 6144;
    norm_mod_store(v, rstd, p.norm_mix_w + l * DM, md + MOD_SCALE1, md + MOD_SHIFT1, p.act + (size_t)t * DM, lane);
  }
}

DEV void phase_gemm_proj(const Params& p, int l, int bid, int nb, char* smem) {
  const int NCT = 29;
  const int tid = fresh_tid(), lane = tid & 63, wid = tid >> 6, wr = wid >> 1, wc = wid & 1, fr = lane & 15,
            fq = lane >> 4;
  const float* W = p.w_in + (size_t)l * DM * DIN;
  for (int tile = bid; tile < 64 * NCT; tile += nb) {
    const int rt = tile / NCT, ct = tile - rt * NCT;
    const int m0 = rt * 256, n0 = ct * 128;
    f32x4 acc[4][4];
    gemm_tile(
        DM, [&](int m) { return p.act + (size_t)(m0 + m) * DM; },
        [&](int k, int n) { return (n0 + n < DIN) ? W[(size_t)k * DIN + n0 + n] : 0.f; }, acc, smem);
#pragma unroll
    for (int mi = 0; mi < 4; ++mi)
#pragma unroll
      for (int ni = 0; ni < 4; ++ni)
#pragma unroll
        for (int j = 0; j < 4; ++j) {
          const int m = m0 + wr * 64 + mi * 16 + fq * 4 + j;
          const int n = n0 + wc * 64 + ni * 16 + fr;
          const float v = acc[mi][ni][j];
          if (n < PROJW)
            p.proj[(size_t)m * PROJW + n] = f2bf(v);
          else if (n < DIN)
            p.gates[(size_t)m * 16 + (n - PROJW)] = v;
        }
  }
}

DEV void phase_conv(const Params& p, int l, int bid, int nb) {
  const float* w = p.conv_a_w + l * 768;
  for (int g = bid * NTHR + fresh_tid(); g < NTOK * 256; g += nb * NTHR) {
    const int t = g >> 8, c = g & 255;
    const int tl = t & (T - 1);
    const bf16_t* r = p.proj + (size_t)t * PROJW;
    const float cb = bf2f(r[OFF_CB + c]);
    const float mid = bf2f(r[OFF_CC + c]) * bf2f(r[OFF_CX + c]);
    float prev = 0.f, next = 0.f;
    if (tl > 0) prev = bf2f(r[OFF_CC + c - PROJW]) * bf2f(r[OFF_CX + c - PROJW]);
    if (tl < T - 1) next = bf2f(r[OFF_CC + c + PROJW]) * bf2f(r[OFF_CX + c + PROJW]);
    const float s = w[c] * prev + w[256 + c] * mid + w[512 + c] * next;
    p.y[(size_t)t * DM + c] = f2bf(cb * s);
  }
}

DEV void phase_na(const Params& p, int l, int wgid, int nwg) {
  const int tid_ = fresh_tid(), lane = tid_ & 63, fr = lane & 15, fq = lane >> 4;
  for (int item = wgid; item < NB * 128 * 4 * 4; item += nwg) {
    const int qg = item & 3, h = (item >> 2) & 3, r = (item >> 4) & 127, b = item >> 11;
    const int rs = min(max(r - 4, 0), 120);
    const int kc0 = (qg == 0) ? 0 : (qg == 1) ? 8 : (qg == 2) ? 24 : 32;
    const int c = qg * 16 + fr;
    const int cs = min(max(c - 8, 0), 48);
    const size_t tq = (size_t)b * T + r * 64 + c;
    bf16x8 bq[2];
#pragma unroll
    for (int ks = 0; ks < 2; ++ks)
      bq[ks] = *(const bf16x8*)(p.proj + tq * PROJW + OFF_NQ + h * 64 + ks * 32 + fq * 8);
    f32x4 sc[16];
#pragma unroll
    for (int tt = 0; tt < 16; ++tt) {
      const int i = tt >> 1, half = tt & 1;
      const size_t kt = (size_t)b * T + (rs + i) * 64 + kc0 + half * 16 + fr;
      const bf16_t* kp = p.proj + kt * PROJW + OFF_NK + h * 64 + fq * 8;
      const bf16x8 a0 = *(const bf16x8*)(kp);
      const bf16x8 a1 = *(const bf16x8*)(kp + 32);
      f32x4 z = {0.f, 0.f, 0.f, 0.f};
      z = MFMA16(a0, bq[0], z);
      sc[tt] = MFMA16(a1, bq[1], z);
    }
    const float* rpb = p.na_rpb + (size_t)(l * 4 + h) * 465;
    float mx = -3.0e38f;
#pragma unroll
    for (int tt = 0; tt < 16; ++tt) {
      const int i = tt >> 1, half = tt & 1;
      const int dr = rs + i - r + 7;
#pragma unroll
      for (int j = 0; j < 4; ++j) {
        const int kcol = kc0 + half * 16 + fq * 4 + j;
        const bool valid = (kcol >= cs) && (kcol < cs + 16);
        const int dc = valid ? (kcol - c + 15) : 0;
        const float s = valid ? (sc[tt][j] * 0.125f + rpb[dr * 31 + dc]) : -3.0e38f;
        sc[tt][j] = s;
        mx = fmaxf(mx, s);
      }
    }
    mx = fmaxf(mx, __shfl_xor(mx, 16, 64));
    mx = fmaxf(mx, __shfl_xor(mx, 32, 64));
    float sum = 0.f;
#pragma unroll
    for (int tt = 0; tt < 16; ++tt)
#pragma unroll
      for (int j = 0; j < 4; ++j) {
        const float s = sc[tt][j];
        const float e = (s > -1.0e38f) ? __expf(s - mx) : 0.f;
        sc[tt][j] = e;
        sum += e;
      }
    sum += __shfl_xor(sum, 16, 64);
    sum += __shfl_xor(sum, 32, 64);
    const float inv = 1.f / sum;
    f32x4 oacc[4];
#pragma unroll
    for (int nt = 0; nt < 4; ++nt) oacc[nt] = f32x4{0.f, 0.f, 0.f, 0.f};
#pragma unroll
    for (int i = 0; i < 8; ++i) {
      uint4 pu;
      pu.x = pack2(sc[2 * i][0] * inv, sc[2 * i][1] * inv);
      pu.y = pack2(sc[2 * i][2] * inv, sc[2 * i][3] * inv);
      pu.z = pack2(sc[2 * i + 1][0] * inv, sc[2 * i + 1][1] * inv);
      pu.w = pack2(sc[2 * i + 1][2] * inv, sc[2 * i + 1][3] * inv);
      const bf16x8 pa = __builtin_bit_cast(bf16x8, pu);
      const bf16_t* vb = p.proj + ((size_t)b * T + (rs + i) * 64 + kc0 + fq * 4) * PROJW + OFF_NV + h * 64 + fr;
#pragma unroll
      for (int nt = 0; nt < 4; ++nt) {
        bf16x8 bv;
#pragma unroll
        for (int j = 0; j < 4; ++j) {
          bv[j] = (short)vb[(size_t)j * PROJW + nt * 16];
          bv[4 + j] = (short)vb[(size_t)(16 + j) * PROJW + nt * 16];
        }
        oacc[nt] = MFMA16(pa, bv, oacc[nt]);
      }
    }
#pragma unroll
    for (int nt = 0; nt < 4; ++nt)
#pragma unroll
      for (int j = 0; j < 4; ++j)
        p.y[((size_t)b * T + r * 64 + qg * 16 + fq * 4 + j) * DM + 256 + h * 64 + nt * 16 + fr] = f2bf(oacc[nt][j]);
  }
}

template <int POS>
struct SolveStep {
  static DEV void run(float (&x)[64], const float* Ld, const float* sclv, const bf16_t* src, int dir, bool isu,
                      unsigned* up, bf16_t* wp) {
    SolveStep<POS - 1>::run(x, Ld, sclv, src, dir, isu, up, wp);
    const int i = dir ? 63 - POS : POS;
    float a = sclv[POS] * bf2f(src[i * 136]);
#pragma unroll
    for (int j4 = 0; j4 < (POS + 3) / 4; ++j4) {
      const float4 lv = *(const float4*)(Ld + POS * 68 + j4 * 4);
      a -= lv.x * x[j4 * 4];
      if (j4 * 4 + 1 < POS) a -= lv.y * x[j4 * 4 + 1];
      if (j4 * 4 + 2 < POS) a -= lv.z * x[j4 * 4 + 2];
      if (j4 * 4 + 3 < POS) a -= lv.w * x[j4 * 4 + 3];
    }
    x[POS] = a;
    if (isu) {
      if (POS & 1) up[(POS >> 1) * 128] = pack2(x[POS - 1], a);
    } else {
      wp[POS * 128] = f2bf(-a);
    }
    asm volatile("" ::: "memory");
  }
};
template <>
struct SolveStep<-1> {
  static DEV void run(float (&)[64], const float*, const float*, const bf16_t*, int, bool, unsigned*, bf16_t*) {}
};

DEV void phase_gdn_prep(const Params& p, int l, int bid, int nb, char* smem) {
  const int tid = fresh_tid(), lane = tid & 63;
  bf16_t* q_bf = (bf16_t*)(smem + PL_Q);
  bf16_t* k_bf = (bf16_t*)(smem + PL_K);
  bf16_t* v_bf = (bf16_t*)(smem + PL_V);
  float* Lm = (float*)(smem + PL_L);
  float* gcl = (float*)(smem + PL_GC);
  float* bl = (float*)(smem + PL_BETA);
  float* bgl = (float*)(smem + PL_BG);
  float* gll = (float*)(smem + PL_GL);
  const float* cw = p.gdn_conv_w + l * 4608;
  for (int item = bid; item < 1024; item += nb) {
    const int b = item >> 9, h = (item >> 7) & 3, n = item & 127;
    const int t0 = b * T + n * 64;
    char* rec0 = p.gdn_rec + (size_t)item * 2 * REC_BYTES;
    if (tid < 128) {
      const int dir = tid >> 6;
      const int i = dir ? 63 - lane : lane;
      const size_t t = (size_t)t0 + i;
      const float a = p.gates[t * 16 + dir * 4 + h], bb = p.gates[t * 16 + 8 + dir * 4 + h];
      const float g = -__expf(p.gdn_a_log[l * 8 + dir * 4 + h]) * softplus_f(a + p.gdn_dt_bias[l * 8 + dir * 4 + h]);
      const float beta = sigmoid_f(bb);
      float cs = g;
#pragma unroll
      for (int o = 1; o < 64; o <<= 1) {
        const float v = __shfl_up(cs, o, 64);
        if (lane >= o) cs += v;
      }
      gcl[dir * 64 + lane] = cs;
      bl[dir * 64 + lane] = beta;
      bgl[dir * 64 + lane] = beta * __expf(cs);
      const float last = __shfl(cs, 63, 64);
      if (lane == 0) {
        gll[dir] = last;
        p.egl[item * 2 + dir] = __expf(last);
      }
    }
    __syncthreads();
    {
      int tA = tid;
      asm volatile("" : "+v"(tA));
      const int i = tA >> 3, oc = tA & 7, d0 = oc * 16;
      const int tl = n * 64 + i;
      const bf16_t* rowp = p.proj + (size_t)(t0 + i) * PROJW + OFF_GQKV + h * 128 + d0;
#pragma unroll
      for (int m = 0; m < 3; ++m) {
        const bf16_t* rp = rowp + m * 512;
        float x0[16], x1[16], x2[16], val[16];
        unpack8(*(const uint4*)(rp), x1);
        unpack8(*(const uint4*)(rp + 8), x1 + 8);
        if (tl > 0) {
          unpack8(*(const uint4*)(rp - PROJW), x0);
          unpack8(*(const uint4*)(rp - PROJW + 8), x0 + 8);
        } else {
#pragma unroll
          for (int e = 0; e < 16; ++e) x0[e] = 0.f;
        }
        if (tl < T - 1) {
          unpack8(*(const uint4*)(rp + PROJW), x2);
          unpack8(*(const uint4*)(rp + PROJW + 8), x2 + 8);
        } else {
#pragma unroll
          for (int e = 0; e < 16; ++e) x2[e] = 0.f;
        }
        const float* cwm = cw + m * 512 + h * 128 + d0;
        float ss = 0.f;
#pragma unroll
        for (int e = 0; e < 16; ++e) {
          val[e] = silu_f(cwm[e] * x0[e] + cwm[1536 + e] * x1[e] + cwm[3072 + e] * x2[e]);
          ss += val[e] * val[e];
        }
        if (m < 2) {
          ss += __shfl_xor(ss, 1, 64);
          ss += __shfl_xor(ss, 2, 64);
          ss += __shfl_xor(ss, 4, 64);
          float sc = rsqrtf(ss + EPS);
          if (m == 0) sc *= 0.08838834764831845f;
#pragma unroll
          for (int e = 0; e < 16; ++e) val[e] *= sc;
        }
        bf16_t* dst = (m == 0 ? q_bf : (m == 1 ? k_bf : v_bf)) + i * 136 + d0;
        *(uint4*)(dst) = pack8(val);
        *(uint4*)(dst + 8) = pack8(val + 8);
        if (m == 0) {
#pragma unroll
          for (int dir = 0; dir < 2; ++dir) {
            const int pos = dir ? 63 - i : i;
            const float f = __expf(gcl[dir * 64 + pos]);
            float tmp[16];
#pragma unroll
            for (int e = 0; e < 16; ++e) tmp[e] = val[e] * f;
            bf16_t* qd = (bf16_t*)(rec0 + dir * REC_BYTES + REC_QD) + pos * 128 + d0;
            *(uint4*)(qd) = pack8(tmp);
            *(uint4*)(qd + 8) = pack8(tmp + 8);
          }
        }
        if (m == 1) {
#pragma unroll
          for (int dir = 0; dir < 2; ++dir) {
            const int pos = dir ? 63 - i : i;
            const float f = __expf(gll[dir] - gcl[dir * 64 + pos]);
            bf16_t* kt = (bf16_t*)(rec0 + dir * REC_BYTES + REC_KT) + d0 * 64 + pos;
#pragma unroll
            for (int e = 0; e < 16; ++e) kt[e * 64] = f2bf(val[e] * f);
          }
        }
      }
    }
    __syncthreads();
    {
      int tB = tid;
      asm volatile("" : "+v"(tB));
      const int laneB = tB & 63, widB = tB >> 6, fr = laneB & 15, fq = laneB >> 4;
      const int mat = widB >> 2, rtile = widB & 3;
      const bf16_t* asrc = mat ? q_bf : k_bf;
      bf16x8 af[4];
#pragma unroll
      for (int ks = 0; ks < 4; ++ks) af[ks] = *(const bf16x8*)(asrc + (rtile * 16 + fr) * 136 + ks * 32 + fq * 8);
#pragma unroll
      for (int nt = 0; nt < 4; ++nt) {
        f32x4 acc = {0.f, 0.f, 0.f, 0.f};
#pragma unroll
        for (int ks = 0; ks < 4; ++ks) {
          const bf16x8 bfrag = *(const bf16x8*)(k_bf + (nt * 16 + fr) * 136 + ks * 32 + fq * 8);
          acc = MFMA16(af[ks], bfrag, acc);
        }
#pragma unroll
        for (int j = 0; j < 4; ++j) {
          const int i = rtile * 16 + fq * 4 + j, jj = nt * 16 + fr;
          const float G = acc[j];
#pragma unroll
          for (int dir = 0; dir < 2; ++dir) {
            const int pi = dir ? 63 - i : i, pj = dir ? 63 - jj : jj;
            const float dec = __expf(fminf(gcl[dir * 64 + pi] - gcl[dir * 64 + pj], 0.f));
            if (mat == 0)
              Lm[(dir * 64 + pi) * 68 + pj] = (pi > pj) ? bl[dir * 64 + pi] * G * dec : 0.f;
            else
              *((bf16_t*)(rec0 + dir * REC_BYTES + REC_IN) + pi * 64 + pj) = f2bf((pi >= pj) ? G * dec : 0.f);
          }
        }
      }
    }
    __syncthreads();
    {
      int tC = tid;
      asm volatile("" : "+v"(tC));
      const int dir = tC >> 8, c = tC & 255;
      const float* Ld = Lm + dir * 64 * 68;
      const bool isu = c < 128;
      unsigned* up = p.gdn_u + ((size_t)(item * 2 + dir) * 32) * 128 + (c & 127);
      bf16_t* wp = (bf16_t*)(rec0 + dir * REC_BYTES + REC_WN) + (c & 127);
      const bf16_t* src = (isu ? v_bf : k_bf) + (c & 127);
      const float* sclv = (isu ? bl : bgl) + dir * 64;
      float x[64];
      SolveStep<63>::run(x, Ld, sclv, src, dir, isu, up, wp);
    }
    __syncthreads();
  }
}

DEV int crow(int reg, int hf) { return (reg & 3) + 8 * (reg >> 2) + 4 * hf; }
DEV bf16x8 pack_acc8(const f32x16& x, int s) {
  uint4 v;
  v.x = pack2(x[8 * s + 0], x[8 * s + 1]);
  v.y = pack2(x[8 * s + 2], x[8 * s + 3]);
  v.z = pack2(x[8 * s + 4], x[8 * s + 5]);
  v.w = pack2(x[8 * s + 6], x[8 * s + 7]);
  return __builtin_bit_cast(bf16x8, v);
}
DEV bf16x8 ld_frag(const char* rowp, int kb) {
  const uint2 lo = *(const uint2*)(rowp + kb);
  const uint2 hi = *(const uint2*)(rowp + kb + 16);
  uint4 v;
  v.x = lo.x; v.y = lo.y; v.z = hi.x; v.w = hi.y;
  return __builtin_bit_cast(bf16x8, v);
}

DEV void phase_gdn_scan(const Params& p, int chain, char* smem) {
  const int tid = fresh_tid(), lane = tid & 63, wid = tid >> 6;
  const int dir = chain & 1, bh = chain >> 1;
  const int b = bh >> 2, hh = bh & 3;
  if (wid >= 4) {
    const int lt = tid - 256;
    uint2 rg[28];
    auto gl = [&](int n) {
      const int item = bh * 128 + (dir ? 127 - n : n);
      const uint2* src = (const uint2*)(p.gdn_rec + ((size_t)item * 2 + dir) * REC_BYTES);
#pragma unroll
      for (int k = 0; k < 28; ++k) rg[k] = src[lt + 256 * k];
    };
    auto st = [&](int buf) {
      char* base = smem + buf * SC_BUF;
#pragma unroll
      for (int k = 0; k < 28; ++k) {
        const int u = lt + 256 * k;
        int off;
        if (k < 8) off = SC_WN + (u >> 5) * 264 + (u & 31) * 8;
        else if (k < 16) off = SC_QD + ((u - 2048) >> 5) * 264 + ((u - 2048) & 31) * 8;
        else if (k < 20) off = SC_IN + ((u - 4096) >> 4) * 136 + ((u - 4096) & 15) * 8;
        else off = SC_KT + ((u - 5120) >> 4) * 136 + ((u - 5120) & 15) * 8;
        *(uint2*)(base + off) = rg[k];
      }
    };
    gl(0);
    st(0);
    gl(1);
    __syncthreads();
    for (int n = 0; n < 128; ++n) {
      if (n + 1 < 128) st((n + 1) & 1);
      if (n + 2 < 128) gl(n + 2);
      __syncthreads();
    }
  } else {
    const int w = wid, r = lane & 31, hf = lane >> 5;
    f32x16 S[4];
#pragma unroll
    for (int t4 = 0; t4 < 4; ++t4)
#pragma unroll
      for (int e = 0; e < 16; ++e) S[t4][e] = 0.f;
    unsigned un[2][8];
    auto load_u = [&](int n) {
      const int item = bh * 128 + (dir ? 127 - n : n);
      const unsigned* up = p.gdn_u + ((size_t)(item * 2 + dir) * 32) * 128 + 32 * w + r;
#pragma unroll
      for (int tm = 0; tm < 2; ++tm)
#pragma unroll
        for (int e2 = 0; e2 < 8; ++e2) un[tm][e2] = up[((32 * tm + crow(2 * e2, hf)) >> 1) * 128];
    };
    float dec_next = p.egl[(bh * 128 + (dir ? 127 : 0)) * 2 + dir];
    load_u(0);
    __syncthreads();
    for (int n = 0; n < 128; ++n) {
      const char* buf = smem + (n & 1) * SC_BUF;
      const float decay = dec_next;
      f32x16 vn[2], o[2];
#pragma unroll
      for (int tm = 0; tm < 2; ++tm)
#pragma unroll
        for (int e2 = 0; e2 < 8; ++e2) {
          vn[tm][2 * e2] = __uint_as_float(un[tm][e2] << 16);
          vn[tm][2 * e2 + 1] = __uint_as_float(un[tm][e2] & 0xffff0000u);
        }
#pragma unroll
      for (int e = 0; e < 16; ++e) { o[0][e] = 0.f; o[1][e] = 0.f; }
      if (n + 1 < 128) {
        load_u(n + 1);
        dec_next = p.egl[(bh * 128 + (dir ? 127 - (n + 1) : (n + 1))) * 2 + dir];
      }
#pragma unroll
      for (int t4 = 0; t4 < 4; ++t4) {
        const bf16x8 sb0 = pack_acc8(S[t4], 0);
        const bf16x8 sb1 = pack_acc8(S[t4], 1);
#pragma unroll
        for (int tm = 0; tm < 2; ++tm) {
          const char* rowW = buf + SC_WN + (32 * tm + r) * 264;
          const char* rowQ = buf + SC_QD + (32 * tm + r) * 264;
          const int kb0 = (32 * t4 + 4 * hf) * 2, kb1 = (32 * t4 + 16 + 4 * hf) * 2;
          vn[tm] = MFMA32(ld_frag(rowW, kb0), sb0, vn[tm]);
          o[tm] = MFMA32(ld_frag(rowQ, kb0), sb0, o[tm]);
          vn[tm] = MFMA32(ld_frag(rowW, kb1), sb1, vn[tm]);
          o[tm] = MFMA32(ld_frag(rowQ, kb1), sb1, o[tm]);
        }
      }
      bf16x8 vb[2][2];
#pragma unroll
      for (int tk = 0; tk < 2; ++tk) {
        vb[tk][0] = pack_acc8(vn[tk], 0);
        vb[tk][1] = pack_acc8(vn[tk], 1);
      }
#pragma unroll
      for (int tm = 0; tm < 2; ++tm) {
        const char* rowI = buf + SC_IN + (32 * tm + r) * 136;
#pragma unroll
        for (int tk = 0; tk <= tm; ++tk)
#pragma unroll
          for (int s = 0; s < 2; ++s) {
            const int kb = (32 * tk + 16 * s + 4 * hf) * 2;
            o[tm] = MFMA32(ld_frag(rowI, kb), vb[tk][s], o[tm]);
          }
      }
#pragma unroll
      for (int t4 = 0; t4 < 4; ++t4) {
#pragma unroll
        for (int e = 0; e < 16; ++e) S[t4][e] *= decay;
        const char* rowK = buf + SC_KT + (32 * t4 + r) * 136;
#pragma unroll
        for (int tk = 0; tk < 2; ++tk)
#pragma unroll
          for (int s = 0; s < 2; ++s) {
            const int kb = (32 * tk + 16 * s + 4 * hf) * 2;
            S[t4] = MFMA32(ld_frag(rowK, kb), vb[tk][s], S[t4]);
          }
      }
#pragma unroll
      for (int tm = 0; tm < 2; ++tm)
#pragma unroll
        for (int e = 0; e < 16; ++e) {
          const int pos = 32 * tm + crow(e, hf);
          const int tok = dir ? (b * T + T - 1 - n * 64 - pos) : (b * T + n * 64 + pos);
          p.obuf[((size_t)dir * NTOK + tok) * 512 + hh * 128 + 32 * w + r] = o[tm][e];
        }
      __syncthreads();
    }
  }
}

DEV void phase_gdn_fin(const Params& p, int l, int bid, int nb) {
  const int tid_ = fresh_tid(), lane = tid_ & 63, wid = tid_ >> 6;
  const float* gnw = p.gdn_norm_w + l * 128;
  for (int t = bid * NWAVE + wid; t < NTOK; t += nb * NWAVE) {
    float o[8];
#pragma unroll
    for (int i = 0; i < 8; ++i) {
      const int idx = lane + 64 * i;
      o[i] = p.obuf[(size_t)t * 512 + idx] + p.obuf[((size_t)NTOK + t) * 512 + idx];
    }
#pragma unroll
    for (int hh = 0; hh < 4; ++hh) {
      float ss = o[2 * hh] * o[2 * hh] + o[2 * hh + 1] * o[2 * hh + 1];
      ss = wave_sum(ss);
      const float rr = rsqrtf(ss * (1.f / 128.f) + EPS);
#pragma unroll
      for (int u = 0; u < 2; ++u) {
        const int i = 2 * hh + u, idx = lane + 64 * i, e = idx & 127;
        const float z = bf2f(p.proj[(size_t)t * PROJW + OFF_GZ + idx]);
        p.y[(size_t)t * DM + 512 + idx] = f2bf(o[i] * rr * gnw[e] * silu_f(z));
      }
    }
  }
}

DEV void phase_gemm_wout(const Params& p, int l, const float* xin, int bid, int nb, char* smem) {
  const int tid = fresh_tid(), lane = tid & 63, wid = tid >> 6, wr = wid >> 1, wc = wid & 1, fr = lane & 15,
            fq = lane >> 4;
  const float* W = p.w_out + (size_t)l * DM * DM;
  for (int tile = bid; tile < 64 * 8; tile += nb) {
    const int rt = tile >> 3, ct = tile & 7;
    const int m0 = rt * 256, n0 = ct * 128;
    f32x4 acc[4][4];
    gemm_tile(
        DM, [&](int m) { return p.y + (size_t)(m0 + m) * DM; },
        [&](int k, int n) { return W[(size_t)k * DM + n0 + n]; }, acc, smem);
    const int b = m0 / T;
    const float* gate = p.mod + (l * 2 + b) * 6144 + MOD_GATE1;
#pragma unroll
    for (int mi = 0; mi < 4; ++mi)
#pragma unroll
      for (int ni = 0; ni < 4; ++ni)
#pragma unroll
        for (int j = 0; j < 4; ++j) {
          const int m = m0 + wr * 64 + mi * 16 + fq * 4 + j;
          const int n = n0 + wc * 64 + ni * 16 + fr;
          p.xbuf[(size_t)m * DM + n] = xin[(size_t)m * DM + n] + gate[n] * acc[mi][ni][j];
        }
  }
}

DEV void phase_router(const Params& p, int l, int bid, int nb) {
  const int tid_ = fresh_tid(), lane = tid_ & 63, wid = tid_ >> 6;
  for (int t = bid * NWAVE + wid; t < NTOK; t += nb * NWAVE) {
    const float4* xr = (const float4*)(p.xbuf + (size_t)t * DM);
    float4 v[4];
    float ss = 0.f;
#pragma unroll
    for (int i = 0; i < 4; ++i) {
      v[i] = xr[lane + 64 * i];
      ss += v[i].x * v[i].x + v[i].y * v[i].y + v[i].z * v[i].z + v[i].w * v[i].w;
    }
    ss = wave_sum(ss);
    const float rstd = rsqrtf(ss * (1.f / DM) + EPS);
    const int b = t / T;
    const float* md = p.mod + (l * 2 + b) * 6144;
    const float* nw = p.norm_ffn_w + l * DM;
    float acc[36];
#pragma unroll
    for (int o = 0; o < 36; ++o) acc[o] = 0.f;
#pragma unroll
    for (int i = 0; i < 4; ++i) {
      const int idx = (lane + 64 * i) * 4;
      const float4 w = *(const float4*)(nw + idx);
      const float4 s = *(const float4*)(md + MOD_SCALE2 + idx);
      const float4 hsh = *(const float4*)(md + MOD_SHIFT2 + idx);
      float hf[4];
      hf[0] = v[i].x * rstd * w.x * (1.f + s.x) + hsh.x;
      hf[1] = v[i].y * rstd * w.y * (1.f + s.y) + hsh.y;
      hf[2] = v[i].z * rstd * w.z * (1.f + s.z) + hsh.z;
      hf[3] = v[i].w * rstd * w.w * (1.f + s.w) + hsh.w;
      uint2 pk;
      pk.x = pack2(hf[0], hf[1]);
      pk.y = pack2(hf[2], hf[3]);
      *(uint2*)(p.act + (size_t)t * DM + idx) = pk;
#pragma unroll
      for (int c4 = 0; c4 < 4; ++c4) {
        const int k = idx + c4;
        const float hv = hf[c4];
        const float4 wg = *(const float4*)(p.rg_w + ((size_t)l * DM + k) * 4);
        acc[0] += hv * wg.x; acc[1] += hv * wg.y; acc[2] += hv * wg.z; acc[3] += hv * wg.w;
        const float4* we = (const float4*)(p.re_w + ((size_t)l * DM + k) * 32);
#pragma unroll
        for (int e4 = 0; e4 < 8; ++e4) {
          const float4 ww = we[e4];
          acc[4 + e4 * 4 + 0] += hv * ww.x;
          acc[4 + e4 * 4 + 1] += hv * ww.y;
          acc[4 + e4 * 4 + 2] += hv * ww.z;
          acc[4 + e4 * 4 + 3] += hv * ww.w;
        }
      }
    }
#pragma unroll
    for (int o = 0; o < 36; ++o) acc[o] = wave_sum(acc[o]);
    float lg[4];
#pragma unroll
    for (int g = 0; g < 4; ++g) lg[g] = acc[g] + p.rg_b[l * 4 + g];
    int grp = 0;
    float mx = lg[0];
#pragma unroll
    for (int g = 1; g < 4; ++g)
      if (lg[g] > mx) { mx = lg[g]; grp = g; }
    float den = 0.f;
#pragma unroll
    for (int g = 0; g < 4; ++g) den += __expf(lg[g] - mx);
    const float pg_top = 1.f / den;
    float el[8];
#pragma unroll
    for (int j = 0; j < 8; ++j) {
      const float a0 = acc[4 + j], a1 = acc[12 + j], a2 = acc[20 + j], a3 = acc[28 + j];
      const float sel = (grp == 0) ? a0 : (grp == 1) ? a1 : (grp == 2) ? a2 : a3;
      el[j] = sel + p.re_b[l * 32 + grp * 8 + j];
    }
    float b0 = -3.0e38f, b1 = -3.0e38f;
    int i0 = 0, i1 = 0;
#pragma unroll
    for (int j = 0; j < 8; ++j)
      if (el[j] > b0) { b0 = el[j]; i0 = j; }
#pragma unroll
    for (int j = 0; j < 8; ++j)
      if (j != i0 && el[j] > b1) { b1 = el[j]; i1 = j; }
    const float ex = __expf(b1 - b0);
    const float g0 = pg_top / (1.f + ex), g1 = pg_top * ex / (1.f + ex);
    if (lane == 0) {
      const int e0 = grp * 8 + i0, e1 = grp * 8 + i1;
      const int pos0 = atomicAdd(&p.cnt[l * NEXP + e0], 1);
      p.list[e0 * CAP + pos0] = 2 * t;
      p.sgate[2 * t] = g0;
      const int pos1 = atomicAdd(&p.cnt[l * NEXP + e1], 1);
      p.list[e1 * CAP + pos1] = 2 * t + 1;
      p.sgate[2 * t + 1] = g1;
    }
  }
}

DEV bool moe_tile(const int* cnt, int tile, int& e, int& rt, int& ct, int& valid) {
  for (e = 0; e < NEXP; ++e) {
    const int c = cnt[e];
    const int ntl = ((c + 255) >> 8) * 8;
    if (tile < ntl) {
      rt = tile >> 3;
      ct = tile & 7;
      valid = min(256, c - rt * 256);
      return true;
    }
    tile -= ntl;
  }
  return false;
}

DEV void phase_moe1(const Params& p, int l, int bid, int nb, char* smem) {
  const int tid = fresh_tid(), lane = tid & 63, wid = tid >> 6, wr = wid >> 1, wc = wid & 1, fr = lane & 15,
            fq = lane >> 4;
  const int* cnt = p.cnt + l * NEXP;
  for (int tile = bid;; tile += nb) {
    int e, rt, ct, valid;
    if (!moe_tile(cnt, tile, e, rt, ct, valid)) break;
    const int* lst = p.list + e * CAP + rt * 256;
    const float* W1 = p.ew1 + (size_t)(l * NEXP + e) * DM * DEXP;
    const float* W3 = p.ew3 + (size_t)(l * NEXP + e) * DM * DEXP;
    f32x4 acc[4][4];
    gemm_tile(
        DM,
        [&](int m) {
          const int slot = lst[(m < valid) ? m : 0];
          return p.act + (size_t)(slot >> 1) * DM;
        },
        [&](int k, int n) {
          const int r = n & 63;
          const int col = ct * 64 + (n >> 6) * 32 + (r & 31);
          const float* W = (r >> 5) ? W3 : W1;
          return W[(size_t)k * DEXP + col];
        },
        acc, smem);
#pragma unroll
    for (int mi = 0; mi < 4; ++mi)
#pragma unroll
      for (int j = 0; j < 4; ++j) {
        const int ml = wr * 64 + mi * 16 + fq * 4 + j;
        if (ml < valid) {
          const int slot = lst[ml];
#pragma unroll
          for (int ni = 0; ni < 2; ++ni) {
            const float a = acc[mi][ni][j], g = acc[mi][ni + 2][j];
            p.hbuf[(size_t)slot * DEXP + ct * 64 + wc * 32 + ni * 16 + fr] = f2bf(silu_f(a) * g);
          }
        }
      }
  }
}

DEV void phase_moe2(const Params& p, int l, int bid, int nb, char* smem) {
  const int tid = fresh_tid(), lane = tid & 63, wid = tid >> 6, wr = wid >> 1, wc = wid & 1, fr = lane & 15,
            fq = lane >> 4;
  const int* cnt = p.cnt + l * NEXP;
  for (int tile = bid;; tile += nb) {
    int e, rt, ct, valid;
    if (!moe_tile(cnt, tile, e, rt, ct, valid)) break;
    const int* lst = p.list + e * CAP + rt * 256;
    const float* W2 = p.ew2 + (size_t)(l * NEXP + e) * DEXP * DM;
    f32x4 acc[4][4];
    gemm_tile(
        DEXP,
        [&](int m) {
          const int slot = lst[(m < valid) ? m : 0];
          return p.hbuf + (size_t)slot * DEXP;
        },
        [&](int k, int n) { return W2[(size_t)k * DM + ct * 128 + n]; }, acc, smem);
#pragma unroll
    for (int mi = 0; mi < 4; ++mi)
#pragma unroll
      for (int j = 0; j < 4; ++j) {
        const int ml = wr * 64 + mi * 16 + fq * 4 + j;
        if (ml < valid) {
          const int slot = lst[ml];
          const float g = p.sgate[slot];
#pragma unroll
          for (int ni = 0; ni < 4; ++ni)
            p.ybuf[(size_t)slot * DM + ct * 128 + wc * 64 + ni * 16 + fr] = f2bf(g * acc[mi][ni][j]);
        }
      }
  }
}

DEV void phase_combine(const Params& p, int l, int bid, int nb) {
  const int tid_ = fresh_tid(), lane = tid_ & 63, wid = tid_ >> 6;
  for (int t = bid * NWAVE + wid; t < NTOK; t += nb * NWAVE) {
    float4* xr = (float4*)(p.xbuf + (size_t)t * DM);
    const int b = t / T;
    const float* md = p.mod + (l * 2 + b) * 6144;
    float4 v[4];
    float ss = 0.f;
#pragma unroll
    for (int i = 0; i < 4; ++i) {
      const int idx = (lane + 64 * i) * 4;
      v[i] = xr[lane + 64 * i];
      const float4 g = *(const float4*)(md + MOD_GATE2 + idx);
      const uint2 ya = *(const uint2*)(p.ybuf + (size_t)(2 * t) * DM + idx);
      const uint2 yb = *(const uint2*)(p.ybuf + (size_t)(2 * t + 1) * DM + idx);
      v[i].x += g.x * (__uint_as_float(ya.x << 16) + __uint_as_float(yb.x << 16));
      v[i].y += g.y * (__uint_as_float(ya.x & 0xffff0000u) + __uint_as_float(yb.x & 0xffff0000u));
      v[i].z += g.z * (__uint_as_float(ya.y << 16) + __uint_as_float(yb.y << 16));
      v[i].w += g.w * (__uint_as_float(ya.y & 0xffff0000u) + __uint_as_float(yb.y & 0xffff0000u));
      ss += v[i].x * v[i].x + v[i].y * v[i].y + v[i].z * v[i].z + v[i].w * v[i].w;
    }
    ss = wave_sum(ss);
    const float rstd = rsqrtf(ss * (1.f / DM) + EPS);
    if (l + 1 < DEPTH) {
#pragma unroll
      for (int i = 0; i < 4; ++i) xr[lane + 64 * i] = v[i];
      const float* md2 = p.mod + ((l + 1) * 2 + b) * 6144;
      norm_mod_store(v, rstd, p.norm_mix_w + (l + 1) * DM, md2 + MOD_SCALE1, md2 + MOD_SHIFT1,
                     p.act + (size_t)t * DM, lane);
    } else {
      float4* orow = (float4*)(p.out + (size_t)t * DM);
#pragma unroll
      for (int i = 0; i < 4; ++i) {
        const float4 w = *(const float4*)(p.final_w + (lane + 64 * i) * 4);
        float4 r;
        r.x = v[i].x * rstd * w.x;
        r.y = v[i].y * rstd * w.y;
        r.z = v[i].z * rstd * w.z;
        r.w = v[i].w * rstd * w.w;
        orow[lane + 64 * i] = r;
      }
    }
  }
}

__global__ void __launch_bounds__(NTHR) mega_kernel(Params p) {
  __shared__ __attribute__((aligned(16))) char smem[SMEM_BYTES];
  cg::grid_group grid = cg::this_grid();
  const int bid = blockIdx.x, nb = gridDim.x;
  phase_ada(p, bid, nb, smem);
  grid.sync();
  phase_hmix(p, 0, p.x, bid, nb);
  grid.sync();
#pragma unroll 1
  for (int l = 0; l < DEPTH; ++l) {
    phase_gemm_proj(p, l, bid, nb, smem);
    grid.sync();
    phase_gdn_prep(p, l, bid, nb, smem);
    grid.sync();
    if (bid < 16) {
      phase_gdn_scan(p, bid, smem);
    } else {
      phase_conv(p, l, bid - 16, nb - 16);
      phase_na(p, l, (bid - 16) * NWAVE + (fresh_tid() >> 6), (nb - 16) * NWAVE);
    }
    grid.sync();
    phase_gdn_fin(p, l, bid, nb);
    grid.sync();
    phase_gemm_wout(p, l, l == 0 ? p.x : p.xbuf, bid, nb, smem);
    grid.sync();
    phase_router(p, l, bid, nb);
    grid.sync();
    phase_moe1(p, l, bid, nb, smem);
    grid.sync();
    phase_moe2(p, l, bid, nb, smem);
    grid.sync();
    phase_combine(p, l, bid, nb);
    if (l + 1 < DEPTH) grid.sync();
  }
}

extern "C" void kernel_launch(void* const* d_in, const int* in_sizes, int n_in, void* d_out, int out_size,
                              void* d_ws, size_t ws_size, hipStream_t stream) {
  Params p{};
  p.x = (const float*)d_in[0];
  p.c = (const float*)d_in[1];
  p.norm_mix_w = (const float*)d_in[2];
  p.norm_ffn_w = (const float*)d_in[3];
  p.w_ada = (const float*)d_in[4];
  p.b_ada = (const float*)d_in[5];
  p.w_in = (const float*)d_in[6];
  p.conv_a_w = (const float*)d_in[7];
  p.na_rpb = (const float*)d_in[8];
  p.gdn_conv_w = (const float*)d_in[9];
  p.gdn_a_log = (const float*)d_in[10];
  p.gdn_dt_bias = (const float*)d_in[11];
  p.gdn_norm_w = (const float*)d_in[12];
  p.w_out = (const float*)d_in[13];
  p.rg_w = (const float*)d_in[14];
  p.rg_b = (const float*)d_in[15];
  p.re_w = (const float*)d_in[16];
  p.re_b = (const float*)d_in[17];
  p.ew1 = (const float*)d_in[18];
  p.ew3 = (const float*)d_in[19];
  p.ew2 = (const float*)d_in[20];
  p.final_w = (const float*)d_in[21];
  p.out = (float*)d_out;
  char* ws = (char*)d_ws;
  size_t off = 0;
  auto take = [&](size_t bytes) {
    char* r = ws + off;
    off += (bytes + 255) & ~(size_t)255;
    return r;
  };
  p.mod = (float*)take(sizeof(float) * DEPTH * NB * 6144);
  p.cnt = (int*)take(sizeof(int) * DEPTH * NEXP);
  p.xbuf = (float*)take(sizeof(float) * (size_t)NTOK * DM);
  p.act = (bf16_t*)take(2 * (size_t)NTOK * DM);
  p.proj = (bf16_t*)take(2 * (size_t)NTOK * PROJW);
  p.gates = (float*)take(sizeof(float) * (size_t)NTOK * 16);
  p.y = (bf16_t*)take(2 * (size_t)NTOK * DM);
  p.list = (int*)take(sizeof(int) * NEXP * CAP);
  p.sgate = (float*)take(sizeof(float) * 2 * NTOK);
  p.egl = (float*)take(sizeof(float) * 2048);
  p.obuf = (float*)take(sizeof(float) * 2 * (size_t)NTOK * 512);
  p.gdn_rec = (char*)take((size_t)2048 * REC_BYTES);
  p.gdn_u = (unsigned*)take(sizeof(unsigned) * (size_t)2048 * 32 * 128);
  p.hbuf = (bf16_t*)p.obuf;
  p.ybuf = (bf16_t*)p.gdn_rec;
  if (off > ws_size) fprintf(stderr, "workspace too small: need %zu have %zu\n", off, ws_size);

  static int grid_blocks = 0;
  if (!grid_blocks) {
    int dev = 0, cus = 0, per_cu = 0;
    (void)hipGetDevice(&dev);
    (void)hipDeviceGetAttribute(&cus, hipDeviceAttributeMultiprocessorCount, dev);
    (void)hipOccupancyMaxActiveBlocksPerMultiprocessor(&per_cu, mega_kernel, NTHR, 0);
    if (per_cu > 1) per_cu = 1;
    if (per_cu < 1) per_cu = 1;
    grid_blocks = cus * per_cu;
  }
  void* args[] = {&p};
  hipError_t e = hipLaunchCooperativeKernel((void*)mega_kernel, dim3(grid_blocks), dim3(NTHR), args, 0, stream);
  if (e != hipSuccess) fprintf(stderr, "cooperative launch failed: %s (grid %d)\n", hipGetErrorString(e), grid_blocks);
}
```

```cpp
#include <hip/hip_runtime.h>
#include <hip/hip_cooperative_groups.h>
#include <stdint.h>
#include <stdio.h>

#define DEV __device__ __forceinline__
namespace cg = cooperative_groups;

typedef __attribute__((ext_vector_type(8))) short bf16x8;
typedef __attribute__((ext_vector_type(4))) float f32x4;
typedef __attribute__((ext_vector_type(16))) float f32x16;
typedef float f32x2_t __attribute__((ext_vector_type(2)));
typedef __bf16 bf16x2_t __attribute__((ext_vector_type(2)));
typedef unsigned short bf16_t;

constexpr int NTHR = 512;
constexpr int NWAVE = 8;
constexpr int DM = 1024;
constexpr int NB = 2;
constexpr int T = 8192;
constexpr int NTOK = NB * T;
constexpr int DEPTH = 2;
constexpr int DIN = 3600;
constexpr int PROJW = 3584;
constexpr int NEXP = 32;
constexpr int DEXP = 512;
constexpr int CAP = 16384;
constexpr float EPS = 1e-6f;
constexpr int OFF_CB = 0, OFF_CC = 256, OFF_CX = 512, OFF_NQ = 768, OFF_NK = 1024, OFF_NV = 1280,
              OFF_GQKV = 1536, OFF_GZ = 3072;
constexpr int MOD_SHIFT1 = 0, MOD_SCALE1 = 1024, MOD_GATE1 = 2048, MOD_SHIFT2 = 3072, MOD_SCALE2 = 4096,
              MOD_GATE2 = 5120;

constexpr int REC_WN = 0, REC_QD = 16384, REC_IN = 32768, REC_KT = 40960, REC_BYTES = 57344;
constexpr int SC_WN = 0, SC_QD = 16896, SC_IN = 33792, SC_KT = 42496, SC_BUF = 59904;
constexpr int PL_Q = 0, PL_K = 17408, PL_V = 34816, PL_L = 52224, PL_GC = 87040, PL_BETA = 87552, PL_BG = 88064,
              PL_GL = 88576;
constexpr int SMEM_BYTES = 2 * SC_BUF;

struct Params {
  const float *x, *c, *norm_mix_w, *norm_ffn_w, *w_ada, *b_ada, *w_in, *conv_a_w, *na_rpb, *gdn_conv_w,
      *gdn_a_log, *gdn_dt_bias, *gdn_norm_w, *w_out, *rg_w, *rg_b, *re_w, *re_b, *ew1, *ew3, *ew2, *final_w;
  float* out;
  float* mod;
  int* cnt;
  float* xbuf;
  bf16_t* act;
  bf16_t* proj;
  float* gates;
  bf16_t* y;
  float* obuf;
  char* gdn_rec;
  unsigned* gdn_u;
  float* egl;
  bf16_t* hbuf;
  bf16_t* ybuf;
  int* list;
  float* sgate;
  unsigned* bar;
};

DEV unsigned pack2(float a, float b) {
  f32x2_t v = {a, b};
  return __builtin_bit_cast(unsigned, __builtin_convertvector(v, bf16x2_t));
}
DEV bf16_t f2bf(float f) { return (bf16_t)(pack2(f, 0.f) & 0xffffu); }
DEV float bf2f(bf16_t h) { return __uint_as_float(((unsigned)h) << 16); }
DEV float silu_f(float x) { return x / (1.f + __expf(-x)); }
DEV float sigmoid_f(float x) { return 1.f / (1.f + __expf(-x)); }
DEV float softplus_f(float x) { return fmaxf(x, 0.f) + log1pf(__expf(-fabsf(x))); }
DEV float wave_sum(float v) {
#pragma unroll
  for (int o = 32; o > 0; o >>= 1) v += __shfl_xor(v, o, 64);
  return v;
}
DEV int fresh_tid() {
  int t = threadIdx.x;
  asm volatile("" : "+v"(t));
  return t;
}
DEV void unpack8(uint4 u, float* f) {
  f[0] = __uint_as_float(u.x << 16);
  f[1] = __uint_as_float(u.x & 0xffff0000u);
  f[2] = __uint_as_float(u.y << 16);
  f[3] = __uint_as_float(u.y & 0xffff0000u);
  f[4] = __uint_as_float(u.z << 16);
  f[5] = __uint_as_float(u.z & 0xffff0000u);
  f[6] = __uint_as_float(u.w << 16);
  f[7] = __uint_as_float(u.w & 0xffff0000u);
}
DEV uint4 pack8(const float* f) {
  uint4 r;
  r.x = pack2(f[0], f[1]);
  r.y = pack2(f[2], f[3]);
  r.z = pack2(f[4], f[5]);
  r.w = pack2(f[6], f[7]);
  return r;
}
#define MFMA16(a, b, c) __builtin_amdgcn_mfma_f32_16x16x32_bf16((a), (b), (c), 0, 0, 0)
#define MFMA32(a, b, c) __builtin_amdgcn_mfma_f32_32x32x16_bf16((a), (b), (c), 0, 0, 0)

constexpr int GBK = 32;
constexpr int LDSROW = GBK + 8;

template <class AF, class BF>
DEV void gemm_tile(int K, AF arow, BF bload, f32x4 (&acc)[4][4], char* smem) {
  bf16_t* sA = (bf16_t*)smem;
  bf16_t* sB = sA + 2 * 256 * LDSROW;
  const int tid = fresh_tid(), lane = tid & 63, wid = tid >> 6, wr = wid >> 1, wc = wid & 1, fr = lane & 15,
            fq = lane >> 4;
  const int ar0 = tid >> 2, ach = tid & 3;
  const bf16_t* ap0 = arow(ar0) + ach * 8;
  const bf16_t* ap1 = arow(ar0 + 128) + ach * 8;
  const int bn = tid & 127, bkg = tid >> 7;
  uint4 ra0, ra1;
  float rb[8];
#pragma unroll
  for (int mi = 0; mi < 4; ++mi)
#pragma unroll
    for (int ni = 0; ni < 4; ++ni) acc[mi][ni] = f32x4{0.f, 0.f, 0.f, 0.f};

  auto gload = [&](int k0) {
    ra0 = *(const uint4*)(ap0 + k0);
    ra1 = *(const uint4*)(ap1 + k0);
#pragma unroll
    for (int j = 0; j < 8; ++j) rb[j] = bload(k0 + bkg * 8 + j, bn);
  };
  auto sstore = [&](int buf) {
    bf16_t* a = sA + buf * 256 * LDSROW;
    bf16_t* b = sB + buf * 128 * LDSROW;
    *(uint4*)(a + ar0 * LDSROW + ach * 8) = ra0;
    *(uint4*)(a + (ar0 + 128) * LDSROW + ach * 8) = ra1;
    *(uint4*)(b + bn * LDSROW + bkg * 8) = pack8(rb);
  };
  const int nt = K / GBK;
  gload(0);
  sstore(0);
  __syncthreads();
  for (int t = 0; t < nt; ++t) {
    const int buf = t & 1;
    if (t + 1 < nt) gload((t + 1) * GBK);
    const bf16_t* a = sA + buf * 256 * LDSROW;
    const bf16_t* b = sB + buf * 128 * LDSROW;
    bf16x8 af[4], bfr[4];
#pragma unroll
    for (int mi = 0; mi < 4; ++mi) af[mi] = *(const bf16x8*)(a + (wr * 64 + mi * 16 + fr) * LDSROW + fq * 8);
#pragma unroll
    for (int ni = 0; ni < 4; ++ni) bfr[ni] = *(const bf16x8*)(b + (wc * 64 + ni * 16 + fr) * LDSROW + fq * 8);
#pragma unroll
    for (int mi = 0; mi < 4; ++mi)
#pragma unroll
      for (int ni = 0; ni < 4; ++ni) acc[mi][ni] = MFMA16(af[mi], bfr[ni], acc[mi][ni]);
    if (t + 1 < nt) sstore(buf ^ 1);
    __syncthreads();
  }
}

DEV void phase_ada(const Params& p, int bid, int nb, char* smem) {
  float* cond = (float*)smem;
  float* red = cond + 2 * DM;
  const int tid = fresh_tid(), lane = tid & 63, wid = tid >> 6;
  for (int i = tid; i < 2 * DM; i += NTHR) cond[i] = silu_f(p.c[i]);
  __syncthreads();
  for (int item = bid; item < DEPTH * 96; item += nb) {
    const int l = item / 96, j = (item - l * 96) * 64 + lane;
    const float* w = p.w_ada + ((size_t)l * DM + wid * 128) * 6144 + j;
    float a0 = 0.f, a1 = 0.f;
#pragma unroll 16
    for (int k = 0; k < 128; ++k) {
      const float wv = w[(size_t)k * 6144];
      a0 += cond[wid * 128 + k] * wv;
      a1 += cond[DM + wid * 128 + k] * wv;
    }
    red[(wid * 2 + 0) * 64 + lane] = a0;
    red[(wid * 2 + 1) * 64 + lane] = a1;
    __syncthreads();
    if (wid < 2) {
      float s = p.b_ada[l * 6144 + j];
#pragma unroll
      for (int w8 = 0; w8 < 8; ++w8) s += red[(w8 * 2 + wid) * 64 + lane];
      p.mod[(l * 2 + wid) * 6144 + j] = s;
    }
    __syncthreads();
  }
  if (bid == 0 && tid < DEPTH * NEXP) p.cnt[tid] = 0;
}

DEV void norm_mod_store(const float4 (&v)[4], float rstd, const float* nw, const float* sc, const float* sh,
                        bf16_t* dst, int lane) {
#pragma unroll
  for (int i = 0; i < 4; ++i) {
    const int idx = (lane + 64 * i) * 4;
    const float4 w = *(const float4*)(nw + idx);
    const float4 s = *(const float4*)(sc + idx);
    const float4 h = *(const float4*)(sh + idx);
    const float r0 = v[i].x * rstd * w.x * (1.f + s.x) + h.x;
    const float r1 = v[i].y * rstd * w.y * (1.f + s.y) + h.y;
    const float r2 = v[i].z * rstd * w.z * (1.f + s.z) + h.z;
    const float r3 = v[i].w * rstd * w.w * (1.f + s.w) + h.w;
    uint2 pk;
    pk.x = pack2(r0, r1);
    pk.y = pack2(r2, r3);
    *(uint2*)(dst + idx) = pk;
  }
}

DEV void phase_hmix(const Params& p, int l, const float* xin, int bid, int nb) {
  const int tid_ = fresh_tid(), lane = tid_ & 63, wid = tid_ >> 6;
  for (int t = bid * NWAVE + wid; t < NTOK; t += nb * NWAVE) {
    const float4* xr = (const float4*)(xin + (size_t)t * DM);
    float4 v[4];
    float ss = 0.f;
#pragma unroll
    for (int i = 0; i < 4; ++i) {
      v[i] = xr[lane + 64 * i];
      ss += v[i].x * v[i].x + v[i].y * v[i].y + v[i].z * v[i].z + v[i].w * v[i].w;
    }
    ss = wave_sum(ss);
    const float rstd = rsqrtf(ss * (1.f / DM) + EPS);
    const int b = t / T;
    const float* md = p.mod + (l * 2 + b) * 6144;
    norm_mod_store(v, rstd, p.norm_mix_w + l * DM, md + MOD_SCALE1, md + MOD_SHIFT1, p.act + (size_t)t * DM, lane);
  }
}

DEV void phase_gemm_proj(const Params& p, int l, int bid, int nb, char* smem) {
  const int NCT = 29;
  const int tid = fresh_tid(), lane = tid & 63, wid = tid >> 6, wr = wid >> 1, wc = wid & 1, fr = lane & 15,
            fq = lane >> 4;
  const float* W = p.w_in + (size_t)l * DM * DIN;
  for (int tile = bid; tile < 64 * NCT; tile += nb) {
    const int rt = tile / NCT, ct = tile - rt * NCT;
    const int m0 = rt * 256, n0 = ct * 128;
    f32x4 acc[4][4];
    gemm_tile(
        DM, [&](int m) { return p.act + (size_t)(m0 + m) * DM; },
        [&](int k, int n) { return (n0 + n < DIN) ? W[(size_t)k * DIN + n0 + n] : 0.f; }, acc, smem);
#pragma unroll
    for (int mi = 0; mi < 4; ++mi)
#pragma unroll
      for (int ni = 0; ni < 4; ++ni)
#pragma unroll
        for (int j = 0; j < 4; ++j) {
          const int m = m0 + wr * 64 + mi * 16 + fq * 4 + j;
          const int n = n0 + wc * 64 + ni * 16 + fr;
          const float v = acc[mi][ni][j];
          if (n < PROJW)
            p.proj[(size_t)m * PROJW + n] = f2bf(v);
          else if (n < DIN)
            p.gates[(size_t)m * 16 + (n - PROJW)] = v;
        }
  }
}

DEV void phase_conv(const Params& p, int l, int bid, int nb) {
  const float* w = p.conv_a_w + l * 768;
  for (int g = bid * NTHR + fresh_tid(); g < NTOK * 256; g += nb * NTHR) {
    const int t = g >> 8, c = g & 255;
    const int tl = t & (T - 1);
    const bf16_t* r = p.proj + (size_t)t * PROJW;
    const float cb = bf2f(r[OFF_CB + c]);
    const float mid = bf2f(r[OFF_CC + c]) * bf2f(r[OFF_CX + c]);
    float prev = 0.f, next = 0.f;
    if (tl > 0) prev = bf2f(r[OFF_CC + c - PROJW]) * bf2f(r[OFF_CX + c - PROJW]);
    if (tl < T - 1) next = bf2f(r[OFF_CC + c + PROJW]) * bf2f(r[OFF_CX + c + PROJW]);
    const float s = w[c] * prev + w[256 + c] * mid + w[512 + c] * next;
    p.y[(size_t)t * DM + c] = f2bf(cb * s);
  }
}

DEV void phase_na(const Params& p, int l, int wgid, int nwg) {
  const int tid_ = fresh_tid(), lane = tid_ & 63, fr = lane & 15, fq = lane >> 4;
  for (int item = wgid; item < NB * 128 * 4 * 4; item += nwg) {
    const int qg = item & 3, h = (item >> 2) & 3, r = (item >> 4) & 127, b = item >> 11;
    const int rs = min(max(r - 4, 0), 120);
    const int kc0 = (qg == 0) ? 0 : (qg == 1) ? 8 : (qg == 2) ? 24 : 32;
    const int c = qg * 16 + fr;
    const int cs = min(max(c - 8, 0), 48);
    const size_t tq = (size_t)b * T + r * 64 + c;
    bf16x8 bq[2];
#pragma unroll
    for (int ks = 0; ks < 2; ++ks)
      bq[ks] = *(const bf16x8*)(p.proj + tq * PROJW + OFF_NQ + h * 64 + ks * 32 + fq * 8);
    f32x4 sc[16];
#pragma unroll
    for (int tt = 0; tt < 16; ++tt) {
      const int i = tt >> 1, half = tt & 1;
      const size_t kt = (size_t)b * T + (rs + i) * 64 + kc0 + half * 16 + fr;
      const bf16_t* kp = p.proj + kt * PROJW + OFF_NK + h * 64 + fq * 8;
      const bf16x8 a0 = *(const bf16x8*)(kp);
      const bf16x8 a1 = *(const bf16x8*)(kp + 32);
      f32x4 z = {0.f, 0.f, 0.f, 0.f};
      z = MFMA16(a0, bq[0], z);
      sc[tt] = MFMA16(a1, bq[1], z);
    }
    const float* rpb = p.na_rpb + (size_t)(l * 4 + h) * 465;
    float mx = -3.0e38f;
#pragma unroll
    for (int tt = 0; tt < 16; ++tt) {
      const int i = tt >> 1, half = tt & 1;
      const int dr = rs + i - r + 7;
#pragma unroll
      for (int j = 0; j < 4; ++j) {
        const int kcol = kc0 + half * 16 + fq * 4 + j;
        const bool valid = (kcol >= cs) && (kcol < cs + 16);
        const int dc = valid ? (kcol - c + 15) : 0;
        const float s = valid ? (sc[tt][j] * 0.125f + rpb[dr * 31 + dc]) : -3.0e38f;
        sc[tt][j] = s;
        mx = fmaxf(mx, s);
      }
    }
    mx = fmaxf(mx, __shfl_xor(mx, 16, 64));
    mx = fmaxf(mx, __shfl_xor(mx, 32, 64));
    float sum = 0.f;
#pragma unroll
    for (int tt = 0; tt < 16; ++tt)
#pragma unroll
      for (int j = 0; j < 4; ++j) {
        const float s = sc[tt][j];
        const float e = (s > -1.0e38f) ? __expf(s - mx) : 0.f;
        sc[tt][j] = e;
        sum += e;
      }
    sum += __shfl_xor(sum, 16, 64);
    sum += __shfl_xor(sum, 32, 64);
    const float inv = 1.f / sum;
    f32x4 oacc[4];
#pragma unroll
    for (int nt = 0; nt < 4; ++nt) oacc[nt] = f32x4{0.f, 0.f, 0.f, 0.f};
#pragma unroll
    for (int i = 0; i < 8; ++i) {
      uint4 pu;
      pu.x = pack2(sc[2 * i][0] * inv, sc[2 * i][1] * inv);
      pu.y = pack2(sc[2 * i][2] * inv, sc[2 * i][3] * inv);
      pu.z = pack2(sc[2 * i + 1][0] * inv, sc[2 * i + 1][1] * inv);
      pu.w = pack2(sc[2 * i + 1][2] * inv, sc[2 * i + 1][3] * inv);
      const bf16x8 pa = __builtin_bit_cast(bf16x8, pu);
      const bf16_t* vb = p.proj + ((size_t)b * T + (rs + i) * 64 + kc0 + fq * 4) * PROJW + OFF_NV + h * 64 + fr;
#pragma unroll
      for (int nt = 0; nt < 4; ++nt) {
        bf16x8 bv;
#pragma unroll
        for (int j = 0; j < 4; ++j) {
          bv[j] = (short)vb[(size_t)j * PROJW + nt * 16];
          bv[4 + j] = (short)vb[(size_t)(16 + j) * PROJW + nt * 16];
        }
        oacc[nt] = MFMA16(pa, bv, oacc[nt]);
      }
    }
#pragma unroll
    for (int nt = 0; nt < 4; ++nt)
#pragma unroll
      for (int j = 0; j < 4; ++j)
        p.y[((size_t)b * T + r * 64 + qg * 16 + fq * 4 + j) * DM + 256 + h * 64 + nt * 16 + fr] = f2bf(oacc[nt][j]);
  }
}

template <int POS>
struct SolveStep {
  static DEV void run(float (&x)[64], const float* Ld, const float* sclv, const bf16_t* src, int dir, bool isu,
                      unsigned* up, bf16_t* wp) {
    SolveStep<POS - 1>::run(x, Ld, sclv, src, dir, isu, up, wp);
    const int i = dir ? 63 - POS : POS;
    float a = sclv[POS] * bf2f(src[i * 136]);
#pragma unroll
    for (int j4 = 0; j4 < (POS + 3) / 4; ++j4) {
      const float4 lv = *(const float4*)(Ld + POS * 68 + j4 * 4);
      a -= lv.x * x[j4 * 4];
      if (j4 * 4 + 1 < POS) a -= lv.y * x[j4 * 4 + 1];
      if (j4 * 4 + 2 < POS) a -= lv.z * x[j4 * 4 + 2];
      if (j4 * 4 + 3 < POS) a -= lv.w * x[j4 * 4 + 3];
    }
    x[POS] = a;
    if (isu) {
      if (POS & 1) up[(POS >> 1) * 128] = pack2(x[POS - 1], a);
    } else {
      wp[POS * 128] = f2bf(-a);
    }
    asm volatile("" ::: "memory");
  }
};
template <>
struct SolveStep<-1> {
  static DEV void run(float (&)[64], const float*, const float*, const bf16_t*, int, bool, unsigned*, bf16_t*) {}
};

DEV void phase_gdn_prep(const Params& p, int l, int bid, int nb, char* smem) {
  const int tid = fresh_tid(), lane = tid & 63;
  bf16_t* q_bf = (bf16_t*)(smem + PL_Q);
  bf16_t* k_bf = (bf16_t*)(smem + PL_K);
  bf16_t* v_bf = (bf16_t*)(smem + PL_V);
  float* Lm = (float*)(smem + PL_L);
  float* gcl = (float*)(smem + PL_GC);
  float* bl = (float*)(smem + PL_BETA);
  float* bgl = (float*)(smem + PL_BG);
  float* gll = (float*)(smem + PL_GL);
  const float* cw = p.gdn_conv_w + l * 4608;
  for (int item = bid; item < 1024; item += nb) {
    const int b = item >> 9, h = (item >> 7) & 3, n = item & 127;
    const int t0 = b * T + n * 64;
    char* rec0 = p.gdn_rec + (size_t)item * 2 * REC_BYTES;
    if (tid < 128) {
      const int dir = tid >> 6;
      const int i = dir ? 63 - lane : lane;
      const size_t t = (size_t)t0 + i;
      const float a = p.gates[t * 16 + dir * 4 + h], bb = p.gates[t * 16 + 8 + dir * 4 + h];
      const float g = -__expf(p.gdn_a_log[l * 8 + dir * 4 + h]) * softplus_f(a + p.gdn_dt_bias[l * 8 + dir * 4 + h]);
      const float beta = sigmoid_f(bb);
      float cs = g;
#pragma unroll
      for (int o = 1; o < 64; o <<= 1) {
        const float v = __shfl_up(cs, o, 64);
        if (lane >= o) cs += v;
      }
      gcl[dir * 64 + lane] = cs;
      bl[dir * 64 + lane] = beta;
      bgl[dir * 64 + lane] = beta * __expf(cs);
      const float last = __shfl(cs, 63, 64);
      if (lane == 0) {
        gll[dir] = last;
        p.egl[item * 2 + dir] = __expf(last);
      }
    }
    __syncthreads();
    {
      int tA = tid;
      asm volatile("" : "+v"(tA));
      const int i = tA >> 3, oc = tA & 7, d0 = oc * 16;
      const int tl = n * 64 + i;
      const bf16_t* rowp = p.proj + (size_t)(t0 + i) * PROJW + OFF_GQKV + h * 128 + d0;
#pragma unroll
      for (int m = 0; m < 3; ++m) {
        const bf16_t* rp = rowp + m * 512;
        float x0[16], x1[16], x2[16], val[16];
        unpack8(*(const uint4*)(rp), x1);
        unpack8(*(const uint4*)(rp + 8), x1 + 8);
        if (tl > 0) {
          unpack8(*(const uint4*)(rp - PROJW), x0);
          unpack8(*(const uint4*)(rp - PROJW + 8), x0 + 8);
        } else {
#pragma unroll
          for (int e = 0; e < 16; ++e) x0[e] = 0.f;
        }
        if (tl < T - 1) {
          unpack8(*(const uint4*)(rp + PROJW), x2);
          unpack8(*(const uint4*)(rp + PROJW + 8), x2 + 8);
        } else {
#pragma unroll
          for (int e = 0; e < 16; ++e) x2[e] = 0.f;
        }
        const float* cwm = cw + m * 512 + h * 128 + d0;
        float ss = 0.f;
#pragma unroll
        for (int e = 0; e < 16; ++e) {
          val[e] = silu_f(cwm[e] * x0[e] + cwm[1536 + e] * x1[e] + cwm[3072 + e] * x2[e]);
          ss += val[e] * val[e];
        }
        if (m < 2) {
          ss += __shfl_xor(ss, 1, 64);
          ss += __shfl_xor(ss, 2, 64);
          ss += __shfl_xor(ss, 4, 64);
          float sc = rsqrtf(ss + EPS);
          if (m == 0) sc *= 0.08838834764831845f;
#pragma unroll
          for (int e = 0; e < 16; ++e) val[e] *= sc;
        }
        bf16_t* dst = (m == 0 ? q_bf : (m == 1 ? k_bf : v_bf)) + i * 136 + d0;
        *(uint4*)(dst) = pack8(val);
        *(uint4*)(dst + 8) = pack8(val + 8);
        if (m == 0) {
#pragma unroll
          for (int dir = 0; dir < 2; ++dir) {
            const int pos = dir ? 63 - i : i;
            const float f = __expf(gcl[dir * 64 + pos]);
            float tmp[16];
#pragma unroll
            for (int e = 0; e < 16; ++e) tmp[e] = val[e] * f;
            bf16_t* qd = (bf16_t*)(rec0 + dir * REC_BYTES + REC_QD) + pos * 128 + d0;
            *(uint4*)(qd) = pack8(tmp);
            *(uint4*)(qd + 8) = pack8(tmp + 8);
          }
        }
        if (m == 1) {
#pragma unroll
          for (int dir = 0; dir < 2; ++dir) {
            const int pos = dir ? 63 - i : i;
            const float f = __expf(gll[dir] - gcl[dir * 64 + pos]);
            bf16_t* kt = (bf16_t*)(rec0 + dir * REC_BYTES + REC_KT) + d0 * 64 + pos;
#pragma unroll
            for (int e = 0; e < 16; ++e) kt[e * 64] = f2bf(val[e] * f);
          }
        }
      }
    }
    __syncthreads();
    {
      int tB = tid;
      asm volatile("" : "+v"(tB));
      const int laneB = tB & 63, widB = tB >> 6, fr = laneB & 15, fq = laneB >> 4;
      const int mat = widB >> 2, rtile = widB & 3;
      const bf16_t* asrc = mat ? q_bf : k_bf;
      bf16x8 af[4];
#pragma unroll
      for (int ks = 0; ks < 4; ++ks) af[ks] = *(const bf16x8*)(asrc + (rtile * 16 + fr) * 136 + ks * 32 + fq * 8);
#pragma unroll
      for (int nt = 0; nt < 4; ++nt) {
        f32x4 acc = {0.f, 0.f, 0.f, 0.f};
#pragma unroll
        for (int ks = 0; ks < 4; ++ks) {
          const bf16x8 bfrag = *(const bf16x8*)(k_bf + (nt * 16 + fr) * 136 + ks * 32 + fq * 8);
          acc = MFMA16(af[ks], bfrag, acc);
        }
#pragma unroll
        for (int j = 0; j < 4; ++j) {
          const int i = rtile * 16 + fq * 4 + j, jj = nt * 16 + fr;
          const float G = acc[j];
#pragma unroll
          for (int dir = 0; dir < 2; ++dir) {
            const int pi = dir ? 63 - i : i, pj = dir ? 63 - jj : jj;
            const float dec = __expf(fminf(gcl[dir * 64 + pi] - gcl[dir * 64 + pj], 0.f));
            if (mat == 0)
              Lm[(dir * 64 + pi) * 68 + pj] = (pi > pj) ? bl[dir * 64 + pi] * G * dec : 0.f;
            else
              *((bf16_t*)(rec0 + dir * REC_BYTES + REC_IN) + pi * 64 + pj) = f2bf((pi >= pj) ? G * dec : 0.f);
          }
        }
      }
    }
    __syncthreads();
    {
      int tC = tid;
      asm volatile("" : "+v"(tC));
      const int dir = tC >> 8, c = tC & 255;
      const float* Ld = Lm + dir * 64 * 68;
      const bool isu = c < 128;
      unsigned* up = p.gdn_u + ((size_t)(item * 2 + dir) * 32) * 128 + (c & 127);
      bf16_t* wp = (bf16_t*)(rec0 + dir * REC_BYTES + REC_WN) + (c & 127);
      const bf16_t* src = (isu ? v_bf : k_bf) + (c & 127);
      const float* sclv = (isu ? bl : bgl) + dir * 64;
      float x[64];
      SolveStep<63>::run(x, Ld, sclv, src, dir, isu, up, wp);
    }
    __syncthreads();
  }
}

DEV int crow(int reg, int hf) { return (reg & 3) + 8 * (reg >> 2) + 4 * hf; }
DEV bf16x8 pack_acc8(const f32x16& x, int s) {
  uint4 v;
  v.x = pack2(x[8 * s + 0], x[8 * s + 1]);
  v.y = pack2(x[8 * s + 2], x[8 * s + 3]);
  v.z = pack2(x[8 * s + 4], x[8 * s + 5]);
  v.w = pack2(x[8 * s + 6], x[8 * s + 7]);
  return __builtin_bit_cast(bf16x8, v);
}
DEV bf16x8 ld_frag(const char* rowp, int kb) {
  const uint2 lo = *(const uint2*)(rowp + kb);
  const uint2 hi = *(const uint2*)(rowp + kb + 16);
  uint4 v;
  v.x = lo.x; v.y = lo.y; v.z = hi.x; v.w = hi.y;
  return __builtin_bit_cast(bf16x8, v);
}

DEV void phase_gdn_scan(const Params& p, int chain, char* smem) {
  const int tid = fresh_tid(), lane = tid & 63, wid = tid >> 6;
  const int dir = chain & 1, bh = chain >> 1;
  const int b = bh >> 2, hh = bh & 3;
  if (wid >= 4) {
    const int lt = tid - 256;
    uint2 rg[28];
    auto gl = [&](int n) {
      const int item = bh * 128 + (dir ? 127 - n : n);
      const uint2* src = (const uint2*)(p.gdn_rec + ((size_t)item * 2 + dir) * REC_BYTES);
#pragma unroll
      for (int k = 0; k < 28; ++k) rg[k] = src[lt + 256 * k];
    };
    auto st = [&](int buf) {
      char* base = smem + buf * SC_BUF;
#pragma unroll
      for (int k = 0; k < 28; ++k) {
        const int u = lt + 256 * k;
        int off;
        if (k < 8) off = SC_WN + (u >> 5) * 264 + (u & 31) * 8;
        else if (k < 16) off = SC_QD + ((u - 2048) >> 5) * 264 + ((u - 2048) & 31) * 8;
        else if (k < 20) off = SC_IN + ((u - 4096) >> 4) * 136 + ((u - 4096) & 15) * 8;
        else off = SC_KT + ((u - 5120) >> 4) * 136 + ((u - 5120) & 15) * 8;
        *(uint2*)(base + off) = rg[k];
      }
    };
    gl(0);
    st(0);
    gl(1);
    __syncthreads();
    for (int n = 0; n < 128; ++n) {
      if (n + 1 < 128) st((n + 1) & 1);
      if (n + 2 < 128) gl(n + 2);
      __syncthreads();
    }
  } else {
    const int w = wid, r = lane & 31, hf = lane >> 5;
    f32x16 S[4];
#pragma unroll
    for (int t4 = 0; t4 < 4; ++t4)
#pragma unroll
      for (int e = 0; e < 16; ++e) S[t4][e] = 0.f;
    unsigned un[2][8];
    auto load_u = [&](int n) {
      const int item = bh * 128 + (dir ? 127 - n : n);
      const unsigned* up = p.gdn_u + ((size_t)(item * 2 + dir) * 32) * 128 + 32 * w + r;
#pragma unroll
      for (int tm = 0; tm < 2; ++tm)
#pragma unroll
        for (int e2 = 0; e2 < 8; ++e2) un[tm][e2] = up[((32 * tm + crow(2 * e2, hf)) >> 1) * 128];
    };
    float dec_next = p.egl[(bh * 128 + (dir ? 127 : 0)) * 2 + dir];
    load_u(0);
    __syncthreads();
    for (int n = 0; n < 128; ++n) {
      const char* buf = smem + (n & 1) * SC_BUF;
      const float decay = dec_next;
      f32x16 vn[2], o[2];
#pragma unroll
      for (int tm = 0; tm < 2; ++tm)
#pragma unroll
        for (int e2 = 0; e2 < 8; ++e2) {
          vn[tm][2 * e2] = __uint_as_float(un[tm][e2] << 16);
          vn[tm][2 * e2 + 1] = __uint_as_float(un[tm][e2] & 0xffff0000u);
        }
#pragma unroll
      for (int e = 0; e < 16; ++e) { o[0][e] = 0.f; o[1][e] = 0.f; }
      if (n + 1 < 128) {
        load_u(n + 1);
        dec_next = p.egl[(bh * 128 + (dir ? 127 - (n + 1) : (n + 1))) * 2 + dir];
      }
#pragma unroll
      for (int t4 = 0; t4 < 4; ++t4) {
        const bf16x8 sb0 = pack_acc8(S[t4], 0);
        const bf16x8 sb1 = pack_acc8(S[t4], 1);
#pragma unroll
        for (int tm = 0; tm < 2; ++tm) {
          const char* rowW = buf + SC_WN + (32 * tm + r) * 264;
          const char* rowQ = buf + SC_QD + (32 * tm + r) * 264;
          const int kb0 = (32 * t4 + 4 * hf) * 2, kb1 = (32 * t4 + 16 + 4 * hf) * 2;
          vn[tm] = MFMA32(ld_frag(rowW, kb0), sb0, vn[tm]);
          o[tm] = MFMA32(ld_frag(rowQ, kb0), sb0, o[tm]);
          vn[tm] = MFMA32(ld_frag(rowW, kb1), sb1, vn[tm]);
          o[tm] = MFMA32(ld_frag(rowQ, kb1), sb1, o[tm]);
        }
      }
      bf16x8 vb[2][2];
#pragma unroll
      for (int tk = 0; tk < 2; ++tk) {
        vb[tk][0] = pack_acc8(vn[tk], 0);
        vb[tk][1] = pack_acc8(vn[tk], 1);
      }
#pragma unroll
      for (int tm = 0; tm < 2; ++tm) {
        const char* rowI = buf + SC_IN + (32 * tm + r) * 136;
#pragma unroll
        for (int tk = 0; tk <= tm; ++tk)
#pragma unroll
          for (int s = 0; s < 2; ++s) {
            const int kb = (32 * tk + 16 * s + 4 * hf) * 2;
            o[tm] = MFMA32(ld_frag(rowI, kb), vb[tk][s], o[tm]);
          }
      }
#pragma unroll
      for (int t4 = 0; t4 < 4; ++t4) {
#pragma unroll
        for (int e = 0; e < 16; ++e) S[t4][e] *= decay;
        const char* rowK = buf + SC_KT + (32 * t4 + r) * 136;
#pragma unroll
        for (int tk = 0; tk < 2; ++tk)
#pragma unroll
          for (int s = 0; s < 2; ++s) {
            const int kb = (32 * tk + 16 * s + 4 * hf) * 2;
            S[t4] = MFMA32(ld_frag(rowK, kb), vb[tk][s], S[t4]);
          }
      }
#pragma unroll
      for (int tm = 0; tm < 2; ++tm)
#pragma unroll
        for (int e = 0; e < 16; ++e) {
          const int pos = 32 * tm + crow(e, hf);
          const int tok = dir ? (b * T + T - 1 - n * 64 - pos) : (b * T + n * 64 + pos);
          p.obuf[((size_t)dir * NTOK + tok) * 512 + hh * 128 + 32 * w + r] = o[tm][e];
        }
      __syncthreads();
    }
  }
}

DEV void phase_gdn_fin(const Params& p, int l, int bid, int nb) {
  const int tid_ = fresh_tid(), lane = tid_ & 63, wid = tid_ >> 6;
  const float* gnw = p.gdn_norm_w + l * 128;
  for (int t = bid * NWAVE + wid; t < NTOK; t += nb * NWAVE) {
    float o[8];
#pragma unroll
    for (int i = 0; i < 8; ++i) {
      const int idx = lane + 64 * i;
      o[i] = p.obuf[(size_t)t * 512 + idx] + p.obuf[((size_t)NTOK + t) * 512 + idx];
    }
#pragma unroll
    for (int hh = 0; hh < 4; ++hh) {
      float ss = o[2 * hh] * o[2 * hh] + o[2 * hh + 1] * o[2 * hh + 1];
      ss = wave_sum(ss);
      const float rr = rsqrtf(ss * (1.f / 128.f) + EPS);
#pragma unroll
      for (int u = 0; u < 2; ++u) {
        const int i = 2 * hh + u, idx = lane + 64 * i, e = idx & 127;
        const float z = bf2f(p.proj[(size_t)t * PROJW + OFF_GZ + idx]);
        p.y[(size_t)t * DM + 512 + idx] = f2bf(o[i] * rr * gnw[e] * silu_f(z));
      }
    }
  }
}

DEV void phase_gemm_wout(const Params& p, int l, const float* xin, int bid, int nb, char* smem) {
  const int tid = fresh_tid(), lane = tid & 63, wid = tid >> 6, wr = wid >> 1, wc = wid & 1, fr = lane & 15,
            fq = lane >> 4;
  const float* W = p.w_out + (size_t)l * DM * DM;
  for (int tile = bid; tile < 64 * 8; tile += nb) {
    const int rt = tile >> 3, ct = tile & 7;
    const int m0 = rt * 256, n0 = ct * 128;
    f32x4 acc[4][4];
    gemm_tile(
        DM, [&](int m) { return p.y + (size_t)(m0 + m) * DM; },
        [&](int k, int n) { return W[(size_t)k * DM + n0 + n]; }, acc, smem);
    const int b = m0 / T;
    const float* gate = p.mod + (l * 2 + b) * 6144 + MOD_GATE1;
#pragma unroll
    for (int mi = 0; mi < 4; ++mi)
#pragma unroll
      for (int ni = 0; ni < 4; ++ni)
#pragma unroll
        for (int j = 0; j < 4; ++j) {
          const int m = m0 + wr * 64 + mi * 16 + fq * 4 + j;
          const int n = n0 + wc * 64 + ni * 16 + fr;
          p.xbuf[(size_t)m * DM + n] = xin[(size_t)m * DM + n] + gate[n] * acc[mi][ni][j];
        }
  }
}

DEV void phase_router(const Params& p, int l, int bid, int nb) {
  const int tid_ = fresh_tid(), lane = tid_ & 63, wid = tid_ >> 6;
  for (int t = bid * NWAVE + wid; t < NTOK; t += nb * NWAVE) {
    const float4* xr = (const float4*)(p.xbuf + (size_t)t * DM);
    float4 v[4];
    float ss = 0.f;
#pragma unroll
    for (int i = 0; i < 4; ++i) {
      v[i] = xr[lane + 64 * i];
      ss += v[i].x * v[i].x + v[i].y * v[i].y + v[i].z * v[i].z + v[i].w * v[i].w;
    }
    ss = wave_sum(ss);
    const float rstd = rsqrtf(ss * (1.f / DM) + EPS);
    const int b = t / T;
    const float* md = p.mod + (l * 2 + b) * 6144;
    const float* nw = p.norm_ffn_w + l * DM;
    float acc[36];
#pragma unroll
    for (int o = 0; o < 36; ++o) acc[o] = 0.f;
#pragma unroll
    for (int i = 0; i < 4; ++i) {
      const int idx = (lane + 64 * i) * 4;
      const float4 w = *(const float4*)(nw + idx);
      const float4 s = *(const float4*)(md + MOD_SCALE2 + idx);
      const float4 hsh = *(const float4*)(md + MOD_SHIFT2 + idx);
      float hf[4];
      hf[0] = v[i].x * rstd * w.x * (1.f + s.x) + hsh.x;
      hf[1] = v[i].y * rstd * w.y * (1.f + s.y) + hsh.y;
      hf[2] = v[i].z * rstd * w.z * (1.f + s.z) + hsh.z;
      hf[3] = v[i].w * rstd * w.w * (1.f + s.w) + hsh.w;
      uint2 pk;
      pk.x = pack2(hf[0], hf[1]);
      pk.y = pack2(hf[2], hf[3]);
      *(uint2*)(p.act + (size_t)t * DM + idx) = pk;
#pragma unroll
      for (int c4 = 0; c4 < 4; ++c4) {
        const int k = idx + c4;
        const float hv = hf[c4];
        const float4 wg = *(const float4*)(p.rg_w + ((size_t)l * DM + k) * 4);
        acc[0] += hv * wg.x; acc[1] += hv * wg.y; acc[2] += hv * wg.z; acc[3] += hv * wg.w;
        const float4* we = (const float4*)(p.re_w + ((size_t)l * DM + k) * 32);
#pragma unroll
        for (int e4 = 0; e4 < 8; ++e4) {
          const float4 ww = we[e4];
          acc[4 + e4 * 4 + 0] += hv * ww.x;
          acc[4 + e4 * 4 + 1] += hv * ww.y;
          acc[4 + e4 * 4 + 2] += hv * ww.z;
          acc[4 + e4 * 4 + 3] += hv * ww.w;
        }
      }
    }
#pragma unroll
    for (int o = 0; o < 36; ++o) acc[o] = wave_sum(acc[o]);
    float lg[4];
#pragma unroll
    for (int g = 0; g < 4; ++g) lg[g] = acc[g] + p.rg_b[l * 4 + g];
    int grp = 0;
    float mx = lg[0];
#pragma unroll
    for (int g = 1; g < 4; ++g)
      if (lg[g] > mx) { mx = lg[g]; grp = g; }
    float den = 0.f;
#pragma unroll
    for (int g = 0; g < 4; ++g) den += __expf(lg[g] - mx);
    const float pg_top = 1.f / den;
    float el[8];
#pragma unroll
    for (int j = 0; j < 8; ++j) {
      const float a0 = acc[4 + j], a1 = acc[12 + j], a2 = acc[20 + j], a3 = acc[28 + j];
      const float sel = (grp == 0) ? a0 : (grp == 1) ? a1 : (grp == 2) ? a2 : a3;
      el[j] = sel + p.re_b[l * 32 + grp * 8 + j];
    }
    float b0 = -3.0e38f, b1 = -3.0e38f;
    int i0 = 0, i1 = 0;
#pragma unroll
    for (int j = 0; j < 8; ++j)
      if (el[j] > b0) { b0 = el[j]; i0 = j; }
#pragma unroll
    for (int j = 0; j < 8; ++j)
      if (j != i0 && el[j] > b1) { b1 = el[j]; i1 = j; }
    const float ex = __expf(b1 - b0);
    const float g0 = pg_top / (1.f + ex), g1 = pg_top * ex / (1.f + ex);
    if (lane == 0) {
      const int e0 = grp * 8 + i0, e1 = grp * 8 + i1;
      const int pos0 = atomicAdd(&p.cnt[l * NEXP + e0], 1);
      p.list[e0 * CAP + pos0] = 2 * t;
      p.sgate[2 * t] = g0;
      const int pos1 = atomicAdd(&p.cnt[l * NEXP + e1], 1);
      p.list[e1 * CAP + pos1] = 2 * t + 1;
      p.sgate[2 * t + 1] = g1;
    }
  }
}

DEV bool moe_tile(const int* cnt, int tile, int& e, int& rt, int& ct, int& valid) {
  for (e = 0; e < NEXP; ++e) {
    const int c = cnt[e];
    const int ntl = ((c + 255) >> 8) * 8;
    if (tile < ntl) {
      rt = tile >> 3;
      ct = tile & 7;
      valid = min(256, c - rt * 256);
      return true;
    }
    tile -= ntl;
  }
  return false;
}

DEV void phase_moe1(const Params& p, int l, int bid, int nb, char* smem) {
  const int tid = fresh_tid(), lane = tid & 63, wid = tid >> 6, wr = wid >> 1, wc = wid & 1, fr = lane & 15,
            fq = lane >> 4;
  const int* cnt = p.cnt + l * NEXP;
  for (int tile = bid;; tile += nb) {
    int e, rt, ct, valid;
    if (!moe_tile(cnt, tile, e, rt, ct, valid)) break;
    const int* lst = p.list + e * CAP + rt * 256;
    const float* W1 = p.ew1 + (size_t)(l * NEXP + e) * DM * DEXP;
    const float* W3 = p.ew3 + (size_t)(l * NEXP + e) * DM * DEXP;
    f32x4 acc[4][4];
    gemm_tile(
        DM,
        [&](int m) {
          const int slot = lst[(m < valid) ? m : 0];
          return p.act + (size_t)(slot >> 1) * DM;
        },
        [&](int k, int n) {
          const int r = n & 63;
          const int col = ct * 64 + (n >> 6) * 32 + (r & 31);
          const float* W = (r >> 5) ? W3 : W1;
          return W[(size_t)k * DEXP + col];
        },
        acc, smem);
#pragma unroll
    for (int mi = 0; mi < 4; ++mi)
#pragma unroll
      for (int j = 0; j < 4; ++j) {
        const int ml = wr * 64 + mi * 16 + fq * 4 + j;
        if (ml < valid) {
          const int slot = lst[ml];
#pragma unroll
          for (int ni = 0; ni < 2; ++ni) {
            const float a = acc[mi][ni][j], g = acc[mi][ni + 2][j];
            p.hbuf[(size_t)slot * DEXP + ct * 64 + wc * 32 + ni * 16 + fr] = f2bf(silu_f(a) * g);
          }
        }
      }
  }
}

DEV void phase_moe2(const Params& p, int l, int bid, int nb, char* smem) {
  const int tid = fresh_tid(), lane = tid & 63, wid = tid >> 6, wr = wid >> 1, wc = wid & 1, fr = lane & 15,
            fq = lane >> 4;
  const int* cnt = p.cnt + l * NEXP;
  for (int tile = bid;; tile += nb) {
    int e, rt, ct, valid;
    if (!moe_tile(cnt, tile, e, rt, ct, valid)) break;
    const int* lst = p.list + e * CAP + rt * 256;
    const float* W2 = p.ew2 + (size_t)(l * NEXP + e) * DEXP * DM;
    f32x4 acc[4][4];
    gemm_tile(
        DEXP,
        [&](int m) {
          const int slot = lst[(m < valid) ? m : 0];
          return p.hbuf + (size_t)slot * DEXP;
        },
        [&](int k, int n) { return W2[(size_t)k * DM + ct * 128 + n]; }, acc, smem);
#pragma unroll
    for (int mi = 0; mi < 4; ++mi)
#pragma unroll
      for (int j = 0; j < 4; ++j) {
        const int ml = wr * 64 + mi * 16 + fq * 4 + j;
        if (ml < valid) {
          const int slot = lst[ml];
          const float g = p.sgate[slot];
#pragma unroll
          for (int ni = 0; ni < 4; ++ni)
            p.ybuf[(size_t)slot * DM + ct * 128 + wc * 64 + ni * 16 + fr] = f2bf(g * acc[mi][ni][j]);
        }
      }
  }
}

DEV void phase_combine(const Params& p, int l, int bid, int nb) {
  const int tid_ = fresh_tid(), lane = tid_ & 63, wid = tid_ >> 6;
  for (int t = bid * NWAVE + wid; t < NTOK; t += nb * NWAVE) {
    float4* xr = (float4*)(p.xbuf + (size_t)t * DM);
    const int b = t / T;
    const float* md = p.mod + (l * 2 + b) * 6144;
    float4 v[4];
    float ss = 0.f;
#pragma unroll
    for (int i = 0; i < 4; ++i) {
      const int idx = (lane + 64 * i) * 4;
      v[i] = xr[lane + 64 * i];
      const float4 g = *(const float4*)(md + MOD_GATE2 + idx);
      const uint2 ya = *(const uint2*)(p.ybuf + (size_t)(2 * t) * DM + idx);
      const uint2 yb = *(const uint2*)(p.ybuf + (size_t)(2 * t + 1) * DM + idx);
      v[i].x += g.x * (__uint_as_float(ya.x << 16) + __uint_as_float(yb.x << 16));
      v[i].y += g.y * (__uint_as_float(ya.x & 0xffff0000u) + __uint_as_float(yb.x & 0xffff0000u));
      v[i].z += g.z * (__uint_as_float(ya.y << 16) + __uint_as_float(yb.y << 16));
      v[i].w += g.w * (__uint_as_float(ya.y & 0xffff0000u) + __uint_as_float(yb.y & 0xffff0000u));
      ss += v[i].x * v[i].x + v[i].y * v[i].y + v[i].z * v[i].z + v[i].w * v[i].w;
    }
    ss = wave_sum(ss);
    const float rstd = rsqrtf(ss * (1.f / DM) + EPS);
    if (l + 1 < DEPTH) {
#pragma unroll
      for (int i = 0; i < 4; ++i) xr[lane + 64 * i] = v[i];
      const float* md2 = p.mod + ((l + 1) * 2 + b) * 6144;
      norm_mod_store(v, rstd, p.norm_mix_w + (l + 1) * DM, md2 + MOD_SCALE1, md2 + MOD_SHIFT1,
                     p.act + (size_t)t * DM, lane);
    } else {
      float4* orow = (float4*)(p.out + (size_t)t * DM);
#pragma unroll
      for (int i = 0; i < 4; ++i) {
        const float4 w = *(const float4*)(p.final_w + (lane + 64 * i) * 4);
        float4 r;
        r.x = v[i].x * rstd * w.x;
        r.y = v[i].y * rstd * w.y;
        r.z = v[i].z * rstd * w.z;
        r.w = v[i].w * rstd * w.w;
        orow[lane + 64 * i] = r;
      }
    }
  }
}

#define XB_TMO      128
#define XB_XCNT(j)  (256  + 64 * (j))
#define XB_XSUB(j)  (1280 + 64 * (j))
#define XB_XGEN(j)  (2304 + 64 * (j))
#define XB_TOP      3328
#define XB_TOPGEN   3392
#define XCD_BAR_WORDS 3456
#define XB_SPIN_CAP (1u << 22)
#define LAS __attribute__((address_space(3)))

DEV unsigned xb_ld(unsigned* p) { return __hip_atomic_load(p, __ATOMIC_RELAXED, __HIP_MEMORY_SCOPE_AGENT); }
DEV unsigned xb_add(unsigned* p, unsigned v) { return __hip_atomic_fetch_add(p, v, __ATOMIC_RELAXED, __HIP_MEMORY_SCOPE_AGENT); }
DEV unsigned xb_xcc_id() { return (unsigned)__builtin_amdgcn_s_getreg((3 << 11) | 20) & 0xFu; }
#define XB_SPIN(cond, bar) do { unsigned _sp = 0; while (cond) { __builtin_amdgcn_s_sleep(1); \
    if ((++_sp & 255u) == 0u) { if (xb_ld(&(bar)[XB_TMO])) break; if (_sp > XB_SPIN_CAP) { atomicAdd(&(bar)[XB_TMO], 1u); break; } } } } while (0)

DEV void xcd_barrier_post(unsigned* bar) {
  if (threadIdx.x == 0) (void)xb_add(&bar[XB_XCNT(xb_xcc_id())], 1u);
}
DEV void xcd_barrier_complete(unsigned* bar, unsigned x, unsigned& nloc, unsigned& nx) {
  const unsigned G = gridDim.x * gridDim.y * gridDim.z;
  unsigned sum, cnt, mine, sp = 0u;
  for (;;) {
    sum = 0u; cnt = 0u; mine = 0u;
#pragma unroll
    for (unsigned j = 0; j < 16; ++j) {
      const unsigned c = xb_ld(&bar[XB_XCNT(j)]);
      sum += c;
      cnt += (c > 0u) ? 1u : 0u;
      mine = (j == x) ? c : mine;
    }
    if (sum == G) break;
    __builtin_amdgcn_s_sleep(1);
    if ((++sp & 255u) == 0u) {
      if (xb_ld(&bar[XB_TMO])) break;
      if (sp > XB_SPIN_CAP) { atomicAdd(&bar[XB_TMO], 1u); break; }
    }
  }
  nloc = mine > 0u ? mine : 1u;
  nx = cnt > 0u ? cnt : 1u;
}
DEV void xcd_barrier(unsigned* bar, volatile LAS unsigned* st) {
  asm volatile("s_waitcnt vmcnt(0)" ::: "memory");
  __syncthreads();
  if (threadIdx.x == 0) {
    const unsigned bx = xb_xcc_id();
    __builtin_amdgcn_s_waitcnt(0);
    unsigned nloc = st[0], nx = st[1];
    if (nloc == 0u) {
      xcd_barrier_complete(bar, bx, nloc, nx);
      st[0] = nloc;
      st[1] = nx;
    }
    const unsigned old = xb_add(&bar[XB_XSUB(bx)], 1u);
    const unsigned gen = old / nloc;
    if (old + 1u == (gen + 1u) * nloc) {
      __builtin_amdgcn_fence(__ATOMIC_RELEASE, "agent");
      asm volatile("s_waitcnt vmcnt(0)" ::: "memory");
      const unsigned og = xb_add(&bar[XB_TOP], 1u);
      const unsigned tg = og / nx;
      if (og + 1u == (tg + 1u) * nx) xb_add(&bar[XB_TOPGEN], 1u);
      else XB_SPIN(xb_ld(&bar[XB_TOPGEN]) == tg, bar);
      __builtin_amdgcn_fence(__ATOMIC_ACQUIRE, "agent");
      xb_add(&bar[XB_XGEN(bx)], 1u);
      asm volatile("s_waitcnt vmcnt(0)" ::: "memory");
    } else {
      XB_SPIN(xb_ld(&bar[XB_XGEN(bx)]) == gen, bar);
      __builtin_amdgcn_fence(__ATOMIC_ACQUIRE, "agent");
      asm volatile("s_waitcnt vmcnt(0)" ::: "memory");
    }
  }
  __syncthreads();
}

__global__ void __launch_bounds__(NTHR) mega_kernel(Params p) {
  __shared__ __attribute__((aligned(16))) char smem[SMEM_BYTES + 16];
  cg::grid_group grid = cg::this_grid();
  const int bid = blockIdx.x, nb = gridDim.x;
  if (threadIdx.x == 0) *(uint4*)(smem + SMEM_BYTES) = make_uint4(0u, 0u, 0u, 0u);
  __syncthreads();
  xcd_barrier_post(p.bar);
  phase_ada(p, bid, nb, smem);
  grid.sync();
  phase_hmix(p, 0, p.x, bid, nb);
  xcd_barrier(p.bar, (volatile LAS unsigned*)(smem + SMEM_BYTES));
#pragma unroll 1
  for (int l = 0; l < DEPTH; ++l) {
    phase_gemm_proj(p, l, bid, nb, smem);
    xcd_barrier(p.bar, (volatile LAS unsigned*)(smem + SMEM_BYTES));
    phase_gdn_prep(p, l, bid, nb, smem);
    xcd_barrier(p.bar, (volatile LAS unsigned*)(smem + SMEM_BYTES));
    if (bid < 16) {
      phase_gdn_scan(p, bid, smem);
    } else {
      phase_conv(p, l, bid - 16, nb - 16);
      phase_na(p, l, (bid - 16) * NWAVE + (fresh_tid() >> 6), (nb - 16) * NWAVE);
    }
    xcd_barrier(p.bar, (volatile LAS unsigned*)(smem + SMEM_BYTES));
    phase_gdn_fin(p, l, bid, nb);
    xcd_barrier(p.bar, (volatile LAS unsigned*)(smem + SMEM_BYTES));
    phase_gemm_wout(p, l, l == 0 ? p.x : p.xbuf, bid, nb, smem);
    xcd_barrier(p.bar, (volatile LAS unsigned*)(smem + SMEM_BYTES));
    phase_router(p, l, bid, nb);
    xcd_barrier(p.bar, (volatile LAS unsigned*)(smem + SMEM_BYTES));
    phase_moe1(p, l, bid, nb, smem);
    xcd_barrier(p.bar, (volatile LAS unsigned*)(smem + SMEM_BYTES));
    phase_moe2(p, l, bid, nb, smem);
    xcd_barrier(p.bar, (volatile LAS unsigned*)(smem + SMEM_BYTES));
    phase_combine(p, l, bid, nb);
    if (l + 1 < DEPTH) xcd_barrier(p.bar, (volatile LAS unsigned*)(smem + SMEM_BYTES));
  }
}

extern "C" void kernel_launch(void* const* d_in, const int* in_sizes, int n_in, void* d_out, int out_size,
                              void* d_ws, size_t ws_size, hipStream_t stream) {
  Params p{};
  p.x = (const float*)d_in[0];
  p.c = (const float*)d_in[1];
  p.norm_mix_w = (const float*)d_in[2];
  p.norm_ffn_w = (const float*)d_in[3];
  p.w_ada = (const float*)d_in[4];
  p.b_ada = (const float*)d_in[5];
  p.w_in = (const float*)d_in[6];
  p.conv_a_w = (const float*)d_in[7];
  p.na_rpb = (const float*)d_in[8];
  p.gdn_conv_w = (const float*)d_in[9];
  p.gdn_a_log = (const float*)d_in[10];
  p.gdn_dt_bias = (const float*)d_in[11];
  p.gdn_norm_w = (const float*)d_in[12];
  p.w_out = (const float*)d_in[13];
  p.rg_w = (const float*)d_in[14];
  p.rg_b = (const float*)d_in[15];
  p.re_w = (const float*)d_in[16];
  p.re_b = (const float*)d_in[17];
  p.ew1 = (const float*)d_in[18];
  p.ew3 = (const float*)d_in[19];
  p.ew2 = (const float*)d_in[20];
  p.final_w = (const float*)d_in[21];
  p.out = (float*)d_out;
  char* ws = (char*)d_ws;
  size_t off = 0;
  auto take = [&](size_t bytes) {
    char* r = ws + off;
    off += (bytes + 255) & ~(size_t)255;
    return r;
  };
  p.bar = (unsigned*)take(sizeof(unsigned) * XCD_BAR_WORDS);
  p.mod = (float*)take(sizeof(float) * DEPTH * NB * 6144);
  p.cnt = (int*)take(sizeof(int) * DEPTH * NEXP);
  p.xbuf = (float*)take(sizeof(float) * (size_t)NTOK * DM);
  p.act = (bf16_t*)take(2 * (size_t)NTOK * DM);
  p.proj = (bf16_t*)take(2 * (size_t)NTOK * PROJW);
  p.gates = (float*)take(sizeof(float) * (size_t)NTOK * 16);
  p.y = (bf16_t*)take(2 * (size_t)NTOK * DM);
  p.list = (int*)take(sizeof(int) * NEXP * CAP);
  p.sgate = (float*)take(sizeof(float) * 2 * NTOK);
  p.egl = (float*)take(sizeof(float) * 2048);
  p.obuf = (float*)take(sizeof(float) * 2 * (size_t)NTOK * 512);
  p.gdn_rec = (char*)take((size_t)2048 * REC_BYTES);
  p.gdn_u = (unsigned*)take(sizeof(unsigned) * (size_t)2048 * 32 * 128);
  p.hbuf = (bf16_t*)p.obuf;
  p.ybuf = (bf16_t*)p.gdn_rec;
  if (off > ws_size) fprintf(stderr, "workspace too small: need %zu have %zu\n", off, ws_size);

  static int grid_blocks = 0;
  if (!grid_blocks) {
    int dev = 0, cus = 0, per_cu = 0;
    (void)hipGetDevice(&dev);
    (void)hipDeviceGetAttribute(&cus, hipDeviceAttributeMultiprocessorCount, dev);
    (void)hipOccupancyMaxActiveBlocksPerMultiprocessor(&per_cu, mega_kernel, NTHR, 0);
    if (per_cu > 1) per_cu = 1;
    if (per_cu < 1) per_cu = 1;
    grid_blocks = cus * per_cu;
  }
  (void)hipMemsetAsync(p.bar, 0, sizeof(unsigned) * XCD_BAR_WORDS, stream);
  void* args[] = {&p};
  hipError_t e = hipLaunchCooperativeKernel((void*)mega_kernel, dim3(grid_blocks), dim3(NTHR), args, 0, stream);
  if (e != hipSuccess) fprintf(stderr, "cooperative launch failed: %s (grid %d)\n", hipGetErrorString(e), grid_blocks);
}
```

```cpp
#include <hip/hip_runtime.h>
#include <hip/hip_cooperative_groups.h>
#include <stdint.h>
#include <stdio.h>

#define DEV __device__ __forceinline__
namespace cg = cooperative_groups;

typedef __attribute__((ext_vector_type(8))) short bf16x8;
typedef __attribute__((ext_vector_type(4))) float f32x4;
typedef __attribute__((ext_vector_type(16))) float f32x16;
typedef float f32x2_t __attribute__((ext_vector_type(2)));
typedef __bf16 bf16x2_t __attribute__((ext_vector_type(2)));
typedef unsigned short bf16_t;
typedef unsigned u32x4 __attribute__((ext_vector_type(4)));

constexpr int NTHR = 512;
constexpr int NWAVE = 8;
constexpr int DM = 1024;
constexpr int NB = 2;
constexpr int T = 8192;
constexpr int NTOK = NB * T;
constexpr int DEPTH = 2;
constexpr int DIN = 3600;
constexpr int PROJW = 3584;
constexpr int NEXP = 32;
constexpr int DEXP = 512;
constexpr int CAP = 16384;
constexpr float EPS = 1e-6f;
constexpr int OFF_CB = 0, OFF_CC = 256, OFF_CX = 512, OFF_NQ = 768, OFF_NK = 1024, OFF_NV = 1280,
              OFF_GQKV = 1536, OFF_GZ = 3072;
constexpr int MOD_SHIFT1 = 0, MOD_SCALE1 = 1024, MOD_GATE1 = 2048, MOD_SHIFT2 = 3072, MOD_SCALE2 = 4096,
              MOD_GATE2 = 5120;

constexpr int REC_WN = 0, REC_QD = 16384, REC_IN = 32768, REC_KT = 40960, REC_BYTES = 57344;
constexpr int SC_WN = 0, SC_QD = 17408, SC_IN = 34816, SC_KT = 44032, SC_U = 62464, SC_BUF = 78848;
constexpr int PL_Q = 0, PL_K = 17408, PL_V = 34816, PL_L = 52224, PL_GC = 87040, PL_BETA = 87552, PL_BG = 88064,
              PL_GL = 88576;
constexpr int SMEM_BYTES = 2 * SC_BUF;

struct Params {
  const float *x, *c, *norm_mix_w, *norm_ffn_w, *w_ada, *b_ada, *w_in, *conv_a_w, *na_rpb, *gdn_conv_w,
      *gdn_a_log, *gdn_dt_bias, *gdn_norm_w, *w_out, *rg_w, *rg_b, *re_w, *re_b, *ew1, *ew3, *ew2, *final_w;
  float* out;
  float* mod;
  int* cnt;
  float* xbuf;
  bf16_t* act;
  bf16_t* proj;
  float* gates;
  bf16_t* y;
  bf16_t* obuf;
  char* gdn_rec;
  unsigned* gdn_u;
  float* egl;
  bf16_t* hbuf;
  bf16_t* ybuf;
  int* list;
  float* sgate;
  bf16_t* btin;
  bf16_t* btg;
  bf16_t* btout;
  bf16_t* bt1;
  bf16_t* bt2;
  float* wcat;
  float* wsc2;
  float* c0;
  unsigned* bar;
  int rep[12];
  int wv;
};

DEV unsigned pack2(float a, float b) {
  f32x2_t v = {a, b};
  return __builtin_bit_cast(unsigned, __builtin_convertvector(v, bf16x2_t));
}
DEV bf16_t f2bf(float f) { return (bf16_t)(pack2(f, 0.f) & 0xffffu); }
DEV float bf2f(bf16_t h) { return __uint_as_float(((unsigned)h) << 16); }
DEV float silu_f(float x) { return x / (1.f + __expf(-x)); }
DEV float sigmoid_f(float x) { return 1.f / (1.f + __expf(-x)); }
DEV float softplus_f(float x) { return fmaxf(x, 0.f) + log1pf(__expf(-fabsf(x))); }
DEV float shx(float v, int k, int lane) {
  return __int_as_float(__builtin_amdgcn_ds_bpermute((lane ^ k) << 2, __float_as_int(v)));
}
DEV float wave_sum(float v, int lane) {
#pragma unroll
  for (int o = 32; o > 0; o >>= 1) v += shx(v, o, lane);
  return v;
}
DEV int fresh_tid_w(int wv) {
  unsigned z = 0u;
  asm volatile("" : "+s"(wv), "+v"(z));
  int t = (wv << 6) | (int)__builtin_amdgcn_mbcnt_hi(~0u, __builtin_amdgcn_mbcnt_lo(~0u, z));
  asm volatile("" : "+v"(t));
  return t;
}
#define fresh_tid() fresh_tid_w(p.wv)
DEV void unpack8(uint4 u, float* f) {
  f[0] = __uint_as_float(u.x << 16);
  f[1] = __uint_as_float(u.x & 0xffff0000u);
  f[2] = __uint_as_float(u.y << 16);
  f[3] = __uint_as_float(u.y & 0xffff0000u);
  f[4] = __uint_as_float(u.z << 16);
  f[5] = __uint_as_float(u.z & 0xffff0000u);
  f[6] = __uint_as_float(u.w << 16);
  f[7] = __uint_as_float(u.w & 0xffff0000u);
}
DEV uint4 pack8(const float* f) {
  uint4 r;
  r.x = pack2(f[0], f[1]);
  r.y = pack2(f[2], f[3]);
  r.z = pack2(f[4], f[5]);
  r.w = pack2(f[6], f[7]);
  return r;
}
#define MFMA16(a, b, c) __builtin_amdgcn_mfma_f32_16x16x32_bf16((a), (b), (c), 0, 0, 0)
#define MFMA32(a, b, c) __builtin_amdgcn_mfma_f32_32x32x16_bf16((a), (b), (c), 0, 0, 0)

#define LAS __attribute__((address_space(3)))
constexpr int G_BK = 64, G_HALF = 128, G_HTB = G_HALF * G_BK * 2, G_STAGE_BYTES = 8 * G_HTB;
DEV int g_lds_byte(int r, int c) {
  const int st = (r >> 4) * 2 + (c >> 5), rr = r & 15, cc = c & 31, ob = rr * 64 + cc * 2;
  return st * 1024 + (ob ^ (((ob >> 9) & 1) << 5));
}
DEV void g_stage_rc(int b, int& R, int& C) {
  const int st = b / 1024, sb = b % 1024, swz = sb ^ (((sb >> 9) & 1) << 5);
  R = (st >> 1) * 16 + swz / 64;
  C = (st & 1) * 32 + (swz % 64) / 2;
}
DEV int g_perm32(int rho) { const int n = rho >> 4, i = rho & 15; return 8 * (i >> 2) + 4 * n + (i & 3); }

struct GUnit { int pm, pn, e, valid; };

template <class Epi, class Sched>
DEV void gemm_phase(LAS unsigned char* lds, const Sched& S, const Epi& E) {
  const int tid = fresh_tid_w(S.wv), wid = S.wv, lane = tid & 63, wr = wid >> 2, wc = wid & 3, fr = lane & 15,
            fq = lane >> 4;
  const int K = S.K, nt = K / G_BK;
  GUnit cur, nxt;
  int ui = 0;
  if (!S.next(0, cur)) return;
  unsigned voffB[2];
#pragma unroll
  for (int i = 0; i < 2; ++i) {
    int R, C;
    g_stage_rc(tid * 16 + i * 8192, R, C);
    const int Rb = Epi::PERM ? ((R & ~31) + g_perm32(R & 31)) : R;
    voffB[i] = (unsigned)(Rb * K + C) * 2u;
  }
  unsigned vA[2][2];
  auto a_offsets = [&](const GUnit& u) {
#pragma unroll
    for (int h = 0; h < 2; ++h)
#pragma unroll
      for (int i = 0; i < 2; ++i) {
        int R, C;
        g_stage_rc(tid * 16 + i * 8192, R, C);
        vA[h][i] = S.rowoff(u, h * G_HALF + R) + (unsigned)C * 2u;
      }
  };
  const size_t kstep = (size_t)(G_BK * 2);
  const size_t hstep = (size_t)G_HALF * K * 2;
  const unsigned ldsw = (unsigned)wid * 1024u;
  const int aoff = g_lds_byte(wr * 64 + fr, fq * 8), boff = g_lds_byte(wc * 32 + fr, fq * 8);
#define PG8_SA(b, h) (((b) * 2 + (h)) * G_HTB)
#define PG8_SB(b, h) ((4 + (b) * 2 + (h)) * G_HTB)
#define PG8_STAGE(bufoff, gbase, voff) do { _Pragma("unroll") for (int _i = 0; _i < 2; ++_i) \
    __builtin_amdgcn_global_load_lds((const unsigned*)((const char*)(gbase) + (voff)[_i]), (LAS unsigned*)(lds + (bufoff) + ldsw + _i * 8192), 16, 0, 0); } while (0)
#define PG8_LDA(dst, b, h) do { _Pragma("unroll") for (int m = 0; m < 4; ++m) _Pragma("unroll") for (int k = 0; k < 2; ++k) dst[m][k] = *(const LAS bf16x8*)(lds + PG8_SA(b, h) + aoff + m * 2048 + k * 1024); } while (0)
#define PG8_LDB(dst, b, h) do { _Pragma("unroll") for (int n = 0; n < 2; ++n) _Pragma("unroll") for (int k = 0; k < 2; ++k) dst[n][k] = *(const LAS bf16x8*)(lds + PG8_SB(b, h) + boff + n * 2048 + k * 1024); } while (0)
#define PG8_MMA(ai, bj, At, Bt) do { __builtin_amdgcn_s_setprio(1); _Pragma("unroll") for (int m = 0; m < 4; ++m) _Pragma("unroll") for (int n = 0; n < 2; ++n) _Pragma("unroll") for (int k = 0; k < 2; ++k) \
    acc[ai][bj][m][n] = __builtin_amdgcn_mfma_f32_16x16x32_bf16(Bt[n][k], At[m][k], acc[ai][bj][m][n], 0, 0, 0); __builtin_amdgcn_s_setprio(0); } while (0)
#define PG8_WAIT_V(n) asm volatile("s_waitcnt vmcnt(" #n ")" ::: "memory")
#define PG8_WAIT_L(n) asm volatile("s_waitcnt lgkmcnt(" #n ")" ::: "memory")
#define PG8_BAR __builtin_amdgcn_s_barrier()
#define PG8_SCHED __builtin_amdgcn_sched_barrier(0)
  f32x4 acc[2][2][4][2];
#pragma unroll
  for (int a = 0; a < 2; ++a)
#pragma unroll
    for (int b = 0; b < 2; ++b)
#pragma unroll
      for (int m = 0; m < 4; ++m)
#pragma unroll
        for (int n = 0; n < 2; ++n) acc[a][b][m][n] = (f32x4){0.f, 0.f, 0.f, 0.f};
  bf16x8 At[4][2], B0[2][2], B1[2][2];
  const char* const gA = (const char*)S.A;
  const char* cB = S.bptr(cur);
  a_offsets(cur);
  PG8_STAGE(PG8_SB(0, 0), cB, voffB); PG8_STAGE(PG8_SA(0, 0), gA, vA[0]); PG8_STAGE(PG8_SB(0, 1), cB + hstep, voffB); PG8_STAGE(PG8_SA(0, 1), gA, vA[1]);
  if (wr == 1) PG8_BAR;
  PG8_WAIT_V(4); PG8_BAR;
  PG8_STAGE(PG8_SB(1, 0), cB + kstep, voffB); PG8_STAGE(PG8_SA(1, 0), gA + kstep, vA[0]); PG8_STAGE(PG8_SB(1, 1), cB + hstep + kstep, voffB);
  PG8_WAIT_V(6); PG8_BAR;
  for (;;) {
    const bool has_next = S.next(ui + 1, nxt);
    const char* nB = has_next ? S.bptr(nxt) : cB;
    for (int t = 0; t < nt; t += 2) {
      const bool last = (t == nt - 2);
      const char* a1 = gA + (size_t)(t + 1) * kstep;
      const char* a2 = last ? gA : gA + (size_t)(t + 2) * kstep;
      const char* b2 = last ? nB : cB + (size_t)(t + 2) * kstep;
      const char* a3 = a2 + kstep; const char* b3 = b2 + kstep;
      PG8_LDB(B0, 0, 0); PG8_SCHED; PG8_LDA(At, 0, 0); PG8_STAGE(PG8_SA(1, 1), a1, vA[1]);
      PG8_WAIT_L(8); PG8_BAR; PG8_WAIT_L(0); PG8_MMA(0, 0, At, B0); PG8_BAR; PG8_SCHED;
      if (last && has_next) a_offsets(nxt);
      PG8_LDB(B1, 0, 1); PG8_STAGE(PG8_SB(0, 0), b2, voffB);
      PG8_BAR; PG8_WAIT_L(0); PG8_MMA(0, 1, At, B1); PG8_BAR;
      PG8_LDA(At, 0, 1); PG8_STAGE(PG8_SA(0, 0), a2, vA[0]);
      PG8_BAR; PG8_WAIT_L(0); PG8_MMA(1, 0, At, B0); PG8_BAR; PG8_SCHED;
      PG8_STAGE(PG8_SB(0, 1), b2 + hstep, voffB);
      PG8_WAIT_V(6); PG8_BAR; PG8_MMA(1, 1, At, B1); PG8_BAR;
      PG8_LDB(B0, 1, 0); PG8_SCHED; PG8_LDA(At, 1, 0); PG8_STAGE(PG8_SA(0, 1), a2, vA[1]);
      PG8_WAIT_L(8); PG8_BAR; PG8_WAIT_L(0); PG8_MMA(0, 0, At, B0); PG8_BAR; PG8_SCHED;
      PG8_LDB(B1, 1, 1); PG8_STAGE(PG8_SB(1, 0), b3, voffB);
      PG8_BAR; PG8_WAIT_L(0); PG8_MMA(0, 1, At, B1); PG8_BAR;
      PG8_LDA(At, 1, 1); PG8_STAGE(PG8_SA(1, 0), a3, vA[0]);
      PG8_BAR; PG8_WAIT_L(0); PG8_MMA(1, 0, At, B0); PG8_BAR; PG8_SCHED;
      PG8_STAGE(PG8_SB(1, 1), b3 + hstep, voffB);
      PG8_WAIT_V(6); PG8_BAR; PG8_MMA(1, 1, At, B1); PG8_BAR;
    }
    E(acc, cur, wr, wc, fr, fq);
    if (!has_next) break;
#pragma unroll
    for (int a = 0; a < 2; ++a)
#pragma unroll
      for (int b = 0; b < 2; ++b)
#pragma unroll
        for (int m = 0; m < 4; ++m)
#pragma unroll
          for (int n = 0; n < 2; ++n) acc[a][b][m][n] = (f32x4){0.f, 0.f, 0.f, 0.f};
    cur = nxt; cB = nB; ++ui;
  }
  PG8_WAIT_V(0);
  if (wr == 0) PG8_BAR;
  PG8_BAR;
#undef PG8_SA
#undef PG8_SB
#undef PG8_STAGE
#undef PG8_LDA
#undef PG8_LDB
#undef PG8_MMA
#undef PG8_WAIT_V
#undef PG8_WAIT_L
#undef PG8_BAR
#undef PG8_SCHED
}

struct DenseSched {
  const bf16_t* A; const bf16_t* Bt; int K, nM, nN, nwg, G, c, wv;
  DEV bool next(int i, GUnit& u) const {
    const long L = (long)i * G + c;
    if (L >= nwg) return false;
    int wgid = (int)L;
    { const int q = nwg / 8, r = nwg % 8, xcd = wgid % 8, off = wgid / 8; wgid = (xcd < r ? xcd * (q + 1) : r * (q + 1) + (xcd - r) * q) + off; }
    const int nig = 8 * nN, gid = wgid / nig, fm = gid * 8;
    u.pm = fm + ((wgid % nig) & 7);
    u.pn = (wgid % nig) >> 3;
    u.e = 0;
    u.valid = 256;
    return true;
  }
  DEV unsigned rowoff(const GUnit& u, int row) const { return (unsigned)((u.pm * 256 + row) * K) * 2u; }
  DEV const char* bptr(const GUnit& u) const { return (const char*)Bt + (size_t)u.pn * 256 * K * 2; }
};
struct MoeSched {
  const bf16_t* A; const bf16_t* Bt; int K; const int* cnt; const int* list; int G, c, shift, wv;
  DEV bool next(int i, GUnit& u) const {
    int L = i * G + c;
    for (int e = 0; e < NEXP; ++e) {
      const int cn = cnt[e];
      const int ntl = ((cn + 255) >> 8) * 4;
      if (L < ntl) {
        u.e = e; u.pm = L >> 2; u.pn = L & 3; u.valid = min(256, cn - u.pm * 256);
        return true;
      }
      L -= ntl;
    }
    return false;
  }
  DEV unsigned rowoff(const GUnit& u, int row) const {
    const int slot = list[u.e * CAP + u.pm * 256 + min(row, u.valid - 1)];
    return (unsigned)((slot >> shift) * K) * 2u;
  }
  DEV const char* bptr(const GUnit& u) const { return (const char*)Bt + ((size_t)u.e * 1024 + u.pn * 256) * K * 2; }
};

DEV void convert_tile(const float* src, int ld, int k0, int n0, bf16_t* dst, int drow0, int dK, float* tl, int tid) {
  {
    const int kk = tid >> 4, n4 = tid & 15;
    const float4 a = *(const float4*)(src + (size_t)(k0 + kk) * ld + n0 + n4 * 4);
    const float4 b = *(const float4*)(src + (size_t)(k0 + kk + 32) * ld + n0 + n4 * 4);
    float* r0 = tl + kk * 65 + n4 * 4;
    r0[0] = a.x; r0[1] = a.y; r0[2] = a.z; r0[3] = a.w;
    float* r1 = tl + (kk + 32) * 65 + n4 * 4;
    r1[0] = b.x; r1[1] = b.y; r1[2] = b.z; r1[3] = b.w;
  }
  __syncthreads();
  {
    const int n = tid >> 3, k8 = tid & 7;
    float v[8];
#pragma unroll
    for (int j = 0; j < 8; ++j) v[j] = tl[(k8 * 8 + j) * 65 + n];
    *(uint4*)(dst + (size_t)(drow0 + n) * dK + k0 + k8 * 8) = pack8(v);
  }
  __syncthreads();
}
DEV void convert_gates(const Params& p, int l, int bid, int nb, int tid) {
  const int g = bid * NTHR + tid;
  if (g < 16 * DM) {
    const int j = g >> 10, k = g & (DM - 1);
    p.btg[g] = f2bf(p.w_in[((size_t)l * DM + k) * DIN + PROJW + j]);
  }
}
DEV void convert_win(const Params& p, int l, int bid, int nb, char* smem) {
  const int tid = fresh_tid();
  for (int t = bid; t < 16 * 56; t += nb) {
    const int kt = t / 56, ntile = t - kt * 56;
    convert_tile(p.w_in + (size_t)l * DM * DIN, DIN, kt * 64, ntile * 64, p.btin, ntile * 64, DM, (float*)smem, tid);
  }
  convert_gates(p, l, bid, nb, tid);
}
DEV void convert_layer(const Params& p, int l, int bid, int nb, char* smem) {
  const int tid = fresh_tid();
  float* tl = (float*)smem;
  const int NT_W1 = NEXP * 16 * 8, NT_W2 = NEXP * 8 * 16, NT_WO = 256;
  for (int t = bid; t < 2 * NT_W1 + NT_W2 + NT_WO; t += nb) {
    if (t < 2 * NT_W1) {
      const int which = t / NT_W1, r = t - which * NT_W1;
      const int e = r >> 7, kt = (r >> 3) & 15, ntile = r & 7;
      const float* src = (which ? p.ew3 : p.ew1) + (size_t)(l * NEXP + e) * DM * DEXP;
      const int n0 = ntile * 64;
      const int drow0 = e * 1024 + 256 * (n0 >> 7) + which * 128 + (n0 & 127);
      convert_tile(src, DEXP, kt * 64, n0, p.bt1, drow0, DM, tl, tid);
    } else if (t < 2 * NT_W1 + NT_W2) {
      const int r = t - 2 * NT_W1;
      const int e = r >> 7, kt = (r >> 4) & 7, ntile = r & 15;
      const float* src = p.ew2 + (size_t)(l * NEXP + e) * DEXP * DM;
      convert_tile(src, DM, kt * 64, ntile * 64, p.bt2, e * 1024 + ntile * 64, DEXP, tl, tid);
    } else {
      const int r = t - 2 * NT_W1 - NT_W2;
      const int kt = r >> 4, ntile = r & 15;
      convert_tile(p.w_out + (size_t)l * DM * DM, DM, kt * 64, ntile * 64, p.btout, ntile * 64, DM, tl, tid);
    }
  }
  if (l + 1 < DEPTH) convert_win(p, l + 1, bid, nb, smem);
}

DEV void phase_ada(const Params& p, int bid, int nb, char* smem) {
  float* cond = (float*)smem;
  float* red = cond + 2 * DM;
  const int tid = fresh_tid(), lane = tid & 63, wid = tid >> 6;
  for (int i = tid; i < 2 * DM; i += NTHR) cond[i] = silu_f(p.c[i]);
  __syncthreads();
  for (int item = bid; item < DEPTH * 96; item += nb) {
    const int l = item / 96, j = (item - l * 96) * 64 + lane;
    const float* w = p.w_ada + ((size_t)l * DM + wid * 128) * 6144 + j;
    float a0 = 0.f, a1 = 0.f;
#pragma unroll 16
    for (int k = 0; k < 128; ++k) {
      const float wv = w[(size_t)k * 6144];
      a0 += cond[wid * 128 + k] * wv;
      a1 += cond[DM + wid * 128 + k] * wv;
    }
    red[(wid * 2 + 0) * 64 + lane] = a0;
    red[(wid * 2 + 1) * 64 + lane] = a1;
    __syncthreads();
    if (wid < 2) {
      float s = p.b_ada[l * 6144 + j];
#pragma unroll
      for (int w8 = 0; w8 < 8; ++w8) s += red[(w8 * 2 + wid) * 64 + lane];
      p.mod[(l * 2 + wid) * 6144 + j] = s;
    }
    __syncthreads();
  }
  if (bid == 0 && tid < DEPTH * NEXP) p.cnt[tid] = 0;
}

DEV void norm_mod_store(const float4 (&v)[4], float rstd, const float* nw, const float* sc, const float* sh,
                        bf16_t* dst, int lane) {
#pragma unroll
  for (int i = 0; i < 4; ++i) {
    const int idx = (lane + 64 * i) * 4;
    const float4 w = *(const float4*)(nw + idx);
    const float4 s = *(const float4*)(sc + idx);
    const float4 h = *(const float4*)(sh + idx);
    const float r0 = v[i].x * rstd * w.x * (1.f + s.x) + h.x;
    const float r1 = v[i].y * rstd * w.y * (1.f + s.y) + h.y;
    const float r2 = v[i].z * rstd * w.z * (1.f + s.z) + h.z;
    const float r3 = v[i].w * rstd * w.w * (1.f + s.w) + h.w;
    uint2 pk;
    pk.x = pack2(r0, r1);
    pk.y = pack2(r2, r3);
    *(uint2*)(dst + idx) = pk;
  }
}

DEV void phase_hmix(const Params& p, int l, const float* xin, int bid, int nb) {
  const int tid_ = fresh_tid(), lane = tid_ & 63, wid = tid_ >> 6;
  for (int t = bid * NWAVE + wid; t < NTOK; t += nb * NWAVE) {
    const float4* xr = (const float4*)(xin + (size_t)t * DM);
    float4 v[4];
    float ss = 0.f;
#pragma unroll
    for (int i = 0; i < 4; ++i) {
      v[i] = xr[lane + 64 * i];
      ss += v[i].x * v[i].x + v[i].y * v[i].y + v[i].z * v[i].z + v[i].w * v[i].w;
    }
    ss = wave_sum(ss, lane);
    const float rstd = rsqrtf(ss * (1.f / DM) + EPS);
    const int b = t / T;
    const float* md = p.mod + (l * 2 + b) * 6144;
    norm_mod_store(v, rstd, p.norm_mix_w + l * DM, md + MOD_SCALE1, md + MOD_SHIFT1, p.act + (size_t)t * DM, lane);
  }
}

struct EpiProj {
  static constexpr bool PERM = true;
  bf16_t* O;
  DEV void operator()(const f32x4 (&acc)[2][2][4][2], const GUnit& u, int wr, int wc, int fr, int fq) const {
    const int row0 = u.pm * 256 + wr * 64 + fr, col0 = u.pn * 256 + wc * 32 + 8 * fq;
#pragma unroll
    for (int ai = 0; ai < 2; ++ai)
#pragma unroll
      for (int m = 0; m < 4; ++m) {
        bf16_t* rowp = O + (size_t)(row0 + ai * G_HALF + m * 16) * PROJW + col0;
#pragma unroll
        for (int bj = 0; bj < 2; ++bj) {
          const f32x4 v0 = acc[ai][bj][m][0], v1 = acc[ai][bj][m][1];
          uint4 w;
          w.x = pack2(v0[0], v0[1]); w.y = pack2(v0[2], v0[3]); w.z = pack2(v1[0], v1[1]); w.w = pack2(v1[2], v1[3]);
          *(uint4*)(rowp + bj * G_HALF) = w;
        }
      }
  }
};

DEV void phase_gemm_proj(const Params& p, int l, int bid, int nb, char* smem) {
  DenseSched S;
  S.A = p.act; S.Bt = p.btin; S.K = DM; S.nM = NTOK / 256; S.nN = PROJW / 256; S.nwg = S.nM * S.nN; S.G = nb; S.c = bid; S.wv = p.wv;
  EpiProj E;
  E.O = p.proj;
  gemm_phase((LAS unsigned char*)smem, S, E);
  const int tid = fresh_tid(), lane = tid & 63, wid = tid >> 6, fr = lane & 15, fq = lane >> 4;
  for (int tb = bid; tb < NTOK / 64; tb += nb) {
    if (wid < 4) {
      const int tok0 = tb * 64 + wid * 16;
      const bf16_t* ap = p.act + (size_t)(tok0 + fr) * DM + fq * 8;
      const bf16_t* bp = p.btg + (size_t)fr * DM + fq * 8;
      f32x4 acc = {0.f, 0.f, 0.f, 0.f};
#pragma unroll 8
      for (int ks = 0; ks < DM / 32; ++ks)
        acc = MFMA16(*(const bf16x8*)(ap + ks * 32), *(const bf16x8*)(bp + ks * 32), acc);
#pragma unroll
      for (int j = 0; j < 4; ++j) p.gates[(size_t)(tok0 + fq * 4 + j) * 16 + fr] = acc[j];
    }
  }
}

DEV void phase_conv(const Params& p, int l, int bid, int nb) {
  const float* w = p.conv_a_w + l * 768;
  for (int g = bid * NTHR + fresh_tid(); g < NTOK * 256; g += nb * NTHR) {
    const int t = g >> 8, c = g & 255;
    const int tl = t & (T - 1);
    const bf16_t* r = p.proj + (size_t)t * PROJW;
    const float cb = bf2f(r[OFF_CB + c]);
    const float mid = bf2f(r[OFF_CC + c]) * bf2f(r[OFF_CX + c]);
    float prev = 0.f, next = 0.f;
    if (tl > 0) prev = bf2f(r[OFF_CC + c - PROJW]) * bf2f(r[OFF_CX + c - PROJW]);
    if (tl < T - 1) next = bf2f(r[OFF_CC + c + PROJW]) * bf2f(r[OFF_CX + c + PROJW]);
    const float s = w[c] * prev + w[256 + c] * mid + w[512 + c] * next;
    p.y[(size_t)t * DM + c] = f2bf(cb * s);
  }
}

DEV void phase_na(const Params& p, int l, int wgid, int nwg) {
  const int tid_ = fresh_tid(), lane = tid_ & 63, fr = lane & 15, fq = lane >> 4;
  for (int item = wgid; item < NB * 128 * 4 * 4; item += nwg) {
    const int qg = item & 3, h = (item >> 2) & 3, r = (item >> 4) & 127, b = item >> 11;
    const int rs = min(max(r - 4, 0), 120);
    const int kc0 = (qg == 0) ? 0 : (qg == 1) ? 8 : (qg == 2) ? 24 : 32;
    const int c = qg * 16 + fr;
    const int cs = min(max(c - 8, 0), 48);
    const size_t tq = (size_t)b * T + r * 64 + c;
    bf16x8 bq[2];
#pragma unroll
    for (int ks = 0; ks < 2; ++ks)
      bq[ks] = *(const bf16x8*)(p.proj + tq * PROJW + OFF_NQ + h * 64 + ks * 32 + fq * 8);
    f32x4 sc[16];
#pragma unroll
    for (int tt = 0; tt < 16; ++tt) {
      const int i = tt >> 1, half = tt & 1;
      const size_t kt = (size_t)b * T + (rs + i) * 64 + kc0 + half * 16 + fr;
      const bf16_t* kp = p.proj + kt * PROJW + OFF_NK + h * 64 + fq * 8;
      const bf16x8 a0 = *(const bf16x8*)(kp);
      const bf16x8 a1 = *(const bf16x8*)(kp + 32);
      f32x4 z = {0.f, 0.f, 0.f, 0.f};
      z = MFMA16(a0, bq[0], z);
      sc[tt] = MFMA16(a1, bq[1], z);
    }
    const float* rpb = p.na_rpb + (size_t)(l * 4 + h) * 465;
    float mx = -3.0e38f;
#pragma unroll
    for (int tt = 0; tt < 16; ++tt) {
      const int i = tt >> 1, half = tt & 1;
      const int dr = rs + i - r + 7;
#pragma unroll
      for (int j = 0; j < 4; ++j) {
        const int kcol = kc0 + half * 16 + fq * 4 + j;
        const bool valid = (kcol >= cs) && (kcol < cs + 16);
        const int dc = valid ? (kcol - c + 15) : 0;
        const float s = valid ? (sc[tt][j] * 0.125f + rpb[dr * 31 + dc]) : -3.0e38f;
        sc[tt][j] = s;
        mx = fmaxf(mx, s);
      }
    }
    mx = fmaxf(mx, shx(mx, 16, lane));
    mx = fmaxf(mx, shx(mx, 32, lane));
    float sum = 0.f;
#pragma unroll
    for (int tt = 0; tt < 16; ++tt)
#pragma unroll
      for (int j = 0; j < 4; ++j) {
        const float s = sc[tt][j];
        const float e = (s > -1.0e38f) ? __expf(s - mx) : 0.f;
        sc[tt][j] = e;
        sum += e;
      }
    sum += shx(sum, 16, lane);
    sum += shx(sum, 32, lane);
    const float inv = 1.f / sum;
    f32x4 oacc[4];
#pragma unroll
    for (int nt = 0; nt < 4; ++nt) oacc[nt] = f32x4{0.f, 0.f, 0.f, 0.f};
#pragma unroll
    for (int i = 0; i < 8; ++i) {
      uint4 pu;
      pu.x = pack2(sc[2 * i][0] * inv, sc[2 * i][1] * inv);
      pu.y = pack2(sc[2 * i][2] * inv, sc[2 * i][3] * inv);
      pu.z = pack2(sc[2 * i + 1][0] * inv, sc[2 * i + 1][1] * inv);
      pu.w = pack2(sc[2 * i + 1][2] * inv, sc[2 * i + 1][3] * inv);
      const bf16x8 pa = __builtin_bit_cast(bf16x8, pu);
      const bf16_t* vb = p.proj + ((size_t)b * T + (rs + i) * 64 + kc0 + fq * 4) * PROJW + OFF_NV + h * 64 + fr;
#pragma unroll
      for (int nt = 0; nt < 4; ++nt) {
        bf16x8 bv;
#pragma unroll
        for (int j = 0; j < 4; ++j) {
          bv[j] = (short)vb[(size_t)j * PROJW + nt * 16];
          bv[4 + j] = (short)vb[(size_t)(16 + j) * PROJW + nt * 16];
        }
        oacc[nt] = MFMA16(pa, bv, oacc[nt]);
      }
    }
#pragma unroll
    for (int nt = 0; nt < 4; ++nt)
#pragma unroll
      for (int j = 0; j < 4; ++j)
        p.y[((size_t)b * T + r * 64 + qg * 16 + fq * 4 + j) * DM + 256 + h * 64 + nt * 16 + fr] = f2bf(oacc[nt][j]);
  }
}

template <int POS>
struct SolveStep {
  static DEV void run(float (&x)[64], const float* Ld, const float* sclv, const bf16_t* src, int dir, bool isu,
                      unsigned* up, bf16_t* wp) {
    SolveStep<POS - 1>::run(x, Ld, sclv, src, dir, isu, up, wp);
    const int i = dir ? 63 - POS : POS;
    float a = sclv[POS] * bf2f(src[i * 136]);
#pragma unroll
    for (int j4 = 0; j4 < (POS + 3) / 4; ++j4) {
      const float4 lv = *(const float4*)(Ld + POS * 68 + j4 * 4);
      a -= lv.x * x[j4 * 4];
      if (j4 * 4 + 1 < POS) a -= lv.y * x[j4 * 4 + 1];
      if (j4 * 4 + 2 < POS) a -= lv.z * x[j4 * 4 + 2];
      if (j4 * 4 + 3 < POS) a -= lv.w * x[j4 * 4 + 3];
    }
    x[POS] = a;
    if (isu) {
      if (POS & 1) up[(POS >> 1) * 128] = pack2(x[POS - 1], a);
    } else {
      wp[POS * 128] = f2bf(-a);
    }
    asm volatile("" ::: "memory");
  }
};
template <>
struct SolveStep<-1> {
  static DEV void run(float (&)[64], const float*, const float*, const bf16_t*, int, bool, unsigned*, bf16_t*) {}
};

DEV void phase_gdn_prep(const Params& p, int l, int bid, int nb, char* smem) {
  const int tid = fresh_tid(), lane = tid & 63;
  bf16_t* q_bf = (bf16_t*)(smem + PL_Q);
  bf16_t* k_bf = (bf16_t*)(smem + PL_K);
  bf16_t* v_bf = (bf16_t*)(smem + PL_V);
  float* Lm = (float*)(smem + PL_L);
  float* gcl = (float*)(smem + PL_GC);
  float* bl = (float*)(smem + PL_BETA);
  float* bgl = (float*)(smem + PL_BG);
  float* gll = (float*)(smem + PL_GL);
  const float* cw = p.gdn_conv_w + l * 4608;
  for (int item = bid; item < 1024; item += nb) {
    const int b = item >> 9, h = (item >> 7) & 3, n = item & 127;
    const int t0 = b * T + n * 64;
    char* rec0 = p.gdn_rec + (size_t)item * 2 * REC_BYTES;
    if (tid < 128) {
      const int dir = tid >> 6;
      const int i = dir ? 63 - lane : lane;
      const size_t t = (size_t)t0 + i;
      const float a = p.gates[t * 16 + dir * 4 + h], bb = p.gates[t * 16 + 8 + dir * 4 + h];
      const float g = -__expf(p.gdn_a_log[l * 8 + dir * 4 + h]) * softplus_f(a + p.gdn_dt_bias[l * 8 + dir * 4 + h]);
      const float beta = sigmoid_f(bb);
      float cs = g;
#pragma unroll
      for (int o = 1; o < 64; o <<= 1) {
        const float v = __int_as_float(__builtin_amdgcn_ds_bpermute((lane - o) << 2, __float_as_int(cs)));
        if (lane >= o) cs += v;
      }
      gcl[dir * 64 + lane] = cs;
      bl[dir * 64 + lane] = beta;
      bgl[dir * 64 + lane] = beta * __expf(cs);
      const float last = __uint_as_float(__builtin_amdgcn_readlane(__float_as_uint(cs), 63));
      if (lane == 0) {
        gll[dir] = last;
        p.egl[item * 2 + dir] = __expf(last);
      }
    }
    __syncthreads();
    {
      int tA = tid;
      asm volatile("" : "+v"(tA));
      const int i = tA >> 3, oc = tA & 7, d0 = oc * 16;
      const int tl = n * 64 + i;
      const bf16_t* rowp = p.proj + (size_t)(t0 + i) * PROJW + OFF_GQKV + h * 128 + d0;
#pragma unroll 1
      for (int m = 0; m < 3; ++m) {
        const bf16_t* rp = rowp + m * 512;
        float x0[16], x1[16], x2[16], val[16];
        unpack8(*(const uint4*)(rp), x1);
        unpack8(*(const uint4*)(rp + 8), x1 + 8);
        if (tl > 0) {
          unpack8(*(const uint4*)(rp - PROJW), x0);
          unpack8(*(const uint4*)(rp - PROJW + 8), x0 + 8);
        } else {
#pragma unroll
          for (int e = 0; e < 16; ++e) x0[e] = 0.f;
        }
        if (tl < T - 1) {
          unpack8(*(const uint4*)(rp + PROJW), x2);
          unpack8(*(const uint4*)(rp + PROJW + 8), x2 + 8);
        } else {
#pragma unroll
          for (int e = 0; e < 16; ++e) x2[e] = 0.f;
        }
        const float* cwm = cw + m * 512 + h * 128 + d0;
        float ss = 0.f;
#pragma unroll
        for (int e = 0; e < 16; ++e) {
          val[e] = silu_f(cwm[e] * x0[e] + cwm[1536 + e] * x1[e] + cwm[3072 + e] * x2[e]);
          ss += val[e] * val[e];
        }
        if (m < 2) {
          ss += shx(ss, 1, lane);
          ss += shx(ss, 2, lane);
          ss += shx(ss, 4, lane);
          float sc = rsqrtf(ss + EPS);
          if (m == 0) sc *= 0.08838834764831845f;
#pragma unroll
          for (int e = 0; e < 16; ++e) val[e] *= sc;
        }
        bf16_t* dst = (m == 0 ? q_bf : (m == 1 ? k_bf : v_bf)) + i * 136 + d0;
        *(uint4*)(dst) = pack8(val);
        *(uint4*)(dst + 8) = pack8(val + 8);
        if (m == 0) {
#pragma unroll
          for (int dir = 0; dir < 2; ++dir) {
            const int pos = dir ? 63 - i : i;
            const float f = __expf(gcl[dir * 64 + pos]);
            float tmp[16];
#pragma unroll
            for (int e = 0; e < 16; ++e) tmp[e] = val[e] * f;
            bf16_t* qd = (bf16_t*)(rec0 + dir * REC_BYTES + REC_QD) + pos * 128 + d0;
            *(uint4*)(qd) = pack8(tmp);
            *(uint4*)(qd + 8) = pack8(tmp + 8);
          }
        }
        if (m == 1) {
#pragma unroll
          for (int dir = 0; dir < 2; ++dir) {
            const int pos = dir ? 63 - i : i;
            const float f = __expf(gll[dir] - gcl[dir * 64 + pos]);
            bf16_t* kt = (bf16_t*)(rec0 + dir * REC_BYTES + REC_KT) + d0 * 64 + pos;
#pragma unroll
            for (int e = 0; e < 16; ++e) kt[e * 64] = f2bf(val[e] * f);
          }
        }
      }
    }
    __syncthreads();
    {
      int tB = tid;
      asm volatile("" : "+v"(tB));
      const int laneB = tB & 63, widB = tB >> 6, fr = laneB & 15, fq = laneB >> 4;
      const int mat = widB >> 2, rtile = widB & 3;
      const bf16_t* asrc = mat ? q_bf : k_bf;
      bf16x8 af[4];
#pragma unroll
      for (int ks = 0; ks < 4; ++ks) af[ks] = *(const bf16x8*)(asrc + (rtile * 16 + fr) * 136 + ks * 32 + fq * 8);
#pragma unroll
      for (int nt = 0; nt < 4; ++nt) {
        f32x4 acc = {0.f, 0.f, 0.f, 0.f};
#pragma unroll
        for (int ks = 0; ks < 4; ++ks) {
          const bf16x8 bfrag = *(const bf16x8*)(k_bf + (nt * 16 + fr) * 136 + ks * 32 + fq * 8);
          acc = MFMA16(af[ks], bfrag, acc);
        }
#pragma unroll
        for (int j = 0; j < 4; ++j) {
          const int i = rtile * 16 + fq * 4 + j, jj = nt * 16 + fr;
          const float G = acc[j];
#pragma unroll
          for (int dir = 0; dir < 2; ++dir) {
            const int pi = dir ? 63 - i : i, pj = dir ? 63 - jj : jj;
            const float dec = __expf(fminf(gcl[dir * 64 + pi] - gcl[dir * 64 + pj], 0.f));
            if (mat == 0)
              Lm[(dir * 64 + pi) * 68 + pj] = (pi > pj) ? bl[dir * 64 + pi] * G * dec : 0.f;
            else
              *((bf16_t*)(rec0 + dir * REC_BYTES + REC_IN) + pi * 64 + pj) = f2bf((pi >= pj) ? G * dec : 0.f);
          }
        }
      }
    }
    __syncthreads();
    {
      int tC = tid;
      asm volatile("" : "+v"(tC));
      const int dir = tC >> 8, c = tC & 255;
      const float* Ld = Lm + dir * 64 * 68;
      const bool isu = c < 128;
      unsigned* up = p.gdn_u + ((size_t)(item * 2 + dir) * 32) * 128 + (c & 127);
      bf16_t* wp = (bf16_t*)(rec0 + dir * REC_BYTES + REC_WN) + (c & 127);
      const bf16_t* src = (isu ? v_bf : k_bf) + (c & 127);
      const float* sclv = (isu ? bl : bgl) + dir * 64;
      float x[64];
      SolveStep<63>::run(x, Ld, sclv, src, dir, isu, up, wp);
    }
    __syncthreads();
  }
}

DEV int crow(int reg, int hf) { return (reg & 3) + 8 * (reg >> 2) + 4 * hf; }
DEV bf16x8 pack_acc8(const f32x16& x, int s) {
  uint4 v;
  v.x = pack2(x[8 * s + 0], x[8 * s + 1]);
  v.y = pack2(x[8 * s + 2], x[8 * s + 3]);
  v.z = pack2(x[8 * s + 4], x[8 * s + 5]);
  v.w = pack2(x[8 * s + 6], x[8 * s + 7]);
  return __builtin_bit_cast(bf16x8, v);
}
DEV bf16x8 ld_frag(const char* rowp, int kb) { return *(const bf16x8*)(rowp + kb); }

DEV void phase_gdn_scan(const Params& p, int chain, char* smem) {
  const int tid = fresh_tid(), lane = tid & 63, wid = tid >> 6;
  const int dir = chain & 1, bh = chain >> 1;
  const int b = bh >> 2, hh = bh & 3;
  if (wid >= 4) {
    const int lt = tid - 256;
    uint4 rA[18], rB[18];
    auto gl = [&](uint4 (&rg)[18], int n) {
      const int item = bh * 128 + (dir ? 127 - n : n);
      const __amdgpu_buffer_rsrc_t rr = __builtin_amdgcn_make_buffer_rsrc(
          (void*)(p.gdn_rec + ((size_t)item * 2 + dir) * REC_BYTES), 0, REC_BYTES, 0x00020000);
      const __amdgpu_buffer_rsrc_t ru = __builtin_amdgcn_make_buffer_rsrc(
          (void*)(p.gdn_u + ((size_t)(item * 2 + dir) * 32) * 128), 0, 16384, 0x00020000);
#pragma unroll
      for (int k = 0; k < 14; ++k) {
        const u32x4 v = __builtin_amdgcn_raw_buffer_load_b128(rr, lt * 16, k * 4096, 0);
        rg[k] = make_uint4(v.x, v.y, v.z, v.w);
      }
#pragma unroll
      for (int k = 0; k < 4; ++k) {
        const u32x4 v = __builtin_amdgcn_raw_buffer_load_b128(ru, lt * 16, k * 4096, 0);
        rg[14 + k] = make_uint4(v.x, v.y, v.z, v.w);
      }
    };
    auto st = [&](const uint4 (&rg)[18], int buf) {
      char* base = smem + buf * SC_BUF;
#pragma unroll
      for (int k = 0; k < 14; ++k) {
        const int u = lt + 256 * k;
        int row, c16, off;
        if (k < 4) { row = u >> 4; c16 = u & 15; off = SC_WN + row * 272; }
        else if (k < 8) { row = (u - 1024) >> 4; c16 = (u - 1024) & 15; off = SC_QD + row * 272; }
        else if (k < 10) { row = (u - 2048) >> 3; c16 = (u - 2048) & 7; off = SC_IN + row * 144; }
        else { row = (u - 2560) >> 3; c16 = (u - 2560) & 7; off = SC_KT + row * 144; }
        char* dst = base + off + (c16 >> 1) * 32 + (c16 & 1) * 8;
        *(uint2*)(dst) = make_uint2(rg[k].x, rg[k].y);
        *(uint2*)(dst + 16) = make_uint2(rg[k].z, rg[k].w);
      }
#pragma unroll
      for (int k = 0; k < 4; ++k) *(uint4*)(base + SC_U + (lt + 256 * k) * 16) = rg[14 + k];
    };
    gl(rA, 0);
    st(rA, 0);
    gl(rB, 1);
    gl(rA, 2);
    __syncthreads();
#pragma unroll 1
    for (int n = 0; n < 128; n += 2) {
      st(rB, 1);
      gl(rB, min(n + 3, 127));
      __syncthreads();
      st(rA, 0);
      gl(rA, min(n + 4, 127));
      __syncthreads();
    }
  } else {
    const int w = wid, r = lane & 31, hf = lane >> 5;
    f32x16 S[4];
#pragma unroll
    for (int t4 = 0; t4 < 4; ++t4)
#pragma unroll
      for (int e = 0; e < 16; ++e) S[t4][e] = 0.f;
    const float dlo = p.egl[(bh * 128 + (dir ? 127 - lane : lane)) * 2 + dir];
    const float dhi = p.egl[(bh * 128 + (dir ? 63 - lane : 64 + lane)) * 2 + dir];
    __syncthreads();
#pragma unroll 1
    for (int n = 0; n < 128; ++n) {
      const char* buf = smem + (n & 1) * SC_BUF;
      const float decay = __uint_as_float(__builtin_amdgcn_readlane(__float_as_uint(n < 64 ? dlo : dhi), n & 63));
      f32x16 vn[2], o[2];
      {
        const unsigned* ul = (const unsigned*)(buf + SC_U) + 32 * w + r;
#pragma unroll
        for (int tm = 0; tm < 2; ++tm)
#pragma unroll
          for (int e2 = 0; e2 < 8; ++e2) {
            const unsigned uu = ul[((32 * tm + crow(2 * e2, hf)) >> 1) * 128];
            vn[tm][2 * e2] = __uint_as_float(uu << 16);
            vn[tm][2 * e2 + 1] = __uint_as_float(uu & 0xffff0000u);
          }
      }
#pragma unroll
      for (int e = 0; e < 16; ++e) { o[0][e] = 0.f; o[1][e] = 0.f; }
      bf16x8 sb[4][2];
#pragma unroll
      for (int t4 = 0; t4 < 4; ++t4) {
        sb[t4][0] = pack_acc8(S[t4], 0);
        sb[t4][1] = pack_acc8(S[t4], 1);
      }
      const char* rw0 = buf + SC_WN + r * 272 + hf * 16;
      const char* rq0 = buf + SC_QD + r * 272 + hf * 16;
      const char* ri0 = buf + SC_IN + r * 144 + hf * 16;
      const char* rk0 = buf + SC_KT + r * 144 + hf * 16;
      bf16x8 fA[8], fB[8];
#define SCAN_LOAD(dst, base, t4a)                                                                        \
  _Pragma("unroll") for (int dt = 0; dt < 2; ++dt) _Pragma("unroll") for (int s = 0; s < 2; ++s)         \
      _Pragma("unroll") for (int tm = 0; tm < 2; ++tm)                                                   \
          dst[dt * 4 + s * 2 + tm] = ld_frag(base + tm * 32 * 272, (32 * ((t4a) + dt) + 16 * s) * 2);
#define SCAN_MMA(acc, f, t4a)                                                                            \
  _Pragma("unroll") for (int dt = 0; dt < 2; ++dt) _Pragma("unroll") for (int s = 0; s < 2; ++s)         \
      _Pragma("unroll") for (int tm = 0; tm < 2; ++tm)                                                   \
          acc[tm] = MFMA32(f[dt * 4 + s * 2 + tm], sb[(t4a) + dt][s], acc[tm]);
#define SCAN_MMA_T(acc, f, t4a)                                                                          \
  _Pragma("unroll") for (int dt = 0; dt < 2; ++dt) _Pragma("unroll") for (int s = 0; s < 2; ++s)         \
      _Pragma("unroll") for (int tm = 0; tm < 2; ++tm)                                                   \
          acc[tm] = MFMA32(sb[(t4a) + dt][s], f[dt * 4 + s * 2 + tm], acc[tm]);
      SCAN_LOAD(fA, rw0, 0)
      __builtin_amdgcn_sched_barrier(0);
      SCAN_LOAD(fB, rw0, 2)
      __builtin_amdgcn_sched_barrier(0);
      SCAN_MMA(vn, fA, 0)
      __builtin_amdgcn_sched_barrier(0);
      SCAN_LOAD(fA, rq0, 0)
      __builtin_amdgcn_sched_barrier(0);
      SCAN_MMA(vn, fB, 2)
      __builtin_amdgcn_sched_barrier(0);
      SCAN_LOAD(fB, rq0, 2)
      __builtin_amdgcn_sched_barrier(0);
      SCAN_MMA_T(o, fA, 0)
      __builtin_amdgcn_sched_barrier(0);
      bf16x8 fi[6], fk0[4];
      fi[0] = ld_frag(ri0, 0);
      fi[1] = ld_frag(ri0, 32);
#pragma unroll
      for (int q4 = 0; q4 < 4; ++q4) fi[2 + q4] = ld_frag(ri0 + 32 * 144, q4 * 32);
#pragma unroll
      for (int q4 = 0; q4 < 4; ++q4) fk0[q4] = ld_frag(rk0, q4 * 32);
      __builtin_amdgcn_sched_barrier(0);
      SCAN_MMA_T(o, fB, 2)
#undef SCAN_LOAD
#undef SCAN_MMA
#undef SCAN_MMA_T
      bf16x8 vb[2][2];
#pragma unroll
      for (int tk = 0; tk < 2; ++tk) {
        vb[tk][0] = pack_acc8(vn[tk], 0);
        vb[tk][1] = pack_acc8(vn[tk], 1);
      }
#pragma unroll
      for (int t4 = 0; t4 < 4; ++t4)
#pragma unroll
        for (int e = 0; e < 16; ++e) S[t4][e] *= decay;
      __builtin_amdgcn_sched_barrier(0);
#pragma unroll
      for (int q4 = 0; q4 < 4; ++q4) {
        fA[q4] = ld_frag(rk0 + 32 * 144, q4 * 32);
        fA[4 + q4] = ld_frag(rk0 + 64 * 144, q4 * 32);
      }
      __builtin_amdgcn_sched_barrier(0);
      o[0] = MFMA32(vb[0][0], fi[0], o[0]);
      o[1] = MFMA32(vb[0][0], fi[2], o[1]);
      o[0] = MFMA32(vb[0][1], fi[1], o[0]);
      o[1] = MFMA32(vb[0][1], fi[3], o[1]);
      S[0] = MFMA32(fk0[0], vb[0][0], S[0]);
      o[1] = MFMA32(vb[1][0], fi[4], o[1]);
      S[0] = MFMA32(fk0[1], vb[0][1], S[0]);
      o[1] = MFMA32(vb[1][1], fi[5], o[1]);
      S[0] = MFMA32(fk0[2], vb[1][0], S[0]);
      S[0] = MFMA32(fk0[3], vb[1][1], S[0]);
      __builtin_amdgcn_sched_barrier(0);
#pragma unroll
      for (int q4 = 0; q4 < 4; ++q4) fB[q4] = ld_frag(rk0 + 96 * 144, q4 * 32);
      __builtin_amdgcn_sched_barrier(0);
#pragma unroll
      for (int q4 = 0; q4 < 4; ++q4) {
        S[1] = MFMA32(fA[q4], vb[q4 >> 1][q4 & 1], S[1]);
        S[2] = MFMA32(fA[4 + q4], vb[q4 >> 1][q4 & 1], S[2]);
      }
      __builtin_amdgcn_sched_barrier(0);
#pragma unroll
      for (int q4 = 0; q4 < 4; ++q4) S[3] = MFMA32(fB[q4], vb[q4 >> 1][q4 & 1], S[3]);
      {
#pragma unroll
        for (int tn = 0; tn < 2; ++tn) {
          const int pos = 32 * tn + r;
          const int tok = dir ? (b * T + T - 1 - n * 64 - pos) : (b * T + n * 64 + pos);
          unsigned pk[4][2];
#pragma unroll
          for (int g = 0; g < 4; ++g) {
            pk[g][0] = pack2(o[tn][4 * g + 0], o[tn][4 * g + 1]);
            pk[g][1] = pack2(o[tn][4 * g + 2], o[tn][4 * g + 3]);
          }
          uint4 st0, st1;
          {
            auto s0 = __builtin_amdgcn_permlane32_swap(pk[0][0], pk[2][0], false, false);
            auto s1 = __builtin_amdgcn_permlane32_swap(pk[0][1], pk[2][1], false, false);
            st0.x = s0[0]; st0.y = s1[0]; st0.z = s0[1]; st0.w = s1[1];
            auto s2 = __builtin_amdgcn_permlane32_swap(pk[1][0], pk[3][0], false, false);
            auto s3 = __builtin_amdgcn_permlane32_swap(pk[1][1], pk[3][1], false, false);
            st1.x = s2[0]; st1.y = s3[0]; st1.z = s2[1]; st1.w = s3[1];
          }
          bf16_t* op = p.obuf + ((size_t)dir * NTOK + tok) * 512 + hh * 128 + 32 * w + 16 * hf;
          *(uint4*)(op) = st0;
          *(uint4*)(op + 8) = st1;
        }
      }
      __syncthreads();
    }
  }
}

DEV void phase_gdn_fin(const Params& p, int l, int bid, int nb) {
  const int tid_ = fresh_tid(), lane = tid_ & 63, wid = tid_ >> 6;
  const float* gnw = p.gdn_norm_w + l * 128 + (lane & 15) * 8;
  for (int t = bid * NWAVE + wid; t < NTOK; t += nb * NWAVE) {
    float of[8], ob[8], z[8], o[8];
    unpack8(*(const uint4*)(p.obuf + (size_t)t * 512 + lane * 8), of);
    unpack8(*(const uint4*)(p.obuf + ((size_t)NTOK + t) * 512 + lane * 8), ob);
    unpack8(*(const uint4*)(p.proj + (size_t)t * PROJW + OFF_GZ + lane * 8), z);
    float ss = 0.f;
#pragma unroll
    for (int e = 0; e < 8; ++e) {
      o[e] = of[e] + ob[e];
      ss += o[e] * o[e];
    }
    ss += shx(ss, 1, lane);
    ss += shx(ss, 2, lane);
    ss += shx(ss, 4, lane);
    ss += shx(ss, 8, lane);
    const float rr = rsqrtf(ss * (1.f / 128.f) + EPS);
    const float4 g0 = *(const float4*)(gnw), g1 = *(const float4*)(gnw + 4);
    const float gw[8] = {g0.x, g0.y, g0.z, g0.w, g1.x, g1.y, g1.z, g1.w};
    float res[8];
#pragma unroll
    for (int e = 0; e < 8; ++e) res[e] = o[e] * rr * gw[e] * silu_f(z[e]);
    *(uint4*)(p.y + (size_t)t * DM + 512 + lane * 8) = pack8(res);
  }
}

struct EpiWout {
  static constexpr bool PERM = false;
  const float* xin; float* xout; const float* mod_l;
  DEV void operator()(const f32x4 (&acc)[2][2][4][2], const GUnit& u, int wr, int wc, int fr, int fq) const {
    const int row0 = u.pm * 256 + wr * 64 + fr, col0 = u.pn * 256 + wc * 32 + 4 * fq;
    const float* gate = mod_l + ((u.pm * 256) / T) * 6144 + MOD_GATE1;
    f32x4 gv[2][2];
#pragma unroll
    for (int bj = 0; bj < 2; ++bj)
#pragma unroll
      for (int n = 0; n < 2; ++n) gv[bj][n] = *(const f32x4*)(gate + col0 + bj * G_HALF + n * 16);
#pragma unroll
    for (int ai = 0; ai < 2; ++ai)
#pragma unroll
      for (int m = 0; m < 4; ++m) {
        const size_t ro = (size_t)(row0 + ai * G_HALF + m * 16) * DM + col0;
#pragma unroll
        for (int bj = 0; bj < 2; ++bj)
#pragma unroll
          for (int n = 0; n < 2; ++n) {
            const f32x4 xi = *(const f32x4*)(xin + ro + bj * G_HALF + n * 16);
            *(f32x4*)(xout + ro + bj * G_HALF + n * 16) = xi + gv[bj][n] * acc[ai][bj][m][n];
          }
      }
  }
};

DEV void phase_gemm_wout(const Params& p, int l, const float* xin, int bid, int nb, char* smem) {
  DenseSched S;
  S.A = p.y; S.Bt = p.btout; S.K = DM; S.nM = NTOK / 256; S.nN = DM / 256; S.nwg = S.nM * S.nN; S.G = nb; S.c = bid; S.wv = p.wv;
  EpiWout E;
  E.xin = xin; E.xout = p.xbuf; E.mod_l = p.mod + l * 2 * 6144;
  gemm_phase((LAS unsigned char*)smem, S, E);
}

DEV void phase_consts(const Params& p, int bid, int nb) {
  const int tid = fresh_tid(), lane = tid & 63, wid = tid >> 6;
  for (int g = bid * NTHR + tid; g < DEPTH * DM * 48; g += nb * NTHR) {
    const int n = g % 48, lk = g / 48;
    float v = 0.f;
    if (n < 4) v = p.rg_w[(size_t)lk * 4 + n];
    else if (n < 36) v = p.re_w[(size_t)lk * 32 + (n - 4)];
    p.wcat[g] = v;
  }
  for (int g = bid * NTHR + tid; g < DEPTH * NB * DM; g += nb * NTHR) {
    const int k = g & (DM - 1), lb = g >> 10, l = lb >> 1;
    p.wsc2[g] = p.norm_ffn_w[l * DM + k] * (1.f + p.mod[lb * 6144 + MOD_SCALE2 + k]);
  }
  for (int o = bid * NWAVE + wid; o < DEPTH * NB * 48; o += nb * NWAVE) {
    const int n = o % 48, lb = o / 48, l = lb >> 1;
    float s = 0.f;
    if (n < 36) {
      for (int k = lane; k < DM; k += 64) {
        const float w = (n < 4) ? p.rg_w[((size_t)l * DM + k) * 4 + n] : p.re_w[((size_t)l * DM + k) * 32 + (n - 4)];
        s += p.mod[lb * 6144 + MOD_SHIFT2 + k] * w;
      }
      s = wave_sum(s, lane);
      s += (n < 4) ? p.rg_b[l * 4 + n] : p.re_b[l * 32 + (n - 4)];
    }
    if (lane == 0) p.c0[o] = s;
  }
}

DEV void phase_router(const Params& p, int l, int bid, int nb, char* smem) {
  float* accb = (float*)smem;
  float* ssqb = accb + 2 * 64 * 49;
  float* rsl = ssqb + 128;
  const int tid = fresh_tid(), lane = tid & 63, wid = tid >> 6, fr = lane & 15, fq = lane >> 4;
  const int tg = wid & 3, kh = wid >> 2;
  for (int tb = bid; tb < NTOK / 64; tb += nb) {
    const int tok0 = tb * 64;
    const int b = tok0 / T;
    const float* wsc = p.wsc2 + (l * 2 + b) * DM;
    {
      const float* xr = p.xbuf + (size_t)(tok0 + tg * 16 + fr) * DM + kh * 512 + fq * 4;
      const float* wv = wsc + kh * 512 + fq * 4;
      const float* Bp = p.wcat + ((size_t)l * DM + kh * 512 + fq * 4) * 48 + fr;
      f32x4 acc[3];
#pragma unroll
      for (int nt = 0; nt < 3; ++nt) acc[nt] = f32x4{0.f, 0.f, 0.f, 0.f};
      float ssq = 0.f;
#pragma unroll 4
      for (int c = 0; c < 32; ++c) {
        const float4 xv = *(const float4*)(xr + c * 16);
        const float4 ww = *(const float4*)(wv + c * 16);
        ssq += xv.x * xv.x + xv.y * xv.y + xv.z * xv.z + xv.w * xv.w;
        const float a0 = xv.x * ww.x, a1 = xv.y * ww.y, a2 = xv.z * ww.z, a3 = xv.w * ww.w;
        const float* bp = Bp + (size_t)c * 16 * 48;
#pragma unroll
        for (int nt = 0; nt < 3; ++nt) {
          acc[nt] = __builtin_amdgcn_mfma_f32_16x16x4f32(a0, bp[0 * 48 + nt * 16], acc[nt], 0, 0, 0);
          acc[nt] = __builtin_amdgcn_mfma_f32_16x16x4f32(a1, bp[1 * 48 + nt * 16], acc[nt], 0, 0, 0);
          acc[nt] = __builtin_amdgcn_mfma_f32_16x16x4f32(a2, bp[2 * 48 + nt * 16], acc[nt], 0, 0, 0);
          acc[nt] = __builtin_amdgcn_mfma_f32_16x16x4f32(a3, bp[3 * 48 + nt * 16], acc[nt], 0, 0, 0);
        }
      }
      ssq += shx(ssq, 16, lane);
      ssq += shx(ssq, 32, lane);
#pragma unroll
      for (int nt = 0; nt < 3; ++nt)
#pragma unroll
        for (int j = 0; j < 4; ++j) accb[(kh * 64 + tg * 16 + fq * 4 + j) * 49 + nt * 16 + fr] = acc[nt][j];
      if (fq == 0) ssqb[kh * 64 + tg * 16 + fr] = ssq;
    }
    __syncthreads();
    if (tid < 64) {
      const int t = tok0 + tid;
      const float rstd = rsqrtf((ssqb[tid] + ssqb[64 + tid]) * (1.f / DM) + EPS);
      rsl[tid] = rstd;
      const float* c0 = p.c0 + (l * 2 + b) * 48;
      float acc[36];
#pragma unroll
      for (int o = 0; o < 36; ++o) acc[o] = rstd * (accb[tid * 49 + o] + accb[(64 + tid) * 49 + o]) + c0[o];
      int grp = 0;
      float mx = acc[0];
#pragma unroll
      for (int g = 1; g < 4; ++g)
        if (acc[g] > mx) { mx = acc[g]; grp = g; }
      float den = 0.f;
#pragma unroll
      for (int g = 0; g < 4; ++g) den += __expf(acc[g] - mx);
      const float pg_top = 1.f / den;
      float el[8];
#pragma unroll
      for (int j = 0; j < 8; ++j) {
        const float a0 = acc[4 + j], a1 = acc[12 + j], a2 = acc[20 + j], a3 = acc[28 + j];
        el[j] = (grp == 0) ? a0 : (grp == 1) ? a1 : (grp == 2) ? a2 : a3;
      }
      float b0 = -3.0e38f, b1 = -3.0e38f;
      int i0 = 0, i1 = 0;
#pragma unroll
      for (int j = 0; j < 8; ++j)
        if (el[j] > b0) { b0 = el[j]; i0 = j; }
#pragma unroll
      for (int j = 0; j < 8; ++j)
        if (j != i0 && el[j] > b1) { b1 = el[j]; i1 = j; }
      const float ex = __expf(b1 - b0);
      const float g0 = pg_top / (1.f + ex), g1 = pg_top * ex / (1.f + ex);
      const int e0 = grp * 8 + i0, e1 = grp * 8 + i1;
      const int pos0 = atomicAdd(&p.cnt[l * NEXP + e0], 1);
      p.list[e0 * CAP + pos0] = 2 * t;
      p.sgate[2 * t] = g0;
      const int pos1 = atomicAdd(&p.cnt[l * NEXP + e1], 1);
      p.list[e1 * CAP + pos1] = 2 * t + 1;
      p.sgate[2 * t + 1] = g1;
    }
    __syncthreads();
    {
      const float* sh = p.mod + (l * 2 + b) * 6144 + MOD_SHIFT2;
#pragma unroll 2
      for (int q = 0; q < 8; ++q) {
        const int tl = wid * 8 + q;
        const float rstd = rsl[tl];
        const float4* xr = (const float4*)(p.xbuf + (size_t)(tok0 + tl) * DM);
#pragma unroll
        for (int i = 0; i < 4; ++i) {
          const int idx = (lane + 64 * i) * 4;
          const float4 xv = xr[lane + 64 * i];
          const float4 w = *(const float4*)(wsc + idx);
          const float4 h = *(const float4*)(sh + idx);
          uint2 pk;
          pk.x = pack2(xv.x * w.x * rstd + h.x, xv.y * w.y * rstd + h.y);
          pk.y = pack2(xv.z * w.z * rstd + h.z, xv.w * w.w * rstd + h.w);
          *(uint2*)(p.act + (size_t)(tok0 + tl) * DM + idx) = pk;
        }
      }
    }
    __syncthreads();
  }
}

struct EpiMoe1 {
  static constexpr bool PERM = true;
  bf16_t* H; const int* list;
  DEV void operator()(const f32x4 (&acc)[2][2][4][2], const GUnit& u, int wr, int wc, int fr, int fq) const {
    const int hcol = u.pn * 128 + wc * 32 + 8 * fq;
#pragma unroll
    for (int ai = 0; ai < 2; ++ai)
#pragma unroll
      for (int m = 0; m < 4; ++m) {
        const int rl = ai * G_HALF + wr * 64 + m * 16 + fr;
        if (rl < u.valid) {
          const int slot = list[u.e * CAP + u.pm * 256 + rl];
          float h[8];
#pragma unroll
          for (int n = 0; n < 2; ++n)
#pragma unroll
            for (int j = 0; j < 4; ++j) h[n * 4 + j] = silu_f(acc[ai][0][m][n][j]) * acc[ai][1][m][n][j];
          *(uint4*)(H + (size_t)slot * DEXP + hcol) = pack8(h);
        }
      }
  }
};
struct EpiMoe2 {
  static constexpr bool PERM = true;
  bf16_t* Y; const int* list; const float* sgate;
  DEV void operator()(const f32x4 (&acc)[2][2][4][2], const GUnit& u, int wr, int wc, int fr, int fq) const {
    const int col0 = u.pn * 256 + wc * 32 + 8 * fq;
#pragma unroll
    for (int ai = 0; ai < 2; ++ai)
#pragma unroll
      for (int m = 0; m < 4; ++m) {
        const int rl = ai * G_HALF + wr * 64 + m * 16 + fr;
        if (rl < u.valid) {
          const int slot = list[u.e * CAP + u.pm * 256 + rl];
          const float g = sgate[slot];
#pragma unroll
          for (int bj = 0; bj < 2; ++bj) {
            float yv[8];
#pragma unroll
            for (int n = 0; n < 2; ++n)
#pragma unroll
              for (int j = 0; j < 4; ++j) yv[n * 4 + j] = g * acc[ai][bj][m][n][j];
            *(uint4*)(Y + (size_t)slot * DM + col0 + bj * G_HALF) = pack8(yv);
          }
        }
      }
  }
};

DEV void phase_moe1(const Params& p, int l, int bid, int nb, char* smem) {
  MoeSched S;
  S.A = p.act; S.Bt = p.bt1; S.K = DM; S.cnt = p.cnt + l * NEXP; S.list = p.list; S.G = nb; S.c = bid; S.wv = p.wv; S.shift = 1;
  EpiMoe1 E;
  E.H = p.hbuf; E.list = p.list;
  gemm_phase((LAS unsigned char*)smem, S, E);
}

DEV void phase_moe2(const Params& p, int l, int bid, int nb, char* smem) {
  MoeSched S;
  S.A = p.hbuf; S.Bt = p.bt2; S.K = DEXP; S.cnt = p.cnt + l * NEXP; S.list = p.list; S.G = nb; S.c = bid; S.wv = p.wv; S.shift = 0;
  EpiMoe2 E;
  E.Y = p.ybuf; E.list = p.list; E.sgate = p.sgate;
  gemm_phase((LAS unsigned char*)smem, S, E);
}

DEV void phase_combine(const Params& p, int l, int bid, int nb) {
  const int tid_ = fresh_tid(), lane = tid_ & 63, wid = tid_ >> 6;
  for (int t = bid * NWAVE + wid; t < NTOK; t += nb * NWAVE) {
    float4* xr = (float4*)(p.xbuf + (size_t)t * DM);
    const int b = t / T;
    const float* md = p.mod + (l * 2 + b) * 6144;
    float4 v[4];
    float ss = 0.f;
#pragma unroll
    for (int i = 0; i < 4; ++i) {
      const int idx = (lane + 64 * i) * 4;
      v[i] = xr[lane + 64 * i];
      const float4 g = *(const float4*)(md + MOD_GATE2 + idx);
      const uint2 ya = *(const uint2*)(p.ybuf + (size_t)(2 * t) * DM + idx);
      const uint2 yb = *(const uint2*)(p.ybuf + (size_t)(2 * t + 1) * DM + idx);
      v[i].x += g.x * (__uint_as_float(ya.x << 16) + __uint_as_float(yb.x << 16));
      v[i].y += g.y * (__uint_as_float(ya.x & 0xffff0000u) + __uint_as_float(yb.x & 0xffff0000u));
      v[i].z += g.z * (__uint_as_float(ya.y << 16) + __uint_as_float(yb.y << 16));
      v[i].w += g.w * (__uint_as_float(ya.y & 0xffff0000u) + __uint_as_float(yb.y & 0xffff0000u));
      ss += v[i].x * v[i].x + v[i].y * v[i].y + v[i].z * v[i].z + v[i].w * v[i].w;
    }
    ss = wave_sum(ss, lane);
    const float rstd = rsqrtf(ss * (1.f / DM) + EPS);
    if (l + 1 < DEPTH) {
#pragma unroll
      for (int i = 0; i < 4; ++i) xr[lane + 64 * i] = v[i];
      const float* md2 = p.mod + ((l + 1) * 2 + b) * 6144;
      norm_mod_store(v, rstd, p.norm_mix_w + (l + 1) * DM, md2 + MOD_SCALE1, md2 + MOD_SHIFT1,
                     p.act + (size_t)t * DM, lane);
    } else {
      float4* orow = (float4*)(p.out + (size_t)t * DM);
#pragma unroll
      for (int i = 0; i < 4; ++i) {
        const float4 w = *(const float4*)(p.final_w + (lane + 64 * i) * 4);
        float4 r;
        r.x = v[i].x * rstd * w.x;
        r.y = v[i].y * rstd * w.y;
        r.z = v[i].z * rstd * w.z;
        r.w = v[i].w * rstd * w.w;
        orow[lane + 64 * i] = r;
      }
    }
  }
}

#define XB_TMO      128
#define XB_XCNT(j)  (256  + 64 * (j))
#define XB_XSUB(j)  (1280 + 64 * (j))
#define XB_XGEN(j)  (2304 + 64 * (j))
#define XB_TOP      3328
#define XB_TOPGEN   3392
#define XCD_BAR_WORDS 3456
#define XB_SPIN_CAP (1u << 22)

DEV unsigned xb_ld(unsigned* p) { return __hip_atomic_load(p, __ATOMIC_RELAXED, __HIP_MEMORY_SCOPE_AGENT); }
DEV unsigned xb_add(unsigned* p, unsigned v) { return __hip_atomic_fetch_add(p, v, __ATOMIC_RELAXED, __HIP_MEMORY_SCOPE_AGENT); }
DEV unsigned xb_xcc_id() { return (unsigned)__builtin_amdgcn_s_getreg((3 << 11) | 20) & 0xFu; }
#define XB_SPIN(cond, bar) do { unsigned _sp = 0; while (cond) { __builtin_amdgcn_s_sleep(1); \
    if ((++_sp & 255u) == 0u) { if (xb_ld(&(bar)[XB_TMO])) break; if (_sp > XB_SPIN_CAP) { atomicAdd(&(bar)[XB_TMO], 1u); break; } } } } while (0)

DEV void xcd_barrier_post(unsigned* bar, int tid) {
  if (tid == 0) (void)xb_add(&bar[XB_XCNT(xb_xcc_id())], 1u);
}
DEV void xcd_barrier_complete(unsigned* bar, unsigned x, unsigned& nloc, unsigned& nx) {
  const unsigned G = gridDim.x * gridDim.y * gridDim.z;
  unsigned sum, cnt, mine, sp = 0u;
  for (;;) {
    sum = 0u; cnt = 0u; mine = 0u;
#pragma unroll
    for (unsigned j = 0; j < 16; ++j) {
      const unsigned c = xb_ld(&bar[XB_XCNT(j)]);
      sum += c;
      cnt += (c > 0u) ? 1u : 0u;
      mine = (j == x) ? c : mine;
    }
    if (sum == G) break;
    __builtin_amdgcn_s_sleep(1);
    if ((++sp & 255u) == 0u) {
      if (xb_ld(&bar[XB_TMO])) break;
      if (sp > XB_SPIN_CAP) { atomicAdd(&bar[XB_TMO], 1u); break; }
    }
  }
  nloc = mine > 0u ? mine : 1u;
  nx = cnt > 0u ? cnt : 1u;
}
DEV void xcd_barrier(unsigned* bar, volatile LAS unsigned* st, int tid) {
  asm volatile("s_waitcnt vmcnt(0)" ::: "memory");
  __syncthreads();
  if (tid == 0) {
    const unsigned bx = xb_xcc_id();
    __builtin_amdgcn_s_waitcnt(0);
    unsigned nloc = st[0], nx = st[1];
    const unsigned gen = st[2];
    st[2] = gen + 1u;
    if (nloc == 0u) {
      xcd_barrier_complete(bar, bx, nloc, nx);
      st[0] = nloc;
      st[1] = nx;
    }
    const unsigned old = xb_add(&bar[XB_XSUB(bx)], 1u);
    if (old + 1u == (gen + 1u) * nloc) {
      __builtin_amdgcn_fence(__ATOMIC_RELEASE, "agent");
      asm volatile("s_waitcnt vmcnt(0)" ::: "memory");
      const unsigned og = xb_add(&bar[XB_TOP], 1u);
      if (og + 1u == (gen + 1u) * nx) xb_add(&bar[XB_TOPGEN], 1u);
      else XB_SPIN(xb_ld(&bar[XB_TOPGEN]) == gen, bar);
      __builtin_amdgcn_fence(__ATOMIC_ACQUIRE, "agent");
      xb_add(&bar[XB_XGEN(bx)], 1u);
      asm volatile("s_waitcnt vmcnt(0)" ::: "memory");
    } else {
      XB_SPIN(xb_ld(&bar[XB_XGEN(bx)]) == gen, bar);
      __builtin_amdgcn_fence(__ATOMIC_ACQUIRE, "agent");
      asm volatile("s_waitcnt vmcnt(0)" ::: "memory");
    }
  }
  __syncthreads();
}

constexpr size_t ws_align(size_t b) { return (b + 255) & ~(size_t)255; }
constexpr size_t WS_bar = 0;
constexpr size_t WS_mod = WS_bar + ws_align(sizeof(unsigned) * XCD_BAR_WORDS);
constexpr size_t WS_btin = WS_mod + ws_align(sizeof(float) * DEPTH * NB * 6144);
constexpr size_t WS_btg = WS_btin + ws_align(2 * (size_t)PROJW * DM);
constexpr size_t WS_btout = WS_btg + ws_align(2 * (size_t)16 * DM);
constexpr size_t WS_bt1 = WS_btout + ws_align(2 * (size_t)DM * DM);
constexpr size_t WS_bt2 = WS_bt1 + ws_align(2 * (size_t)NEXP * 1024 * DM);
constexpr size_t WS_wcat = WS_bt2 + ws_align(2 * (size_t)NEXP * DM * DEXP);
constexpr size_t WS_wsc2 = WS_wcat + ws_align(sizeof(float) * DEPTH * DM * 48);
constexpr size_t WS_c0 = WS_wsc2 + ws_align(sizeof(float) * DEPTH * NB * DM);
constexpr size_t WS_cnt = WS_c0 + ws_align(sizeof(float) * DEPTH * NB * 48);
constexpr size_t WS_xbuf = WS_cnt + ws_align(sizeof(int) * DEPTH * NEXP);
constexpr size_t WS_act = WS_xbuf + ws_align(sizeof(float) * (size_t)NTOK * DM);
constexpr size_t WS_proj = WS_act + ws_align(2 * (size_t)NTOK * DM);
constexpr size_t WS_gates = WS_proj + ws_align(2 * (size_t)NTOK * PROJW);
constexpr size_t WS_y = WS_gates + ws_align(sizeof(float) * (size_t)NTOK * 16);
constexpr size_t WS_list = WS_y + ws_align(2 * (size_t)NTOK * DM);
constexpr size_t WS_sgate = WS_list + ws_align(sizeof(int) * NEXP * CAP);
constexpr size_t WS_egl = WS_sgate + ws_align(sizeof(float) * 2 * NTOK);
constexpr size_t WS_obuf = WS_egl + ws_align(sizeof(float) * 2048);
constexpr size_t WS_gdn_rec = WS_obuf + ws_align(2 * 2 * (size_t)NTOK * 512);
constexpr size_t WS_gdn_u = WS_gdn_rec + ws_align((size_t)2048 * REC_BYTES);
constexpr size_t WS_TOTAL = WS_gdn_u + ws_align(sizeof(unsigned) * (size_t)2048 * 32 * 128);

struct KArgs {
  const float *x, *c, *norm_mix_w, *norm_ffn_w, *w_ada, *b_ada, *w_in, *conv_a_w, *na_rpb, *gdn_conv_w,
      *gdn_a_log, *gdn_dt_bias, *gdn_norm_w, *w_out, *rg_w, *rg_b, *re_w, *re_b, *ew1, *ew3, *ew2, *final_w;
  float* out;
  char* ws;
  int rep[12];
};
DEV Params make_params(const KArgs& a) {
  Params p;
  p.x = a.x; p.c = a.c; p.norm_mix_w = a.norm_mix_w; p.norm_ffn_w = a.norm_ffn_w; p.w_ada = a.w_ada; p.b_ada = a.b_ada;
  p.w_in = a.w_in; p.conv_a_w = a.conv_a_w; p.na_rpb = a.na_rpb; p.gdn_conv_w = a.gdn_conv_w; p.gdn_a_log = a.gdn_a_log;
  p.gdn_dt_bias = a.gdn_dt_bias; p.gdn_norm_w = a.gdn_norm_w; p.w_out = a.w_out; p.rg_w = a.rg_w; p.rg_b = a.rg_b;
  p.re_w = a.re_w; p.re_b = a.re_b; p.ew1 = a.ew1; p.ew3 = a.ew3; p.ew2 = a.ew2; p.final_w = a.final_w;
  p.out = a.out;
  p.bar = (unsigned*)(a.ws + WS_bar);
  p.mod = (float*)(a.ws + WS_mod);
  p.btin = (bf16_t*)(a.ws + WS_btin);
  p.btg = (bf16_t*)(a.ws + WS_btg);
  p.btout = (bf16_t*)(a.ws + WS_btout);
  p.bt1 = (bf16_t*)(a.ws + WS_bt1);
  p.bt2 = (bf16_t*)(a.ws + WS_bt2);
  p.wcat = (float*)(a.ws + WS_wcat);
  p.wsc2 = (float*)(a.ws + WS_wsc2);
  p.c0 = (float*)(a.ws + WS_c0);
  p.cnt = (int*)(a.ws + WS_cnt);
  p.xbuf = (float*)(a.ws + WS_xbuf);
  p.act = (bf16_t*)(a.ws + WS_act);
  p.proj = (bf16_t*)(a.ws + WS_proj);
  p.gates = (float*)(a.ws + WS_gates);
  p.y = (bf16_t*)(a.ws + WS_y);
  p.list = (int*)(a.ws + WS_list);
  p.sgate = (float*)(a.ws + WS_sgate);
  p.egl = (float*)(a.ws + WS_egl);
  p.obuf = (bf16_t*)(a.ws + WS_obuf);
  p.gdn_rec = (char*)(a.ws + WS_gdn_rec);
  p.gdn_u = (unsigned*)(a.ws + WS_gdn_u);
  p.hbuf = (bf16_t*)p.obuf;
  p.ybuf = (bf16_t*)p.gdn_rec;
#pragma unroll
  for (int i = 0; i < 12; ++i) p.rep[i] = a.rep[i];
  p.wv = __builtin_amdgcn_readfirstlane((int)(threadIdx.x >> 6));
  return p;
}

__global__ void __launch_bounds__(NTHR) mega_kernel(KArgs ka) {
  const Params p = make_params(ka);
  __shared__ __attribute__((aligned(16))) char smem[SMEM_BYTES + 16];
  cg::grid_group grid = cg::this_grid();
  const int bid = blockIdx.x, nb = gridDim.x;
  if (fresh_tid() == 0) *(uint4*)(smem + SMEM_BYTES) = make_uint4(0u, 0u, 0u, 0u);
  __syncthreads();
  xcd_barrier_post(p.bar, fresh_tid());
#pragma unroll 1
  for (int rp = 0; rp < p.rep[7]; ++rp) {
    phase_ada(p, bid, nb, smem);
    convert_win(p, 0, bid, nb, smem);
  }
  grid.sync();
#pragma unroll 1
  for (int rp = 0; rp < p.rep[8]; ++rp) {
    phase_hmix(p, 0, p.x, bid, nb);
    phase_consts(p, bid, nb);
  }
  xcd_barrier(p.bar, (volatile LAS unsigned*)(smem + SMEM_BYTES), fresh_tid());
#pragma unroll 1
  for (int l = 0; l < DEPTH; ++l) {
#pragma unroll 1
    for (int rp = 0; rp < p.rep[0]; ++rp) phase_gemm_proj(p, l, bid, nb, smem);
    xcd_barrier(p.bar, (volatile LAS unsigned*)(smem + SMEM_BYTES), fresh_tid());
#pragma unroll 1
    for (int rp = 0; rp < p.rep[1]; ++rp) phase_gdn_prep(p, l, bid, nb, smem);
    xcd_barrier(p.bar, (volatile LAS unsigned*)(smem + SMEM_BYTES), fresh_tid());
#pragma unroll 1
    for (int rp = 0; rp < p.rep[2]; ++rp) {
      if (bid < 16) {
        phase_gdn_scan(p, bid, smem);
      } else {
#pragma unroll 1
        for (int rq = 0; rq < p.rep[6]; ++rq) {
          phase_conv(p, l, bid - 16, nb - 16);
          phase_na(p, l, (bid - 16) * NWAVE + (fresh_tid() >> 6), (nb - 16) * NWAVE);
        }
        convert_layer(p, l, bid - 16, nb - 16, smem);
      }
    }
    xcd_barrier(p.bar, (volatile LAS unsigned*)(smem + SMEM_BYTES), fresh_tid());
#pragma unroll 1
    for (int rp = 0; rp < p.rep[5]; ++rp) phase_gdn_fin(p, l, bid, nb);
    xcd_barrier(p.bar, (volatile LAS unsigned*)(smem + SMEM_BYTES), fresh_tid());
#pragma unroll 1
    for (int rp = 0; rp < (l == 0 ? p.rep[9] : 1); ++rp) phase_gemm_wout(p, l, l == 0 ? p.x : p.xbuf, bid, nb, smem);
    xcd_barrier(p.bar, (volatile LAS unsigned*)(smem + SMEM_BYTES), fresh_tid());
    phase_router(p, l, bid, nb, smem);
    xcd_barrier(p.bar, (volatile LAS unsigned*)(smem + SMEM_BYTES), fresh_tid());
#pragma unroll 1
    for (int rp = 0; rp < p.rep[3]; ++rp) phase_moe1(p, l, bid, nb, smem);
    xcd_barrier(p.bar, (volatile LAS unsigned*)(smem + SMEM_BYTES), fresh_tid());
#pragma unroll 1
    for (int rp = 0; rp < p.rep[4]; ++rp) phase_moe2(p, l, bid, nb, smem);
    xcd_barrier(p.bar, (volatile LAS unsigned*)(smem + SMEM_BYTES), fresh_tid());
    phase_combine(p, l, bid, nb);
    if (l + 1 < DEPTH) xcd_barrier(p.bar, (volatile LAS unsigned*)(smem + SMEM_BYTES), fresh_tid());
  }
}

extern "C" void kernel_launch(void* const* d_in, const int* in_sizes, int n_in, void* d_out, int out_size,
                              void* d_ws, size_t ws_size, hipStream_t stream) {
  KArgs p{};
  p.x = (const float*)d_in[0];
  p.c = (const float*)d_in[1];
  p.norm_mix_w = (const float*)d_in[2];
  p.norm_ffn_w = (const float*)d_in[3];
  p.w_ada = (const float*)d_in[4];
  p.b_ada = (const float*)d_in[5];
  p.w_in = (const float*)d_in[6];
  p.conv_a_w = (const float*)d_in[7];
  p.na_rpb = (const float*)d_in[8];
  p.gdn_conv_w = (const float*)d_in[9];
  p.gdn_a_log = (const float*)d_in[10];
  p.gdn_dt_bias = (const float*)d_in[11];
  p.gdn_norm_w = (const float*)d_in[12];
  p.w_out = (const float*)d_in[13];
  p.rg_w = (const float*)d_in[14];
  p.rg_b = (const float*)d_in[15];
  p.re_w = (const float*)d_in[16];
  p.re_b = (const float*)d_in[17];
  p.ew1 = (const float*)d_in[18];
  p.ew3 = (const float*)d_in[19];
  p.ew2 = (const float*)d_in[20];
  p.final_w = (const float*)d_in[21];
  p.out = (float*)d_out;
  p.ws = (char*)d_ws;
  if (WS_TOTAL > ws_size) fprintf(stderr, "workspace too small: need %zu have %zu\n", (size_t)WS_TOTAL, ws_size);

  static int grid_blocks = 0;
  if (!grid_blocks) {
    int dev = 0, cus = 0, per_cu = 0;
    (void)hipGetDevice(&dev);
    (void)hipDeviceGetAttribute(&cus, hipDeviceAttributeMultiprocessorCount, dev);
    (void)hipOccupancyMaxActiveBlocksPerMultiprocessor(&per_cu, mega_kernel, NTHR, 0);
    if (per_cu > 1) per_cu = 1;
    if (per_cu < 1) per_cu = 1;
    grid_blocks = cus * per_cu;
  }
  (void)hipMemsetAsync((char*)d_ws + WS_bar, 0, sizeof(unsigned) * XCD_BAR_WORDS, stream);
  for (int i = 0; i < 12; ++i) p.rep[i] = 1;
  void* args[] = {&p};
  hipError_t e = hipLaunchCooperativeKernel((void*)mega_kernel, dim3(grid_blocks), dim3(NTHR), args, 0, stream);
  if (e != hipSuccess) fprintf(stderr, "cooperative launch failed: %s (grid %d)\n", hipGetErrorString(e), grid_blocks);
}
```

```cpp
#include <hip/hip_runtime.h>
#include <hip/hip_cooperative_groups.h>
#include <stdint.h>
#include <stdio.h>

#define DEV __device__ __forceinline__
namespace cg = cooperative_groups;

typedef __attribute__((ext_vector_type(8))) short bf16x8;
typedef __attribute__((ext_vector_type(4))) float f32x4;
typedef __attribute__((ext_vector_type(16))) float f32x16;
typedef float f32x2_t __attribute__((ext_vector_type(2)));
typedef __bf16 bf16x2_t __attribute__((ext_vector_type(2)));
typedef unsigned short bf16_t;
typedef unsigned u32x4 __attribute__((ext_vector_type(4)));

constexpr int NTHR = 512;
constexpr int NWAVE = 8;
constexpr int DM = 1024;
constexpr int NB = 2;
constexpr int T = 8192;
constexpr int NTOK = NB * T;
constexpr int DEPTH = 2;
constexpr int DIN = 3600;
constexpr int PROJW = 3584;
constexpr int NEXP = 32;
constexpr int DEXP = 512;
constexpr int CAP = 16384;
constexpr float EPS = 1e-6f;
constexpr int OFF_CB = 0, OFF_CC = 256, OFF_CX = 512, OFF_NQ = 768, OFF_NK = 1024, OFF_NV = 1280,
              OFF_GQKV = 1536, OFF_GZ = 3072;
constexpr int MOD_SHIFT1 = 0, MOD_SCALE1 = 1024, MOD_GATE1 = 2048, MOD_SHIFT2 = 3072, MOD_SCALE2 = 4096,
              MOD_GATE2 = 5120;

constexpr int REC_WN = 0, REC_QD = 16384, REC_IN = 32768, REC_KT = 40960, REC_BYTES = 57344;
constexpr int SC_WN = 0, SC_QD = 17408, SC_IN = 34816, SC_KT = 44032, SC_U = 62464, SC_BUF = 78848;
constexpr int PL_Q = 0, PL_K = 17408, PL_V = 34816, PL_L = 52224, PL_GC = 87040, PL_BETA = 87552, PL_BG = 88064,
              PL_GL = 88576;
constexpr int SMEM_BYTES = 2 * SC_BUF;

struct Params {
  const float *x, *c, *norm_mix_w, *norm_ffn_w, *w_ada, *b_ada, *w_in, *conv_a_w, *na_rpb, *gdn_conv_w,
      *gdn_a_log, *gdn_dt_bias, *gdn_norm_w, *w_out, *rg_w, *rg_b, *re_w, *re_b, *ew1, *ew3, *ew2, *final_w;
  float* out;
  float* mod;
  int* cnt;
  float* xbuf;
  bf16_t* act;
  bf16_t* proj;
  float* gates;
  bf16_t* y;
  bf16_t* obuf;
  char* gdn_rec;
  unsigned* gdn_u;
  float* egl;
  bf16_t* hbuf;
  bf16_t* ybuf;
  int* list;
  float* sgate;
  bf16_t* btin;
  bf16_t* btg;
  bf16_t* btout;
  bf16_t* bt1;
  bf16_t* bt2;
  float* wcat;
  float* wsc2;
  float* c0;
  unsigned* bar;
  int rep[12];
  int wv;
};

DEV unsigned pack2(float a, float b) {
  f32x2_t v = {a, b};
  return __builtin_bit_cast(unsigned, __builtin_convertvector(v, bf16x2_t));
}
DEV bf16_t f2bf(float f) { return (bf16_t)(pack2(f, 0.f) & 0xffffu); }
DEV float bf2f(bf16_t h) { return __uint_as_float(((unsigned)h) << 16); }
DEV float silu_f(float x) { return x / (1.f + __expf(-x)); }
DEV float sigmoid_f(float x) { return 1.f / (1.f + __expf(-x)); }
DEV float softplus_f(float x) { return fmaxf(x, 0.f) + log1pf(__expf(-fabsf(x))); }
DEV float shx(float v, int k, int lane) {
  return __int_as_float(__builtin_amdgcn_ds_bpermute((lane ^ k) << 2, __float_as_int(v)));
}
DEV float wave_sum(float v, int lane) {
#pragma unroll
  for (int o = 32; o > 0; o >>= 1) v += shx(v, o, lane);
  return v;
}
DEV int fresh_tid_w(int wv) {
  unsigned z = 0u;
  asm volatile("" : "+s"(wv), "+v"(z));
  int t = (wv << 6) | (int)__builtin_amdgcn_mbcnt_hi(~0u, __builtin_amdgcn_mbcnt_lo(~0u, z));
  asm volatile("" : "+v"(t));
  return t;
}
#define fresh_tid() fresh_tid_w(p.wv)
DEV void unpack8(uint4 u, float* f) {
  f[0] = __uint_as_float(u.x << 16);
  f[1] = __uint_as_float(u.x & 0xffff0000u);
  f[2] = __uint_as_float(u.y << 16);
  f[3] = __uint_as_float(u.y & 0xffff0000u);
  f[4] = __uint_as_float(u.z << 16);
  f[5] = __uint_as_float(u.z & 0xffff0000u);
  f[6] = __uint_as_float(u.w << 16);
  f[7] = __uint_as_float(u.w & 0xffff0000u);
}
DEV uint4 pack8(const float* f) {
  uint4 r;
  r.x = pack2(f[0], f[1]);
  r.y = pack2(f[2], f[3]);
  r.z = pack2(f[4], f[5]);
  r.w = pack2(f[6], f[7]);
  return r;
}
#define MFMA16(a, b, c) __builtin_amdgcn_mfma_f32_16x16x32_bf16((a), (b), (c), 0, 0, 0)
#define MFMA32(a, b, c) __builtin_amdgcn_mfma_f32_32x32x16_bf16((a), (b), (c), 0, 0, 0)

#define LAS __attribute__((address_space(3)))
#define XB_TMO      128
#define XB_XCNT(j)  (256  + 64 * (j))
#define XB_XSUB(j)  (1280 + 64 * (j))
#define XB_XGEN(j)  (2304 + 64 * (j))
#define XB_TOP      3328
#define XB_TOPGEN   3392
#define XCD_BAR_WORDS 3456
#define XB_PROG(c)   (3456 + 64 * (c))
#define XB_CXCC(c)   (3456 + 1024 + 64 * (c))
#define BAR_WORDS_TOTAL (3456 + 2048)
#define XB_SPIN_CAP (1u << 22)

DEV unsigned xb_ld(unsigned* p) { return __hip_atomic_load(p, __ATOMIC_RELAXED, __HIP_MEMORY_SCOPE_AGENT); }
DEV unsigned xb_add(unsigned* p, unsigned v) { return __hip_atomic_fetch_add(p, v, __ATOMIC_RELAXED, __HIP_MEMORY_SCOPE_AGENT); }
DEV unsigned xb_xcc_id() { return (unsigned)__builtin_amdgcn_s_getreg((3 << 11) | 20) & 0xFu; }
#define XB_SPIN(cond, bar) do { unsigned _sp = 0; while (cond) { __builtin_amdgcn_s_sleep(1); \
    if ((++_sp & 255u) == 0u) { if (xb_ld(&(bar)[XB_TMO])) break; if (_sp > XB_SPIN_CAP) { atomicAdd(&(bar)[XB_TMO], 1u); break; } } } } while (0)

DEV void xcd_barrier_post(unsigned* bar, int tid) {
  if (tid == 0) (void)xb_add(&bar[XB_XCNT(xb_xcc_id())], 1u);
}
DEV void xcd_barrier_complete(unsigned* bar, unsigned x, unsigned& nloc, unsigned& nx) {
  const unsigned G = gridDim.x * gridDim.y * gridDim.z;
  unsigned sum, cnt, mine, sp = 0u;
  for (;;) {
    sum = 0u; cnt = 0u; mine = 0u;
#pragma unroll
    for (unsigned j = 0; j < 16; ++j) {
      const unsigned c = xb_ld(&bar[XB_XCNT(j)]);
      sum += c;
      cnt += (c > 0u) ? 1u : 0u;
      mine = (j == x) ? c : mine;
    }
    if (sum == G) break;
    __builtin_amdgcn_s_sleep(1);
    if ((++sp & 255u) == 0u) {
      if (xb_ld(&bar[XB_TMO])) break;
      if (sp > XB_SPIN_CAP) { atomicAdd(&bar[XB_TMO], 1u); break; }
    }
  }
  nloc = mine > 0u ? mine : 1u;
  nx = cnt > 0u ? cnt : 1u;
}
DEV void xcd_barrier(unsigned* bar, volatile LAS unsigned* st, int tid) {
  asm volatile("s_waitcnt vmcnt(0)" ::: "memory");
  __syncthreads();
  if (tid == 0) {
    const unsigned bx = xb_xcc_id();
    __builtin_amdgcn_s_waitcnt(0);
    unsigned nloc = st[0], nx = st[1];
    const unsigned gen = st[2];
    st[2] = gen + 1u;
    if (nloc == 0u) {
      xcd_barrier_complete(bar, bx, nloc, nx);
      st[0] = nloc;
      st[1] = nx;
    }
    const unsigned old = xb_add(&bar[XB_XSUB(bx)], 1u);
    if (old + 1u == (gen + 1u) * nloc) {
      __builtin_amdgcn_fence(__ATOMIC_RELEASE, "agent");
      asm volatile("s_waitcnt vmcnt(0)" ::: "memory");
      const unsigned og = xb_add(&bar[XB_TOP], 1u);
      if (og + 1u == (gen + 1u) * nx) xb_add(&bar[XB_TOPGEN], 1u);
      else XB_SPIN(xb_ld(&bar[XB_TOPGEN]) == gen, bar);
      __builtin_amdgcn_fence(__ATOMIC_ACQUIRE, "agent");
      xb_add(&bar[XB_XGEN(bx)], 1u);
      asm volatile("s_waitcnt vmcnt(0)" ::: "memory");
    } else {
      XB_SPIN(xb_ld(&bar[XB_XGEN(bx)]) == gen, bar);
      __builtin_amdgcn_fence(__ATOMIC_ACQUIRE, "agent");
      asm volatile("s_waitcnt vmcnt(0)" ::: "memory");
    }
  }
  __syncthreads();
}

constexpr int G_BK = 64, G_HALF = 128, G_HTB = G_HALF * G_BK * 2, G_STAGE_BYTES = 8 * G_HTB;
DEV int g_lds_byte(int r, int c) {
  const int st = (r >> 4) * 2 + (c >> 5), rr = r & 15, cc = c & 31, ob = rr * 64 + cc * 2;
  return st * 1024 + (ob ^ (((ob >> 9) & 1) << 5));
}
DEV void g_stage_rc(int b, int& R, int& C) {
  const int st = b / 1024, sb = b % 1024, swz = sb ^ (((sb >> 9) & 1) << 5);
  R = (st >> 1) * 16 + swz / 64;
  C = (st & 1) * 32 + (swz % 64) / 2;
}
DEV int g_perm32(int rho) { const int n = rho >> 4, i = rho & 15; return 8 * (i >> 2) + 4 * n + (i & 3); }

struct GUnit { int pm, pn, e, valid; };

template <class Epi, class Sched>
DEV void gemm_phase(LAS unsigned char* lds, const Sched& S, const Epi& E) {
  const int tid = fresh_tid_w(S.wv), wid = S.wv, lane = tid & 63, wr = wid >> 2, wc = wid & 3, fr = lane & 15,
            fq = lane >> 4;
  const int K = S.K, nt = K / G_BK;
  GUnit cur, nxt;
  int ui = 0;
  if (!S.next(0, cur)) return;
  unsigned voffB[2];
#pragma unroll
  for (int i = 0; i < 2; ++i) {
    int R, C;
    g_stage_rc(tid * 16 + i * 8192, R, C);
    const int Rb = Epi::PERM ? ((R & ~31) + g_perm32(R & 31)) : R;
    voffB[i] = (unsigned)(Rb * K + C) * 2u;
  }
  unsigned vA[2][2];
  auto a_offsets = [&](const GUnit& u) {
#pragma unroll
    for (int h = 0; h < 2; ++h)
#pragma unroll
      for (int i = 0; i < 2; ++i) {
        int R, C;
        g_stage_rc(tid * 16 + i * 8192, R, C);
        vA[h][i] = S.rowoff(u, h * G_HALF + R) + (unsigned)C * 2u;
      }
  };
  const size_t kstep = (size_t)(G_BK * 2);
  const size_t hstep = (size_t)G_HALF * K * 2;
  const unsigned ldsw = (unsigned)wid * 1024u;
  const int aoff = g_lds_byte(wr * 64 + fr, fq * 8), boff = g_lds_byte(wc * 32 + fr, fq * 8);
#define PG8_SA(b, h) (((b) * 2 + (h)) * G_HTB)
#define PG8_SB(b, h) ((4 + (b) * 2 + (h)) * G_HTB)
#define PG8_STAGE(bufoff, gbase, voff) do { _Pragma("unroll") for (int _i = 0; _i < 2; ++_i) \
    __builtin_amdgcn_global_load_lds((const unsigned*)((const char*)(gbase) + (voff)[_i]), (LAS unsigned*)(lds + (bufoff) + ldsw + _i * 8192), 16, 0, 0); } while (0)
#define PG8_LDA(dst, b, h) do { _Pragma("unroll") for (int m = 0; m < 4; ++m) _Pragma("unroll") for (int k = 0; k < 2; ++k) dst[m][k] = *(const LAS bf16x8*)(lds + PG8_SA(b, h) + aoff + m * 2048 + k * 1024); } while (0)
#define PG8_LDB(dst, b, h) do { _Pragma("unroll") for (int n = 0; n < 2; ++n) _Pragma("unroll") for (int k = 0; k < 2; ++k) dst[n][k] = *(const LAS bf16x8*)(lds + PG8_SB(b, h) + boff + n * 2048 + k * 1024); } while (0)
#define PG8_MMA(ai, bj, At, Bt) do { __builtin_amdgcn_s_setprio(1); _Pragma("unroll") for (int m = 0; m < 4; ++m) _Pragma("unroll") for (int n = 0; n < 2; ++n) _Pragma("unroll") for (int k = 0; k < 2; ++k) \
    acc[ai][bj][m][n] = __builtin_amdgcn_mfma_f32_16x16x32_bf16(Bt[n][k], At[m][k], acc[ai][bj][m][n], 0, 0, 0); __builtin_amdgcn_s_setprio(0); } while (0)
#define PG8_WAIT_V(n) asm volatile("s_waitcnt vmcnt(" #n ")" ::: "memory")
#define PG8_WAIT_L(n) asm volatile("s_waitcnt lgkmcnt(" #n ")" ::: "memory")
#define PG8_BAR __builtin_amdgcn_s_barrier()
#define PG8_SCHED __builtin_amdgcn_sched_barrier(0)
  f32x4 acc[2][2][4][2];
#pragma unroll
  for (int a = 0; a < 2; ++a)
#pragma unroll
    for (int b = 0; b < 2; ++b)
#pragma unroll
      for (int m = 0; m < 4; ++m)
#pragma unroll
        for (int n = 0; n < 2; ++n) acc[a][b][m][n] = (f32x4){0.f, 0.f, 0.f, 0.f};
  bf16x8 At[4][2], B0[2][2], B1[2][2];
  const char* const gA = (const char*)S.A;
  const char* cB = S.bptr(cur);
  a_offsets(cur);
  PG8_STAGE(PG8_SB(0, 0), cB, voffB); PG8_STAGE(PG8_SA(0, 0), gA, vA[0]); PG8_STAGE(PG8_SB(0, 1), cB + hstep, voffB); PG8_STAGE(PG8_SA(0, 1), gA, vA[1]);
  if (wr == 1) PG8_BAR;
  PG8_WAIT_V(4); PG8_BAR;
  PG8_STAGE(PG8_SB(1, 0), cB + kstep, voffB); PG8_STAGE(PG8_SA(1, 0), gA + kstep, vA[0]); PG8_STAGE(PG8_SB(1, 1), cB + hstep + kstep, voffB);
  PG8_WAIT_V(6); PG8_BAR;
  for (;;) {
    const bool has_next = S.next(ui + 1, nxt);
    const char* nB = has_next ? S.bptr(nxt) : cB;
    for (int t = 0; t < nt; t += 2) {
      const bool last = (t == nt - 2);
      const char* a1 = gA + (size_t)(t + 1) * kstep;
      const char* a2 = last ? gA : gA + (size_t)(t + 2) * kstep;
      const char* b2 = last ? nB : cB + (size_t)(t + 2) * kstep;
      const char* a3 = a2 + kstep; const char* b3 = b2 + kstep;
      PG8_LDB(B0, 0, 0); PG8_SCHED; PG8_LDA(At, 0, 0); PG8_STAGE(PG8_SA(1, 1), a1, vA[1]);
      PG8_WAIT_L(8); PG8_BAR; PG8_WAIT_L(0); PG8_MMA(0, 0, At, B0); PG8_BAR; PG8_SCHED;
      if (last && has_next) a_offsets(nxt);
      PG8_LDB(B1, 0, 1); PG8_STAGE(PG8_SB(0, 0), b2, voffB);
      PG8_BAR; PG8_WAIT_L(0); PG8_MMA(0, 1, At, B1); PG8_BAR;
      PG8_LDA(At, 0, 1); PG8_STAGE(PG8_SA(0, 0), a2, vA[0]);
      PG8_BAR; PG8_WAIT_L(0); PG8_MMA(1, 0, At, B0); PG8_BAR; PG8_SCHED;
      PG8_STAGE(PG8_SB(0, 1), b2 + hstep, voffB);
      PG8_WAIT_V(6); PG8_BAR; PG8_MMA(1, 1, At, B1); PG8_BAR;
      PG8_LDB(B0, 1, 0); PG8_SCHED; PG8_LDA(At, 1, 0); PG8_STAGE(PG8_SA(0, 1), a2, vA[1]);
      PG8_WAIT_L(8); PG8_BAR; PG8_WAIT_L(0); PG8_MMA(0, 0, At, B0); PG8_BAR; PG8_SCHED;
      PG8_LDB(B1, 1, 1); PG8_STAGE(PG8_SB(1, 0), b3, voffB);
      PG8_BAR; PG8_WAIT_L(0); PG8_MMA(0, 1, At, B1); PG8_BAR;
      PG8_LDA(At, 1, 1); PG8_STAGE(PG8_SA(1, 0), a3, vA[0]);
      PG8_BAR; PG8_WAIT_L(0); PG8_MMA(1, 0, At, B0); PG8_BAR; PG8_SCHED;
      PG8_STAGE(PG8_SB(1, 1), b3 + hstep, voffB);
      PG8_WAIT_V(6); PG8_BAR; PG8_MMA(1, 1, At, B1); PG8_BAR;
    }
    E(acc, cur, wr, wc, fr, fq);
    if (!has_next) break;
#pragma unroll
    for (int a = 0; a < 2; ++a)
#pragma unroll
      for (int b = 0; b < 2; ++b)
#pragma unroll
        for (int m = 0; m < 4; ++m)
#pragma unroll
          for (int n = 0; n < 2; ++n) acc[a][b][m][n] = (f32x4){0.f, 0.f, 0.f, 0.f};
    cur = nxt; cB = nB; ++ui;
  }
  PG8_WAIT_V(0);
  if (wr == 0) PG8_BAR;
  PG8_BAR;
#undef PG8_SA
#undef PG8_SB
#undef PG8_STAGE
#undef PG8_LDA
#undef PG8_LDB
#undef PG8_MMA
#undef PG8_WAIT_V
#undef PG8_WAIT_L
#undef PG8_BAR
#undef PG8_SCHED
}

struct DenseSched {
  const bf16_t* A; const bf16_t* Bt; int K, nM, nN, nwg, G, c, wv;
  DEV bool next(int i, GUnit& u) const {
    const long L = (long)i * G + c;
    if (L >= nwg) return false;
    int wgid = (int)L;
    { const int q = nwg / 8, r = nwg % 8, xcd = wgid % 8, off = wgid / 8; wgid = (xcd < r ? xcd * (q + 1) : r * (q + 1) + (xcd - r) * q) + off; }
    const int nig = 8 * nN, gid = wgid / nig, fm = gid * 8;
    u.pm = fm + ((wgid % nig) & 7);
    u.pn = (wgid % nig) >> 3;
    u.e = 0;
    u.valid = 256;
    return true;
  }
  DEV unsigned rowoff(const GUnit& u, int row) const { return (unsigned)((u.pm * 256 + row) * K) * 2u; }
  DEV const char* bptr(const GUnit& u) const { return (const char*)Bt + (size_t)u.pn * 256 * K * 2; }
};
struct MoeSched {
  const bf16_t* A; const bf16_t* Bt; int K; const int* cnt; const int* list; int G, c, shift, wv;
  DEV bool next(int i, GUnit& u) const {
    int L = i * G + c;
    for (int e = 0; e < NEXP; ++e) {
      const int cn = cnt[e];
      const int ntl = ((cn + 255) >> 8) * 4;
      if (L < ntl) {
        u.e = e; u.pm = L >> 2; u.pn = L & 3; u.valid = min(256, cn - u.pm * 256);
        return true;
      }
      L -= ntl;
    }
    return false;
  }
  DEV unsigned rowoff(const GUnit& u, int row) const {
    const int slot = list[u.e * CAP + u.pm * 256 + min(row, u.valid - 1)];
    return (unsigned)((slot >> shift) * K) * 2u;
  }
  DEV const char* bptr(const GUnit& u) const { return (const char*)Bt + ((size_t)u.e * 1024 + u.pn * 256) * K * 2; }
};

DEV void convert_tile(const float* src, int ld, int k0, int n0, bf16_t* dst, int drow0, int dK, float* tl, int tid) {
  {
    const int kk = tid >> 4, n4 = tid & 15;
    const float4 a = *(const float4*)(src + (size_t)(k0 + kk) * ld + n0 + n4 * 4);
    const float4 b = *(const float4*)(src + (size_t)(k0 + kk + 32) * ld + n0 + n4 * 4);
    float* r0 = tl + kk * 65 + n4 * 4;
    r0[0] = a.x; r0[1] = a.y; r0[2] = a.z; r0[3] = a.w;
    float* r1 = tl + (kk + 32) * 65 + n4 * 4;
    r1[0] = b.x; r1[1] = b.y; r1[2] = b.z; r1[3] = b.w;
  }
  __syncthreads();
  {
    const int n = tid >> 3, k8 = tid & 7;
    float v[8];
#pragma unroll
    for (int j = 0; j < 8; ++j) v[j] = tl[(k8 * 8 + j) * 65 + n];
    *(uint4*)(dst + (size_t)(drow0 + n) * dK + k0 + k8 * 8) = pack8(v);
  }
  __syncthreads();
}
DEV void convert_gates(const Params& p, int l, int bid, int nb, int tid) {
  int bs = bid;
  asm volatile("" : "+s"(bs));
  const int g = bs * NTHR + tid;
  if (g < 16 * DM) {
    const int j = g >> 10, k = g & (DM - 1);
    p.btg[g] = f2bf(p.w_in[((size_t)l * DM + k) * DIN + PROJW + j]);
  }
}
DEV void convert_win(const Params& p, int l, int bid, int nb, char* smem) {
  const int tid = fresh_tid();
  for (int t = bid; t < 16 * 56; t += nb) {
    const int kt = t / 56, ntile = t - kt * 56;
    convert_tile(p.w_in + (size_t)l * DM * DIN, DIN, kt * 64, ntile * 64, p.btin, ntile * 64, DM, (float*)smem, tid);
  }
  convert_gates(p, l, bid, nb, tid);
}
DEV void convert_layer(const Params& p, int l, int bid, int nb, char* smem) {
  const int tid = fresh_tid();
  float* tl = (float*)smem;
  const int NT_W1 = NEXP * 16 * 8, NT_W2 = NEXP * 8 * 16, NT_WO = 256;
  for (int t = bid; t < 2 * NT_W1 + NT_W2 + NT_WO; t += nb) {
    if (t < 2 * NT_W1) {
      const int which = t / NT_W1, r = t - which * NT_W1;
      const int e = r >> 7, kt = (r >> 3) & 15, ntile = r & 7;
      const float* src = (which ? p.ew3 : p.ew1) + (size_t)(l * NEXP + e) * DM * DEXP;
      const int n0 = ntile * 64;
      const int drow0 = e * 1024 + 256 * (n0 >> 7) + which * 128 + (n0 & 127);
      convert_tile(src, DEXP, kt * 64, n0, p.bt1, drow0, DM, tl, tid);
    } else if (t < 2 * NT_W1 + NT_W2) {
      const int r = t - 2 * NT_W1;
      const int e = r >> 7, kt = (r >> 4) & 7, ntile = r & 15;
      const float* src = p.ew2 + (size_t)(l * NEXP + e) * DEXP * DM;
      convert_tile(src, DM, kt * 64, ntile * 64, p.bt2, e * 1024 + ntile * 64, DEXP, tl, tid);
    } else {
      const int r = t - 2 * NT_W1 - NT_W2;
      const int kt = r >> 4, ntile = r & 15;
      convert_tile(p.w_out + (size_t)l * DM * DM, DM, kt * 64, ntile * 64, p.btout, ntile * 64, DM, tl, tid);
    }
  }
  if (l + 1 < DEPTH) convert_win(p, l + 1, bid, nb, smem);
}

DEV void phase_ada(const Params& p, int bid, int nb, char* smem) {
  float* cond = (float*)smem;
  float* red = cond + 2 * DM;
  const int tid = fresh_tid(), lane = tid & 63, wid = tid >> 6;
  for (int i = tid; i < 2 * DM; i += NTHR) cond[i] = silu_f(p.c[i]);
  __syncthreads();
  for (int item = bid; item < DEPTH * 96; item += nb) {
    const int l = item / 96, j = (item - l * 96) * 64 + lane;
    const float* w = p.w_ada + ((size_t)l * DM + wid * 128) * 6144 + j;
    float a0 = 0.f, a1 = 0.f;
#pragma unroll 16
    for (int k = 0; k < 128; ++k) {
      const float wv = w[(size_t)k * 6144];
      a0 += cond[wid * 128 + k] * wv;
      a1 += cond[DM + wid * 128 + k] * wv;
    }
    red[(wid * 2 + 0) * 64 + lane] = a0;
    red[(wid * 2 + 1) * 64 + lane] = a1;
    __syncthreads();
    if (wid < 2) {
      float s = p.b_ada[l * 6144 + j];
#pragma unroll
      for (int w8 = 0; w8 < 8; ++w8) s += red[(w8 * 2 + wid) * 64 + lane];
      p.mod[(l * 2 + wid) * 6144 + j] = s;
    }
    __syncthreads();
  }
  if (bid == 0 && tid < DEPTH * NEXP) p.cnt[tid] = 0;
}

DEV void norm_mod_store(const float4 (&v)[4], float rstd, const float* nw, const float* sc, const float* sh,
                        bf16_t* dst, int lane) {
#pragma unroll
  for (int i = 0; i < 4; ++i) {
    const int idx = (lane + 64 * i) * 4;
    const float4 w = *(const float4*)(nw + idx);
    const float4 s = *(const float4*)(sc + idx);
    const float4 h = *(const float4*)(sh + idx);
    const float r0 = v[i].x * rstd * w.x * (1.f + s.x) + h.x;
    const float r1 = v[i].y * rstd * w.y * (1.f + s.y) + h.y;
    const float r2 = v[i].z * rstd * w.z * (1.f + s.z) + h.z;
    const float r3 = v[i].w * rstd * w.w * (1.f + s.w) + h.w;
    uint2 pk;
    pk.x = pack2(r0, r1);
    pk.y = pack2(r2, r3);
    *(uint2*)(dst + idx) = pk;
  }
}

DEV void phase_hmix(const Params& p, int l, const float* xin, int bid, int nb) {
  const int tid_ = fresh_tid(), lane = tid_ & 63, wid = tid_ >> 6;
  for (int t = bid * NWAVE + wid; t < NTOK; t += nb * NWAVE) {
    const float4* xr = (const float4*)(xin + (size_t)t * DM);
    float4 v[4];
    float ss = 0.f;
#pragma unroll
    for (int i = 0; i < 4; ++i) {
      v[i] = xr[lane + 64 * i];
      ss += v[i].x * v[i].x + v[i].y * v[i].y + v[i].z * v[i].z + v[i].w * v[i].w;
    }
    ss = wave_sum(ss, lane);
    const float rstd = rsqrtf(ss * (1.f / DM) + EPS);
    const int b = t / T;
    const float* md = p.mod + (l * 2 + b) * 6144;
    norm_mod_store(v, rstd, p.norm_mix_w + l * DM, md + MOD_SCALE1, md + MOD_SHIFT1, p.act + (size_t)t * DM, lane);
  }
}

struct EpiProj {
  static constexpr bool PERM = true;
  bf16_t* O;
  DEV void operator()(const f32x4 (&acc)[2][2][4][2], const GUnit& u, int wr, int wc, int fr, int fq) const {
    const int row0 = u.pm * 256 + wr * 64 + fr, col0 = u.pn * 256 + wc * 32 + 8 * fq;
#pragma unroll
    for (int ai = 0; ai < 2; ++ai)
#pragma unroll
      for (int m = 0; m < 4; ++m) {
        bf16_t* rowp = O + (size_t)(row0 + ai * G_HALF + m * 16) * PROJW + col0;
#pragma unroll
        for (int bj = 0; bj < 2; ++bj) {
          const f32x4 v0 = acc[ai][bj][m][0], v1 = acc[ai][bj][m][1];
          uint4 w;
          w.x = pack2(v0[0], v0[1]); w.y = pack2(v0[2], v0[3]); w.z = pack2(v1[0], v1[1]); w.w = pack2(v1[2], v1[3]);
          *(uint4*)(rowp + bj * G_HALF) = w;
        }
      }
  }
};

DEV void phase_gemm_proj(const Params& p, int l, int bid, int nb, char* smem) {
  DenseSched S;
  S.A = p.act; S.Bt = p.btin; S.K = DM; S.nM = NTOK / 256; S.nN = PROJW / 256; S.nwg = S.nM * S.nN; S.G = nb; S.c = bid; S.wv = p.wv;
  EpiProj E;
  E.O = p.proj;
  gemm_phase((LAS unsigned char*)smem, S, E);
  const int tid = fresh_tid(), lane = tid & 63, wid = tid >> 6, fr = lane & 15, fq = lane >> 4;
  for (int tb = bid; tb < NTOK / 64; tb += nb) {
    if (wid < 4) {
      const int tok0 = tb * 64 + wid * 16;
      const bf16_t* ap = p.act + (size_t)(tok0 + fr) * DM + fq * 8;
      const bf16_t* bp = p.btg + (size_t)fr * DM + fq * 8;
      f32x4 acc = {0.f, 0.f, 0.f, 0.f};
#pragma unroll 8
      for (int ks = 0; ks < DM / 32; ++ks)
        acc = MFMA16(*(const bf16x8*)(ap + ks * 32), *(const bf16x8*)(bp + ks * 32), acc);
#pragma unroll
      for (int j = 0; j < 4; ++j) p.gates[(size_t)(tok0 + fq * 4 + j) * 16 + fr] = acc[j];
    }
  }
}

DEV void phase_conv(const Params& p, int l, int bid, int nb) {
  const float* w = p.conv_a_w + l * 768;
  int bs = bid;
  asm volatile("" : "+s"(bs));
  for (int g = bs * NTHR + fresh_tid(); g < NTOK * 256; g += nb * NTHR) {
    const int t = g >> 8, c = g & 255;
    const int tl = t & (T - 1);
    const bf16_t* r = p.proj + (size_t)t * PROJW;
    const float cb = bf2f(r[OFF_CB + c]);
    const float mid = bf2f(r[OFF_CC + c]) * bf2f(r[OFF_CX + c]);
    float prev = 0.f, next = 0.f;
    if (tl > 0) prev = bf2f(r[OFF_CC + c - PROJW]) * bf2f(r[OFF_CX + c - PROJW]);
    if (tl < T - 1) next = bf2f(r[OFF_CC + c + PROJW]) * bf2f(r[OFF_CX + c + PROJW]);
    const float s = w[c] * prev + w[256 + c] * mid + w[512 + c] * next;
    p.y[(size_t)t * DM + c] = f2bf(cb * s);
  }
}

DEV void phase_na(const Params& p, int l, int wgid, int nwg) {
  const int tid_ = fresh_tid(), lane = tid_ & 63, fr = lane & 15, fq = lane >> 4;
  for (int item = wgid; item < NB * 128 * 4 * 4; item += nwg) {
    const int qg = item & 3, h = (item >> 2) & 3, r = (item >> 4) & 127, b = item >> 11;
    const int rs = min(max(r - 4, 0), 120);
    const int kc0 = (qg == 0) ? 0 : (qg == 1) ? 8 : (qg == 2) ? 24 : 32;
    const int c = qg * 16 + fr;
    const int cs = min(max(c - 8, 0), 48);
    const size_t tq = (size_t)b * T + r * 64 + c;
    bf16x8 bq[2];
#pragma unroll
    for (int ks = 0; ks < 2; ++ks)
      bq[ks] = *(const bf16x8*)(p.proj + tq * PROJW + OFF_NQ + h * 64 + ks * 32 + fq * 8);
    f32x4 sc[16];
#pragma unroll
    for (int tt = 0; tt < 16; ++tt) {
      const int i = tt >> 1, half = tt & 1;
      const size_t kt = (size_t)b * T + (rs + i) * 64 + kc0 + half * 16 + fr;
      const bf16_t* kp = p.proj + kt * PROJW + OFF_NK + h * 64 + fq * 8;
      const bf16x8 a0 = *(const bf16x8*)(kp);
      const bf16x8 a1 = *(const bf16x8*)(kp + 32);
      f32x4 z = {0.f, 0.f, 0.f, 0.f};
      z = MFMA16(a0, bq[0], z);
      sc[tt] = MFMA16(a1, bq[1], z);
    }
    const float* rpb = p.na_rpb + (size_t)(l * 4 + h) * 465;
    float mx = -3.0e38f;
#pragma unroll
    for (int tt = 0; tt < 16; ++tt) {
      const int i = tt >> 1, half = tt & 1;
      const int dr = rs + i - r + 7;
#pragma unroll
      for (int j = 0; j < 4; ++j) {
        const int kcol = kc0 + half * 16 + fq * 4 + j;
        const bool valid = (kcol >= cs) && (kcol < cs + 16);
        const int dc = valid ? (kcol - c + 15) : 0;
        const float s = valid ? (sc[tt][j] * 0.125f + rpb[dr * 31 + dc]) : -3.0e38f;
        sc[tt][j] = s;
        mx = fmaxf(mx, s);
      }
    }
    mx = fmaxf(mx, shx(mx, 16, lane));
    mx = fmaxf(mx, shx(mx, 32, lane));
    float sum = 0.f;
#pragma unroll
    for (int tt = 0; tt < 16; ++tt)
#pragma unroll
      for (int j = 0; j < 4; ++j) {
        const float s = sc[tt][j];
        const float e = (s > -1.0e38f) ? __expf(s - mx) : 0.f;
        sc[tt][j] = e;
        sum += e;
      }
    sum += shx(sum, 16, lane);
    sum += shx(sum, 32, lane);
    const float inv = 1.f / sum;
    f32x4 oacc[4];
#pragma unroll
    for (int nt = 0; nt < 4; ++nt) oacc[nt] = f32x4{0.f, 0.f, 0.f, 0.f};
#pragma unroll
    for (int i = 0; i < 8; ++i) {
      uint4 pu;
      pu.x = pack2(sc[2 * i][0] * inv, sc[2 * i][1] * inv);
      pu.y = pack2(sc[2 * i][2] * inv, sc[2 * i][3] * inv);
      pu.z = pack2(sc[2 * i + 1][0] * inv, sc[2 * i + 1][1] * inv);
      pu.w = pack2(sc[2 * i + 1][2] * inv, sc[2 * i + 1][3] * inv);
      const bf16x8 pa = __builtin_bit_cast(bf16x8, pu);
      const bf16_t* vb = p.proj + ((size_t)b * T + (rs + i) * 64 + kc0 + fq * 4) * PROJW + OFF_NV + h * 64 + fr;
#pragma unroll
      for (int nt = 0; nt < 4; ++nt) {
        bf16x8 bv;
#pragma unroll
        for (int j = 0; j < 4; ++j) {
          bv[j] = (short)vb[(size_t)j * PROJW + nt * 16];
          bv[4 + j] = (short)vb[(size_t)(16 + j) * PROJW + nt * 16];
        }
        oacc[nt] = MFMA16(pa, bv, oacc[nt]);
      }
    }
#pragma unroll
    for (int nt = 0; nt < 4; ++nt)
#pragma unroll
      for (int j = 0; j < 4; ++j)
        p.y[((size_t)b * T + r * 64 + qg * 16 + fq * 4 + j) * DM + 256 + h * 64 + nt * 16 + fr] = f2bf(oacc[nt][j]);
  }
}

template <int POS>
struct SolveStep {
  static DEV void run(float (&x)[64], const float* Ld, const float* sclv, const bf16_t* src, int dir, bool isu,
                      unsigned* up, bf16_t* wp) {
    SolveStep<POS - 1>::run(x, Ld, sclv, src, dir, isu, up, wp);
    const int i = dir ? 63 - POS : POS;
    float a = sclv[POS] * bf2f(src[i * 136]);
#pragma unroll
    for (int j4 = 0; j4 < (POS + 3) / 4; ++j4) {
      const float4 lv = *(const float4*)(Ld + POS * 68 + j4 * 4);
      a -= lv.x * x[j4 * 4];
      if (j4 * 4 + 1 < POS) a -= lv.y * x[j4 * 4 + 1];
      if (j4 * 4 + 2 < POS) a -= lv.z * x[j4 * 4 + 2];
      if (j4 * 4 + 3 < POS) a -= lv.w * x[j4 * 4 + 3];
    }
    x[POS] = a;
    if (isu) {
      if (POS & 1) up[(POS >> 1) * 128] = pack2(x[POS - 1], a);
    } else {
      wp[POS * 128] = f2bf(-a);
    }
    asm volatile("" ::: "memory");
  }
};
template <>
struct SolveStep<-1> {
  static DEV void run(float (&)[64], const float*, const float*, const bf16_t*, int, bool, unsigned*, bf16_t*) {}
};

DEV void phase_gdn_prep(const Params& p, int l, int bid, int nb, char* smem) {
  const int tid = fresh_tid(), lane = tid & 63;
  bf16_t* q_bf = (bf16_t*)(smem + PL_Q);
  bf16_t* k_bf = (bf16_t*)(smem + PL_K);
  bf16_t* v_bf = (bf16_t*)(smem + PL_V);
  float* Lm = (float*)(smem + PL_L);
  float* gcl = (float*)(smem + PL_GC);
  float* bl = (float*)(smem + PL_BETA);
  float* bgl = (float*)(smem + PL_BG);
  float* gll = (float*)(smem + PL_GL);
  const float* cw = p.gdn_conv_w + l * 4608;
  for (int item = bid; item < 1024; item += nb) {
    const int b = item >> 9, h = (item >> 7) & 3, n = item & 127;
    const int t0 = b * T + n * 64;
    char* rec0 = p.gdn_rec + (size_t)item * 2 * REC_BYTES;
    if (tid < 128) {
      const int dir = tid >> 6;
      const int i = dir ? 63 - lane : lane;
      const size_t t = (size_t)t0 + i;
      const float a = p.gates[t * 16 + dir * 4 + h], bb = p.gates[t * 16 + 8 + dir * 4 + h];
      const float g = -__expf(p.gdn_a_log[l * 8 + dir * 4 + h]) * softplus_f(a + p.gdn_dt_bias[l * 8 + dir * 4 + h]);
      const float beta = sigmoid_f(bb);
      float cs = g;
#pragma unroll
      for (int o = 1; o < 64; o <<= 1) {
        const float v = __int_as_float(__builtin_amdgcn_ds_bpermute((lane - o) << 2, __float_as_int(cs)));
        if (lane >= o) cs += v;
      }
      gcl[dir * 64 + lane] = cs;
      bl[dir * 64 + lane] = beta;
      bgl[dir * 64 + lane] = beta * __expf(cs);
      const float last = __uint_as_float(__builtin_amdgcn_readlane(__float_as_uint(cs), 63));
      if (lane == 0) {
        gll[dir] = last;
        p.egl[item * 2 + dir] = __expf(last);
      }
    }
    __syncthreads();
    {
      int tA = tid;
      asm volatile("" : "+v"(tA));
      const int i = tA >> 3, oc = tA & 7, d0 = oc * 16;
      const int tl = n * 64 + i;
      const bf16_t* rowp = p.proj + (size_t)(t0 + i) * PROJW + OFF_GQKV + h * 128 + d0;
#pragma unroll 1
      for (int m = 0; m < 3; ++m) {
        const bf16_t* rp = rowp + m * 512;
        float x0[16], x1[16], x2[16], val[16];
        unpack8(*(const uint4*)(rp), x1);
        unpack8(*(const uint4*)(rp + 8), x1 + 8);
        if (tl > 0) {
          unpack8(*(const uint4*)(rp - PROJW), x0);
          unpack8(*(const uint4*)(rp - PROJW + 8), x0 + 8);
        } else {
#pragma unroll
          for (int e = 0; e < 16; ++e) x0[e] = 0.f;
        }
        if (tl < T - 1) {
          unpack8(*(const uint4*)(rp + PROJW), x2);
          unpack8(*(const uint4*)(rp + PROJW + 8), x2 + 8);
        } else {
#pragma unroll
          for (int e = 0; e < 16; ++e) x2[e] = 0.f;
        }
        const float* cwm = cw + m * 512 + h * 128 + d0;
        float ss = 0.f;
#pragma unroll
        for (int e = 0; e < 16; ++e) {
          val[e] = silu_f(cwm[e] * x0[e] + cwm[1536 + e] * x1[e] + cwm[3072 + e] * x2[e]);
          ss += val[e] * val[e];
        }
        if (m < 2) {
          ss += shx(ss, 1, lane);
          ss += shx(ss, 2, lane);
          ss += shx(ss, 4, lane);
          float sc = rsqrtf(ss + EPS);
          if (m == 0) sc *= 0.08838834764831845f;
#pragma unroll
          for (int e = 0; e < 16; ++e) val[e] *= sc;
        }
        bf16_t* dst = (m == 0 ? q_bf : (m == 1 ? k_bf : v_bf)) + i * 136 + d0;
        *(uint4*)(dst) = pack8(val);
        *(uint4*)(dst + 8) = pack8(val + 8);
        if (m == 0) {
#pragma unroll
          for (int dir = 0; dir < 2; ++dir) {
            const int pos = dir ? 63 - i : i;
            const float f = __expf(gcl[dir * 64 + pos]);
            float tmp[16];
#pragma unroll
            for (int e = 0; e < 16; ++e) tmp[e] = val[e] * f;
            bf16_t* qd = (bf16_t*)(rec0 + dir * REC_BYTES + REC_QD) + pos * 128 + d0;
            *(uint4*)(qd) = pack8(tmp);
            *(uint4*)(qd + 8) = pack8(tmp + 8);
          }
        }
        if (m == 1) {
#pragma unroll
          for (int dir = 0; dir < 2; ++dir) {
            const int pos = dir ? 63 - i : i;
            const float f = __expf(gll[dir] - gcl[dir * 64 + pos]);
            bf16_t* kt = (bf16_t*)(rec0 + dir * REC_BYTES + REC_KT) + d0 * 64 + pos;
#pragma unroll
            for (int e = 0; e < 16; ++e) kt[e * 64] = f2bf(val[e] * f);
          }
        }
      }
    }
    __syncthreads();
    {
      int tB = tid;
      asm volatile("" : "+v"(tB));
      const int laneB = tB & 63, widB = tB >> 6, fr = laneB & 15, fq = laneB >> 4;
      const int mat = widB >> 2, rtile = widB & 3;
      const bf16_t* asrc = mat ? q_bf : k_bf;
      bf16x8 af[4];
#pragma unroll
      for (int ks = 0; ks < 4; ++ks) af[ks] = *(const bf16x8*)(asrc + (rtile * 16 + fr) * 136 + ks * 32 + fq * 8);
#pragma unroll
      for (int nt = 0; nt < 4; ++nt) {
        f32x4 acc = {0.f, 0.f, 0.f, 0.f};
#pragma unroll
        for (int ks = 0; ks < 4; ++ks) {
          const bf16x8 bfrag = *(const bf16x8*)(k_bf + (nt * 16 + fr) * 136 + ks * 32 + fq * 8);
          acc = MFMA16(af[ks], bfrag, acc);
        }
#pragma unroll
        for (int j = 0; j < 4; ++j) {
          const int i = rtile * 16 + fq * 4 + j, jj = nt * 16 + fr;
          const float G = acc[j];
#pragma unroll
          for (int dir = 0; dir < 2; ++dir) {
            const int pi = dir ? 63 - i : i, pj = dir ? 63 - jj : jj;
            const float dec = __expf(fminf(gcl[dir * 64 + pi] - gcl[dir * 64 + pj], 0.f));
            if (mat == 0)
              Lm[(dir * 64 + pi) * 68 + pj] = (pi > pj) ? bl[dir * 64 + pi] * G * dec : 0.f;
            else
              *((bf16_t*)(rec0 + dir * REC_BYTES + REC_IN) + pi * 64 + pj) = f2bf((pi >= pj) ? G * dec : 0.f);
          }
        }
      }
    }
    __syncthreads();
    {
      int tC = tid;
      asm volatile("" : "+v"(tC));
      const int dir = tC >> 8, c = tC & 255;
      const float* Ld = Lm + dir * 64 * 68;
      const bool isu = c < 128;
      unsigned* up = p.gdn_u + ((size_t)(item * 2 + dir) * 32) * 128 + (c & 127);
      bf16_t* wp = (bf16_t*)(rec0 + dir * REC_BYTES + REC_WN) + (c & 127);
      const bf16_t* src = (isu ? v_bf : k_bf) + (c & 127);
      const float* sclv = (isu ? bl : bgl) + dir * 64;
      float x[64];
      SolveStep<63>::run(x, Ld, sclv, src, dir, isu, up, wp);
    }
    __syncthreads();
  }
}

DEV int crow(int reg, int hf) { return (reg & 3) + 8 * (reg >> 2) + 4 * hf; }
DEV bf16x8 pack_acc8(const f32x16& x, int s) {
  uint4 v;
  v.x = pack2(x[8 * s + 0], x[8 * s + 1]);
  v.y = pack2(x[8 * s + 2], x[8 * s + 3]);
  v.z = pack2(x[8 * s + 4], x[8 * s + 5]);
  v.w = pack2(x[8 * s + 6], x[8 * s + 7]);
  return __builtin_bit_cast(bf16x8, v);
}
DEV bf16x8 ld_frag(const char* rowp, int kb) { return *(const bf16x8*)(rowp + kb); }

DEV void phase_gdn_scan(const Params& p, int l, int chain, char* smem) {
  const int tid = fresh_tid(), lane = tid & 63, wid = tid >> 6;
  const int dir = chain & 1, bh = chain >> 1;
  const int b = bh >> 2, hh = bh & 3;
  if (wid >= 4) {
    const int lt = tid - 256;
    uint4 rA[18], rB[18];
    auto gl = [&](uint4 (&rg)[18], int n) {
      const int item = bh * 128 + (dir ? 127 - n : n);
      const __amdgpu_buffer_rsrc_t rr = __builtin_amdgcn_make_buffer_rsrc(
          (void*)(p.gdn_rec + ((size_t)item * 2 + dir) * REC_BYTES), 0, REC_BYTES, 0x00020000);
      const __amdgpu_buffer_rsrc_t ru = __builtin_amdgcn_make_buffer_rsrc(
          (void*)(p.gdn_u + ((size_t)(item * 2 + dir) * 32) * 128), 0, 16384, 0x00020000);
#pragma unroll
      for (int k = 0; k < 14; ++k) {
        const u32x4 v = __builtin_amdgcn_raw_buffer_load_b128(rr, lt * 16, k * 4096, 0);
        rg[k] = make_uint4(v.x, v.y, v.z, v.w);
      }
#pragma unroll
      for (int k = 0; k < 4; ++k) {
        const u32x4 v = __builtin_amdgcn_raw_buffer_load_b128(ru, lt * 16, k * 4096, 0);
        rg[14 + k] = make_uint4(v.x, v.y, v.z, v.w);
      }
    };
    auto st = [&](const uint4 (&rg)[18], int buf) {
      char* base = smem + buf * SC_BUF;
#pragma unroll
      for (int k = 0; k < 14; ++k) {
        const int u = lt + 256 * k;
        int row, c16, off;
        if (k < 4) { row = u >> 4; c16 = u & 15; off = SC_WN + row * 272; }
        else if (k < 8) { row = (u - 1024) >> 4; c16 = (u - 1024) & 15; off = SC_QD + row * 272; }
        else if (k < 10) { row = (u - 2048) >> 3; c16 = (u - 2048) & 7; off = SC_IN + row * 144; }
        else { row = (u - 2560) >> 3; c16 = (u - 2560) & 7; off = SC_KT + row * 144; }
        char* dst = base + off + (c16 >> 1) * 32 + (c16 & 1) * 8;
        *(uint2*)(dst) = make_uint2(rg[k].x, rg[k].y);
        *(uint2*)(dst + 16) = make_uint2(rg[k].z, rg[k].w);
      }
#pragma unroll
      for (int k = 0; k < 4; ++k) *(uint4*)(base + SC_U + (lt + 256 * k) * 16) = rg[14 + k];
    };
    gl(rA, 0);
    st(rA, 0);
    gl(rB, 1);
    gl(rA, 2);
    __syncthreads();
#pragma unroll 1
    for (int n = 0; n < 128; n += 2) {
      st(rB, 1);
      gl(rB, min(n + 3, 127));
      __syncthreads();
      st(rA, 0);
      gl(rA, min(n + 4, 127));
      __syncthreads();
    }
  } else {
    const int w = wid, r = lane & 31, hf = lane >> 5;
    f32x16 S[4];
#pragma unroll
    for (int t4 = 0; t4 < 4; ++t4)
#pragma unroll
      for (int e = 0; e < 16; ++e) S[t4][e] = 0.f;
    const float dlo = p.egl[(bh * 128 + (dir ? 127 - lane : lane)) * 2 + dir];
    const float dhi = p.egl[(bh * 128 + (dir ? 63 - lane : 64 + lane)) * 2 + dir];
    if (tid == 0) __hip_atomic_store(&p.bar[XB_CXCC(chain)], ((unsigned)(l + 1) << 4) | xb_xcc_id(), __ATOMIC_RELAXED, __HIP_MEMORY_SCOPE_AGENT);
    __syncthreads();
#pragma unroll 1
    for (int n = 0; n < 128; ++n) {
      if (tid == 0) __hip_atomic_store(&p.bar[XB_PROG(chain)], (unsigned)(l + 1) * 1024u + (unsigned)n, __ATOMIC_RELAXED, __HIP_MEMORY_SCOPE_AGENT);
      const char* buf = smem + (n & 1) * SC_BUF;
      const float decay = __uint_as_float(__builtin_amdgcn_readlane(__float_as_uint(n < 64 ? dlo : dhi), n & 63));
      f32x16 vn[2], o[2];
      {
        const unsigned* ul = (const unsigned*)(buf + SC_U) + 32 * w + r;
#pragma unroll
        for (int tm = 0; tm < 2; ++tm)
#pragma unroll
          for (int e2 = 0; e2 < 8; ++e2) {
            const unsigned uu = ul[((32 * tm + crow(2 * e2, hf)) >> 1) * 128];
            vn[tm][2 * e2] = __uint_as_float(uu << 16);
            vn[tm][2 * e2 + 1] = __uint_as_float(uu & 0xffff0000u);
          }
      }
#pragma unroll
      for (int e = 0; e < 16; ++e) { o[0][e] = 0.f; o[1][e] = 0.f; }
      bf16x8 sb[4][2];
#pragma unroll
      for (int t4 = 0; t4 < 4; ++t4) {
        sb[t4][0] = pack_acc8(S[t4], 0);
        sb[t4][1] = pack_acc8(S[t4], 1);
      }
      const char* rw0 = buf + SC_WN + r * 272 + hf * 16;
      const char* rq0 = buf + SC_QD + r * 272 + hf * 16;
      const char* ri0 = buf + SC_IN + r * 144 + hf * 16;
      const char* rk0 = buf + SC_KT + r * 144 + hf * 16;
      bf16x8 fA[8], fB[8];
#define SCAN_LOAD(dst, base, t4a)                                                                        \
  _Pragma("unroll") for (int dt = 0; dt < 2; ++dt) _Pragma("unroll") for (int s = 0; s < 2; ++s)         \
      _Pragma("unroll") for (int tm = 0; tm < 2; ++tm)                                                   \
          dst[dt * 4 + s * 2 + tm] = ld_frag(base + tm * 32 * 272, (32 * ((t4a) + dt) + 16 * s) * 2);
#define SCAN_MMA(acc, f, t4a)                                                                            \
  _Pragma("unroll") for (int dt = 0; dt < 2; ++dt) _Pragma("unroll") for (int s = 0; s < 2; ++s)         \
      _Pragma("unroll") for (int tm = 0; tm < 2; ++tm)                                                   \
          acc[tm] = MFMA32(f[dt * 4 + s * 2 + tm], sb[(t4a) + dt][s], acc[tm]);
#define SCAN_MMA_T(acc, f, t4a)                                                                          \
  _Pragma("unroll") for (int dt = 0; dt < 2; ++dt) _Pragma("unroll") for (int s = 0; s < 2; ++s)         \
      _Pragma("unroll") for (int tm = 0; tm < 2; ++tm)                                                   \
          acc[tm] = MFMA32(sb[(t4a) + dt][s], f[dt * 4 + s * 2 + tm], acc[tm]);
      SCAN_LOAD(fA, rw0, 0)
      __builtin_amdgcn_sched_barrier(0);
      SCAN_LOAD(fB, rw0, 2)
      __builtin_amdgcn_sched_barrier(0);
      SCAN_MMA(vn, fA, 0)
      __builtin_amdgcn_sched_barrier(0);
      SCAN_LOAD(fA, rq0, 0)
      __builtin_amdgcn_sched_barrier(0);
      SCAN_MMA(vn, fB, 2)
      __builtin_amdgcn_sched_barrier(0);
      SCAN_LOAD(fB, rq0, 2)
      __builtin_amdgcn_sched_barrier(0);
      SCAN_MMA_T(o, fA, 0)
      __builtin_amdgcn_sched_barrier(0);
      bf16x8 fi[6], fk0[4];
      fi[0] = ld_frag(ri0, 0);
      fi[1] = ld_frag(ri0, 32);
#pragma unroll
      for (int q4 = 0; q4 < 4; ++q4) fi[2 + q4] = ld_frag(ri0 + 32 * 144, q4 * 32);
#pragma unroll
      for (int q4 = 0; q4 < 4; ++q4) fk0[q4] = ld_frag(rk0, q4 * 32);
      __builtin_amdgcn_sched_barrier(0);
      SCAN_MMA_T(o, fB, 2)
#undef SCAN_LOAD
#undef SCAN_MMA
#undef SCAN_MMA_T
      bf16x8 vb[2][2];
#pragma unroll
      for (int tk = 0; tk < 2; ++tk) {
        vb[tk][0] = pack_acc8(vn[tk], 0);
        vb[tk][1] = pack_acc8(vn[tk], 1);
      }
#pragma unroll
      for (int t4 = 0; t4 < 4; ++t4)
#pragma unroll
        for (int e = 0; e < 16; ++e) S[t4][e] *= decay;
      __builtin_amdgcn_sched_barrier(0);
#pragma unroll
      for (int q4 = 0; q4 < 4; ++q4) {
        fA[q4] = ld_frag(rk0 + 32 * 144, q4 * 32);
        fA[4 + q4] = ld_frag(rk0 + 64 * 144, q4 * 32);
      }
      __builtin_amdgcn_sched_barrier(0);
      o[0] = MFMA32(vb[0][0], fi[0], o[0]);
      o[1] = MFMA32(vb[0][0], fi[2], o[1]);
      o[0] = MFMA32(vb[0][1], fi[1], o[0]);
      o[1] = MFMA32(vb[0][1], fi[3], o[1]);
      S[0] = MFMA32(fk0[0], vb[0][0], S[0]);
      o[1] = MFMA32(vb[1][0], fi[4], o[1]);
      S[0] = MFMA32(fk0[1], vb[0][1], S[0]);
      o[1] = MFMA32(vb[1][1], fi[5], o[1]);
      S[0] = MFMA32(fk0[2], vb[1][0], S[0]);
      S[0] = MFMA32(fk0[3], vb[1][1], S[0]);
      __builtin_amdgcn_sched_barrier(0);
#pragma unroll
      for (int q4 = 0; q4 < 4; ++q4) fB[q4] = ld_frag(rk0 + 96 * 144, q4 * 32);
      __builtin_amdgcn_sched_barrier(0);
#pragma unroll
      for (int q4 = 0; q4 < 4; ++q4) {
        S[1] = MFMA32(fA[q4], vb[q4 >> 1][q4 & 1], S[1]);
        S[2] = MFMA32(fA[4 + q4], vb[q4 >> 1][q4 & 1], S[2]);
      }
      __builtin_amdgcn_sched_barrier(0);
#pragma unroll
      for (int q4 = 0; q4 < 4; ++q4) S[3] = MFMA32(fB[q4], vb[q4 >> 1][q4 & 1], S[3]);
      {
#pragma unroll
        for (int tn = 0; tn < 2; ++tn) {
          const int pos = 32 * tn + r;
          const int tok = dir ? (b * T + T - 1 - n * 64 - pos) : (b * T + n * 64 + pos);
          unsigned pk[4][2];
#pragma unroll
          for (int g = 0; g < 4; ++g) {
            pk[g][0] = pack2(o[tn][4 * g + 0], o[tn][4 * g + 1]);
            pk[g][1] = pack2(o[tn][4 * g + 2], o[tn][4 * g + 3]);
          }
          uint4 st0, st1;
          {
            auto s0 = __builtin_amdgcn_permlane32_swap(pk[0][0], pk[2][0], false, false);
            auto s1 = __builtin_amdgcn_permlane32_swap(pk[0][1], pk[2][1], false, false);
            st0.x = s0[0]; st0.y = s1[0]; st0.z = s0[1]; st0.w = s1[1];
            auto s2 = __builtin_amdgcn_permlane32_swap(pk[1][0], pk[3][0], false, false);
            auto s3 = __builtin_amdgcn_permlane32_swap(pk[1][1], pk[3][1], false, false);
            st1.x = s2[0]; st1.y = s3[0]; st1.z = s2[1]; st1.w = s3[1];
          }
          bf16_t* op = p.obuf + ((size_t)dir * NTOK + tok) * 512 + hh * 128 + 32 * w + 16 * hf;
          *(uint4*)(op) = st0;
          *(uint4*)(op + 8) = st1;
        }
      }
      __syncthreads();
    }
  }
}

DEV void phase_scan_helper(const Params& p, int l, int c, int j, char* smem) {
  const int tid = fresh_tid(), lane = tid & 63, wid = tid >> 6;
  volatile unsigned* lprog = (volatile unsigned*)smem;
  const unsigned epoch = (unsigned)(l + 1);
  const int dir = c & 1, bh = c >> 1;
  constexpr unsigned AHEAD = 8u;
  if (tid == 0) lprog[0] = 0u;
  __syncthreads();
  if (wid == 0) {
    unsigned v = 0u, spins = 0u;
    for (;;) {
      v = xb_ld(&p.bar[XB_CXCC(c)]);
      if ((v >> 4) == epoch || ++spins > 200000u) break;
      __builtin_amdgcn_s_sleep(8);
    }
    const bool mine = ((v >> 4) == epoch) && ((v & 15u) == xb_xcc_id());
    if (!mine) {
      if (lane == 0) lprog[0] = 0xffffffffu;
    } else {
      unsigned idle = 0u;
      for (;;) {
        const unsigned g = xb_ld(&p.bar[XB_PROG(c)]);
        const unsigned cur = (g >= epoch * 1024u) ? (g - epoch * 1024u + 1u) : 0u;
        if (lane == 0) lprog[0] = cur + 1u;
        if (cur >= 128u || ++idle > 400000u) break;
        __builtin_amdgcn_s_sleep(16);
      }
      if (lane == 0) lprog[0] = 0xffffffffu;
    }
  } else {
    u32x4 sink = {0u, 0u, 0u, 0u};
    unsigned spins = 0u;
    for (int n = 0; n < 128;) {
      const unsigned s = lprog[0];
      if (s == 0xffffffffu) break;
      if (s == 0u) {
        if (++spins > 4000000u) break;
        __builtin_amdgcn_s_sleep(4);
        continue;
      }
      const unsigned started = s - 1u;
      if ((unsigned)n < started) n = (int)started;
      if (n >= 128) break;
      if ((unsigned)n >= started + AHEAD) {
        if (++spins > 4000000u) break;
        __builtin_amdgcn_s_sleep(4);
        continue;
      }
      const int item = bh * 128 + (dir ? 127 - n : n);
      const char* rec = p.gdn_rec + ((size_t)item * 2 + dir) * REC_BYTES;
      const char* uu = (const char*)(p.gdn_u + ((size_t)(item * 2 + dir) * 32) * 128);
#pragma unroll
      for (int q = 0; q < 3; ++q) {
        const int pc = wid - 1 + 7 * q;
        if (pc < 18) {
          const int piece = 18 * j + pc;
          const char* ptr = (piece < 56 ? rec + piece * 1024 : uu + (piece - 56) * 1024) + lane * 16;
          asm volatile("global_load_dwordx4 %0, %1, off" : "+v"(sink) : "v"(ptr) : "memory");
        }
      }
      ++n;
    }
    asm volatile("s_waitcnt vmcnt(0)" ::: "memory");
    asm volatile("" :: "v"(sink));
  }
  __syncthreads();
}

DEV void phase_gdn_fin(const Params& p, int l, int bid, int nb) {
  const int tid_ = fresh_tid(), lane = tid_ & 63, wid = tid_ >> 6;
  const float* gnw = p.gdn_norm_w + l * 128 + (lane & 15) * 8;
  for (int t = bid * NWAVE + wid; t < NTOK; t += nb * NWAVE) {
    float of[8], ob[8], z[8], o[8];
    unpack8(*(const uint4*)(p.obuf + (size_t)t * 512 + lane * 8), of);
    unpack8(*(const uint4*)(p.obuf + ((size_t)NTOK + t) * 512 + lane * 8), ob);
    unpack8(*(const uint4*)(p.proj + (size_t)t * PROJW + OFF_GZ + lane * 8), z);
    float ss = 0.f;
#pragma unroll
    for (int e = 0; e < 8; ++e) {
      o[e] = of[e] + ob[e];
      ss += o[e] * o[e];
    }
    ss += shx(ss, 1, lane);
    ss += shx(ss, 2, lane);
    ss += shx(ss, 4, lane);
    ss += shx(ss, 8, lane);
    const float rr = rsqrtf(ss * (1.f / 128.f) + EPS);
    const float4 g0 = *(const float4*)(gnw), g1 = *(const float4*)(gnw + 4);
    const float gw[8] = {g0.x, g0.y, g0.z, g0.w, g1.x, g1.y, g1.z, g1.w};
    float res[8];
#pragma unroll
    for (int e = 0; e < 8; ++e) res[e] = o[e] * rr * gw[e] * silu_f(z[e]);
    *(uint4*)(p.y + (size_t)t * DM + 512 + lane * 8) = pack8(res);
  }
}

struct EpiWout {
  static constexpr bool PERM = false;
  const float* xin; float* xout; const float* mod_l;
  DEV void operator()(const f32x4 (&acc)[2][2][4][2], const GUnit& u, int wr, int wc, int fr, int fq) const {
    const int row0 = u.pm * 256 + wr * 64 + fr, col0 = u.pn * 256 + wc * 32 + 4 * fq;
    const float* gate = mod_l + ((u.pm * 256) / T) * 6144 + MOD_GATE1;
    f32x4 gv[2][2];
#pragma unroll
    for (int bj = 0; bj < 2; ++bj)
#pragma unroll
      for (int n = 0; n < 2; ++n) gv[bj][n] = *(const f32x4*)(gate + col0 + bj * G_HALF + n * 16);
#pragma unroll
    for (int ai = 0; ai < 2; ++ai)
#pragma unroll
      for (int m = 0; m < 4; ++m) {
        const size_t ro = (size_t)(row0 + ai * G_HALF + m * 16) * DM + col0;
#pragma unroll
        for (int bj = 0; bj < 2; ++bj)
#pragma unroll
          for (int n = 0; n < 2; ++n) {
            const f32x4 xi = *(const f32x4*)(xin + ro + bj * G_HALF + n * 16);
            *(f32x4*)(xout + ro + bj * G_HALF + n * 16) = xi + gv[bj][n] * acc[ai][bj][m][n];
          }
      }
  }
};

DEV void phase_gemm_wout(const Params& p, int l, const float* xin, int bid, int nb, char* smem) {
  DenseSched S;
  S.A = p.y; S.Bt = p.btout; S.K = DM; S.nM = NTOK / 256; S.nN = DM / 256; S.nwg = S.nM * S.nN; S.G = nb; S.c = bid; S.wv = p.wv;
  EpiWout E;
  E.xin = xin; E.xout = p.xbuf; E.mod_l = p.mod + l * 2 * 6144;
  gemm_phase((LAS unsigned char*)smem, S, E);
}

DEV void phase_consts(const Params& p, int bid, int nb) {
  const int tid = fresh_tid(), lane = tid & 63, wid = tid >> 6;
  for (int g = bid * NTHR + tid; g < DEPTH * DM * 48; g += nb * NTHR) {
    const int n = g % 48, lk = g / 48;
    float v = 0.f;
    if (n < 4) v = p.rg_w[(size_t)lk * 4 + n];
    else if (n < 36) v = p.re_w[(size_t)lk * 32 + (n - 4)];
    p.wcat[g] = v;
  }
  for (int g = bid * NTHR + tid; g < DEPTH * NB * DM; g += nb * NTHR) {
    const int k = g & (DM - 1), lb = g >> 10, l = lb >> 1;
    p.wsc2[g] = p.norm_ffn_w[l * DM + k] * (1.f + p.mod[lb * 6144 + MOD_SCALE2 + k]);
  }
  for (int o = bid * NWAVE + wid; o < DEPTH * NB * 48; o += nb * NWAVE) {
    const int n = o % 48, lb = o / 48, l = lb >> 1;
    float s = 0.f;
    if (n < 36) {
      for (int k = lane; k < DM; k += 64) {
        const float w = (n < 4) ? p.rg_w[((size_t)l * DM + k) * 4 + n] : p.re_w[((size_t)l * DM + k) * 32 + (n - 4)];
        s += p.mod[lb * 6144 + MOD_SHIFT2 + k] * w;
      }
      s = wave_sum(s, lane);
      s += (n < 4) ? p.rg_b[l * 4 + n] : p.re_b[l * 32 + (n - 4)];
    }
    if (lane == 0) p.c0[o] = s;
  }
}

DEV void phase_router(const Params& p, int l, int bid, int nb, char* smem) {
  float* accb = (float*)smem;
  float* ssqb = accb + 2 * 64 * 49;
  float* rsl = ssqb + 128;
  const int tid = fresh_tid(), lane = tid & 63, wid = tid >> 6, fr = lane & 15, fq = lane >> 4;
  const int tg = wid & 3, kh = wid >> 2;
  for (int tb = bid; tb < NTOK / 64; tb += nb) {
    const int tok0 = tb * 64;
    const int b = tok0 / T;
    const float* wsc = p.wsc2 + (l * 2 + b) * DM;
    {
      const float* xr = p.xbuf + (size_t)(tok0 + tg * 16 + fr) * DM + kh * 512 + fq * 4;
      const float* wv = wsc + kh * 512 + fq * 4;
      const float* Bp = p.wcat + ((size_t)l * DM + kh * 512 + fq * 4) * 48 + fr;
      f32x4 acc[3];
#pragma unroll
      for (int nt = 0; nt < 3; ++nt) acc[nt] = f32x4{0.f, 0.f, 0.f, 0.f};
      float ssq = 0.f;
#pragma unroll 4
      for (int c = 0; c < 32; ++c) {
        const float4 xv = *(const float4*)(xr + c * 16);
        const float4 ww = *(const float4*)(wv + c * 16);
        ssq += xv.x * xv.x + xv.y * xv.y + xv.z * xv.z + xv.w * xv.w;
        const float a0 = xv.x * ww.x, a1 = xv.y * ww.y, a2 = xv.z * ww.z, a3 = xv.w * ww.w;
        const float* bp = Bp + (size_t)c * 16 * 48;
#pragma unroll
        for (int nt = 0; nt < 3; ++nt) {
          acc[nt] = __builtin_amdgcn_mfma_f32_16x16x4f32(a0, bp[0 * 48 + nt * 16], acc[nt], 0, 0, 0);
          acc[nt] = __builtin_amdgcn_mfma_f32_16x16x4f32(a1, bp[1 * 48 + nt * 16], acc[nt], 0, 0, 0);
          acc[nt] = __builtin_amdgcn_mfma_f32_16x16x4f32(a2, bp[2 * 48 + nt * 16], acc[nt], 0, 0, 0);
          acc[nt] = __builtin_amdgcn_mfma_f32_16x16x4f32(a3, bp[3 * 48 + nt * 16], acc[nt], 0, 0, 0);
        }
      }
      ssq += shx(ssq, 16, lane);
      ssq += shx(ssq, 32, lane);
#pragma unroll
      for (int nt = 0; nt < 3; ++nt)
#pragma unroll
        for (int j = 0; j < 4; ++j) accb[(kh * 64 + tg * 16 + fq * 4 + j) * 49 + nt * 16 + fr] = acc[nt][j];
      if (fq == 0) ssqb[kh * 64 + tg * 16 + fr] = ssq;
    }
    __syncthreads();
    if (tid < 64) {
      const int t = tok0 + tid;
      const float rstd = rsqrtf((ssqb[tid] + ssqb[64 + tid]) * (1.f / DM) + EPS);
      rsl[tid] = rstd;
      const float* c0 = p.c0 + (l * 2 + b) * 48;
      float acc[36];
#pragma unroll
      for (int o = 0; o < 36; ++o) acc[o] = rstd * (accb[tid * 49 + o] + accb[(64 + tid) * 49 + o]) + c0[o];
      int grp = 0;
      float mx = acc[0];
#pragma unroll
      for (int g = 1; g < 4; ++g)
        if (acc[g] > mx) { mx = acc[g]; grp = g; }
      float den = 0.f;
#pragma unroll
      for (int g = 0; g < 4; ++g) den += __expf(acc[g] - mx);
      const float pg_top = 1.f / den;
      float el[8];
#pragma unroll
      for (int j = 0; j < 8; ++j) {
        const float a0 = acc[4 + j], a1 = acc[12 + j], a2 = acc[20 + j], a3 = acc[28 + j];
        el[j] = (grp == 0) ? a0 : (grp == 1) ? a1 : (grp == 2) ? a2 : a3;
      }
      float b0 = -3.0e38f, b1 = -3.0e38f;
      int i0 = 0, i1 = 0;
#pragma unroll
      for (int j = 0; j < 8; ++j)
        if (el[j] > b0) { b0 = el[j]; i0 = j; }
#pragma unroll
      for (int j = 0; j < 8; ++j)
        if (j != i0 && el[j] > b1) { b1 = el[j]; i1 = j; }
      const float ex = __expf(b1 - b0);
      const float g0 = pg_top / (1.f + ex), g1 = pg_top * ex / (1.f + ex);
      const int e0 = grp * 8 + i0, e1 = grp * 8 + i1;
      const int pos0 = atomicAdd(&p.cnt[l * NEXP + e0], 1);
      p.list[e0 * CAP + pos0] = 2 * t;
      p.sgate[2 * t] = g0;
      const int pos1 = atomicAdd(&p.cnt[l * NEXP + e1], 1);
      p.list[e1 * CAP + pos1] = 2 * t + 1;
      p.sgate[2 * t + 1] = g1;
    }
    __syncthreads();
    {
      const float* sh = p.mod + (l * 2 + b) * 6144 + MOD_SHIFT2;
#pragma unroll 2
      for (int q = 0; q < 8; ++q) {
        const int tl = wid * 8 + q;
        const float rstd = rsl[tl];
        const float4* xr = (const float4*)(p.xbuf + (size_t)(tok0 + tl) * DM);
#pragma unroll
        for (int i = 0; i < 4; ++i) {
          const int idx = (lane + 64 * i) * 4;
          const float4 xv = xr[lane + 64 * i];
          const float4 w = *(const float4*)(wsc + idx);
          const float4 h = *(const float4*)(sh + idx);
          uint2 pk;
          pk.x = pack2(xv.x * w.x * rstd + h.x, xv.y * w.y * rstd + h.y);
          pk.y = pack2(xv.z * w.z * rstd + h.z, xv.w * w.w * rstd + h.w);
          *(uint2*)(p.act + (size_t)(tok0 + tl) * DM + idx) = pk;
        }
      }
    }
    __syncthreads();
  }
}

struct EpiMoe1 {
  static constexpr bool PERM = true;
  bf16_t* H; const int* list;
  DEV void operator()(const f32x4 (&acc)[2][2][4][2], const GUnit& u, int wr, int wc, int fr, int fq) const {
    const int hcol = u.pn * 128 + wc * 32 + 8 * fq;
#pragma unroll
    for (int ai = 0; ai < 2; ++ai)
#pragma unroll
      for (int m = 0; m < 4; ++m) {
        const int rl = ai * G_HALF + wr * 64 + m * 16 + fr;
        if (rl < u.valid) {
          const int slot = list[u.e * CAP + u.pm * 256 + rl];
          float h[8];
#pragma unroll
          for (int n = 0; n < 2; ++n)
#pragma unroll
            for (int j = 0; j < 4; ++j) h[n * 4 + j] = silu_f(acc[ai][0][m][n][j]) * acc[ai][1][m][n][j];
          *(uint4*)(H + (size_t)slot * DEXP + hcol) = pack8(h);
        }
      }
  }
};
struct EpiMoe2 {
  static constexpr bool PERM = true;
  bf16_t* Y; const int* list; const float* sgate;
  DEV void operator()(const f32x4 (&acc)[2][2][4][2], const GUnit& u, int wr, int wc, int fr, int fq) const {
    const int col0 = u.pn * 256 + wc * 32 + 8 * fq;
#pragma unroll
    for (int ai = 0; ai < 2; ++ai)
#pragma unroll
      for (int m = 0; m < 4; ++m) {
        const int rl = ai * G_HALF + wr * 64 + m * 16 + fr;
        if (rl < u.valid) {
          const int slot = list[u.e * CAP + u.pm * 256 + rl];
          const float g = sgate[slot];
#pragma unroll
          for (int bj = 0; bj < 2; ++bj) {
            float yv[8];
#pragma unroll
            for (int n = 0; n < 2; ++n)
#pragma unroll
              for (int j = 0; j < 4; ++j) yv[n * 4 + j] = g * acc[ai][bj][m][n][j];
            *(uint4*)(Y + (size_t)slot * DM + col0 + bj * G_HALF) = pack8(yv);
          }
        }
      }
  }
};

DEV void phase_moe1(const Params& p, int l, int bid, int nb, char* smem) {
  MoeSched S;
  S.A = p.act; S.Bt = p.bt1; S.K = DM; S.cnt = p.cnt + l * NEXP; S.list = p.list; S.G = nb; S.c = bid; S.wv = p.wv; S.shift = 1;
  EpiMoe1 E;
  E.H = p.hbuf; E.list = p.list;
  gemm_phase((LAS unsigned char*)smem, S, E);
}

DEV void phase_moe2(const Params& p, int l, int bid, int nb, char* smem) {
  MoeSched S;
  S.A = p.hbuf; S.Bt = p.bt2; S.K = DEXP; S.cnt = p.cnt + l * NEXP; S.list = p.list; S.G = nb; S.c = bid; S.wv = p.wv; S.shift = 0;
  EpiMoe2 E;
  E.Y = p.ybuf; E.list = p.list; E.sgate = p.sgate;
  gemm_phase((LAS unsigned char*)smem, S, E);
}

DEV void phase_combine(const Params& p, int l, int bid, int nb) {
  const int tid_ = fresh_tid(), lane = tid_ & 63, wid = tid_ >> 6;
  for (int t = bid * NWAVE + wid; t < NTOK; t += nb * NWAVE) {
    float4* xr = (float4*)(p.xbuf + (size_t)t * DM);
    const int b = t / T;
    const float* md = p.mod + (l * 2 + b) * 6144;
    float4 v[4];
    float ss = 0.f;
#pragma unroll
    for (int i = 0; i < 4; ++i) {
      const int idx = (lane + 64 * i) * 4;
      v[i] = xr[lane + 64 * i];
      const float4 g = *(const float4*)(md + MOD_GATE2 + idx);
      const uint2 ya = *(const uint2*)(p.ybuf + (size_t)(2 * t) * DM + idx);
      const uint2 yb = *(const uint2*)(p.ybuf + (size_t)(2 * t + 1) * DM + idx);
      v[i].x += g.x * (__uint_as_float(ya.x << 16) + __uint_as_float(yb.x << 16));
      v[i].y += g.y * (__uint_as_float(ya.x & 0xffff0000u) + __uint_as_float(yb.x & 0xffff0000u));
      v[i].z += g.z * (__uint_as_float(ya.y << 16) + __uint_as_float(yb.y << 16));
      v[i].w += g.w * (__uint_as_float(ya.y & 0xffff0000u) + __uint_as_float(yb.y & 0xffff0000u));
      ss += v[i].x * v[i].x + v[i].y * v[i].y + v[i].z * v[i].z + v[i].w * v[i].w;
    }
    ss = wave_sum(ss, lane);
    const float rstd = rsqrtf(ss * (1.f / DM) + EPS);
    if (l + 1 < DEPTH) {
#pragma unroll
      for (int i = 0; i < 4; ++i) xr[lane + 64 * i] = v[i];
      const float* md2 = p.mod + ((l + 1) * 2 + b) * 6144;
      norm_mod_store(v, rstd, p.norm_mix_w + (l + 1) * DM, md2 + MOD_SCALE1, md2 + MOD_SHIFT1,
                     p.act + (size_t)t * DM, lane);
    } else {
      float4* orow = (float4*)(p.out + (size_t)t * DM);
#pragma unroll
      for (int i = 0; i < 4; ++i) {
        const float4 w = *(const float4*)(p.final_w + (lane + 64 * i) * 4);
        float4 r;
        r.x = v[i].x * rstd * w.x;
        r.y = v[i].y * rstd * w.y;
        r.z = v[i].z * rstd * w.z;
        r.w = v[i].w * rstd * w.w;
        orow[lane + 64 * i] = r;
      }
    }
  }
}

constexpr size_t ws_align(size_t b) { return (b + 255) & ~(size_t)255; }
constexpr size_t WS_bar = 0;
constexpr size_t WS_mod = WS_bar + ws_align(sizeof(unsigned) * BAR_WORDS_TOTAL);
constexpr size_t WS_btin = WS_mod + ws_align(sizeof(float) * DEPTH * NB * 6144);
constexpr size_t WS_btg = WS_btin + ws_align(2 * (size_t)PROJW * DM);
constexpr size_t WS_btout = WS_btg + ws_align(2 * (size_t)16 * DM);
constexpr size_t WS_bt1 = WS_btout + ws_align(2 * (size_t)DM * DM);
constexpr size_t WS_bt2 = WS_bt1 + ws_align(2 * (size_t)NEXP * 1024 * DM);
constexpr size_t WS_wcat = WS_bt2 + ws_align(2 * (size_t)NEXP * DM * DEXP);
constexpr size_t WS_wsc2 = WS_wcat + ws_align(sizeof(float) * DEPTH * DM * 48);
constexpr size_t WS_c0 = WS_wsc2 + ws_align(sizeof(float) * DEPTH * NB * DM);
constexpr size_t WS_cnt = WS_c0 + ws_align(sizeof(float) * DEPTH * NB * 48);
constexpr size_t WS_xbuf = WS_cnt + ws_align(sizeof(int) * DEPTH * NEXP);
constexpr size_t WS_act = WS_xbuf + ws_align(sizeof(float) * (size_t)NTOK * DM);
constexpr size_t WS_proj = WS_act + ws_align(2 * (size_t)NTOK * DM);
constexpr size_t WS_gates = WS_proj + ws_align(2 * (size_t)NTOK * PROJW);
constexpr size_t WS_y = WS_gates + ws_align(sizeof(float) * (size_t)NTOK * 16);
constexpr size_t WS_list = WS_y + ws_align(2 * (size_t)NTOK * DM);
constexpr size_t WS_sgate = WS_list + ws_align(sizeof(int) * NEXP * CAP);
constexpr size_t WS_egl = WS_sgate + ws_align(sizeof(float) * 2 * NTOK);
constexpr size_t WS_obuf = WS_egl + ws_align(sizeof(float) * 2048);
constexpr size_t WS_gdn_rec = WS_obuf + ws_align(2 * 2 * (size_t)NTOK * 512);
constexpr size_t WS_gdn_u = WS_gdn_rec + ws_align((size_t)2048 * REC_BYTES);
constexpr size_t WS_TOTAL = WS_gdn_u + ws_align(sizeof(unsigned) * (size_t)2048 * 32 * 128);

struct KArgs {
  const float *x, *c, *norm_mix_w, *norm_ffn_w, *w_ada, *b_ada, *w_in, *conv_a_w, *na_rpb, *gdn_conv_w,
      *gdn_a_log, *gdn_dt_bias, *gdn_norm_w, *w_out, *rg_w, *rg_b, *re_w, *re_b, *ew1, *ew3, *ew2, *final_w;
  float* out;
  char* ws;
  int rep[12];
};
DEV Params make_params(const KArgs& a) {
  Params p;
  p.x = a.x; p.c = a.c; p.norm_mix_w = a.norm_mix_w; p.norm_ffn_w = a.norm_ffn_w; p.w_ada = a.w_ada; p.b_ada = a.b_ada;
  p.w_in = a.w_in; p.conv_a_w = a.conv_a_w; p.na_rpb = a.na_rpb; p.gdn_conv_w = a.gdn_conv_w; p.gdn_a_log = a.gdn_a_log;
  p.gdn_dt_bias = a.gdn_dt_bias; p.gdn_norm_w = a.gdn_norm_w; p.w_out = a.w_out; p.rg_w = a.rg_w; p.rg_b = a.rg_b;
  p.re_w = a.re_w; p.re_b = a.re_b; p.ew1 = a.ew1; p.ew3 = a.ew3; p.ew2 = a.ew2; p.final_w = a.final_w;
  p.out = a.out;
  p.bar = (unsigned*)(a.ws + WS_bar);
  p.mod = (float*)(a.ws + WS_mod);
  p.btin = (bf16_t*)(a.ws + WS_btin);
  p.btg = (bf16_t*)(a.ws + WS_btg);
  p.btout = (bf16_t*)(a.ws + WS_btout);
  p.bt1 = (bf16_t*)(a.ws + WS_bt1);
  p.bt2 = (bf16_t*)(a.ws + WS_bt2);
  p.wcat = (float*)(a.ws + WS_wcat);
  p.wsc2 = (float*)(a.ws + WS_wsc2);
  p.c0 = (float*)(a.ws + WS_c0);
  p.cnt = (int*)(a.ws + WS_cnt);
  p.xbuf = (float*)(a.ws + WS_xbuf);
  p.act = (bf16_t*)(a.ws + WS_act);
  p.proj = (bf16_t*)(a.ws + WS_proj);
  p.gates = (float*)(a.ws + WS_gates);
  p.y = (bf16_t*)(a.ws + WS_y);
  p.list = (int*)(a.ws + WS_list);
  p.sgate = (float*)(a.ws + WS_sgate);
  p.egl = (float*)(a.ws + WS_egl);
  p.obuf = (bf16_t*)(a.ws + WS_obuf);
  p.gdn_rec = (char*)(a.ws + WS_gdn_rec);
  p.gdn_u = (unsigned*)(a.ws + WS_gdn_u);
  p.hbuf = (bf16_t*)p.obuf;
  p.ybuf = (bf16_t*)p.gdn_rec;
#pragma unroll
  for (int i = 0; i < 12; ++i) p.rep[i] = a.rep[i];
  p.wv = __builtin_amdgcn_readfirstlane((int)(threadIdx.x >> 6));
  return p;
}

__global__ void __launch_bounds__(NTHR) mega_kernel(KArgs ka) {
  const Params p = make_params(ka);
  __shared__ __attribute__((aligned(16))) char smem[SMEM_BYTES + 16];
  cg::grid_group grid = cg::this_grid();
  const int bid = blockIdx.x, nb = gridDim.x;
  if (fresh_tid() == 0) *(uint4*)(smem + SMEM_BYTES) = make_uint4(0u, 0u, 0u, 0u);
  __syncthreads();
  xcd_barrier_post(p.bar, fresh_tid());
#pragma unroll 1
  for (int rp = 0; rp < p.rep[7]; ++rp) {
    phase_ada(p, bid, nb, smem);
    convert_win(p, 0, bid, nb, smem);
  }
  grid.sync();
#pragma unroll 1
  for (int rp = 0; rp < p.rep[8]; ++rp) {
    phase_hmix(p, 0, p.x, bid, nb);
    phase_consts(p, bid, nb);
  }
  xcd_barrier(p.bar, (volatile LAS unsigned*)(smem + SMEM_BYTES), fresh_tid());
#pragma unroll 1
  for (int l = 0; l < DEPTH; ++l) {
#pragma unroll 1
    for (int rp = 0; rp < p.rep[0]; ++rp) phase_gemm_proj(p, l, bid, nb, smem);
    xcd_barrier(p.bar, (volatile LAS unsigned*)(smem + SMEM_BYTES), fresh_tid());
#pragma unroll 1
    for (int rp = 0; rp < p.rep[1]; ++rp) phase_gdn_prep(p, l, bid, nb, smem);
    xcd_barrier(p.bar, (volatile LAS unsigned*)(smem + SMEM_BYTES), fresh_tid());
#pragma unroll 1
    for (int rp = 0; rp < p.rep[2]; ++rp) {
      if (bid < 16) {
        phase_gdn_scan(p, l, bid, smem);
      } else if (bid < 80) {
        phase_scan_helper(p, l, (bid - 16) & 15, (bid - 16) >> 4, smem);
      } else {
#pragma unroll 1
        for (int rq = 0; rq < p.rep[6]; ++rq) {
          phase_conv(p, l, bid - 80, nb - 80);
          phase_na(p, l, (bid - 80) * NWAVE + (fresh_tid() >> 6), (nb - 80) * NWAVE);
        }
#pragma unroll 1
        for (int rq = 0; rq < p.rep[10]; ++rq) convert_layer(p, l, bid - 80, nb - 80, smem);
      }
    }
    xcd_barrier(p.bar, (volatile LAS unsigned*)(smem + SMEM_BYTES), fresh_tid());
#pragma unroll 1
    for (int rp = 0; rp < p.rep[5]; ++rp) phase_gdn_fin(p, l, bid, nb);
    xcd_barrier(p.bar, (volatile LAS unsigned*)(smem + SMEM_BYTES), fresh_tid());
#pragma unroll 1
    for (int rp = 0; rp < (l == 0 ? p.rep[9] : 1); ++rp) phase_gemm_wout(p, l, l == 0 ? p.x : p.xbuf, bid, nb, smem);
    xcd_barrier(p.bar, (volatile LAS unsigned*)(smem + SMEM_BYTES), fresh_tid());
    phase_router(p, l, bid, nb, smem);
    xcd_barrier(p.bar, (volatile LAS unsigned*)(smem + SMEM_BYTES), fresh_tid());
#pragma unroll 1
    for (int rp = 0; rp < p.rep[3]; ++rp) phase_moe1(p, l, bid, nb, smem);
    xcd_barrier(p.bar, (volatile LAS unsigned*)(smem + SMEM_BYTES), fresh_tid());
#pragma unroll 1
    for (int rp = 0; rp < p.rep[4]; ++rp) phase_moe2(p, l, bid, nb, smem);
    xcd_barrier(p.bar, (volatile LAS unsigned*)(smem + SMEM_BYTES), fresh_tid());
    phase_combine(p, l, bid, nb);
    if (l + 1 < DEPTH) xcd_barrier(p.bar, (volatile LAS unsigned*)(smem + SMEM_BYTES), fresh_tid());
  }
}

extern "C" void kernel_launch(void* const* d_in, const int* in_sizes, int n_in, void* d_out, int out_size,
                              void* d_ws, size_t ws_size, hipStream_t stream) {
  KArgs p{};
  p.x = (const float*)d_in[0];
  p.c = (const float*)d_in[1];
  p.norm_mix_w = (const float*)d_in[2];
  p.norm_ffn_w = (const float*)d_in[3];
  p.w_ada = (const float*)d_in[4];
  p.b_ada = (const float*)d_in[5];
  p.w_in = (const float*)d_in[6];
  p.conv_a_w = (const float*)d_in[7];
  p.na_rpb = (const float*)d_in[8];
  p.gdn_conv_w = (const float*)d_in[9];
  p.gdn_a_log = (const float*)d_in[10];
  p.gdn_dt_bias = (const float*)d_in[11];
  p.gdn_norm_w = (const float*)d_in[12];
  p.w_out = (const float*)d_in[13];
  p.rg_w = (const float*)d_in[14];
  p.rg_b = (const float*)d_in[15];
  p.re_w = (const float*)d_in[16];
  p.re_b = (const float*)d_in[17];
  p.ew1 = (const float*)d_in[18];
  p.ew3 = (const float*)d_in[19];
  p.ew2 = (const float*)d_in[20];
  p.final_w = (const float*)d_in[21];
  p.out = (float*)d_out;
  p.ws = (char*)d_ws;
  if (WS_TOTAL > ws_size) fprintf(stderr, "workspace too small: need %zu have %zu\n", (size_t)WS_TOTAL, ws_size);

  static int grid_blocks = 0;
  if (!grid_blocks) {
    int dev = 0, cus = 0, per_cu = 0;
    (void)hipGetDevice(&dev);
    (void)hipDeviceGetAttribute(&cus, hipDeviceAttributeMultiprocessorCount, dev);
    (void)hipOccupancyMaxActiveBlocksPerMultiprocessor(&per_cu, mega_kernel, NTHR, 0);
    if (per_cu > 1) per_cu = 1;
    if (per_cu < 1) per_cu = 1;
    grid_blocks = cus * per_cu;
  }
  (void)hipMemsetAsync((char*)d_ws + WS_bar, 0, sizeof(unsigned) * BAR_WORDS_TOTAL, stream);
  for (int i = 0; i < 12; ++i) p.rep[i] = 1;
  void* args[] = {&p};
  hipError_t e = hipLaunchCooperativeKernel((void*)mega_kernel, dim3(grid_blocks), dim3(NTHR), args, 0, stream);
  if (e != hipSuccess) fprintf(stderr, "cooperative launch failed: %s (grid %d)\n", hipGetErrorString(e), grid_blocks);
}
```

```cpp
#include <hip/hip_runtime.h>
#include <hip/hip_cooperative_groups.h>
#include <stdint.h>
#include <stdio.h>

#define DEV __device__ __forceinline__
namespace cg = cooperative_groups;

typedef __attribute__((ext_vector_type(8))) short bf16x8;
typedef __attribute__((ext_vector_type(4))) float f32x4;
typedef __attribute__((ext_vector_type(16))) float f32x16;
typedef float f32x2_t __attribute__((ext_vector_type(2)));
typedef __bf16 bf16x2_t __attribute__((ext_vector_type(2)));
typedef unsigned short bf16_t;
typedef unsigned u32x4 __attribute__((ext_vector_type(4)));

constexpr int NTHR = 512;
constexpr int NWAVE = 8;
constexpr int DM = 1024;
constexpr int NB = 2;
constexpr int T = 8192;
constexpr int NTOK = NB * T;
constexpr int DEPTH = 2;
constexpr int DIN = 3600;
constexpr int PROJW = 3584;
constexpr int NEXP = 32;
constexpr int DEXP = 512;
constexpr int CAP = 16384;
constexpr float EPS = 1e-6f;
constexpr int OFF_CB = 0, OFF_CC = 256, OFF_CX = 512, OFF_NQ = 768, OFF_NK = 1024, OFF_NV = 1280,
              OFF_GQKV = 1536, OFF_GZ = 3072;
constexpr int MOD_SHIFT1 = 0, MOD_SCALE1 = 1024, MOD_GATE1 = 2048, MOD_SHIFT2 = 3072, MOD_SCALE2 = 4096,
              MOD_GATE2 = 5120;

constexpr int REC_WN = 0, REC_QD = 16384, REC_IN = 32768, REC_KT = 40960, REC_BYTES = 57344;
constexpr int SC_WN = 0, SC_QD = 17408, SC_IN = 34816, SC_KT = 44032, SC_U = 62464, SC_BUF = 78848;
constexpr int PL_Q = 0, PL_K = 17408, PL_V = 34816, PL_L = 52224, PL_GC = 87040, PL_BETA = 87552, PL_BG = 88064,
              PL_GL = 88576, PL_KT = 88832  , PL_IN = 125696  ;
constexpr int SMEM_BYTES = 2 * SC_BUF;

struct Params {
  const float *x, *c, *norm_mix_w, *norm_ffn_w, *w_ada, *b_ada, *w_in, *conv_a_w, *na_rpb, *gdn_conv_w,
      *gdn_a_log, *gdn_dt_bias, *gdn_norm_w, *w_out, *rg_w, *rg_b, *re_w, *re_b, *ew1, *ew3, *ew2, *final_w;
  float* out;
  float* mod;
  int* cnt;
  float* xbuf;
  bf16_t* act;
  bf16_t* proj;
  float* gates;
  bf16_t* y;
  bf16_t* obuf;
  char* gdn_rec;
  unsigned* gdn_u;
  float* egl;
  bf16_t* hbuf;
  bf16_t* ybuf;
  int* list;
  float* sgate;
  bf16_t* btin;
  bf16_t* btg;
  bf16_t* btout;
  bf16_t* bt1;
  bf16_t* bt2;
  float* wcat;
  float* wsc2;
  float* c0;
  unsigned* bar;
  int rep[12];
  int wv;
};

DEV unsigned pack2(float a, float b) {
  f32x2_t v = {a, b};
  return __builtin_bit_cast(unsigned, __builtin_convertvector(v, bf16x2_t));
}
DEV bf16_t f2bf(float f) { return (bf16_t)(pack2(f, 0.f) & 0xffffu); }
DEV float bf2f(bf16_t h) { return __uint_as_float(((unsigned)h) << 16); }
DEV float silu_f(float x) { return x / (1.f + __expf(-x)); }
DEV float sigmoid_f(float x) { return 1.f / (1.f + __expf(-x)); }
DEV float softplus_f(float x) { return fmaxf(x, 0.f) + log1pf(__expf(-fabsf(x))); }
DEV float shx(float v, int k, int lane) {
  return __int_as_float(__builtin_amdgcn_ds_bpermute((lane ^ k) << 2, __float_as_int(v)));
}
DEV float wave_sum(float v, int lane) {
#pragma unroll
  for (int o = 32; o > 0; o >>= 1) v += shx(v, o, lane);
  return v;
}
DEV int fresh_tid_w(int wv) {
  unsigned z = 0u;
  asm volatile("" : "+s"(wv), "+v"(z));
  int t = (wv << 6) | (int)__builtin_amdgcn_mbcnt_hi(~0u, __builtin_amdgcn_mbcnt_lo(~0u, z));
  asm volatile("" : "+v"(t));
  return t;
}
#define fresh_tid() fresh_tid_w(p.wv)
DEV void unpack8(uint4 u, float* f) {
  f[0] = __uint_as_float(u.x << 16);
  f[1] = __uint_as_float(u.x & 0xffff0000u);
  f[2] = __uint_as_float(u.y << 16);
  f[3] = __uint_as_float(u.y & 0xffff0000u);
  f[4] = __uint_as_float(u.z << 16);
  f[5] = __uint_as_float(u.z & 0xffff0000u);
  f[6] = __uint_as_float(u.w << 16);
  f[7] = __uint_as_float(u.w & 0xffff0000u);
}
DEV uint4 pack8(const float* f) {
  uint4 r;
  r.x = pack2(f[0], f[1]);
  r.y = pack2(f[2], f[3]);
  r.z = pack2(f[4], f[5]);
  r.w = pack2(f[6], f[7]);
  return r;
}
#define MFMA16(a, b, c) __builtin_amdgcn_mfma_f32_16x16x32_bf16((a), (b), (c), 0, 0, 0)
#define MFMA32(a, b, c) __builtin_amdgcn_mfma_f32_32x32x16_bf16((a), (b), (c), 0, 0, 0)

#define LAS __attribute__((address_space(3)))
#define XB_TMO      128
#define XB_XCNT(j)  (256  + 64 * (j))
#define XB_XSUB(j)  (1280 + 64 * (j))
#define XB_XGEN(j)  (2304 + 64 * (j))
#define XB_TOP      3328
#define XB_TOPGEN   3392
#define XCD_BAR_WORDS 3456
#define XB_PROG(c)   (3456 + 64 * (c))
#define XB_CXCC(c)   (3456 + 1024 + 64 * (c))
#define BAR_WORDS_TOTAL (3456 + 2048)
#define XB_SPIN_CAP (1u << 22)

DEV unsigned xb_ld(unsigned* p) { return __hip_atomic_load(p, __ATOMIC_RELAXED, __HIP_MEMORY_SCOPE_AGENT); }
DEV unsigned xb_add(unsigned* p, unsigned v) { return __hip_atomic_fetch_add(p, v, __ATOMIC_RELAXED, __HIP_MEMORY_SCOPE_AGENT); }
DEV unsigned xb_xcc_id() { return (unsigned)__builtin_amdgcn_s_getreg((3 << 11) | 20) & 0xFu; }
#define XB_SPIN(cond, bar) do { unsigned _sp = 0; while (cond) { __builtin_amdgcn_s_sleep(1); \
    if ((++_sp & 255u) == 0u) { if (xb_ld(&(bar)[XB_TMO])) break; if (_sp > XB_SPIN_CAP) { atomicAdd(&(bar)[XB_TMO], 1u); break; } } } } while (0)

DEV void xcd_barrier_post(unsigned* bar, int tid) {
  if (tid == 0) (void)xb_add(&bar[XB_XCNT(xb_xcc_id())], 1u);
}
DEV void xcd_barrier_complete(unsigned* bar, unsigned x, unsigned& nloc, unsigned& nx) {
  const unsigned G = gridDim.x * gridDim.y * gridDim.z;
  unsigned sum, cnt, mine, sp = 0u;
  for (;;) {
    sum = 0u; cnt = 0u; mine = 0u;
#pragma unroll
    for (unsigned j = 0; j < 16; ++j) {
      const unsigned c = xb_ld(&bar[XB_XCNT(j)]);
      sum += c;
      cnt += (c > 0u) ? 1u : 0u;
      mine = (j == x) ? c : mine;
    }
    if (sum == G) break;
    __builtin_amdgcn_s_sleep(1);
    if ((++sp & 255u) == 0u) {
      if (xb_ld(&bar[XB_TMO])) break;
      if (sp > XB_SPIN_CAP) { atomicAdd(&bar[XB_TMO], 1u); break; }
    }
  }
  nloc = mine > 0u ? mine : 1u;
  nx = cnt > 0u ? cnt : 1u;
}
DEV void xcd_barrier(unsigned* bar, volatile LAS unsigned* st, int tid) {
  asm volatile("s_waitcnt vmcnt(0)" ::: "memory");
  __syncthreads();
  if (tid == 0) {
    const unsigned bx = xb_xcc_id();
    __builtin_amdgcn_s_waitcnt(0);
    unsigned nloc = st[0], nx = st[1];
    const unsigned gen = st[2];
    st[2] = gen + 1u;
    if (nloc == 0u) {
      xcd_barrier_complete(bar, bx, nloc, nx);
      st[0] = nloc;
      st[1] = nx;
    }
    const unsigned old = xb_add(&bar[XB_XSUB(bx)], 1u);
    if (old + 1u == (gen + 1u) * nloc) {
      __builtin_amdgcn_fence(__ATOMIC_RELEASE, "agent");
      asm volatile("s_waitcnt vmcnt(0)" ::: "memory");
      const unsigned og = xb_add(&bar[XB_TOP], 1u);
      if (og + 1u == (gen + 1u) * nx) xb_add(&bar[XB_TOPGEN], 1u);
      else XB_SPIN(xb_ld(&bar[XB_TOPGEN]) == gen, bar);
      __builtin_amdgcn_fence(__ATOMIC_ACQUIRE, "agent");
      xb_add(&bar[XB_XGEN(bx)], 1u);
      asm volatile("s_waitcnt vmcnt(0)" ::: "memory");
    } else {
      XB_SPIN(xb_ld(&bar[XB_XGEN(bx)]) == gen, bar);
      __builtin_amdgcn_fence(__ATOMIC_ACQUIRE, "agent");
      asm volatile("s_waitcnt vmcnt(0)" ::: "memory");
    }
  }
  __syncthreads();
}

constexpr int G_BK = 64, G_HALF = 128, G_HTB = G_HALF * G_BK * 2, G_STAGE_BYTES = 8 * G_HTB;
DEV int g_lds_byte(int r, int c) {
  const int st = (r >> 4) * 2 + (c >> 5), rr = r & 15, cc = c & 31, ob = rr * 64 + cc * 2;
  return st * 1024 + (ob ^ (((ob >> 9) & 1) << 5));
}
DEV void g_stage_rc(int b, int& R, int& C) {
  const int st = b / 1024, sb = b % 1024, swz = sb ^ (((sb >> 9) & 1) << 5);
  R = (st >> 1) * 16 + swz / 64;
  C = (st & 1) * 32 + (swz % 64) / 2;
}
DEV int g_perm32(int rho) { const int n = rho >> 4, i = rho & 15; return 8 * (i >> 2) + 4 * n + (i & 3); }

struct GUnit { int pm, pn, e, valid; };

template <class Epi, class Sched>
DEV void gemm_phase(LAS unsigned char* lds, const Sched& S, const Epi& E) {
  const int tid = fresh_tid_w(S.wv), wid = S.wv, lane = tid & 63, wr = wid >> 2, wc = wid & 3, fr = lane & 15,
            fq = lane >> 4;
  const int K = S.K, nt = K / G_BK;
  GUnit cur, nxt;
  int ui = 0;
  if (!S.next(0, cur)) return;
  unsigned voffB[2];
#pragma unroll
  for (int i = 0; i < 2; ++i) {
    int R, C;
    g_stage_rc(tid * 16 + i * 8192, R, C);
    const int Rb = Epi::PERM ? ((R & ~31) + g_perm32(R & 31)) : R;
    voffB[i] = (unsigned)(Rb * K + C) * 2u;
  }
  unsigned vA[2][2];
  auto a_offsets = [&](const GUnit& u) {
#pragma unroll
    for (int h = 0; h < 2; ++h)
#pragma unroll
      for (int i = 0; i < 2; ++i) {
        int R, C;
        g_stage_rc(tid * 16 + i * 8192, R, C);
        vA[h][i] = S.rowoff(u, h * G_HALF + R) + (unsigned)C * 2u;
      }
  };
  const size_t kstep = (size_t)(G_BK * 2);
  const size_t hstep = (size_t)G_HALF * K * 2;
  const unsigned ldsw = (unsigned)wid * 1024u;
  const int aoff = g_lds_byte(wr * 64 + fr, fq * 8), boff = g_lds_byte(wc * 32 + fr, fq * 8);
#define PG8_SA(b, h) (((b) * 2 + (h)) * G_HTB)
#define PG8_SB(b, h) ((4 + (b) * 2 + (h)) * G_HTB)
#define PG8_STAGE(bufoff, gbase, voff) do { _Pragma("unroll") for (int _i = 0; _i < 2; ++_i) \
    __builtin_amdgcn_global_load_lds((const unsigned*)((const char*)(gbase) + (voff)[_i]), (LAS unsigned*)(lds + (bufoff) + ldsw + _i * 8192), 16, 0, 0); } while (0)
#define PG8_LDA(dst, b, h) do { _Pragma("unroll") for (int m = 0; m < 4; ++m) _Pragma("unroll") for (int k = 0; k < 2; ++k) dst[m][k] = *(const LAS bf16x8*)(lds + PG8_SA(b, h) + aoff + m * 2048 + k * 1024); } while (0)
#define PG8_LDB(dst, b, h) do { _Pragma("unroll") for (int n = 0; n < 2; ++n) _Pragma("unroll") for (int k = 0; k < 2; ++k) dst[n][k] = *(const LAS bf16x8*)(lds + PG8_SB(b, h) + boff + n * 2048 + k * 1024); } while (0)
#define PG8_MMA(ai, bj, At, Bt) do { __builtin_amdgcn_s_setprio(1); _Pragma("unroll") for (int m = 0; m < 4; ++m) _Pragma("unroll") for (int n = 0; n < 2; ++n) _Pragma("unroll") for (int k = 0; k < 2; ++k) \
    acc[ai][bj][m][n] = __builtin_amdgcn_mfma_f32_16x16x32_bf16(Bt[n][k], At[m][k], acc[ai][bj][m][n], 0, 0, 0); __builtin_amdgcn_s_setprio(0); } while (0)
#define PG8_WAIT_V(n) asm volatile("s_waitcnt vmcnt(" #n ")" ::: "memory")
#define PG8_WAIT_L(n) asm volatile("s_waitcnt lgkmcnt(" #n ")" ::: "memory")
#define PG8_BAR __builtin_amdgcn_s_barrier()
#define PG8_SCHED __builtin_amdgcn_sched_barrier(0)
  f32x4 acc[2][2][4][2];
#pragma unroll
  for (int a = 0; a < 2; ++a)
#pragma unroll
    for (int b = 0; b < 2; ++b)
#pragma unroll
      for (int m = 0; m < 4; ++m)
#pragma unroll
        for (int n = 0; n < 2; ++n) acc[a][b][m][n] = (f32x4){0.f, 0.f, 0.f, 0.f};
  bf16x8 At[4][2], B0[2][2], B1[2][2];
  const char* const gA = (const char*)S.A;
  const char* cB = S.bptr(cur);
  a_offsets(cur);
  PG8_STAGE(PG8_SB(0, 0), cB, voffB); PG8_STAGE(PG8_SA(0, 0), gA, vA[0]); PG8_STAGE(PG8_SB(0, 1), cB + hstep, voffB); PG8_STAGE(PG8_SA(0, 1), gA, vA[1]);
  if (wr == 1) PG8_BAR;
  PG8_WAIT_V(4); PG8_BAR;
  PG8_STAGE(PG8_SB(1, 0), cB + kstep, voffB); PG8_STAGE(PG8_SA(1, 0), gA + kstep, vA[0]); PG8_STAGE(PG8_SB(1, 1), cB + hstep + kstep, voffB);
  PG8_WAIT_V(6); PG8_BAR;
  for (;;) {
    const bool has_next = S.next(ui + 1, nxt);
    const char* nB = has_next ? S.bptr(nxt) : cB;
    for (int t = 0; t < nt; t += 2) {
      const bool last = (t == nt - 2);
      const char* a1 = gA + (size_t)(t + 1) * kstep;
      const char* a2 = last ? gA : gA + (size_t)(t + 2) * kstep;
      const char* b2 = last ? nB : cB + (size_t)(t + 2) * kstep;
      const char* a3 = a2 + kstep; const char* b3 = b2 + kstep;
      PG8_LDB(B0, 0, 0); PG8_SCHED; PG8_LDA(At, 0, 0); PG8_STAGE(PG8_SA(1, 1), a1, vA[1]);
      PG8_WAIT_L(8); PG8_BAR; PG8_WAIT_L(0); PG8_MMA(0, 0, At, B0); PG8_BAR; PG8_SCHED;
      if (last && has_next) a_offsets(nxt);
      PG8_LDB(B1, 0, 1); PG8_STAGE(PG8_SB(0, 0), b2, voffB);
      PG8_BAR; PG8_WAIT_L(0); PG8_MMA(0, 1, At, B1); PG8_BAR;
      PG8_LDA(At, 0, 1); PG8_STAGE(PG8_SA(0, 0), a2, vA[0]);
      PG8_BAR; PG8_WAIT_L(0); PG8_MMA(1, 0, At, B0); PG8_BAR; PG8_SCHED;
      PG8_STAGE(PG8_SB(0, 1), b2 + hstep, voffB);
      PG8_WAIT_V(6); PG8_BAR; PG8_MMA(1, 1, At, B1); PG8_BAR;
      PG8_LDB(B0, 1, 0); PG8_SCHED; PG8_LDA(At, 1, 0); PG8_STAGE(PG8_SA(0, 1), a2, vA[1]);
      PG8_WAIT_L(8); PG8_BAR; PG8_WAIT_L(0); PG8_MMA(0, 0, At, B0); PG8_BAR; PG8_SCHED;
      PG8_LDB(B1, 1, 1); PG8_STAGE(PG8_SB(1, 0), b3, voffB);
      PG8_BAR; PG8_WAIT_L(0); PG8_MMA(0, 1, At, B1); PG8_BAR;
      PG8_LDA(At, 1, 1); PG8_STAGE(PG8_SA(1, 0), a3, vA[0]);
      PG8_BAR; PG8_WAIT_L(0); PG8_MMA(1, 0, At, B0); PG8_BAR; PG8_SCHED;
      PG8_STAGE(PG8_SB(1, 1), b3 + hstep, voffB);
      PG8_WAIT_V(6); PG8_BAR; PG8_MMA(1, 1, At, B1); PG8_BAR;
    }
    E(acc, cur, wr, wc, fr, fq);
    if (!has_next) break;
#pragma unroll
    for (int a = 0; a < 2; ++a)
#pragma unroll
      for (int b = 0; b < 2; ++b)
#pragma unroll
        for (int m = 0; m < 4; ++m)
#pragma unroll
          for (int n = 0; n < 2; ++n) acc[a][b][m][n] = (f32x4){0.f, 0.f, 0.f, 0.f};
    cur = nxt; cB = nB; ++ui;
  }
  PG8_WAIT_V(0);
  if (wr == 0) PG8_BAR;
  PG8_BAR;
#undef PG8_SA
#undef PG8_SB
#undef PG8_STAGE
#undef PG8_LDA
#undef PG8_LDB
#undef PG8_MMA
#undef PG8_WAIT_V
#undef PG8_WAIT_L
#undef PG8_BAR
#undef PG8_SCHED
}

struct DenseSched {
  const bf16_t* A; const bf16_t* Bt; int K, nM, nN, nwg, G, c, wv;
  DEV bool next(int i, GUnit& u) const {
    const long L = (long)i * G + c;
    if (L >= nwg) return false;
    int wgid = (int)L;
    { const int q = nwg / 8, r = nwg % 8, xcd = wgid % 8, off = wgid / 8; wgid = (xcd < r ? xcd * (q + 1) : r * (q + 1) + (xcd - r) * q) + off; }
    const int nig = 8 * nN, gid = wgid / nig, fm = gid * 8;
    u.pm = fm + ((wgid % nig) & 7);
    u.pn = (wgid % nig) >> 3;
    u.e = 0;
    u.valid = 256;
    return true;
  }
  DEV unsigned rowoff(const GUnit& u, int row) const { return (unsigned)((u.pm * 256 + row) * K) * 2u; }
  DEV const char* bptr(const GUnit& u) const { return (const char*)Bt + (size_t)u.pn * 256 * K * 2; }
};
struct MoeSched {
  const bf16_t* A; const bf16_t* Bt; int K; const int* cnt; const int* list; int G, c, shift, wv;
  DEV bool next(int i, GUnit& u) const {
    int L = i * G + c;
    for (int e = 0; e < NEXP; ++e) {
      const int cn = cnt[e];
      const int ntl = ((cn + 255) >> 8) * 4;
      if (L < ntl) {
        u.e = e; u.pm = L >> 2; u.pn = L & 3; u.valid = min(256, cn - u.pm * 256);
        return true;
      }
      L -= ntl;
    }
    return false;
  }
  DEV unsigned rowoff(const GUnit& u, int row) const {
    const int slot = list[u.e * CAP + u.pm * 256 + min(row, u.valid - 1)];
    return (unsigned)((slot >> shift) * K) * 2u;
  }
  DEV const char* bptr(const GUnit& u) const { return (const char*)Bt + ((size_t)u.e * 1024 + u.pn * 256) * K * 2; }
};

DEV void convert_tile(const float* src, int ld, int k0, int n0, bf16_t* dst, int drow0, int dK, float* tl, int tid) {
  {
    const int kk = tid >> 4, n4 = tid & 15;
    const float4 a = *(const float4*)(src + (size_t)(k0 + kk) * ld + n0 + n4 * 4);
    const float4 b = *(const float4*)(src + (size_t)(k0 + kk + 32) * ld + n0 + n4 * 4);
    float* r0 = tl + kk * 65 + n4 * 4;
    r0[0] = a.x; r0[1] = a.y; r0[2] = a.z; r0[3] = a.w;
    float* r1 = tl + (kk + 32) * 65 + n4 * 4;
    r1[0] = b.x; r1[1] = b.y; r1[2] = b.z; r1[3] = b.w;
  }
  __syncthreads();
  {
    const int n = tid >> 3, k8 = tid & 7;
    float v[8];
#pragma unroll
    for (int j = 0; j < 8; ++j) v[j] = tl[(k8 * 8 + j) * 65 + n];
    *(uint4*)(dst + (size_t)(drow0 + n) * dK + k0 + k8 * 8) = pack8(v);
  }
  __syncthreads();
}
DEV void convert_gates(const Params& p, int l, int bid, int nb, int tid) {
  const int bs = bid;
  const int g = bs * NTHR + tid;
  if (g < 16 * DM) {
    const int j = g >> 10, k = g & (DM - 1);
    p.btg[g] = f2bf(p.w_in[((size_t)l * DM + k) * DIN + PROJW + j]);
  }
}
DEV void convert_win(const Params& p, int l, int bid, int nb, char* smem) {
  const int tid = fresh_tid();
  for (int t = bid; t < 16 * 56; t += nb) {
    const int kt = t / 56, ntile = t - kt * 56;
    convert_tile(p.w_in + (size_t)l * DM * DIN, DIN, kt * 64, ntile * 64, p.btin, ntile * 64, DM, (float*)smem, tid);
  }
  convert_gates(p, l, bid, nb, tid);
}
struct CvtDesc { const float* src; bf16_t* dst; int ld, dK, k0, n0, drow0; };
DEV CvtDesc cvt_desc(const Params& p, int l, int t) {
  constexpr int NT_W1 = NEXP * 16 * 8, NT_W2 = NEXP * 8 * 16, NT_WO = 256;
  CvtDesc d;
  if (t < 2 * NT_W1) {
    const int which = t / NT_W1, r = t - which * NT_W1;
    const int e = r >> 7, kt = (r >> 3) & 15, ntile = r & 7;
    d.src = (which ? p.ew3 : p.ew1) + (size_t)(l * NEXP + e) * DM * DEXP;
    d.ld = DEXP; d.k0 = kt * 64; d.n0 = ntile * 64;
    d.dst = p.bt1; d.dK = DM;
    d.drow0 = e * 1024 + 256 * (d.n0 >> 7) + which * 128 + (d.n0 & 127);
  } else if (t < 2 * NT_W1 + NT_W2) {
    const int r = t - 2 * NT_W1;
    const int e = r >> 7, kt = (r >> 4) & 7, ntile = r & 15;
    d.src = p.ew2 + (size_t)(l * NEXP + e) * DEXP * DM;
    d.ld = DM; d.k0 = kt * 64; d.n0 = ntile * 64;
    d.dst = p.bt2; d.dK = DEXP; d.drow0 = e * 1024 + ntile * 64;
  } else {
    const int r = t - 2 * NT_W1 - NT_W2;
    const int kt = r >> 4, ntile = r & 15;
    d.src = p.w_out + (size_t)l * DM * DM;
    d.ld = DM; d.k0 = kt * 64; d.n0 = ntile * 64;
    d.dst = p.btout; d.dK = DM; d.drow0 = ntile * 64;
  }
  return d;
}
DEV void convert_layer(const Params& p, int l, int bid_, int nb, char* smem) {
  const int bid = bid_;
  const int tid = fresh_tid();
  float* tl = (float*)smem;
  constexpr int NT = 2 * (NEXP * 16 * 8) + NEXP * 8 * 16 + 256;
  const int kk = tid >> 4, n4 = tid & 15;
  auto fetch = [&](int t, float4& a, float4& b) {
    const CvtDesc d = cvt_desc(p, l, min(t, NT - 1));
    const float* s = d.src + (size_t)(d.k0 + kk) * d.ld + d.n0 + n4 * 4;
    {
      const f32x4 av = __builtin_nontemporal_load((const f32x4*)(s));
      const f32x4 bv = __builtin_nontemporal_load((const f32x4*)(s + (size_t)32 * d.ld));
      a = make_float4(av[0], av[1], av[2], av[3]);
      b = make_float4(bv[0], bv[1], bv[2], bv[3]);
    }
  };
  float4 a0, b0, a1, b1, a2, b2;
  fetch(bid, a0, b0);
  fetch(bid + nb, a1, b1);
#pragma unroll 1
  for (int t = bid; t < NT; t += nb) {
    fetch(t + 2 * nb, a2, b2);
    const CvtDesc d = cvt_desc(p, l, t);
    {
      float* r0 = tl + kk * 65 + n4 * 4;
      r0[0] = a0.x; r0[1] = a0.y; r0[2] = a0.z; r0[3] = a0.w;
      float* r1 = tl + (kk + 32) * 65 + n4 * 4;
      r1[0] = b0.x; r1[1] = b0.y; r1[2] = b0.z; r1[3] = b0.w;
    }
    __syncthreads();
    {
      const int n = tid >> 3, k8 = tid & 7;
      float v[8];
#pragma unroll
      for (int j = 0; j < 8; ++j) v[j] = tl[(k8 * 8 + j) * 65 + n];
      const uint4 pk = pack8(v);
      const u32x4 pkv = {pk.x, pk.y, pk.z, pk.w};
      __builtin_nontemporal_store(pkv, (u32x4*)(d.dst + (size_t)(d.drow0 + n) * d.dK + d.k0 + k8 * 8));
    }
    __syncthreads();
    a0 = a1; b0 = b1; a1 = a2; b1 = b2;
  }
  if (l + 1 < DEPTH) convert_win(p, l + 1, bid, nb, smem);
}

DEV void phase_ada(const Params& p, int bid, int nb, char* smem) {
  float* cond = (float*)smem;
  float* red = cond + 2 * DM;
  const int tid = fresh_tid(), lane = tid & 63, wid = tid >> 6;
  for (int i = tid; i < 2 * DM; i += NTHR) cond[i] = silu_f(p.c[i]);
  __syncthreads();
  for (int item = bid; item < DEPTH * 96; item += nb) {
    const int l = item / 96, j = (item - l * 96) * 64 + lane;
    const float* w = p.w_ada + ((size_t)l * DM + wid * 128) * 6144 + j;
    float a0 = 0.f, a1 = 0.f;
#pragma unroll 16
    for (int k = 0; k < 128; ++k) {
      const float wv = w[(size_t)k * 6144];
      a0 += cond[wid * 128 + k] * wv;
      a1 += cond[DM + wid * 128 + k] * wv;
    }
    red[(wid * 2 + 0) * 64 + lane] = a0;
    red[(wid * 2 + 1) * 64 + lane] = a1;
    __syncthreads();
    if (wid < 2) {
      float s = p.b_ada[l * 6144 + j];
#pragma unroll
      for (int w8 = 0; w8 < 8; ++w8) s += red[(w8 * 2 + wid) * 64 + lane];
      p.mod[(l * 2 + wid) * 6144 + j] = s;
    }
    __syncthreads();
  }
  if (bid == 0 && tid < DEPTH * NEXP) p.cnt[tid] = 0;
}

DEV void norm_mod_store(const float4 (&v)[4], float rstd, const float* nw, const float* sc, const float* sh,
                        bf16_t* dst, int lane) {
#pragma unroll
  for (int i = 0; i < 4; ++i) {
    const int idx = (lane + 64 * i) * 4;
    const float4 w = *(const float4*)(nw + idx);
    const float4 s = *(const float4*)(sc + idx);
    const float4 h = *(const float4*)(sh + idx);
    const float r0 = v[i].x * rstd * w.x * (1.f + s.x) + h.x;
    const float r1 = v[i].y * rstd * w.y * (1.f + s.y) + h.y;
    const float r2 = v[i].z * rstd * w.z * (1.f + s.z) + h.z;
    const float r3 = v[i].w * rstd * w.w * (1.f + s.w) + h.w;
    uint2 pk;
    pk.x = pack2(r0, r1);
    pk.y = pack2(r2, r3);
    *(uint2*)(dst + idx) = pk;
  }
}

DEV void phase_hmix(const Params& p, int l, const float* xin, int bid, int nb) {
  const int tid_ = fresh_tid(), lane = tid_ & 63, wid = tid_ >> 6;
  for (int t = bid * NWAVE + wid; t < NTOK; t += nb * NWAVE) {
    const float4* xr = (const float4*)(xin + (size_t)t * DM);
    float4 v[4];
    float ss = 0.f;
#pragma unroll
    for (int i = 0; i < 4; ++i) {
      v[i] = xr[lane + 64 * i];
      ss += v[i].x * v[i].x + v[i].y * v[i].y + v[i].z * v[i].z + v[i].w * v[i].w;
    }
    ss = wave_sum(ss, lane);
    const float rstd = rsqrtf(ss * (1.f / DM) + EPS);
    const int b = t / T;
    const float* md = p.mod + (l * 2 + b) * 6144;
    norm_mod_store(v, rstd, p.norm_mix_w + l * DM, md + MOD_SCALE1, md + MOD_SHIFT1, p.act + (size_t)t * DM, lane);
  }
}

struct EpiProj {
  static constexpr bool PERM = true;
  bf16_t* O;
  DEV void operator()(const f32x4 (&acc)[2][2][4][2], const GUnit& u, int wr, int wc, int fr, int fq) const {
    const int row0 = u.pm * 256 + wr * 64 + fr, col0 = u.pn * 256 + wc * 32 + 8 * fq;
#pragma unroll
    for (int ai = 0; ai < 2; ++ai)
#pragma unroll
      for (int m = 0; m < 4; ++m) {
        bf16_t* rowp = O + (size_t)(row0 + ai * G_HALF + m * 16) * PROJW + col0;
#pragma unroll
        for (int bj = 0; bj < 2; ++bj) {
          const f32x4 v0 = acc[ai][bj][m][0], v1 = acc[ai][bj][m][1];
          uint4 w;
          w.x = pack2(v0[0], v0[1]); w.y = pack2(v0[2], v0[3]); w.z = pack2(v1[0], v1[1]); w.w = pack2(v1[2], v1[3]);
          *(uint4*)(rowp + bj * G_HALF) = w;
        }
      }
  }
};

DEV void phase_gemm_proj(const Params& p, int l, int bid, int nb, char* smem) {
  DenseSched S;
  S.A = p.act; S.Bt = p.btin; S.K = DM; S.nM = NTOK / 256; S.nN = PROJW / 256; S.nwg = S.nM * S.nN; S.G = nb; S.c = bid; S.wv = p.wv;
  EpiProj E;
  E.O = p.proj;
  gemm_phase((LAS unsigned char*)smem, S, E);
  const int tid = fresh_tid(), lane = tid & 63, wid = tid >> 6, fr = lane & 15, fq = lane >> 4;
  for (int tb = bid; tb < NTOK / 64; tb += nb) {
    if (wid < 4) {
      const int tok0 = tb * 64 + wid * 16;
      const bf16_t* ap = p.act + (size_t)(tok0 + fr) * DM + fq * 8;
      const bf16_t* bp = p.btg + (size_t)fr * DM + fq * 8;
      f32x4 acc = {0.f, 0.f, 0.f, 0.f};
#pragma unroll 8
      for (int ks = 0; ks < DM / 32; ++ks)
        acc = MFMA16(*(const bf16x8*)(ap + ks * 32), *(const bf16x8*)(bp + ks * 32), acc);
#pragma unroll
      for (int j = 0; j < 4; ++j) p.gates[(size_t)(tok0 + fq * 4 + j) * 16 + fr] = acc[j];
    }
  }
}

DEV void phase_conv(const Params& p, int l, int bid, int nb) {
  const float* w = p.conv_a_w + l * 768;
  const int bs = bid;
  for (int g = bs * NTHR + fresh_tid(); g < NTOK * 32; g += nb * NTHR) {
    const int t = g >> 5, c = (g & 31) * 8;
    const int tl = t & (T - 1);
    const bf16_t* r = p.proj + (size_t)t * PROJW + c;
    float cb[8], cc[8], cx[8], s[8], wk[8];
    unpack8(*(const uint4*)(r + OFF_CB), cb);
    unpack8(*(const uint4*)(r + OFF_CC), cc);
    unpack8(*(const uint4*)(r + OFF_CX), cx);
    {
      const float4 w0 = *(const float4*)(w + 256 + c), w1 = *(const float4*)(w + 256 + c + 4);
      wk[0] = w0.x; wk[1] = w0.y; wk[2] = w0.z; wk[3] = w0.w; wk[4] = w1.x; wk[5] = w1.y; wk[6] = w1.z; wk[7] = w1.w;
    }
#pragma unroll
    for (int e = 0; e < 8; ++e) s[e] = wk[e] * cc[e] * cx[e];
    if (tl > 0) {
      unpack8(*(const uint4*)(r + OFF_CC - PROJW), cc);
      unpack8(*(const uint4*)(r + OFF_CX - PROJW), cx);
      const float4 w0 = *(const float4*)(w + c), w1 = *(const float4*)(w + c + 4);
      wk[0] = w0.x; wk[1] = w0.y; wk[2] = w0.z; wk[3] = w0.w; wk[4] = w1.x; wk[5] = w1.y; wk[6] = w1.z; wk[7] = w1.w;
#pragma unroll
      for (int e = 0; e < 8; ++e) s[e] += wk[e] * cc[e] * cx[e];
    }
    if (tl < T - 1) {
      unpack8(*(const uint4*)(r + OFF_CC + PROJW), cc);
      unpack8(*(const uint4*)(r + OFF_CX + PROJW), cx);
      const float4 w0 = *(const float4*)(w + 512 + c), w1 = *(const float4*)(w + 512 + c + 4);
      wk[0] = w0.x; wk[1] = w0.y; wk[2] = w0.z; wk[3] = w0.w; wk[4] = w1.x; wk[5] = w1.y; wk[6] = w1.z; wk[7] = w1.w;
#pragma unroll
      for (int e = 0; e < 8; ++e) s[e] += wk[e] * cc[e] * cx[e];
    }
#pragma unroll
    for (int e = 0; e < 8; ++e) s[e] *= cb[e];
    *(uint4*)(p.y + (size_t)t * DM + c) = pack8(s);
  }
}

DEV void phase_na(const Params& p, int l, int wgid, int nwg) {
  const int tid_ = fresh_tid(), lane = tid_ & 63, fr = lane & 15, fq = lane >> 4;
  for (int item = wgid; item < NB * 128 * 4 * 4; item += nwg) {
    const int qg = item & 3, h = (item >> 2) & 3, r = (item >> 4) & 127, b = item >> 11;
    const int rs = min(max(r - 4, 0), 120);
    const int kc0 = (qg == 0) ? 0 : (qg == 1) ? 8 : (qg == 2) ? 24 : 32;
    const int c = qg * 16 + fr;
    const int cs = min(max(c - 8, 0), 48);
    const size_t tq = (size_t)b * T + r * 64 + c;
    bf16x8 bq[2];
#pragma unroll
    for (int ks = 0; ks < 2; ++ks)
      bq[ks] = *(const bf16x8*)(p.proj + tq * PROJW + OFF_NQ + h * 64 + ks * 32 + fq * 8);
    f32x4 sc[16];
#pragma unroll
    for (int tt = 0; tt < 16; ++tt) {
      const int i = tt >> 1, half = tt & 1;
      const size_t kt = (size_t)b * T + (rs + i) * 64 + kc0 + half * 16 + fr;
      const bf16_t* kp = p.proj + kt * PROJW + OFF_NK + h * 64 + fq * 8;
      const bf16x8 a0 = *(const bf16x8*)(kp);
      const bf16x8 a1 = *(const bf16x8*)(kp + 32);
      f32x4 z = {0.f, 0.f, 0.f, 0.f};
      z = MFMA16(a0, bq[0], z);
      sc[tt] = MFMA16(a1, bq[1], z);
    }
    const float* rpb = p.na_rpb + (size_t)(l * 4 + h) * 465;
    float mx = -3.0e38f;
#pragma unroll
    for (int tt = 0; tt < 16; ++tt) {
      const int i = tt >> 1, half = tt & 1;
      const int dr = rs + i - r + 7;
#pragma unroll
      for (int j = 0; j < 4; ++j) {
        const int kcol = kc0 + half * 16 + fq * 4 + j;
        const bool valid = (kcol >= cs) && (kcol < cs + 16);
        const int dc = valid ? (kcol - c + 15) : 0;
        const float s = valid ? (sc[tt][j] * 0.125f + rpb[dr * 31 + dc]) : -3.0e38f;
        sc[tt][j] = s;
        mx = fmaxf(mx, s);
      }
    }
    mx = fmaxf(mx, shx(mx, 16, lane));
    mx = fmaxf(mx, shx(mx, 32, lane));
    float sum = 0.f;
#pragma unroll
    for (int tt = 0; tt < 16; ++tt)
#pragma unroll
      for (int j = 0; j < 4; ++j) {
        const float s = sc[tt][j];
        const float e = (s > -1.0e38f) ? __expf(s - mx) : 0.f;
        sc[tt][j] = e;
        sum += e;
      }
    sum += shx(sum, 16, lane);
    sum += shx(sum, 32, lane);
    const float inv = 1.f / sum;
    f32x4 oacc[4];
#pragma unroll
    for (int nt = 0; nt < 4; ++nt) oacc[nt] = f32x4{0.f, 0.f, 0.f, 0.f};
#pragma unroll
    for (int i = 0; i < 8; ++i) {
      uint4 pu;
      pu.x = pack2(sc[2 * i][0] * inv, sc[2 * i][1] * inv);
      pu.y = pack2(sc[2 * i][2] * inv, sc[2 * i][3] * inv);
      pu.z = pack2(sc[2 * i + 1][0] * inv, sc[2 * i + 1][1] * inv);
      pu.w = pack2(sc[2 * i + 1][2] * inv, sc[2 * i + 1][3] * inv);
      const bf16x8 pa = __builtin_bit_cast(bf16x8, pu);
      const bf16_t* vb = p.proj + ((size_t)b * T + (rs + i) * 64 + kc0 + fq * 4) * PROJW + OFF_NV + h * 64 + fr * 4;
      uint2 wv[8];
#pragma unroll
      for (int j = 0; j < 8; ++j) wv[j] = *(const uint2*)(vb + (size_t)(j < 4 ? j : 12 + j) * PROJW);
#pragma unroll
      for (int t = 0; t < 4; ++t) {
        uint4 bu;
        const unsigned sel = (t & 1) ? 0x07060302u : 0x05040100u;
#define NA_E(j) ((t & 2) ? wv[j].y : wv[j].x)
        bu.x = __builtin_amdgcn_perm(NA_E(1), NA_E(0), sel);
        bu.y = __builtin_amdgcn_perm(NA_E(3), NA_E(2), sel);
        bu.z = __builtin_amdgcn_perm(NA_E(5), NA_E(4), sel);
        bu.w = __builtin_amdgcn_perm(NA_E(7), NA_E(6), sel);
#undef NA_E
        oacc[t] = MFMA16(pa, __builtin_bit_cast(bf16x8, bu), oacc[t]);
      }
    }
#pragma unroll
    for (int j = 0; j < 4; ++j) {
      uint2 st;
      st.x = pack2(oacc[0][j], oacc[1][j]);
      st.y = pack2(oacc[2][j], oacc[3][j]);
      *(uint2*)(p.y + ((size_t)b * T + r * 64 + qg * 16 + fq * 4 + j) * DM + 256 + h * 64 + fr * 4) = st;
    }
  }
}

DEV void fmac1(float& acc, float a, float b) { asm("v_fmac_f32 %0, %1, %2" : "+v"(acc) : "v"(a), "v"(b)); }
struct LRow { float4 v[8]; };
template <int POS>
struct SolveStep {
  static DEV void run(float (&x)[64], LRow& row, const float* Ld, const float* sclv, const bf16_t* srcq, int sstep,
                      bool isu, unsigned* up, bf16_t* wp) {
    float s0 = 0.f, s1 = 0.f, s2 = 0.f, s3 = 0.f;
    float4 hi[8];
#pragma unroll
    for (int j4 = 8; j4 < (POS + 3) / 4; ++j4) hi[j4 - 8] = *(const float4*)(Ld + POS * 68 + j4 * 4);
#pragma unroll
    for (int j4 = 0; j4 < 8; ++j4) {
      if (j4 < (POS + 3) / 4) {
        const float4 lv = row.v[j4];
        fmac1(s0, lv.x, x[j4 * 4]);
        if (j4 * 4 + 1 < POS) fmac1(s1, lv.y, x[j4 * 4 + 1]);
        if (j4 * 4 + 2 < POS) fmac1(s2, lv.z, x[j4 * 4 + 2]);
        if (j4 * 4 + 3 < POS) fmac1(s3, lv.w, x[j4 * 4 + 3]);
      }
      if (POS + 1 < 64 && j4 < (POS + 4) / 4) row.v[j4] = *(const float4*)(Ld + (POS + 1) * 68 + j4 * 4);
    }
#pragma unroll
    for (int j4 = 8; j4 < (POS + 3) / 4; ++j4) {
      const float4 lv = hi[j4 - 8];
      fmac1(s0, lv.x, x[j4 * 4]);
      if (j4 * 4 + 1 < POS) fmac1(s1, lv.y, x[j4 * 4 + 1]);
      if (j4 * 4 + 2 < POS) fmac1(s2, lv.z, x[j4 * 4 + 2]);
      if (j4 * 4 + 3 < POS) fmac1(s3, lv.w, x[j4 * 4 + 3]);
    }
    const float a = sclv[POS] * bf2f(srcq[0]) - ((s0 + s1) + (s2 + s3));
    x[POS] = a;
    if (isu) {
      if (POS & 1) up[(POS >> 1) * 128] = pack2(x[POS - 1], a);
    } else {
      wp[POS * 128] = f2bf(-a);
    }
    asm volatile("" ::: "memory");
    SolveStep<POS + 1>::run(x, row, Ld, sclv, srcq + sstep, sstep, isu, up, wp);
  }
};
template <>
struct SolveStep<64> {
  static DEV void run(float (&)[64], LRow&, const float*, const float*, const bf16_t*, int, bool, unsigned*, bf16_t*) {}
};

DEV int kperm16(int k) { const int s = (k >> 2) & 3; return (k & ~15) | ((((s & 1) << 1) | (s >> 1)) << 2) | (k & 3); }

DEV void phase_gdn_prep(const Params& p, int l, int bid, int nb, char* smem) {
  const int tid = fresh_tid(), lane = tid & 63;
  bf16_t* q_bf = (bf16_t*)(smem + PL_Q);
  bf16_t* k_bf = (bf16_t*)(smem + PL_K);
  bf16_t* v_bf = (bf16_t*)(smem + PL_V);
  float* Lm = (float*)(smem + PL_L);
  float* gcl = (float*)(smem + PL_GC);
  float* bl = (float*)(smem + PL_BETA);
  float* bgl = (float*)(smem + PL_BG);
  float* gll = (float*)(smem + PL_GL);
  const float* cw = p.gdn_conv_w + l * 4608;
  for (int item = bid; item < 1024; item += nb) {
    const int b = item >> 9, h = (item >> 7) & 3, n = item & 127;
    const int t0 = b * T + n * 64;
    char* rec0 = p.gdn_rec + (size_t)item * 2 * REC_BYTES;
    uint4 raw[3][3][2];
    {
      const int i = tid >> 3, oc = tid & 7, d0 = oc * 16;
      const int tl = n * 64 + i;
      const bf16_t* rowp = p.proj + (size_t)(t0 + i) * PROJW + OFF_GQKV + h * 128 + d0;
      const int dm = (tl > 0) ? -PROJW : 0, dp = (tl < T - 1) ? PROJW : 0;
#pragma unroll
      for (int m = 0; m < 3; ++m) {
        const bf16_t* rp = rowp + m * 512;
        raw[m][0][0] = *(const uint4*)(rp + dm);
        raw[m][0][1] = *(const uint4*)(rp + dm + 8);
        raw[m][1][0] = *(const uint4*)(rp);
        raw[m][1][1] = *(const uint4*)(rp + 8);
        raw[m][2][0] = *(const uint4*)(rp + dp);
        raw[m][2][1] = *(const uint4*)(rp + dp + 8);
      }
    }
    if (tid < 128) {
      const int dir = tid >> 6;
      const int i = dir ? 63 - lane : lane;
      const size_t t = (size_t)t0 + i;
      const float a = p.gates[t * 16 + dir * 4 + h], bb = p.gates[t * 16 + 8 + dir * 4 + h];
      const float g = -__expf(p.gdn_a_log[l * 8 + dir * 4 + h]) * softplus_f(a + p.gdn_dt_bias[l * 8 + dir * 4 + h]);
      const float beta = sigmoid_f(bb);
      float cs = g;
#pragma unroll
      for (int o = 1; o < 64; o <<= 1) {
        const float v = __int_as_float(__builtin_amdgcn_ds_bpermute((lane - o) << 2, __float_as_int(cs)));
        if (lane >= o) cs += v;
      }
      gcl[dir * 64 + lane] = cs;
      bl[dir * 64 + lane] = beta;
      bgl[dir * 64 + lane] = beta * __expf(cs);
      const float last = __uint_as_float(__builtin_amdgcn_readlane(__float_as_uint(cs), 63));
      if (lane == 0) {
        gll[dir] = last;
        p.egl[item * 2 + dir] = __expf(last);
      }
    }
    __syncthreads();
    {
      int tA = tid;
      asm volatile("" : "+v"(tA));
      const int i = tA >> 3, oc = tA & 7, d0 = oc * 16;
      const int tl = n * 64 + i;
      const float zm = (tl > 0) ? 1.f : 0.f, zp = (tl < T - 1) ? 1.f : 0.f;
#pragma unroll
      for (int m = 0; m < 3; ++m) {
        float x0[16], x1[16], x2[16], val[16];
        unpack8(raw[m][0][0], x0);
        unpack8(raw[m][0][1], x0 + 8);
        unpack8(raw[m][1][0], x1);
        unpack8(raw[m][1][1], x1 + 8);
        unpack8(raw[m][2][0], x2);
        unpack8(raw[m][2][1], x2 + 8);
#pragma unroll
        for (int e = 0; e < 16; ++e) { x0[e] *= zm; x2[e] *= zp; }
        const float* cwm = cw + m * 512 + h * 128 + d0;
        float ss = 0.f;
#pragma unroll
        for (int e = 0; e < 16; ++e) {
          val[e] = silu_f(cwm[e] * x0[e] + cwm[1536 + e] * x1[e] + cwm[3072 + e] * x2[e]);
          ss += val[e] * val[e];
        }
        if (m < 2) {
          ss += shx(ss, 1, lane);
          ss += shx(ss, 2, lane);
          ss += shx(ss, 4, lane);
          float sc = rsqrtf(ss + EPS);
          if (m == 0) sc *= 0.08838834764831845f;
#pragma unroll
          for (int e = 0; e < 16; ++e) val[e] *= sc;
        }
        bf16_t* dst = (m == 0 ? q_bf : (m == 1 ? k_bf : v_bf)) + i * 136 + d0;
        *(uint4*)(dst) = pack8(val);
        *(uint4*)(dst + 8) = pack8(val + 8);
        if (m == 0) {
#pragma unroll
          for (int dir = 0; dir < 2; ++dir) {
            const int pos = dir ? 63 - i : i;
            const float f = __expf(gcl[dir * 64 + pos]);
            float tmp[16];
#pragma unroll
            for (int e = 0; e < 16; ++e) tmp[kperm16(e)] = val[e] * f;
            bf16_t* qd = (bf16_t*)(rec0 + dir * REC_BYTES + REC_QD) + pos * 128 + d0;
            *(uint4*)(qd) = pack8(tmp);
            *(uint4*)(qd + 8) = pack8(tmp + 8);
          }
        }
        if (m == 1) {
#pragma unroll
          for (int dir = 0; dir < 2; ++dir) {
            const int pos = dir ? 63 - i : i;
            const float f = __expf(gll[dir] - gcl[dir * 64 + pos]);
            bf16_t* kt = (bf16_t*)(smem + PL_KT) + (dir * 128 + d0) * 72 + kperm16(pos);
#pragma unroll
            for (int e = 0; e < 16; ++e) kt[e * 72] = f2bf(val[e] * f);
          }
        }
      }
    }
    __syncthreads();
    {
      int tB = tid;
      asm volatile("" : "+v"(tB));
      const int laneB = tB & 63, widB = tB >> 6, fr = laneB & 15, fq = laneB >> 4;
#pragma unroll
      for (int q = 0; q < 4; ++q) {
        const int u = tB + NTHR * q;
        const int dir = u >> 10, row = (u >> 3) & 127, c8 = u & 7;
        *(uint4*)((bf16_t*)(rec0 + dir * REC_BYTES + REC_KT) + row * 64 + c8 * 8) =
            *(const uint4*)((const bf16_t*)(smem + PL_KT) + (dir * 128 + row) * 72 + c8 * 8);
      }
      const int mat = __builtin_amdgcn_readfirstlane(widB >> 2), rtile = widB & 3;
      const bf16_t* asrc = mat ? q_bf : k_bf;
      bf16x8 af[4];
#pragma unroll
      for (int ks = 0; ks < 4; ++ks) af[ks] = *(const bf16x8*)(asrc + (rtile * 16 + fr) * 136 + ks * 32 + fq * 8);
#pragma unroll
      for (int nt = 0; nt < 4; ++nt) {
        f32x4 acc = {0.f, 0.f, 0.f, 0.f};
#pragma unroll
        for (int ks = 0; ks < 4; ++ks) {
          const bf16x8 bfrag = *(const bf16x8*)(k_bf + (nt * 16 + fr) * 136 + ks * 32 + fq * 8);
          acc = MFMA16(af[ks], bfrag, acc);
        }
#pragma unroll
        for (int j = 0; j < 4; ++j) {
          const int i = rtile * 16 + fq * 4 + j, jj = nt * 16 + fr;
          const float G = acc[j];
#pragma unroll
          for (int dir = 0; dir < 2; ++dir) {
            const int pi = dir ? 63 - i : i, pj = dir ? 63 - jj : jj;
            const float dec = __expf(fminf(gcl[dir * 64 + pi] - gcl[dir * 64 + pj], 0.f));
            if (mat == 0)
              Lm[(dir * 64 + pi) * 68 + pj] = (pi > pj) ? bl[dir * 64 + pi] * G * dec : 0.f;
            else
              *((bf16_t*)(smem + PL_IN) + (dir * 64 + pi) * 72 + kperm16(pj)) = f2bf((pi >= pj) ? G * dec : 0.f);
          }
        }
      }
    }
    __syncthreads();
    {
      int tC = tid;
      asm volatile("" : "+v"(tC));
#pragma unroll
      for (int q = 0; q < 2; ++q) {
        const int u = tC + NTHR * q;
        const int dirc = u >> 9, row = (u >> 3) & 63, c8 = u & 7;
        *(uint4*)((bf16_t*)(rec0 + dirc * REC_BYTES + REC_IN) + row * 64 + c8 * 8) =
            *(const uint4*)((const bf16_t*)(smem + PL_IN) + (dirc * 64 + row) * 72 + c8 * 8);
      }
      const int dir = tC >> 8, c = tC & 255;
      const float* Ld = Lm + dir * 64 * 68;
      const bool isu = __builtin_amdgcn_readfirstlane((int)(c < 128)) != 0;
      unsigned* up = p.gdn_u + ((size_t)(item * 2 + dir) * 32) * 128 + (c & 127);
      bf16_t* wp = (bf16_t*)(rec0 + dir * REC_BYTES + REC_WN) + kperm16(c & 127);
      const bf16_t* src = (isu ? v_bf : k_bf) + (c & 127);
      const float* sclv = (isu ? bl : bgl) + dir * 64;
      float x[64];
      LRow row0;
      SolveStep<0>::run(x, row0, Ld, sclv, src + (dir ? 63 * 136 : 0), dir ? -136 : 136, isu, up, wp);
    }
    __syncthreads();
  }
}

DEV int crow(int reg, int hf) { return (reg & 3) + 8 * (reg >> 2) + 4 * hf; }
DEV bf16x8 pack_acc8(const f32x16& x, int s) {
  uint4 v;
  v.x = pack2(x[8 * s + 0], x[8 * s + 1]);
  v.y = pack2(x[8 * s + 2], x[8 * s + 3]);
  v.z = pack2(x[8 * s + 4], x[8 * s + 5]);
  v.w = pack2(x[8 * s + 6], x[8 * s + 7]);
  return __builtin_bit_cast(bf16x8, v);
}
DEV bf16x8 ld_frag(const char* rowp, int kb) { return *(const bf16x8*)(rowp + kb); }

DEV void phase_gdn_scan(const Params& p, int ep, int chain, char* smem) {
  const int tid = fresh_tid(), lane = tid & 63, wid = tid >> 6;
  const int dir = chain & 1, bh = chain >> 1;
  const int b = bh >> 2, hh = bh & 3;
  if (wid >= 4) {
    const int lt = tid - 256;
    uint4 rA[18], rB[18];
    auto gl = [&](uint4 (&rg)[18], int n) {
      const int item = bh * 128 + (dir ? 127 - n : n);
      const __amdgpu_buffer_rsrc_t rr = __builtin_amdgcn_make_buffer_rsrc(
          (void*)(p.gdn_rec + ((size_t)item * 2 + dir) * REC_BYTES), 0, REC_BYTES, 0x00020000);
      const __amdgpu_buffer_rsrc_t ru = __builtin_amdgcn_make_buffer_rsrc(
          (void*)(p.gdn_u + ((size_t)(item * 2 + dir) * 32) * 128), 0, 16384, 0x00020000);
#pragma unroll
      for (int k = 0; k < 14; ++k) {
        const u32x4 v = __builtin_amdgcn_raw_buffer_load_b128(rr, lt * 16, k * 4096, 0);
        rg[k] = make_uint4(v.x, v.y, v.z, v.w);
      }
#pragma unroll
      for (int k = 0; k < 4; ++k) {
        const u32x4 v = __builtin_amdgcn_raw_buffer_load_b128(ru, lt * 16, k * 4096, 0);
        rg[14 + k] = make_uint4(v.x, v.y, v.z, v.w);
      }
    };
    auto st = [&](const uint4 (&rg)[18], int buf) {
      char* base = smem + buf * SC_BUF;
#pragma unroll
      for (int k = 0; k < 14; ++k) {
        const int u = lt + 256 * k;
        int row, c16, off;
        if (k < 4) { row = u >> 4; c16 = u & 15; off = SC_WN + row * 272; }
        else if (k < 8) { row = (u - 1024) >> 4; c16 = (u - 1024) & 15; off = SC_QD + row * 272; }
        else if (k < 10) { row = (u - 2048) >> 3; c16 = (u - 2048) & 7; off = SC_IN + row * 144; }
        else { row = (u - 2560) >> 3; c16 = (u - 2560) & 7; off = SC_KT + row * 144; }
        *(uint4*)(base + off + c16 * 16) = rg[k];
      }
#pragma unroll
      for (int k = 0; k < 4; ++k) *(uint4*)(base + SC_U + (lt + 256 * k) * 16) = rg[14 + k];
    };
    gl(rA, 0);
    st(rA, 0);
    gl(rB, 1);
    gl(rA, 2);
    __syncthreads();
#pragma unroll 1
    for (int n = 0; n < 128; n += 2) {
      st(rB, 1);
      gl(rB, min(n + 3, 127));
      __syncthreads();
      st(rA, 0);
      gl(rA, min(n + 4, 127));
      __syncthreads();
    }
  } else {
    const int w = wid, r = lane & 31, hf = lane >> 5;
    f32x16 S[4];
#pragma unroll
    for (int t4 = 0; t4 < 4; ++t4)
#pragma unroll
      for (int e = 0; e < 16; ++e) S[t4][e] = 0.f;
    __builtin_amdgcn_s_setprio(3);
    const float dlo = p.egl[(bh * 128 + (dir ? 127 - lane : lane)) * 2 + dir];
    const float dhi = p.egl[(bh * 128 + (dir ? 63 - lane : 64 + lane)) * 2 + dir];
    if (tid == 0) __hip_atomic_store(&p.bar[XB_CXCC(chain)], ((unsigned)ep << 4) | xb_xcc_id(), __ATOMIC_RELAXED, __HIP_MEMORY_SCOPE_AGENT);
    __syncthreads();
#pragma unroll 1
    for (int n = 0; n < 128; ++n) {
      if (tid == 0) __hip_atomic_store(&p.bar[XB_PROG(chain)], (unsigned)ep * 1024u + (unsigned)n, __ATOMIC_RELAXED, __HIP_MEMORY_SCOPE_AGENT);
      const char* buf = smem + (n & 1) * SC_BUF;
      const float decay = __uint_as_float(__builtin_amdgcn_readlane(__float_as_uint(n < 64 ? dlo : dhi), n & 63));
      f32x16 vn[2], o[2];
      {
        const unsigned* ul = (const unsigned*)(buf + SC_U) + 32 * w + r;
#pragma unroll
        for (int tm = 0; tm < 2; ++tm)
#pragma unroll
          for (int e2 = 0; e2 < 8; ++e2) {
            const unsigned uu = ul[((32 * tm + crow(2 * e2, hf)) >> 1) * 128];
            vn[tm][2 * e2] = __uint_as_float(uu << 16);
            vn[tm][2 * e2 + 1] = __uint_as_float(uu & 0xffff0000u);
          }
      }
#pragma unroll
      for (int e = 0; e < 16; ++e) { o[0][e] = 0.f; o[1][e] = 0.f; }
      const char* rw0 = buf + SC_WN + r * 272 + hf * 16;
      const char* rq0 = buf + SC_QD + r * 272 + hf * 16;
      const char* ri0 = buf + SC_IN + r * 144 + hf * 16;
      const char* rk0 = buf + SC_KT + r * 144 + hf * 16;
      bf16x8 fA[8], fB[8], sb[4][2];
#define SCAN_LOAD(dst, base, t4a)                                                                        \
  _Pragma("unroll") for (int dt = 0; dt < 2; ++dt) _Pragma("unroll") for (int s = 0; s < 2; ++s)         \
      _Pragma("unroll") for (int tm = 0; tm < 2; ++tm)                                                   \
          dst[dt * 4 + s * 2 + tm] = ld_frag(base + tm * 32 * 272, (32 * ((t4a) + dt) + 16 * s) * 2);
#define SCAN_MMA(acc, f, t4a)                                                                            \
  _Pragma("unroll") for (int dt = 0; dt < 2; ++dt) _Pragma("unroll") for (int s = 0; s < 2; ++s)         \
      _Pragma("unroll") for (int tm = 0; tm < 2; ++tm)                                                   \
          acc[tm] = MFMA32(f[dt * 4 + s * 2 + tm], sb[(t4a) + dt][s], acc[tm]);
#define SCAN_MMA_T(acc, f, t4a)                                                                          \
  _Pragma("unroll") for (int dt = 0; dt < 2; ++dt) _Pragma("unroll") for (int s = 0; s < 2; ++s)         \
      _Pragma("unroll") for (int tm = 0; tm < 2; ++tm)                                                   \
          acc[tm] = MFMA32(sb[(t4a) + dt][s], f[dt * 4 + s * 2 + tm], acc[tm]);
#define SCAN_MIX(nmfma, nds, nvalu)                                                                      \
  _Pragma("unroll") for (int _g = 0; _g < (nmfma); ++_g) {                                               \
    __builtin_amdgcn_sched_group_barrier(0x008, 1, 0);                                                   \
    if (_g < (nds)) __builtin_amdgcn_sched_group_barrier(0x100, 1, 0);                                   \
    __builtin_amdgcn_sched_group_barrier(0x002, (nvalu), 0);                                             \
  }
      SCAN_LOAD(fA, rw0, 0)
      sb[0][0] = pack_acc8(S[0], 0); sb[0][1] = pack_acc8(S[0], 1);
      sb[1][0] = pack_acc8(S[1], 0); sb[1][1] = pack_acc8(S[1], 1);
      __builtin_amdgcn_sched_barrier(0);
      SCAN_MMA(vn, fA, 0)
      SCAN_LOAD(fB, rw0, 2)
      sb[2][0] = pack_acc8(S[2], 0); sb[2][1] = pack_acc8(S[2], 1);
      sb[3][0] = pack_acc8(S[3], 0); sb[3][1] = pack_acc8(S[3], 1);
      SCAN_MIX(8, 8, 2)
      __builtin_amdgcn_sched_barrier(0);
      SCAN_MMA(vn, fB, 2)
      SCAN_LOAD(fA, rq0, 0)
#pragma unroll
      for (int e = 0; e < 16; ++e) S[0][e] *= decay;
      SCAN_MIX(8, 8, 2)
      __builtin_amdgcn_sched_barrier(0);
      SCAN_MMA_T(o, fA, 0)
      SCAN_LOAD(fB, rq0, 2)
#pragma unroll
      for (int e = 0; e < 16; ++e) { S[1][e] *= decay; S[2][e] *= decay; }
      SCAN_MIX(8, 8, 3)
      __builtin_amdgcn_sched_barrier(0);
      bf16x8 fi[6], fk0[4];
      SCAN_MMA_T(o, fB, 2)
      fi[0] = ld_frag(ri0, 0);
      fi[1] = ld_frag(ri0, 32);
#pragma unroll
      for (int q4 = 0; q4 < 4; ++q4) fi[2 + q4] = ld_frag(ri0 + 32 * 144, q4 * 32);
#pragma unroll
      for (int q4 = 0; q4 < 4; ++q4) fk0[q4] = ld_frag(rk0, q4 * 32);
      bf16x8 vb[2][2];
#pragma unroll
      for (int tk = 0; tk < 2; ++tk) {
        vb[tk][0] = pack_acc8(vn[tk], 0);
        vb[tk][1] = pack_acc8(vn[tk], 1);
      }
#pragma unroll
      for (int e = 0; e < 16; ++e) S[3][e] *= decay;
      SCAN_MIX(8, 8, 4)
      __builtin_amdgcn_sched_barrier(0);
#undef SCAN_LOAD
#undef SCAN_MMA
#undef SCAN_MMA_T
      o[0] = MFMA32(vb[0][0], fi[0], o[0]);
      o[1] = MFMA32(vb[0][0], fi[2], o[1]);
      o[0] = MFMA32(vb[0][1], fi[1], o[0]);
      o[1] = MFMA32(vb[0][1], fi[3], o[1]);
      S[0] = MFMA32(fk0[0], vb[0][0], S[0]);
      o[1] = MFMA32(vb[1][0], fi[4], o[1]);
      S[0] = MFMA32(fk0[1], vb[0][1], S[0]);
      o[1] = MFMA32(vb[1][1], fi[5], o[1]);
      S[0] = MFMA32(fk0[2], vb[1][0], S[0]);
      S[0] = MFMA32(fk0[3], vb[1][1], S[0]);
#pragma unroll
      for (int q4 = 0; q4 < 4; ++q4) {
        fA[q4] = ld_frag(rk0 + 32 * 144, q4 * 32);
        fA[4 + q4] = ld_frag(rk0 + 64 * 144, q4 * 32);
      }
      SCAN_MIX(10, 8, 0)
      __builtin_amdgcn_sched_barrier(0);
#pragma unroll
      for (int q4 = 0; q4 < 4; ++q4) {
        S[1] = MFMA32(fA[q4], vb[q4 >> 1][q4 & 1], S[1]);
        S[2] = MFMA32(fA[4 + q4], vb[q4 >> 1][q4 & 1], S[2]);
      }
#pragma unroll
      for (int q4 = 0; q4 < 4; ++q4) fB[q4] = ld_frag(rk0 + 96 * 144, q4 * 32);
      SCAN_MIX(8, 4, 0)
      __builtin_amdgcn_sched_barrier(0);
#pragma unroll
      for (int q4 = 0; q4 < 4; ++q4) S[3] = MFMA32(fB[q4], vb[q4 >> 1][q4 & 1], S[3]);
#undef SCAN_MIX
      {
#pragma unroll
        for (int tn = 0; tn < 2; ++tn) {
          const int pos = 32 * tn + r;
          const int tok = dir ? (b * T + T - 1 - n * 64 - pos) : (b * T + n * 64 + pos);
          unsigned pk[4][2];
#pragma unroll
          for (int g = 0; g < 4; ++g) {
            pk[g][0] = pack2(o[tn][4 * g + 0], o[tn][4 * g + 1]);
            pk[g][1] = pack2(o[tn][4 * g + 2], o[tn][4 * g + 3]);
          }
          uint4 st0, st1;
          {
            auto s0 = __builtin_amdgcn_permlane32_swap(pk[0][0], pk[2][0], false, false);
            auto s1 = __builtin_amdgcn_permlane32_swap(pk[0][1], pk[2][1], false, false);
            st0.x = s0[0]; st0.y = s1[0]; st0.z = s0[1]; st0.w = s1[1];
            auto s2 = __builtin_amdgcn_permlane32_swap(pk[1][0], pk[3][0], false, false);
            auto s3 = __builtin_amdgcn_permlane32_swap(pk[1][1], pk[3][1], false, false);
            st1.x = s2[0]; st1.y = s3[0]; st1.z = s2[1]; st1.w = s3[1];
          }
          bf16_t* op = p.obuf + ((size_t)dir * NTOK + tok) * 512 + hh * 128 + 32 * w + 16 * hf;
          *(uint4*)(op) = st0;
          *(uint4*)(op + 8) = st1;
        }
      }
      __syncthreads();
    }
    __builtin_amdgcn_s_setprio(0);
  }
}

DEV void phase_scan_helper(const Params& p, int ep, int c, int j, char* smem) {
  const int tid = fresh_tid(), lane = tid & 63, wid = tid >> 6;
  volatile unsigned* lprog = (volatile unsigned*)smem;
  const unsigned epoch = (unsigned)ep;
  const int dir = c & 1, bh = c >> 1;
  constexpr unsigned AHEAD = 8u;
  if (tid == 0) lprog[0] = 0u;
  __syncthreads();
  if (wid == 0) {
    unsigned v = 0u, spins = 0u;
    for (;;) {
      v = xb_ld(&p.bar[XB_CXCC(c)]);
      if ((v >> 4) == epoch || ++spins > 200000u) break;
      __builtin_amdgcn_s_sleep(8);
    }
    const bool mine = ((v >> 4) == epoch) && ((v & 15u) == xb_xcc_id());
    if (!mine) {
      if (lane == 0) lprog[0] = 0xffffffffu;
    } else {
      unsigned idle = 0u;
      for (;;) {
        const unsigned g = xb_ld(&p.bar[XB_PROG(c)]);
        const unsigned cur = (g >= epoch * 1024u) ? (g - epoch * 1024u + 1u) : 0u;
        if (lane == 0) lprog[0] = cur + 1u;
        if (cur >= 128u || ++idle > 400000u) break;
        __builtin_amdgcn_s_sleep(16);
      }
      if (lane == 0) lprog[0] = 0xffffffffu;
    }
  } else {
    u32x4 sink = {0u, 0u, 0u, 0u};
    unsigned spins = 0u;
    for (int n = 0; n < 128;) {
      const unsigned s = lprog[0];
      if (s == 0xffffffffu) break;
      if (s == 0u) {
        if (++spins > 4000000u) break;
        __builtin_amdgcn_s_sleep(4);
        continue;
      }
      const unsigned started = s - 1u;
      if ((unsigned)n < started) n = (int)started;
      if (n >= 128) break;
      if ((unsigned)n >= started + AHEAD) {
        if (++spins > 4000000u) break;
        __builtin_amdgcn_s_sleep(4);
        continue;
      }
      const int item = bh * 128 + (dir ? 127 - n : n);
      const char* rec = p.gdn_rec + ((size_t)item * 2 + dir) * REC_BYTES;
      const char* uu = (const char*)(p.gdn_u + ((size_t)(item * 2 + dir) * 32) * 128);
#pragma unroll
      for (int q = 0; q < 4; ++q) {
        const int pc = wid - 1 + 7 * q;
        if (pc < 24) {
          const int piece = 24 * j + pc;
          const char* ptr = (piece < 56 ? rec + piece * 1024 : uu + (piece - 56) * 1024) + lane * 16;
          asm volatile("global_load_dwordx4 %0, %1, off" : "+v"(sink) : "v"(ptr) : "memory");
        }
      }
      ++n;
    }
    asm volatile("s_waitcnt vmcnt(0)" ::: "memory");
    asm volatile("" :: "v"(sink));
  }
  __syncthreads();
}

DEV void phase_gdn_fin(const Params& p, int l, int bid, int nb) {
  const int tid_ = fresh_tid(), lane = tid_ & 63, wid = tid_ >> 6;
  const float* gnw = p.gdn_norm_w + l * 128 + (lane & 15) * 8;
  for (int t = bid * NWAVE + wid; t < NTOK; t += nb * NWAVE) {
    float of[8], ob[8], z[8], o[8];
    unpack8(*(const uint4*)(p.obuf + (size_t)t * 512 + lane * 8), of);
    unpack8(*(const uint4*)(p.obuf + ((size_t)NTOK + t) * 512 + lane * 8), ob);
    unpack8(*(const uint4*)(p.proj + (size_t)t * PROJW + OFF_GZ + lane * 8), z);
    float ss = 0.f;
#pragma unroll
    for (int e = 0; e < 8; ++e) {
      o[e] = of[e] + ob[e];
      ss += o[e] * o[e];
    }
    ss += shx(ss, 1, lane);
    ss += shx(ss, 2, lane);
    ss += shx(ss, 4, lane);
    ss += shx(ss, 8, lane);
    const float rr = rsqrtf(ss * (1.f / 128.f) + EPS);
    const float4 g0 = *(const float4*)(gnw), g1 = *(const float4*)(gnw + 4);
    const float gw[8] = {g0.x, g0.y, g0.z, g0.w, g1.x, g1.y, g1.z, g1.w};
    float res[8];
#pragma unroll
    for (int e = 0; e < 8; ++e) res[e] = o[e] * rr * gw[e] * silu_f(z[e]);
    *(uint4*)(p.y + (size_t)t * DM + 512 + lane * 8) = pack8(res);
  }
}

struct EpiWout {
  static constexpr bool PERM = false;
  const float* xin; float* xout; const float* mod_l;
  DEV void operator()(const f32x4 (&acc)[2][2][4][2], const GUnit& u, int wr, int wc, int fr, int fq) const {
    const int row0 = u.pm * 256 + wr * 64 + fr, col0 = u.pn * 256 + wc * 32 + 4 * fq;
    const float* gate = mod_l + ((u.pm * 256) / T) * 6144 + MOD_GATE1;
    f32x4 gv[2][2];
#pragma unroll
    for (int bj = 0; bj < 2; ++bj)
#pragma unroll
      for (int n = 0; n < 2; ++n) gv[bj][n] = *(const f32x4*)(gate + col0 + bj * G_HALF + n * 16);
#pragma unroll
    for (int ai = 0; ai < 2; ++ai)
#pragma unroll
      for (int m = 0; m < 4; ++m) {
        const size_t ro = (size_t)(row0 + ai * G_HALF + m * 16) * DM + col0;
#pragma unroll
        for (int bj = 0; bj < 2; ++bj)
#pragma unroll
          for (int n = 0; n < 2; ++n) {
            const f32x4 xi = *(const f32x4*)(xin + ro + bj * G_HALF + n * 16);
            *(f32x4*)(xout + ro + bj * G_HALF + n * 16) = xi + gv[bj][n] * acc[ai][bj][m][n];
          }
      }
  }
};

DEV void phase_gemm_wout(const Params& p, int l, const float* xin, int bid, int nb, char* smem) {
  DenseSched S;
  S.A = p.y; S.Bt = p.btout; S.K = DM; S.nM = NTOK / 256; S.nN = DM / 256; S.nwg = S.nM * S.nN; S.G = nb; S.c = bid; S.wv = p.wv;
  EpiWout E;
  E.xin = xin; E.xout = p.xbuf; E.mod_l = p.mod + l * 2 * 6144;
  gemm_phase((LAS unsigned char*)smem, S, E);
}

DEV void phase_consts(const Params& p, int bid, int nb) {
  const int tid = fresh_tid(), lane = tid & 63, wid = tid >> 6;
  for (int g = bid * NTHR + tid; g < DEPTH * DM * 48; g += nb * NTHR) {
    const int n = g % 48, lk = g / 48;
    float v = 0.f;
    if (n < 4) v = p.rg_w[(size_t)lk * 4 + n];
    else if (n < 36) v = p.re_w[(size_t)lk * 32 + (n - 4)];
    p.wcat[g] = v;
  }
  for (int g = bid * NTHR + tid; g < DEPTH * NB * DM; g += nb * NTHR) {
    const int k = g & (DM - 1), lb = g >> 10, l = lb >> 1;
    p.wsc2[g] = p.norm_ffn_w[l * DM + k] * (1.f + p.mod[lb * 6144 + MOD_SCALE2 + k]);
  }
  for (int o = bid * NWAVE + wid; o < DEPTH * NB * 48; o += nb * NWAVE) {
    const int n = o % 48, lb = o / 48, l = lb >> 1;
    float s = 0.f;
    if (n < 36) {
      for (int k = lane; k < DM; k += 64) {
        const float w = (n < 4) ? p.rg_w[((size_t)l * DM + k) * 4 + n] : p.re_w[((size_t)l * DM + k) * 32 + (n - 4)];
        s += p.mod[lb * 6144 + MOD_SHIFT2 + k] * w;
      }
      s = wave_sum(s, lane);
      s += (n < 4) ? p.rg_b[l * 4 + n] : p.re_b[l * 32 + (n - 4)];
    }
    if (lane == 0) p.c0[o] = s;
  }
}

DEV void phase_router(const Params& p, int l, int bid, int nb, char* smem) {
  float* accb = (float*)smem;
  float* ssqb = accb + 2 * 64 * 49;
  float* rsl = ssqb + 128;
  const int tid = fresh_tid(), lane = tid & 63, wid = tid >> 6, fr = lane & 15, fq = lane >> 4;
  const int tg = wid & 3, kh = wid >> 2;
  for (int tb = bid; tb < NTOK / 64; tb += nb) {
    const int tok0 = tb * 64;
    const int b = tok0 / T;
    const float* wsc = p.wsc2 + (l * 2 + b) * DM;
    {
      const float* xr = p.xbuf + (size_t)(tok0 + tg * 16 + fr) * DM + kh * 512 + fq * 4;
      const float* wv = wsc + kh * 512 + fq * 4;
      const float* Bp = p.wcat + ((size_t)l * DM + kh * 512 + fq * 4) * 48 + fr;
      f32x4 acc[3];
#pragma unroll
      for (int nt = 0; nt < 3; ++nt) acc[nt] = f32x4{0.f, 0.f, 0.f, 0.f};
      float ssq = 0.f;
#pragma unroll 4
      for (int c = 0; c < 32; ++c) {
        const float4 xv = *(const float4*)(xr + c * 16);
        const float4 ww = *(const float4*)(wv + c * 16);
        ssq += xv.x * xv.x + xv.y * xv.y + xv.z * xv.z + xv.w * xv.w;
        const float a0 = xv.x * ww.x, a1 = xv.y * ww.y, a2 = xv.z * ww.z, a3 = xv.w * ww.w;
        const float* bp = Bp + (size_t)c * 16 * 48;
#pragma unroll
        for (int nt = 0; nt < 3; ++nt) {
          acc[nt] = __builtin_amdgcn_mfma_f32_16x16x4f32(a0, bp[0 * 48 + nt * 16], acc[nt], 0, 0, 0);
          acc[nt] = __builtin_amdgcn_mfma_f32_16x16x4f32(a1, bp[1 * 48 + nt * 16], acc[nt], 0, 0, 0);
          acc[nt] = __builtin_amdgcn_mfma_f32_16x16x4f32(a2, bp[2 * 48 + nt * 16], acc[nt], 0, 0, 0);
          acc[nt] = __builtin_amdgcn_mfma_f32_16x16x4f32(a3, bp[3 * 48 + nt * 16], acc[nt], 0, 0, 0);
        }
      }
      ssq += shx(ssq, 16, lane);
      ssq += shx(ssq, 32, lane);
#pragma unroll
      for (int nt = 0; nt < 3; ++nt)
#pragma unroll
        for (int j = 0; j < 4; ++j) accb[(kh * 64 + tg * 16 + fq * 4 + j) * 49 + nt * 16 + fr] = acc[nt][j];
      if (fq == 0) ssqb[kh * 64 + tg * 16 + fr] = ssq;
    }
    __syncthreads();
    if (tid < 64) {
      const int t = tok0 + tid;
      const float rstd = rsqrtf((ssqb[tid] + ssqb[64 + tid]) * (1.f / DM) + EPS);
      rsl[tid] = rstd;
      const float* c0 = p.c0 + (l * 2 + b) * 48;
      float acc[36];
#pragma unroll
      for (int o = 0; o < 36; ++o) acc[o] = rstd * (accb[tid * 49 + o] + accb[(64 + tid) * 49 + o]) + c0[o];
      int grp = 0;
      float mx = acc[0];
#pragma unroll
      for (int g = 1; g < 4; ++g)
        if (acc[g] > mx) { mx = acc[g]; grp = g; }
      float den = 0.f;
#pragma unroll
      for (int g = 0; g < 4; ++g) den += __expf(acc[g] - mx);
      const float pg_top = 1.f / den;
      float el[8];
#pragma unroll
      for (int j = 0; j < 8; ++j) {
        const float a0 = acc[4 + j], a1 = acc[12 + j], a2 = acc[20 + j], a3 = acc[28 + j];
        el[j] = (grp == 0) ? a0 : (grp == 1) ? a1 : (grp == 2) ? a2 : a3;
      }
      float b0 = -3.0e38f, b1 = -3.0e38f;
      int i0 = 0, i1 = 0;
#pragma unroll
      for (int j = 0; j < 8; ++j)
        if (el[j] > b0) { b0 = el[j]; i0 = j; }
#pragma unroll
      for (int j = 0; j < 8; ++j)
        if (j != i0 && el[j] > b1) { b1 = el[j]; i1 = j; }
      const float ex = __expf(b1 - b0);
      const float g0 = pg_top / (1.f + ex), g1 = pg_top * ex / (1.f + ex);
      const int e0 = grp * 8 + i0, e1 = grp * 8 + i1;
      const int pos0 = atomicAdd(&p.cnt[l * NEXP + e0], 1);
      p.list[e0 * CAP + pos0] = 2 * t;
      p.sgate[2 * t] = g0;
      const int pos1 = atomicAdd(&p.cnt[l * NEXP + e1], 1);
      p.list[e1 * CAP + pos1] = 2 * t + 1;
      p.sgate[2 * t + 1] = g1;
    }
    __syncthreads();
    {
      const float* sh = p.mod + (l * 2 + b) * 6144 + MOD_SHIFT2;
#pragma unroll 2
      for (int q = 0; q < 8; ++q) {
        const int tl = wid * 8 + q;
        const float rstd = rsl[tl];
        const float4* xr = (const float4*)(p.xbuf + (size_t)(tok0 + tl) * DM);
#pragma unroll
        for (int i = 0; i < 4; ++i) {
          const int idx = (lane + 64 * i) * 4;
          const float4 xv = xr[lane + 64 * i];
          const float4 w = *(const float4*)(wsc + idx);
          const float4 h = *(const float4*)(sh + idx);
          uint2 pk;
          pk.x = pack2(xv.x * w.x * rstd + h.x, xv.y * w.y * rstd + h.y);
          pk.y = pack2(xv.z * w.z * rstd + h.z, xv.w * w.w * rstd + h.w);
          *(uint2*)(p.act + (size_t)(tok0 + tl) * DM + idx) = pk;
        }
      }
    }
    __syncthreads();
  }
}

struct EpiMoe1 {
  static constexpr bool PERM = true;
  bf16_t* H; const int* list;
  DEV void operator()(const f32x4 (&acc)[2][2][4][2], const GUnit& u, int wr, int wc, int fr, int fq) const {
    const int hcol = u.pn * 128 + wc * 32 + 8 * fq;
#pragma unroll
    for (int ai = 0; ai < 2; ++ai)
#pragma unroll
      for (int m = 0; m < 4; ++m) {
        const int rl = ai * G_HALF + wr * 64 + m * 16 + fr;
        if (rl < u.valid) {
          const int slot = list[u.e * CAP + u.pm * 256 + rl];
          float h[8];
#pragma unroll
          for (int n = 0; n < 2; ++n)
#pragma unroll
            for (int j = 0; j < 4; ++j) h[n * 4 + j] = silu_f(acc[ai][0][m][n][j]) * acc[ai][1][m][n][j];
          *(uint4*)(H + (size_t)slot * DEXP + hcol) = pack8(h);
        }
      }
  }
};
struct EpiMoe2 {
  static constexpr bool PERM = true;
  bf16_t* Y; const int* list; const float* sgate;
  DEV void operator()(const f32x4 (&acc)[2][2][4][2], const GUnit& u, int wr, int wc, int fr, int fq) const {
    const int col0 = u.pn * 256 + wc * 32 + 8 * fq;
#pragma unroll
    for (int ai = 0; ai < 2; ++ai)
#pragma unroll
      for (int m = 0; m < 4; ++m) {
        const int rl = ai * G_HALF + wr * 64 + m * 16 + fr;
        if (rl < u.valid) {
          const int slot = list[u.e * CAP + u.pm * 256 + rl];
          const float g = sgate[slot];
#pragma unroll
          for (int bj = 0; bj < 2; ++bj) {
            float yv[8];
#pragma unroll
            for (int n = 0; n < 2; ++n)
#pragma unroll
              for (int j = 0; j < 4; ++j) yv[n * 4 + j] = g * acc[ai][bj][m][n][j];
            *(uint4*)(Y + (size_t)slot * DM + col0 + bj * G_HALF) = pack8(yv);
          }
        }
      }
  }
};

DEV void phase_moe1(const Params& p, int l, int bid, int nb, char* smem) {
  MoeSched S;
  S.A = p.act; S.Bt = p.bt1; S.K = DM; S.cnt = p.cnt + l * NEXP; S.list = p.list; S.G = nb; S.c = bid; S.wv = p.wv; S.shift = 1;
  EpiMoe1 E;
  E.H = p.hbuf; E.list = p.list;
  gemm_phase((LAS unsigned char*)smem, S, E);
}

DEV void phase_moe2(const Params& p, int l, int bid, int nb, char* smem) {
  MoeSched S;
  S.A = p.hbuf; S.Bt = p.bt2; S.K = DEXP; S.cnt = p.cnt + l * NEXP; S.list = p.list; S.G = nb; S.c = bid; S.wv = p.wv; S.shift = 0;
  EpiMoe2 E;
  E.Y = p.ybuf; E.list = p.list; E.sgate = p.sgate;
  gemm_phase((LAS unsigned char*)smem, S, E);
}

DEV void phase_combine(const Params& p, int l, int bid, int nb) {
  const int tid_ = fresh_tid(), lane = tid_ & 63, wid = tid_ >> 6;
  for (int t = bid * NWAVE + wid; t < NTOK; t += nb * NWAVE) {
    float4* xr = (float4*)(p.xbuf + (size_t)t * DM);
    const int b = t / T;
    const float* md = p.mod + (l * 2 + b) * 6144;
    float4 v[4];
    float ss = 0.f;
#pragma unroll
    for (int i = 0; i < 4; ++i) {
      const int idx = (lane + 64 * i) * 4;
      v[i] = xr[lane + 64 * i];
      const float4 g = *(const float4*)(md + MOD_GATE2 + idx);
      const uint2 ya = *(const uint2*)(p.ybuf + (size_t)(2 * t) * DM + idx);
      const uint2 yb = *(const uint2*)(p.ybuf + (size_t)(2 * t + 1) * DM + idx);
      v[i].x += g.x * (__uint_as_float(ya.x << 16) + __uint_as_float(yb.x << 16));
      v[i].y += g.y * (__uint_as_float(ya.x & 0xffff0000u) + __uint_as_float(yb.x & 0xffff0000u));
      v[i].z += g.z * (__uint_as_float(ya.y << 16) + __uint_as_float(yb.y << 16));
      v[i].w += g.w * (__uint_as_float(ya.y & 0xffff0000u) + __uint_as_float(yb.y & 0xffff0000u));
      ss += v[i].x * v[i].x + v[i].y * v[i].y + v[i].z * v[i].z + v[i].w * v[i].w;
    }
    ss = wave_sum(ss, lane);
    const float rstd = rsqrtf(ss * (1.f / DM) + EPS);
    if (l + 1 < DEPTH) {
#pragma unroll
      for (int i = 0; i < 4; ++i) xr[lane + 64 * i] = v[i];
      const float* md2 = p.mod + ((l + 1) * 2 + b) * 6144;
      norm_mod_store(v, rstd, p.norm_mix_w + (l + 1) * DM, md2 + MOD_SCALE1, md2 + MOD_SHIFT1,
                     p.act + (size_t)t * DM, lane);
    } else {
      float4* orow = (float4*)(p.out + (size_t)t * DM);
#pragma unroll
      for (int i = 0; i < 4; ++i) {
        const float4 w = *(const float4*)(p.final_w + (lane + 64 * i) * 4);
        float4 r;
        r.x = v[i].x * rstd * w.x;
        r.y = v[i].y * rstd * w.y;
        r.z = v[i].z * rstd * w.z;
        r.w = v[i].w * rstd * w.w;
        orow[lane + 64 * i] = r;
      }
    }
  }
}

constexpr size_t ws_align(size_t b) { return (b + 255) & ~(size_t)255; }
constexpr size_t WS_bar = 0;
constexpr size_t WS_mod = WS_bar + ws_align(sizeof(unsigned) * BAR_WORDS_TOTAL);
constexpr size_t WS_btin = WS_mod + ws_align(sizeof(float) * DEPTH * NB * 6144);
constexpr size_t WS_btg = WS_btin + ws_align(2 * (size_t)PROJW * DM);
constexpr size_t WS_btout = WS_btg + ws_align(2 * (size_t)16 * DM);
constexpr size_t WS_bt1 = WS_btout + ws_align(2 * (size_t)DM * DM);
constexpr size_t WS_bt2 = WS_bt1 + ws_align(2 * (size_t)NEXP * 1024 * DM);
constexpr size_t WS_wcat = WS_bt2 + ws_align(2 * (size_t)NEXP * DM * DEXP);
constexpr size_t WS_wsc2 = WS_wcat + ws_align(sizeof(float) * DEPTH * DM * 48);
constexpr size_t WS_c0 = WS_wsc2 + ws_align(sizeof(float) * DEPTH * NB * DM);
constexpr size_t WS_cnt = WS_c0 + ws_align(sizeof(float) * DEPTH * NB * 48);
constexpr size_t WS_xbuf = WS_cnt + ws_align(sizeof(int) * DEPTH * NEXP);
constexpr size_t WS_act = WS_xbuf + ws_align(sizeof(float) * (size_t)NTOK * DM);
constexpr size_t WS_proj = WS_act + ws_align(2 * (size_t)NTOK * DM);
constexpr size_t WS_gates = WS_proj + ws_align(2 * (size_t)NTOK * PROJW);
constexpr size_t WS_y = WS_gates + ws_align(sizeof(float) * (size_t)NTOK * 16);
constexpr size_t WS_list = WS_y + ws_align(2 * (size_t)NTOK * DM);
constexpr size_t WS_sgate = WS_list + ws_align(sizeof(int) * NEXP * CAP);
constexpr size_t WS_egl = WS_sgate + ws_align(sizeof(float) * 2 * NTOK);
constexpr size_t WS_obuf = WS_egl + ws_align(sizeof(float) * 2048);
constexpr size_t WS_gdn_rec = WS_obuf + ws_align(2 * 2 * (size_t)NTOK * 512);
constexpr size_t WS_gdn_u = WS_gdn_rec + ws_align((size_t)2048 * REC_BYTES);
constexpr size_t WS_TOTAL = WS_gdn_u + ws_align(sizeof(unsigned) * (size_t)2048 * 32 * 128);

struct KArgs {
  const float *x, *c, *norm_mix_w, *norm_ffn_w, *w_ada, *b_ada, *w_in, *conv_a_w, *na_rpb, *gdn_conv_w,
      *gdn_a_log, *gdn_dt_bias, *gdn_norm_w, *w_out, *rg_w, *rg_b, *re_w, *re_b, *ew1, *ew3, *ew2, *final_w;
  float* out;
  char* ws;
  int rep[12];
};
DEV Params make_params(const KArgs& a) {
  Params p;
  p.x = a.x; p.c = a.c; p.norm_mix_w = a.norm_mix_w; p.norm_ffn_w = a.norm_ffn_w; p.w_ada = a.w_ada; p.b_ada = a.b_ada;
  p.w_in = a.w_in; p.conv_a_w = a.conv_a_w; p.na_rpb = a.na_rpb; p.gdn_conv_w = a.gdn_conv_w; p.gdn_a_log = a.gdn_a_log;
  p.gdn_dt_bias = a.gdn_dt_bias; p.gdn_norm_w = a.gdn_norm_w; p.w_out = a.w_out; p.rg_w = a.rg_w; p.rg_b = a.rg_b;
  p.re_w = a.re_w; p.re_b = a.re_b; p.ew1 = a.ew1; p.ew3 = a.ew3; p.ew2 = a.ew2; p.final_w = a.final_w;
  p.out = a.out;
  p.bar = (unsigned*)(a.ws + WS_bar);
  p.mod = (float*)(a.ws + WS_mod);
  p.btin = (bf16_t*)(a.ws + WS_btin);
  p.btg = (bf16_t*)(a.ws + WS_btg);
  p.btout = (bf16_t*)(a.ws + WS_btout);
  p.bt1 = (bf16_t*)(a.ws + WS_bt1);
  p.bt2 = (bf16_t*)(a.ws + WS_bt2);
  p.wcat = (float*)(a.ws + WS_wcat);
  p.wsc2 = (float*)(a.ws + WS_wsc2);
  p.c0 = (float*)(a.ws + WS_c0);
  p.cnt = (int*)(a.ws + WS_cnt);
  p.xbuf = (float*)(a.ws + WS_xbuf);
  p.act = (bf16_t*)(a.ws + WS_act);
  p.proj = (bf16_t*)(a.ws + WS_proj);
  p.gates = (float*)(a.ws + WS_gates);
  p.y = (bf16_t*)(a.ws + WS_y);
  p.list = (int*)(a.ws + WS_list);
  p.sgate = (float*)(a.ws + WS_sgate);
  p.egl = (float*)(a.ws + WS_egl);
  p.obuf = (bf16_t*)(a.ws + WS_obuf);
  p.gdn_rec = (char*)(a.ws + WS_gdn_rec);
  p.gdn_u = (unsigned*)(a.ws + WS_gdn_u);
  p.hbuf = (bf16_t*)p.obuf;
  p.ybuf = (bf16_t*)p.gdn_rec;
#pragma unroll
  for (int i = 0; i < 12; ++i) p.rep[i] = a.rep[i];
  p.wv = __builtin_amdgcn_readfirstlane((int)(threadIdx.x >> 6));
  return p;
}

__global__ void __launch_bounds__(NTHR) mega_kernel(KArgs ka) {
  const Params p = make_params(ka);
  __shared__ __attribute__((aligned(16))) char smem[SMEM_BYTES + 16];
  const int bid0 = blockIdx.x, nb = gridDim.x;
  if (fresh_tid() == 0) *(uint4*)(smem + SMEM_BYTES) = make_uint4(0u, 0u, 0u, 0u);
  __syncthreads();
  xcd_barrier_post(p.bar, fresh_tid());
#pragma unroll 1
  for (int rp = 0; rp < p.rep[7]; ++rp) {
    phase_ada(p, bid0, nb, smem);
    convert_win(p, 0, bid0, nb, smem);
  }
  xcd_barrier(p.bar, (volatile LAS unsigned*)(smem + SMEM_BYTES), fresh_tid());
#pragma unroll 1
  for (int rp = 0; rp < p.rep[8]; ++rp) {
    phase_hmix(p, 0, p.x, bid0, nb);
    phase_consts(p, bid0, nb);
  }
  xcd_barrier(p.bar, (volatile LAS unsigned*)(smem + SMEM_BYTES), fresh_tid());
#pragma unroll 1
  for (int l = 0; l < DEPTH; ++l) {
    int lz = l;
    asm volatile("" : "+s"(lz));
    const int bid = bid0 + (lz - l);
#pragma unroll 1
    for (int rp = 0; rp < p.rep[0]; ++rp) phase_gemm_proj(p, l, bid, nb, smem);
    xcd_barrier(p.bar, (volatile LAS unsigned*)(smem + SMEM_BYTES), fresh_tid());
#pragma unroll 1
    for (int rp = 0; rp < p.rep[1]; ++rp) phase_gdn_prep(p, l, bid, nb, smem);
    xcd_barrier(p.bar, (volatile LAS unsigned*)(smem + SMEM_BYTES), fresh_tid());
#pragma unroll 1
    for (int rp = 0; rp < p.rep[2]; ++rp) {
      if (bid < 16) {
        phase_gdn_scan(p, l * 4 + rp + 1, bid, smem);
      } else if (bid < 64) {
        phase_scan_helper(p, l * 4 + rp + 1, (bid - 16) & 15, (bid - 16) >> 4, smem);
      } else {
#pragma unroll 1
        for (int rq = 0; rq < p.rep[6]; ++rq) {
          phase_conv(p, l, bid - 64, nb - 64);
          phase_na(p, l, (bid - 64) * NWAVE + (fresh_tid() >> 6), (nb - 64) * NWAVE);
        }
#pragma unroll 1
        for (int rq = 0; rq < p.rep[10]; ++rq) convert_layer(p, l, bid - 64, nb - 64, smem);
      }
    }
    xcd_barrier(p.bar, (volatile LAS unsigned*)(smem + SMEM_BYTES), fresh_tid());
#pragma unroll 1
    for (int rp = 0; rp < p.rep[5]; ++rp) phase_gdn_fin(p, l, bid, nb);
    xcd_barrier(p.bar, (volatile LAS unsigned*)(smem + SMEM_BYTES), fresh_tid());
#pragma unroll 1
    for (int rp = 0; rp < (l == 0 ? p.rep[9] : 1); ++rp) phase_gemm_wout(p, l, l == 0 ? p.x : p.xbuf, bid, nb, smem);
    xcd_barrier(p.bar, (volatile LAS unsigned*)(smem + SMEM_BYTES), fresh_tid());
    phase_router(p, l, bid, nb, smem);
    xcd_barrier(p.bar, (volatile LAS unsigned*)(smem + SMEM_BYTES), fresh_tid());
#pragma unroll 1
    for (int rp = 0; rp < p.rep[3]; ++rp) phase_moe1(p, l, bid, nb, smem);
    xcd_barrier(p.bar, (volatile LAS unsigned*)(smem + SMEM_BYTES), fresh_tid());
#pragma unroll 1
    for (int rp = 0; rp < p.rep[4]; ++rp) phase_moe2(p, l, bid, nb, smem);
    xcd_barrier(p.bar, (volatile LAS unsigned*)(smem + SMEM_BYTES), fresh_tid());
    phase_combine(p, l, bid, nb);
#pragma unroll 1
    for (int rp = 1; rp < p.rep[11]; ++rp) xcd_barrier(p.bar, (volatile LAS unsigned*)(smem + SMEM_BYTES), fresh_tid());
    if (l + 1 < DEPTH) xcd_barrier(p.bar, (volatile LAS unsigned*)(smem + SMEM_BYTES), fresh_tid());
  }
}

extern "C" void kernel_launch(void* const* d_in, const int* in_sizes, int n_in, void* d_out, int out_size,
                              void* d_ws, size_t ws_size, hipStream_t stream) {
  KArgs p{};
  p.x = (const float*)d_in[0];
  p.c = (const float*)d_in[1];
  p.norm_mix_w = (const float*)d_in[2];
  p.norm_ffn_w = (const float*)d_in[3];
  p.w_ada = (const float*)d_in[4];
  p.b_ada = (const float*)d_in[5];
  p.w_in = (const float*)d_in[6];
  p.conv_a_w = (const float*)d_in[7];
  p.na_rpb = (const float*)d_in[8];
  p.gdn_conv_w = (const float*)d_in[9];
  p.gdn_a_log = (const float*)d_in[10];
  p.gdn_dt_bias = (const float*)d_in[11];
  p.gdn_norm_w = (const float*)d_in[12];
  p.w_out = (const float*)d_in[13];
  p.rg_w = (const float*)d_in[14];
  p.rg_b = (const float*)d_in[15];
  p.re_w = (const float*)d_in[16];
  p.re_b = (const float*)d_in[17];
  p.ew1 = (const float*)d_in[18];
  p.ew3 = (const float*)d_in[19];
  p.ew2 = (const float*)d_in[20];
  p.final_w = (const float*)d_in[21];
  p.out = (float*)d_out;
  p.ws = (char*)d_ws;
  if (WS_TOTAL > ws_size) fprintf(stderr, "workspace too small: need %zu have %zu\n", (size_t)WS_TOTAL, ws_size);

  static int grid_blocks = 0;
  if (!grid_blocks) {
    int dev = 0, cus = 0, per_cu = 0;
    (void)hipGetDevice(&dev);
    (void)hipDeviceGetAttribute(&cus, hipDeviceAttributeMultiprocessorCount, dev);
    (void)hipOccupancyMaxActiveBlocksPerMultiprocessor(&per_cu, mega_kernel, NTHR, 0);
    if (per_cu > 1) per_cu = 1;
    if (per_cu < 1) per_cu = 1;
    grid_blocks = cus * per_cu;
  }
  (void)hipMemsetAsync((char*)d_ws + WS_bar, 0, sizeof(unsigned) * BAR_WORDS_TOTAL, stream);
  for (int i = 0; i < 12; ++i) p.rep[i] = 1;
  void* args[] = {&p};
  hipError_t e = hipLaunchCooperativeKernel((void*)mega_kernel, dim3(grid_blocks), dim3(NTHR), args, 0, stream);
  if (e != hipSuccess) fprintf(stderr, "cooperative launch failed: %s (grid %d)\n", hipGetErrorString(e), grid_blocks);
}
```

```cpp
#include <hip/hip_runtime.h>
#include <hip/hip_cooperative_groups.h>
#include <stdint.h>
#include <stdio.h>

#define DEV __device__ __forceinline__
namespace cg = cooperative_groups;

typedef __attribute__((ext_vector_type(8))) short bf16x8;
typedef __attribute__((ext_vector_type(4))) float f32x4;
typedef __attribute__((ext_vector_type(16))) float f32x16;
typedef float f32x2_t __attribute__((ext_vector_type(2)));
typedef __bf16 bf16x2_t __attribute__((ext_vector_type(2)));
typedef unsigned short bf16_t;
typedef unsigned u32x4 __attribute__((ext_vector_type(4)));

constexpr int NTHR = 512;
constexpr int NWAVE = 8;
constexpr int DM = 1024;
constexpr int NB = 2;
constexpr int T = 8192;
constexpr int NTOK = NB * T;
constexpr int DEPTH = 2;
constexpr int DIN = 3600;
constexpr int PROJW = 3584;
constexpr int NEXP = 32;
constexpr int DEXP = 512;
constexpr int CAP = 16384;
constexpr float EPS = 1e-6f;
constexpr int OFF_CB = 0, OFF_CC = 256, OFF_CX = 512, OFF_NQ = 768, OFF_NK = 1024, OFF_NV = 1280,
              OFF_GQKV = 1536, OFF_GZ = 3072;
constexpr int MOD_SHIFT1 = 0, MOD_SCALE1 = 1024, MOD_GATE1 = 2048, MOD_SHIFT2 = 3072, MOD_SCALE2 = 4096,
              MOD_GATE2 = 5120;

constexpr int REC_WN = 0, REC_QD = 16384, REC_IN = 32768, REC_KT = 40960, REC_BYTES = 57344;
constexpr int SC_WN = 0, SC_QD = 17408, SC_IN = 34816, SC_KT = 44032, SC_U = 62464, SC_BUF = 78848;
constexpr int PL_Q = 0, PL_K = 17408, PL_V = 34816, PL_L = 52224, PL_GC = 87040, PL_BETA = 87552, PL_BG = 88064,
              PL_GL = 88576;
constexpr int SMEM_BYTES = 2 * SC_BUF;

struct Params {
  const float *x, *c, *norm_mix_w, *norm_ffn_w, *w_ada, *b_ada, *w_in, *conv_a_w, *na_rpb, *gdn_conv_w,
      *gdn_a_log, *gdn_dt_bias, *gdn_norm_w, *w_out, *rg_w, *rg_b, *re_w, *re_b, *ew1, *ew3, *ew2, *final_w;
  float* out;
  float* mod;
  int* cnt;
  float* xbuf;
  bf16_t* act;
  bf16_t* proj;
  float* gates;
  bf16_t* y;
  bf16_t* obuf;
  char* gdn_rec;
  unsigned* gdn_u;
  float* egl;
  bf16_t* hbuf;
  bf16_t* ybuf;
  int* list;
  float* sgate;
  bf16_t* btin;
  bf16_t* btg;
  bf16_t* btout;
  bf16_t* bt1;
  bf16_t* bt2;
  float* wcat;
  float* wsc2;
  float* c0;
  unsigned* bar;
  int rep[12];
  int wv;
};

DEV unsigned pack2(float a, float b) {
  f32x2_t v = {a, b};
  return __builtin_bit_cast(unsigned, __builtin_convertvector(v, bf16x2_t));
}
DEV bf16_t f2bf(float f) { return (bf16_t)(pack2(f, 0.f) & 0xffffu); }
DEV float bf2f(bf16_t h) { return __uint_as_float(((unsigned)h) << 16); }
DEV float silu_f(float x) { return x / (1.f + __expf(-x)); }
DEV float sigmoid_f(float x) { return 1.f / (1.f + __expf(-x)); }
DEV float softplus_f(float x) { return fmaxf(x, 0.f) + log1pf(__expf(-fabsf(x))); }
DEV float shx(float v, int k, int lane) {
  return __int_as_float(__builtin_amdgcn_ds_bpermute((lane ^ k) << 2, __float_as_int(v)));
}
DEV float wave_sum(float v, int lane) {
#pragma unroll
  for (int o = 32; o > 0; o >>= 1) v += shx(v, o, lane);
  return v;
}
DEV int fresh_tid_w(int wv) {
  unsigned z = 0u;
  asm volatile("" : "+s"(wv), "+v"(z));
  int t = (wv << 6) | (int)__builtin_amdgcn_mbcnt_hi(~0u, __builtin_amdgcn_mbcnt_lo(~0u, z));
  asm volatile("" : "+v"(t));
  return t;
}
#define fresh_tid() fresh_tid_w(p.wv)
DEV void unpack8(uint4 u, float* f) {
  f[0] = __uint_as_float(u.x << 16);
  f[1] = __uint_as_float(u.x & 0xffff0000u);
  f[2] = __uint_as_float(u.y << 16);
  f[3] = __uint_as_float(u.y & 0xffff0000u);
  f[4] = __uint_as_float(u.z << 16);
  f[5] = __uint_as_float(u.z & 0xffff0000u);
  f[6] = __uint_as_float(u.w << 16);
  f[7] = __uint_as_float(u.w & 0xffff0000u);
}
DEV uint4 pack8(const float* f) {
  uint4 r;
  r.x = pack2(f[0], f[1]);
  r.y = pack2(f[2], f[3]);
  r.z = pack2(f[4], f[5]);
  r.w = pack2(f[6], f[7]);
  return r;
}
#define MFMA16(a, b, c) __builtin_amdgcn_mfma_f32_16x16x32_bf16((a), (b), (c), 0, 0, 0)
#define MFMA32(a, b, c) __builtin_amdgcn_mfma_f32_32x32x16_bf16((a), (b), (c), 0, 0, 0)

#define LAS __attribute__((address_space(3)))
#define XB_TMO      128
#define XB_XCNT(j)  (256  + 64 * (j))
#define XB_XSUB(j)  (1280 + 64 * (j))
#define XB_XGEN(j)  (2304 + 64 * (j))
#define XB_TOP      3328
#define XB_TOPGEN   3392
#define XCD_BAR_WORDS 3456
#define XB_PROG(c)   (3456 + 64 * (c))
#define XB_CXCC(c)   (3456 + 1024 + 64 * (c))
#define XB_RDY       (3456 + 2048)
#define BAR_WORDS_TOTAL (3456 + 2048 + 384)
#define XB_SPIN_CAP (1u << 22)

DEV unsigned xb_ld(unsigned* p) { return __hip_atomic_load(p, __ATOMIC_RELAXED, __HIP_MEMORY_SCOPE_AGENT); }
DEV unsigned xb_add(unsigned* p, unsigned v) { return __hip_atomic_fetch_add(p, v, __ATOMIC_RELAXED, __HIP_MEMORY_SCOPE_AGENT); }
DEV unsigned xb_xcc_id() { return (unsigned)__builtin_amdgcn_s_getreg((3 << 11) | 20) & 0xFu; }
#define XB_SPIN(cond, bar) do { unsigned _sp = 0; while (cond) { __builtin_amdgcn_s_sleep(1); \
    if ((++_sp & 255u) == 0u) { if (xb_ld(&(bar)[XB_TMO])) break; if (_sp > XB_SPIN_CAP) { atomicAdd(&(bar)[XB_TMO], 1u); break; } } } } while (0)

DEV void xcd_barrier_post(unsigned* bar, int tid) {
  if (tid == 0) (void)xb_add(&bar[XB_XCNT(xb_xcc_id())], 1u);
}
DEV void xcd_barrier_complete(unsigned* bar, unsigned x, unsigned& nloc, unsigned& nx) {
  const unsigned G = gridDim.x * gridDim.y * gridDim.z;
  unsigned sum, cnt, mine, sp = 0u;
  for (;;) {
    sum = 0u; cnt = 0u; mine = 0u;
#pragma unroll
    for (unsigned j = 0; j < 16; ++j) {
      const unsigned c = xb_ld(&bar[XB_XCNT(j)]);
      sum += c;
      cnt += (c > 0u) ? 1u : 0u;
      mine = (j == x) ? c : mine;
    }
    if (sum == G) break;
    __builtin_amdgcn_s_sleep(1);
    if ((++sp & 255u) == 0u) {
      if (xb_ld(&bar[XB_TMO])) break;
      if (sp > XB_SPIN_CAP) { atomicAdd(&bar[XB_TMO], 1u); break; }
    }
  }
  nloc = mine > 0u ? mine : 1u;
  nx = cnt > 0u ? cnt : 1u;
}
DEV void xcd_barrier(unsigned* bar, volatile LAS unsigned* st, int tid) {
  asm volatile("s_waitcnt vmcnt(0)" ::: "memory");
  __syncthreads();
  if (tid == 0) {
    const unsigned bx = xb_xcc_id();
    __builtin_amdgcn_s_waitcnt(0);
    unsigned nloc = st[0], nx = st[1];
    const unsigned gen = st[2];
    st[2] = gen + 1u;
    if (nloc == 0u) {
      xcd_barrier_complete(bar, bx, nloc, nx);
      st[0] = nloc;
      st[1] = nx;
    }
    const unsigned old = xb_add(&bar[XB_XSUB(bx)], 1u);
    if (old + 1u == (gen + 1u) * nloc) {
      __builtin_amdgcn_fence(__ATOMIC_RELEASE, "agent");
      asm volatile("s_waitcnt vmcnt(0)" ::: "memory");
      const unsigned og = xb_add(&bar[XB_TOP], 1u);
      if (og + 1u == (gen + 1u) * nx) xb_add(&bar[XB_TOPGEN], 1u);
      else XB_SPIN(xb_ld(&bar[XB_TOPGEN]) == gen, bar);
      __builtin_amdgcn_fence(__ATOMIC_ACQUIRE, "agent");
      xb_add(&bar[XB_XGEN(bx)], 1u);
      asm volatile("s_waitcnt vmcnt(0)" ::: "memory");
    } else {
      XB_SPIN(xb_ld(&bar[XB_XGEN(bx)]) == gen, bar);
      __builtin_amdgcn_fence(__ATOMIC_ACQUIRE, "agent");
      asm volatile("s_waitcnt vmcnt(0)" ::: "memory");
    }
  }
  __syncthreads();
}

constexpr int G_BK = 64, G_HALF = 128, G_HTB = G_HALF * G_BK * 2, G_STAGE_BYTES = 8 * G_HTB;
DEV int g_lds_byte(int r, int c) {
  const int st = (r >> 4) * 2 + (c >> 5), rr = r & 15, cc = c & 31, ob = rr * 64 + cc * 2;
  return st * 1024 + (ob ^ (((ob >> 9) & 1) << 5));
}
DEV void g_stage_rc(int b, int& R, int& C) {
  const int st = b / 1024, sb = b % 1024, swz = sb ^ (((sb >> 9) & 1) << 5);
  R = (st >> 1) * 16 + swz / 64;
  C = (st & 1) * 32 + (swz % 64) / 2;
}
DEV int g_perm32(int rho) { const int n = rho >> 4, i = rho & 15; return 8 * (i >> 2) + 4 * n + (i & 3); }

struct GUnit { int pm, pn, e, valid, ph, ridx; };

template <class Epi, class Sched>
DEV void gemm_phase(LAS unsigned char* lds, const Sched& S, const Epi& E) {
  const int tid = fresh_tid_w(S.wv), wid = S.wv, lane = tid & 63, wr = wid >> 2, wc = wid & 3, fr = lane & 15,
            fq = lane >> 4;
  GUnit cur, nxt;
  int ui = 0;
  if (!S.next(0, cur)) return;
  int K = S.kof(cur), nt = K / G_BK;
  unsigned voffB[2];
  auto b_offsets = [&](int Ku) {
    const int tl_ = fresh_tid_w(S.wv);
#pragma unroll
    for (int i = 0; i < 2; ++i) {
      int R, C;
      g_stage_rc(tl_ * 16 + i * 8192, R, C);
      const int Rb = Epi::PERM ? ((R & ~31) + g_perm32(R & 31)) : R;
      voffB[i] = (unsigned)(Rb * Ku + C) * 2u;
    }
  };
  b_offsets(K);
  unsigned vA[2][2];
  auto a_offsets = [&](const GUnit& u) {
    const int tl_ = fresh_tid_w(S.wv);
#pragma unroll
    for (int h = 0; h < 2; ++h)
#pragma unroll
      for (int i = 0; i < 2; ++i) {
        int R, C;
        g_stage_rc(tl_ * 16 + i * 8192, R, C);
        vA[h][i] = S.rowoff(u, h * G_HALF + R) + (unsigned)C * 2u;
      }
  };
  const size_t kstep = (size_t)(G_BK * 2);
  size_t hstep = (size_t)G_HALF * K * 2;
  const unsigned ldsw = (unsigned)wid * 1024u;
  const int aoff = g_lds_byte(wr * 64 + fr, fq * 8), boff = g_lds_byte(wc * 32 + fr, fq * 8);
#define PG8_SA(b, h) (((b) * 2 + (h)) * G_HTB)
#define PG8_SB(b, h) ((4 + (b) * 2 + (h)) * G_HTB)
#define PG8_STAGE(bufoff, gbase, voff) do { _Pragma("unroll") for (int _i = 0; _i < 2; ++_i) \
    __builtin_amdgcn_global_load_lds((const unsigned*)((const char*)(gbase) + (voff)[_i]), (LAS unsigned*)(lds + (bufoff) + ldsw + _i * 8192), 16, 0, 0); } while (0)
#define PG8_LDA(dst, b, h) do { _Pragma("unroll") for (int m = 0; m < 4; ++m) _Pragma("unroll") for (int k = 0; k < 2; ++k) dst[m][k] = *(const LAS bf16x8*)(lds + PG8_SA(b, h) + aoff + m * 2048 + k * 1024); } while (0)
#define PG8_LDB(dst, b, h) do { _Pragma("unroll") for (int n = 0; n < 2; ++n) _Pragma("unroll") for (int k = 0; k < 2; ++k) dst[n][k] = *(const LAS bf16x8*)(lds + PG8_SB(b, h) + boff + n * 2048 + k * 1024); } while (0)
#define PG8_MMA(ai, bj, At, Bt) do { __builtin_amdgcn_s_setprio(1); _Pragma("unroll") for (int m = 0; m < 4; ++m) _Pragma("unroll") for (int n = 0; n < 2; ++n) _Pragma("unroll") for (int k = 0; k < 2; ++k) \
    acc[ai][bj][m][n] = __builtin_amdgcn_mfma_f32_16x16x32_bf16(Bt[n][k], At[m][k], acc[ai][bj][m][n], 0, 0, 0); __builtin_amdgcn_s_setprio(0); } while (0)
#define PG8_WAIT_V(n) asm volatile("s_waitcnt vmcnt(" #n ")" ::: "memory")
#define PG8_WAIT_L(n) asm volatile("s_waitcnt lgkmcnt(" #n ")" ::: "memory")
#define PG8_BAR __builtin_amdgcn_s_barrier()
#define PG8_SCHED __builtin_amdgcn_sched_barrier(0)
  f32x4 acc[2][2][4][2];
#pragma unroll
  for (int a = 0; a < 2; ++a)
#pragma unroll
    for (int b = 0; b < 2; ++b)
#pragma unroll
      for (int m = 0; m < 4; ++m)
#pragma unroll
        for (int n = 0; n < 2; ++n) acc[a][b][m][n] = (f32x4){0.f, 0.f, 0.f, 0.f};
  bf16x8 At[4][2], B0[2][2], B1[2][2];
  const char* gA = S.aptr(cur);
  const char* cB = S.bptr(cur);
  S.a_ready(cur);
  a_offsets(cur);
  PG8_STAGE(PG8_SB(0, 0), cB, voffB); PG8_STAGE(PG8_SA(0, 0), gA, vA[0]); PG8_STAGE(PG8_SB(0, 1), cB + hstep, voffB); PG8_STAGE(PG8_SA(0, 1), gA, vA[1]);
  if (wr == 1) PG8_BAR;
  PG8_WAIT_V(4); PG8_BAR;
  PG8_STAGE(PG8_SB(1, 0), cB + kstep, voffB); PG8_STAGE(PG8_SA(1, 0), gA + kstep, vA[0]); PG8_STAGE(PG8_SB(1, 1), cB + hstep + kstep, voffB);
  PG8_WAIT_V(6); PG8_BAR;
  for (;;) {
    const bool has_next = S.next(ui + 1, nxt);
    const char* nB = has_next ? S.bptr(nxt) : cB;
    for (int t = 0; t < nt; t += 2) {
      const bool last = (t == nt - 2);
      const char* a1 = gA + (size_t)(t + 1) * kstep;
      const char* b2 = last ? nB : cB + (size_t)(t + 2) * kstep;
      const char* b3 = b2 + kstep;
      PG8_LDB(B0, 0, 0); PG8_SCHED; PG8_LDA(At, 0, 0); PG8_STAGE(PG8_SA(1, 1), a1, vA[1]);
      PG8_WAIT_L(8); PG8_BAR; PG8_WAIT_L(0); PG8_MMA(0, 0, At, B0); PG8_BAR; PG8_SCHED;
      if (last && has_next) {
        S.a_ready(nxt);
        a_offsets(nxt);
        gA = S.aptr(nxt);
        const int Kn = S.kof(nxt);
        b_offsets(Kn);
        hstep = (size_t)G_HALF * Kn * 2;
      }
      const char* a2 = last ? gA : gA + (size_t)(t + 2) * kstep;
      const char* a3 = a2 + kstep;
      PG8_LDB(B1, 0, 1); PG8_STAGE(PG8_SB(0, 0), b2, voffB);
      PG8_BAR; PG8_WAIT_L(0); PG8_MMA(0, 1, At, B1); PG8_BAR;
      PG8_LDA(At, 0, 1); PG8_STAGE(PG8_SA(0, 0), a2, vA[0]);
      PG8_BAR; PG8_WAIT_L(0); PG8_MMA(1, 0, At, B0); PG8_BAR; PG8_SCHED;
      PG8_STAGE(PG8_SB(0, 1), b2 + hstep, voffB);
      PG8_WAIT_V(6); PG8_BAR; PG8_MMA(1, 1, At, B1); PG8_BAR;
      PG8_LDB(B0, 1, 0); PG8_SCHED; PG8_LDA(At, 1, 0); PG8_STAGE(PG8_SA(0, 1), a2, vA[1]);
      PG8_WAIT_L(8); PG8_BAR; PG8_WAIT_L(0); PG8_MMA(0, 0, At, B0); PG8_BAR; PG8_SCHED;
      PG8_LDB(B1, 1, 1); PG8_STAGE(PG8_SB(1, 0), b3, voffB);
      PG8_BAR; PG8_WAIT_L(0); PG8_MMA(0, 1, At, B1); PG8_BAR;
      PG8_LDA(At, 1, 1); PG8_STAGE(PG8_SA(1, 0), a3, vA[0]);
      PG8_BAR; PG8_WAIT_L(0); PG8_MMA(1, 0, At, B0); PG8_BAR; PG8_SCHED;
      PG8_STAGE(PG8_SB(1, 1), b3 + hstep, voffB);
      PG8_WAIT_V(6); PG8_BAR; PG8_MMA(1, 1, At, B1); PG8_BAR;
    }
    {
      const int te_ = fresh_tid_w(S.wv), le_ = te_ & 63;
      E(acc, cur, wr, wc, le_ & 15, le_ >> 4);
      S.done(cur, le_);
    }
    if (!has_next) break;
#pragma unroll
    for (int a = 0; a < 2; ++a)
#pragma unroll
      for (int b = 0; b < 2; ++b)
#pragma unroll
        for (int m = 0; m < 4; ++m)
#pragma unroll
          for (int n = 0; n < 2; ++n) acc[a][b][m][n] = (f32x4){0.f, 0.f, 0.f, 0.f};
    cur = nxt; cB = nB; ++ui;
    K = S.kof(cur); nt = K / G_BK;
  }
  PG8_WAIT_V(0);
  if (wr == 0) PG8_BAR;
  PG8_BAR;
#undef PG8_SA
#undef PG8_SB
#undef PG8_STAGE
#undef PG8_LDA
#undef PG8_LDB
#undef PG8_MMA
#undef PG8_WAIT_V
#undef PG8_WAIT_L
#undef PG8_BAR
#undef PG8_SCHED
}

struct DenseSched {
  const bf16_t* A; const bf16_t* Bt; int K, nM, nN, nwg, G, c, wv;
  DEV bool next(int i, GUnit& u) const {
    const long L = (long)i * G + c;
    if (L >= nwg) return false;
    int wgid = (int)L;
    { const int q = nwg / 8, r = nwg % 8, xcd = wgid % 8, off = wgid / 8; wgid = (xcd < r ? xcd * (q + 1) : r * (q + 1) + (xcd - r) * q) + off; }
    const int nig = 8 * nN, gid = wgid / nig, fm = gid * 8;
    u.pm = fm + ((wgid % nig) & 7);
    u.pn = (wgid % nig) >> 3;
    u.e = 0;
    u.valid = 256;
    return true;
  }
  DEV unsigned rowoff(const GUnit& u, int row) const { return (unsigned)((u.pm * 256 + row) * K) * 2u; }
  DEV const char* bptr(const GUnit& u) const { return (const char*)Bt + (size_t)u.pn * 256 * K * 2; }
  DEV const char* aptr(const GUnit&) const { return (const char*)A; }
  DEV int kof(const GUnit&) const { return K; }
  DEV void a_ready(const GUnit&) const {}
  DEV void done(const GUnit&, int) const {}
};
struct MoeSched {
  const bf16_t* act; const bf16_t* hbuf; const bf16_t* bt1; const bf16_t* bt2; const int* cnt; const int* list;
  unsigned* rdy; unsigned* tmo; int G, c, wv;
  DEV bool next(int i, GUnit& u) const {
    int L = i * G + c;
    int U = 0;
    for (int e = 0; e < NEXP; ++e) U += ((cnt[e] + 255) >> 8) * 4;
    u.ph = (L >= U) ? 1 : 0;
    if (u.ph) L -= U;
    int base = 0;
    for (int e = 0; e < NEXP; ++e) {
      const int cn = cnt[e];
      const int tiles = (cn + 255) >> 8, ntl = tiles * 4;
      if (L < ntl) {
        u.e = e; u.pm = L >> 2; u.pn = L & 3; u.valid = min(256, cn - u.pm * 256); u.ridx = base + u.pm;
        return true;
      }
      L -= ntl;
      base += tiles;
    }
    return false;
  }
  DEV unsigned rowoff(const GUnit& u, int row) const {
    const int slot = list[u.e * CAP + u.pm * 256 + min(row, u.valid - 1)];
    return u.ph ? (unsigned)(slot * DEXP) * 2u : (unsigned)((slot >> 1) * DM) * 2u;
  }
  DEV const char* bptr(const GUnit& u) const {
    return (const char*)bt1 + (ptrdiff_t)u.ph * ((const char*)bt2 - (const char*)bt1) +
           (((size_t)u.e * 1024 + u.pn * 256) * (size_t)(DM * 2 >> u.ph));
  }
  DEV const char* aptr(const GUnit& u) const {
    return (const char*)act + (ptrdiff_t)u.ph * ((const char*)hbuf - (const char*)act);
  }
  DEV int kof(const GUnit& u) const { return u.ph ? DEXP : DM; }
  DEV void a_ready(const GUnit& u) const {
    if (u.ph) {
      if (wv == 0) {
        unsigned spins = 0u;
        while (xb_ld(rdy + u.ridx) < 32u) {
          if (++spins > 4000000u) { atomicAdd(tmo, 1u); break; }
          __builtin_amdgcn_s_sleep(2);
        }
        __builtin_amdgcn_fence(__ATOMIC_ACQUIRE, "agent");
        asm volatile("s_waitcnt vmcnt(0)" ::: "memory");
      }
      asm volatile("" ::: "memory");
      __builtin_amdgcn_s_barrier();
      asm volatile("" ::: "memory");
    }
  }
  DEV void done(const GUnit& u, int lane) const {
    if (!u.ph) {
      asm volatile("s_waitcnt vmcnt(0)" ::: "memory");
      if (lane == 0) xb_add(rdy + u.ridx, 1u);
    }
  }
};

DEV void convert_tile(const float* src, int ld, int k0, int n0, bf16_t* dst, int drow0, int dK, float* tl, int tid) {
  {
    const int kk = tid >> 4, n4 = tid & 15;
    const float4 a = *(const float4*)(src + (size_t)(k0 + kk) * ld + n0 + n4 * 4);
    const float4 b = *(const float4*)(src + (size_t)(k0 + kk + 32) * ld + n0 + n4 * 4);
    float* r0 = tl + kk * 65 + n4 * 4;
    r0[0] = a.x; r0[1] = a.y; r0[2] = a.z; r0[3] = a.w;
    float* r1 = tl + (kk + 32) * 65 + n4 * 4;
    r1[0] = b.x; r1[1] = b.y; r1[2] = b.z; r1[3] = b.w;
  }
  __syncthreads();
  {
    const int n = tid >> 3, k8 = tid & 7;
    float v[8];
#pragma unroll
    for (int j = 0; j < 8; ++j) v[j] = tl[(k8 * 8 + j) * 65 + n];
    *(uint4*)(dst + (size_t)(drow0 + n) * dK + k0 + k8 * 8) = pack8(v);
  }
  __syncthreads();
}
DEV void convert_gates(const Params& p, int l, int bid, int nb, int tid) {
  const int bs = bid;
  const int g = bs * NTHR + tid;
  if (g < 16 * DM) {
    const int j = g >> 10, k = g & (DM - 1);
    p.btg[g] = f2bf(p.w_in[((size_t)l * DM + k) * DIN + PROJW + j]);
  }
}
DEV void convert_win(const Params& p, int l, int bid, int nb, char* smem) {
  const int tid = fresh_tid();
  for (int t = bid; t < 16 * 56; t += nb) {
    const int kt = t / 56, ntile = t - kt * 56;
    convert_tile(p.w_in + (size_t)l * DM * DIN, DIN, kt * 64, ntile * 64, p.btin, ntile * 64, DM, (float*)smem, tid);
  }
  convert_gates(p, l, bid, nb, tid);
}
struct CvtDesc { const float* src; bf16_t* dst; int ld, dK, k0, n0, drow0; };
DEV CvtDesc cvt_desc(const Params& p, int l, int t) {
  constexpr int NT_W1 = NEXP * 16 * 8, NT_W2 = NEXP * 8 * 16, NT_WO = 256;
  CvtDesc d;
  if (t < 2 * NT_W1) {
    const int which = t / NT_W1, r = t - which * NT_W1;
    const int e = r >> 7, kt = (r >> 3) & 15, ntile = r & 7;
    d.src = (which ? p.ew3 : p.ew1) + (size_t)(l * NEXP + e) * DM * DEXP;
    d.ld = DEXP; d.k0 = kt * 64; d.n0 = ntile * 64;
    d.dst = p.bt1; d.dK = DM;
    d.drow0 = e * 1024 + 256 * (d.n0 >> 7) + which * 128 + (d.n0 & 127);
  } else if (t < 2 * NT_W1 + NT_W2) {
    const int r = t - 2 * NT_W1;
    const int e = r >> 7, kt = (r >> 4) & 7, ntile = r & 15;
    d.src = p.ew2 + (size_t)(l * NEXP + e) * DEXP * DM;
    d.ld = DM; d.k0 = kt * 64; d.n0 = ntile * 64;
    d.dst = p.bt2; d.dK = DEXP; d.drow0 = e * 1024 + ntile * 64;
  } else {
    const int r = t - 2 * NT_W1 - NT_W2;
    const int kt = r >> 4, ntile = r & 15;
    d.src = p.w_out + (size_t)l * DM * DM;
    d.ld = DM; d.k0 = kt * 64; d.n0 = ntile * 64;
    d.dst = p.btout; d.dK = DM; d.drow0 = ntile * 64;
  }
  return d;
}
DEV void convert_layer(const Params& p, int l, int bid_, int nb, char* smem) {
  const int bid = bid_;
  const int tid = fresh_tid();
  float* tl = (float*)smem;
  constexpr int NT = 2 * (NEXP * 16 * 8) + NEXP * 8 * 16 + 256;
  const int kk = tid >> 4, n4 = tid & 15;
  auto fetch = [&](int t, float4& a, float4& b) {
    const CvtDesc d = cvt_desc(p, l, min(t, NT - 1));
    const float* s = d.src + (size_t)(d.k0 + kk) * d.ld + d.n0 + n4 * 4;
    {
      const f32x4 av = __builtin_nontemporal_load((const f32x4*)(s));
      const f32x4 bv = __builtin_nontemporal_load((const f32x4*)(s + (size_t)32 * d.ld));
      a = make_float4(av[0], av[1], av[2], av[3]);
      b = make_float4(bv[0], bv[1], bv[2], bv[3]);
    }
  };
  float4 a0, b0, a1, b1, a2, b2;
  fetch(bid, a0, b0);
  fetch(bid + nb, a1, b1);
#pragma unroll 1
  for (int t = bid; t < NT; t += nb) {
    fetch(t + 2 * nb, a2, b2);
    const CvtDesc d = cvt_desc(p, l, t);
    {
      float* r0 = tl + kk * 65 + n4 * 4;
      r0[0] = a0.x; r0[1] = a0.y; r0[2] = a0.z; r0[3] = a0.w;
      float* r1 = tl + (kk + 32) * 65 + n4 * 4;
      r1[0] = b0.x; r1[1] = b0.y; r1[2] = b0.z; r1[3] = b0.w;
    }
    __syncthreads();
    {
      const int n = tid >> 3, k8 = tid & 7;
      float v[8];
#pragma unroll
      for (int j = 0; j < 8; ++j) v[j] = tl[(k8 * 8 + j) * 65 + n];
      const uint4 pk = pack8(v);
      const u32x4 pkv = {pk.x, pk.y, pk.z, pk.w};
      __builtin_nontemporal_store(pkv, (u32x4*)(d.dst + (size_t)(d.drow0 + n) * d.dK + d.k0 + k8 * 8));
    }
    __syncthreads();
    a0 = a1; b0 = b1; a1 = a2; b1 = b2;
  }
  if (l + 1 < DEPTH) convert_win(p, l + 1, bid, nb, smem);
}

DEV void phase_ada(const Params& p, int bid, int nb, char* smem) {
  float* cond = (float*)smem;
  float* red = cond + 2 * DM;
  const int tid = fresh_tid(), lane = tid & 63, wid = tid >> 6;
  for (int i = tid; i < 2 * DM; i += NTHR) cond[i] = silu_f(p.c[i]);
  __syncthreads();
  for (int item = bid; item < DEPTH * 96; item += nb) {
    const int l = item / 96, j = (item - l * 96) * 64 + lane;
    const float* w = p.w_ada + ((size_t)l * DM + wid * 128) * 6144 + j;
    float a0 = 0.f, a1 = 0.f;
#pragma unroll 16
    for (int k = 0; k < 128; ++k) {
      const float wv = w[(size_t)k * 6144];
      a0 += cond[wid * 128 + k] * wv;
      a1 += cond[DM + wid * 128 + k] * wv;
    }
    red[(wid * 2 + 0) * 64 + lane] = a0;
    red[(wid * 2 + 1) * 64 + lane] = a1;
    __syncthreads();
    if (wid < 2) {
      float s = p.b_ada[l * 6144 + j];
#pragma unroll
      for (int w8 = 0; w8 < 8; ++w8) s += red[(w8 * 2 + wid) * 64 + lane];
      p.mod[(l * 2 + wid) * 6144 + j] = s;
    }
    __syncthreads();
  }
  if (bid == 0 && tid < DEPTH * NEXP) p.cnt[tid] = 0;
}

DEV void norm_mod_store(const float4 (&v)[4], float rstd, const float* nw, const float* sc, const float* sh,
                        bf16_t* dst, int lane) {
#pragma unroll
  for (int i = 0; i < 4; ++i) {
    const int idx = (lane + 64 * i) * 4;
    const float4 w = *(const float4*)(nw + idx);
    const float4 s = *(const float4*)(sc + idx);
    const float4 h = *(const float4*)(sh + idx);
    const float r0 = v[i].x * rstd * w.x * (1.f + s.x) + h.x;
    const float r1 = v[i].y * rstd * w.y * (1.f + s.y) + h.y;
    const float r2 = v[i].z * rstd * w.z * (1.f + s.z) + h.z;
    const float r3 = v[i].w * rstd * w.w * (1.f + s.w) + h.w;
    uint2 pk;
    pk.x = pack2(r0, r1);
    pk.y = pack2(r2, r3);
    *(uint2*)(dst + idx) = pk;
  }
}

DEV void phase_hmix(const Params& p, int l, const float* xin, int bid, int nb) {
  const int tid_ = fresh_tid(), lane = tid_ & 63, wid = tid_ >> 6;
  for (int t = bid * NWAVE + wid; t < NTOK; t += nb * NWAVE) {
    const float4* xr = (const float4*)(xin + (size_t)t * DM);
    float4 v[4];
    float ss = 0.f;
#pragma unroll
    for (int i = 0; i < 4; ++i) {
      v[i] = xr[lane + 64 * i];
      ss += v[i].x * v[i].x + v[i].y * v[i].y + v[i].z * v[i].z + v[i].w * v[i].w;
    }
    ss = wave_sum(ss, lane);
    const float rstd = rsqrtf(ss * (1.f / DM) + EPS);
    const int b = t / T;
    const float* md = p.mod + (l * 2 + b) * 6144;
    norm_mod_store(v, rstd, p.norm_mix_w + l * DM, md + MOD_SCALE1, md + MOD_SHIFT1, p.act + (size_t)t * DM, lane);
  }
}

struct EpiProj {
  static constexpr bool PERM = true;
  bf16_t* O;
  DEV void operator()(const f32x4 (&acc)[2][2][4][2], const GUnit& u, int wr, int wc, int fr, int fq) const {
    const int row0 = u.pm * 256 + wr * 64 + fr, col0 = u.pn * 256 + wc * 32 + 8 * fq;
#pragma unroll
    for (int ai = 0; ai < 2; ++ai)
#pragma unroll
      for (int m = 0; m < 4; ++m) {
        bf16_t* rowp = O + (size_t)(row0 + ai * G_HALF + m * 16) * PROJW + col0;
#pragma unroll
        for (int bj = 0; bj < 2; ++bj) {
          const f32x4 v0 = acc[ai][bj][m][0], v1 = acc[ai][bj][m][1];
          uint4 w;
          w.x = pack2(v0[0], v0[1]); w.y = pack2(v0[2], v0[3]); w.z = pack2(v1[0], v1[1]); w.w = pack2(v1[2], v1[3]);
          *(uint4*)(rowp + bj * G_HALF) = w;
        }
      }
  }
};

DEV void phase_gemm_proj(const Params& p, int l, int bid, int nb, char* smem) {
  DenseSched S;
  S.A = p.act; S.Bt = p.btin; S.K = DM; S.nM = NTOK / 256; S.nN = PROJW / 256; S.nwg = S.nM * S.nN; S.G = nb; S.c = bid; S.wv = p.wv;
  EpiProj E;
  E.O = p.proj;
  gemm_phase((LAS unsigned char*)smem, S, E);
  const int tid = fresh_tid(), lane = tid & 63, wid = tid >> 6, fr = lane & 15, fq = lane >> 4;
  for (int tb = bid; tb < NTOK / 64; tb += nb) {
    if (wid < 4) {
      const int tok0 = tb * 64 + wid * 16;
      const bf16_t* ap = p.act + (size_t)(tok0 + fr) * DM + fq * 8;
      const bf16_t* bp = p.btg + (size_t)fr * DM + fq * 8;
      f32x4 acc = {0.f, 0.f, 0.f, 0.f};
#pragma unroll 8
      for (int ks = 0; ks < DM / 32; ++ks)
        acc = MFMA16(*(const bf16x8*)(ap + ks * 32), *(const bf16x8*)(bp + ks * 32), acc);
#pragma unroll
      for (int j = 0; j < 4; ++j) p.gates[(size_t)(tok0 + fq * 4 + j) * 16 + fr] = acc[j];
    }
  }
}

DEV void phase_conv(const Params& p, int l, int bid, int nb) {
  const float* w = p.conv_a_w + l * 768;
  const int bs = bid;
  for (int g = bs * NTHR + fresh_tid(); g < NTOK * 32; g += nb * NTHR) {
    const int t = g >> 5, c = (g & 31) * 8;
    const int tl = t & (T - 1);
    const bf16_t* r = p.proj + (size_t)t * PROJW + c;
    float cb[8], cc[8], cx[8], s[8], wk[8];
    unpack8(*(const uint4*)(r + OFF_CB), cb);
    unpack8(*(const uint4*)(r + OFF_CC), cc);
    unpack8(*(const uint4*)(r + OFF_CX), cx);
    {
      const float4 w0 = *(const float4*)(w + 256 + c), w1 = *(const float4*)(w + 256 + c + 4);
      wk[0] = w0.x; wk[1] = w0.y; wk[2] = w0.z; wk[3] = w0.w; wk[4] = w1.x; wk[5] = w1.y; wk[6] = w1.z; wk[7] = w1.w;
    }
#pragma unroll
    for (int e = 0; e < 8; ++e) s[e] = wk[e] * cc[e] * cx[e];
    if (tl > 0) {
      unpack8(*(const uint4*)(r + OFF_CC - PROJW), cc);
      unpack8(*(const uint4*)(r + OFF_CX - PROJW), cx);
      const float4 w0 = *(const float4*)(w + c), w1 = *(const float4*)(w + c + 4);
      wk[0] = w0.x; wk[1] = w0.y; wk[2] = w0.z; wk[3] = w0.w; wk[4] = w1.x; wk[5] = w1.y; wk[6] = w1.z; wk[7] = w1.w;
#pragma unroll
      for (int e = 0; e < 8; ++e) s[e] += wk[e] * cc[e] * cx[e];
    }
    if (tl < T - 1) {
      unpack8(*(const uint4*)(r + OFF_CC + PROJW), cc);
      unpack8(*(const uint4*)(r + OFF_CX + PROJW), cx);
      const float4 w0 = *(const float4*)(w + 512 + c), w1 = *(const float4*)(w + 512 + c + 4);
      wk[0] = w0.x; wk[1] = w0.y; wk[2] = w0.z; wk[3] = w0.w; wk[4] = w1.x; wk[5] = w1.y; wk[6] = w1.z; wk[7] = w1.w;
#pragma unroll
      for (int e = 0; e < 8; ++e) s[e] += wk[e] * cc[e] * cx[e];
    }
#pragma unroll
    for (int e = 0; e < 8; ++e) s[e] *= cb[e];
    *(uint4*)(p.y + (size_t)t * DM + c) = pack8(s);
  }
}

DEV void phase_na(const Params& p, int l, int wgid, int nwg) {
  const int tid_ = fresh_tid(), lane = tid_ & 63, fr = lane & 15, fq = lane >> 4;
  for (int item = wgid; item < NB * 128 * 4 * 4; item += nwg) {
    const int qg = item & 3, h = (item >> 2) & 3, r = (item >> 4) & 127, b = item >> 11;
    const int rs = min(max(r - 4, 0), 120);
    const int kc0 = (qg == 0) ? 0 : (qg == 1) ? 8 : (qg == 2) ? 24 : 32;
    const int c = qg * 16 + fr;
    const int cs = min(max(c - 8, 0), 48);
    const size_t tq = (size_t)b * T + r * 64 + c;
    bf16x8 bq[2];
#pragma unroll
    for (int ks = 0; ks < 2; ++ks)
      bq[ks] = *(const bf16x8*)(p.proj + tq * PROJW + OFF_NQ + h * 64 + ks * 32 + fq * 8);
    f32x4 sc[16];
#pragma unroll
    for (int tt = 0; tt < 16; ++tt) {
      const int i = tt >> 1, half = tt & 1;
      const size_t kt = (size_t)b * T + (rs + i) * 64 + kc0 + half * 16 + fr;
      const bf16_t* kp = p.proj + kt * PROJW + OFF_NK + h * 64 + fq * 8;
      const bf16x8 a0 = *(const bf16x8*)(kp);
      const bf16x8 a1 = *(const bf16x8*)(kp + 32);
      f32x4 z = {0.f, 0.f, 0.f, 0.f};
      z = MFMA16(a0, bq[0], z);
      sc[tt] = MFMA16(a1, bq[1], z);
    }
    const float* rpb = p.na_rpb + (size_t)(l * 4 + h) * 465;
    float mx = -3.0e38f;
#pragma unroll
    for (int tt = 0; tt < 16; ++tt) {
      const int i = tt >> 1, half = tt & 1;
      const int dr = rs + i - r + 7;
#pragma unroll
      for (int j = 0; j < 4; ++j) {
        const int kcol = kc0 + half * 16 + fq * 4 + j;
        const bool valid = (kcol >= cs) && (kcol < cs + 16);
        const int dc = valid ? (kcol - c + 15) : 0;
        const float s = valid ? (sc[tt][j] * 0.125f + rpb[dr * 31 + dc]) : -3.0e38f;
        sc[tt][j] = s;
        mx = fmaxf(mx, s);
      }
    }
    mx = fmaxf(mx, shx(mx, 16, lane));
    mx = fmaxf(mx, shx(mx, 32, lane));
    float sum = 0.f;
#pragma unroll
    for (int tt = 0; tt < 16; ++tt)
#pragma unroll
      for (int j = 0; j < 4; ++j) {
        const float s = sc[tt][j];
        const float e = (s > -1.0e38f) ? __expf(s - mx) : 0.f;
        sc[tt][j] = e;
        sum += e;
      }
    sum += shx(sum, 16, lane);
    sum += shx(sum, 32, lane);
    const float inv = 1.f / sum;
    f32x4 oacc[4];
#pragma unroll
    for (int nt = 0; nt < 4; ++nt) oacc[nt] = f32x4{0.f, 0.f, 0.f, 0.f};
#pragma unroll
    for (int i = 0; i < 8; ++i) {
      uint4 pu;
      pu.x = pack2(sc[2 * i][0] * inv, sc[2 * i][1] * inv);
      pu.y = pack2(sc[2 * i][2] * inv, sc[2 * i][3] * inv);
      pu.z = pack2(sc[2 * i + 1][0] * inv, sc[2 * i + 1][1] * inv);
      pu.w = pack2(sc[2 * i + 1][2] * inv, sc[2 * i + 1][3] * inv);
      const bf16x8 pa = __builtin_bit_cast(bf16x8, pu);
      const bf16_t* vb = p.proj + ((size_t)b * T + (rs + i) * 64 + kc0 + fq * 4) * PROJW + OFF_NV + h * 64 + fr * 4;
      uint2 wv[8];
#pragma unroll
      for (int j = 0; j < 8; ++j) wv[j] = *(const uint2*)(vb + (size_t)(j < 4 ? j : 12 + j) * PROJW);
#pragma unroll
      for (int t = 0; t < 4; ++t) {
        uint4 bu;
        const unsigned sel = (t & 1) ? 0x07060302u : 0x05040100u;
#define NA_E(j) ((t & 2) ? wv[j].y : wv[j].x)
        bu.x = __builtin_amdgcn_perm(NA_E(1), NA_E(0), sel);
        bu.y = __builtin_amdgcn_perm(NA_E(3), NA_E(2), sel);
        bu.z = __builtin_amdgcn_perm(NA_E(5), NA_E(4), sel);
        bu.w = __builtin_amdgcn_perm(NA_E(7), NA_E(6), sel);
#undef NA_E
        oacc[t] = MFMA16(pa, __builtin_bit_cast(bf16x8, bu), oacc[t]);
      }
    }
#pragma unroll
    for (int j = 0; j < 4; ++j) {
      uint2 st;
      st.x = pack2(oacc[0][j], oacc[1][j]);
      st.y = pack2(oacc[2][j], oacc[3][j]);
      *(uint2*)(p.y + ((size_t)b * T + r * 64 + qg * 16 + fq * 4 + j) * DM + 256 + h * 64 + fr * 4) = st;
    }
  }
}

DEV void fmac1(float& acc, float a, float b) { asm("v_fmac_f32 %0, %1, %2" : "+v"(acc) : "v"(a), "v"(b)); }
struct LRow { float4 v[8]; };
template <int POS>
struct SolveStep {
  static DEV void run(float (&x)[64], LRow& row, const float* Ld, const float* sclv, const bf16_t* srcq, int sstep,
                      bool isu, unsigned* up, bf16_t* wp) {
    float s0 = 0.f, s1 = 0.f, s2 = 0.f, s3 = 0.f;
    float4 hi[8];
#pragma unroll
    for (int j4 = 8; j4 < (POS + 3) / 4; ++j4) hi[j4 - 8] = *(const float4*)(Ld + POS * 68 + j4 * 4);
#pragma unroll
    for (int j4 = 0; j4 < 8; ++j4) {
      if (j4 < (POS + 3) / 4) {
        const float4 lv = row.v[j4];
        fmac1(s0, lv.x, x[j4 * 4]);
        if (j4 * 4 + 1 < POS) fmac1(s1, lv.y, x[j4 * 4 + 1]);
        if (j4 * 4 + 2 < POS) fmac1(s2, lv.z, x[j4 * 4 + 2]);
        if (j4 * 4 + 3 < POS) fmac1(s3, lv.w, x[j4 * 4 + 3]);
      }
      if (POS + 1 < 64 && j4 < (POS + 4) / 4) row.v[j4] = *(const float4*)(Ld + (POS + 1) * 68 + j4 * 4);
    }
#pragma unroll
    for (int j4 = 8; j4 < (POS + 3) / 4; ++j4) {
      const float4 lv = hi[j4 - 8];
      fmac1(s0, lv.x, x[j4 * 4]);
      if (j4 * 4 + 1 < POS) fmac1(s1, lv.y, x[j4 * 4 + 1]);
      if (j4 * 4 + 2 < POS) fmac1(s2, lv.z, x[j4 * 4 + 2]);
      if (j4 * 4 + 3 < POS) fmac1(s3, lv.w, x[j4 * 4 + 3]);
    }
    const float a = sclv[POS] * bf2f(srcq[0]) - ((s0 + s1) + (s2 + s3));
    x[POS] = a;
    if (isu) {
      if (POS & 1) up[(POS >> 1) * 128] = pack2(x[POS - 1], a);
    } else {
      wp[POS * 128] = f2bf(-a);
    }
    asm volatile("" ::: "memory");
    SolveStep<POS + 1>::run(x, row, Ld, sclv, srcq + sstep, sstep, isu, up, wp);
  }
};
template <>
struct SolveStep<64> {
  static DEV void run(float (&)[64], LRow&, const float*, const float*, const bf16_t*, int, bool, unsigned*, bf16_t*) {}
};

DEV int kperm16(int k) { const int s = (k >> 2) & 3; return (k & ~15) | ((((s & 1) << 1) | (s >> 1)) << 2) | (k & 3); }

DEV void phase_gdn_prep(const Params& p, int l, int bid, int nb, char* smem) {
  const int tid = fresh_tid(), lane = tid & 63;
  bf16_t* q_bf = (bf16_t*)(smem + PL_Q);
  bf16_t* k_bf = (bf16_t*)(smem + PL_K);
  bf16_t* v_bf = (bf16_t*)(smem + PL_V);
  float* Lm = (float*)(smem + PL_L);
  float* gcl = (float*)(smem + PL_GC);
  float* bl = (float*)(smem + PL_BETA);
  float* bgl = (float*)(smem + PL_BG);
  float* gll = (float*)(smem + PL_GL);
  const float* cw = p.gdn_conv_w + l * 4608;
  for (int item = bid; item < 1024; item += nb) {
    const int b = item >> 9, h = (item >> 7) & 3, n = item & 127;
    const int t0 = b * T + n * 64;
    char* rec0 = p.gdn_rec + (size_t)item * 2 * REC_BYTES;
    uint4 raw[3][3][2];
    {
      const int i = tid >> 3, oc = tid & 7, d0 = oc * 16;
      const int tl = n * 64 + i;
      const bf16_t* rowp = p.proj + (size_t)(t0 + i) * PROJW + OFF_GQKV + h * 128 + d0;
      const int dm = (tl > 0) ? -PROJW : 0, dp = (tl < T - 1) ? PROJW : 0;
#pragma unroll
      for (int m = 0; m < 3; ++m) {
        const bf16_t* rp = rowp + m * 512;
        raw[m][0][0] = *(const uint4*)(rp + dm);
        raw[m][0][1] = *(const uint4*)(rp + dm + 8);
        raw[m][1][0] = *(const uint4*)(rp);
        raw[m][1][1] = *(const uint4*)(rp + 8);
        raw[m][2][0] = *(const uint4*)(rp + dp);
        raw[m][2][1] = *(const uint4*)(rp + dp + 8);
      }
    }
    if (tid < 128) {
      const int dir = tid >> 6;
      const int i = dir ? 63 - lane : lane;
      const size_t t = (size_t)t0 + i;
      const float a = p.gates[t * 16 + dir * 4 + h], bb = p.gates[t * 16 + 8 + dir * 4 + h];
      const float g = -__expf(p.gdn_a_log[l * 8 + dir * 4 + h]) * softplus_f(a + p.gdn_dt_bias[l * 8 + dir * 4 + h]);
      const float beta = sigmoid_f(bb);
      float cs = g;
#pragma unroll
      for (int o = 1; o < 64; o <<= 1) {
        const float v = __int_as_float(__builtin_amdgcn_ds_bpermute((lane - o) << 2, __float_as_int(cs)));
        if (lane >= o) cs += v;
      }
      gcl[dir * 64 + lane] = cs;
      bl[dir * 64 + lane] = beta;
      bgl[dir * 64 + lane] = beta * __expf(cs);
      const float last = __uint_as_float(__builtin_amdgcn_readlane(__float_as_uint(cs), 63));
      if (lane == 0) {
        gll[dir] = last;
        p.egl[item * 2 + dir] = __expf(last);
      }
    }
    __syncthreads();
    {
      int tA = tid;
      asm volatile("" : "+v"(tA));
      const int i = tA >> 3, oc = tA & 7, d0 = oc * 16;
      const int tl = n * 64 + i;
      const float zm = (tl > 0) ? 1.f : 0.f, zp = (tl < T - 1) ? 1.f : 0.f;
#pragma unroll
      for (int m = 0; m < 3; ++m) {
        float x0[16], x1[16], x2[16], val[16];
        unpack8(raw[m][0][0], x0);
        unpack8(raw[m][0][1], x0 + 8);
        unpack8(raw[m][1][0], x1);
        unpack8(raw[m][1][1], x1 + 8);
        unpack8(raw[m][2][0], x2);
        unpack8(raw[m][2][1], x2 + 8);
#pragma unroll
        for (int e = 0; e < 16; ++e) { x0[e] *= zm; x2[e] *= zp; }
        const float* cwm = cw + m * 512 + h * 128 + d0;
        float ss = 0.f;
#pragma unroll
        for (int e = 0; e < 16; ++e) {
          val[e] = silu_f(cwm[e] * x0[e] + cwm[1536 + e] * x1[e] + cwm[3072 + e] * x2[e]);
          ss += val[e] * val[e];
        }
        if (m < 2) {
          ss += shx(ss, 1, lane);
          ss += shx(ss, 2, lane);
          ss += shx(ss, 4, lane);
          float sc = rsqrtf(ss + EPS);
          if (m == 0) sc *= 0.08838834764831845f;
#pragma unroll
          for (int e = 0; e < 16; ++e) val[e] *= sc;
        }
        bf16_t* dst = (m == 0 ? q_bf : (m == 1 ? k_bf : v_bf)) + i * 136 + d0;
        *(uint4*)(dst) = pack8(val);
        *(uint4*)(dst + 8) = pack8(val + 8);
        if (m == 0) {
#pragma unroll
          for (int dir = 0; dir < 2; ++dir) {
            const int pos = dir ? 63 - i : i;
            const float f = __expf(gcl[dir * 64 + pos]);
            float tmp[16];
#pragma unroll
            for (int e = 0; e < 16; ++e) tmp[kperm16(e)] = val[e] * f;
            bf16_t* qd = (bf16_t*)(rec0 + dir * REC_BYTES + REC_QD) + pos * 128 + d0;
            *(uint4*)(qd) = pack8(tmp);
            *(uint4*)(qd + 8) = pack8(tmp + 8);
          }
        }
        if (m == 1) {
#pragma unroll
          for (int dir = 0; dir < 2; ++dir) {
            const int pos = dir ? 63 - i : i;
            const float f = __expf(gll[dir] - gcl[dir * 64 + pos]);
            bf16_t* kt = (bf16_t*)(rec0 + dir * REC_BYTES + REC_KT) + d0 * 64 + kperm16(pos);
#pragma unroll
            for (int e = 0; e < 16; ++e) kt[e * 64] = f2bf(val[e] * f);
          }
        }
      }
    }
    __syncthreads();
    {
      int tB = tid;
      asm volatile("" : "+v"(tB));
      const int laneB = tB & 63, widB = tB >> 6, fr = laneB & 15, fq = laneB >> 4;
      const int mat = __builtin_amdgcn_readfirstlane(widB >> 2), rtile = widB & 3;
      const bf16_t* asrc = mat ? q_bf : k_bf;
      bf16x8 af[4];
#pragma unroll
      for (int ks = 0; ks < 4; ++ks) af[ks] = *(const bf16x8*)(asrc + (rtile * 16 + fr) * 136 + ks * 32 + fq * 8);
#pragma unroll
      for (int nt = 0; nt < 4; ++nt) {
        f32x4 acc = {0.f, 0.f, 0.f, 0.f};
#pragma unroll
        for (int ks = 0; ks < 4; ++ks) {
          const bf16x8 bfrag = *(const bf16x8*)(k_bf + (nt * 16 + fr) * 136 + ks * 32 + fq * 8);
          acc = MFMA16(af[ks], bfrag, acc);
        }
#pragma unroll
        for (int j = 0; j < 4; ++j) {
          const int i = rtile * 16 + fq * 4 + j, jj = nt * 16 + fr;
          const float G = acc[j];
#pragma unroll
          for (int dir = 0; dir < 2; ++dir) {
            const int pi = dir ? 63 - i : i, pj = dir ? 63 - jj : jj;
            const float dec = __expf(fminf(gcl[dir * 64 + pi] - gcl[dir * 64 + pj], 0.f));
            if (mat == 0)
              Lm[(dir * 64 + pi) * 68 + pj] = (pi > pj) ? bl[dir * 64 + pi] * G * dec : 0.f;
            else
              *((bf16_t*)(rec0 + dir * REC_BYTES + REC_IN) + pi * 64 + kperm16(pj)) = f2bf((pi >= pj) ? G * dec : 0.f);
          }
        }
      }
    }
    __syncthreads();
    {
      int tC = tid;
      asm volatile("" : "+v"(tC));
      const int dir = tC >> 8, c = tC & 255;
      const float* Ld = Lm + dir * 64 * 68;
      const bool isu = __builtin_amdgcn_readfirstlane((int)(c < 128)) != 0;
      unsigned* up = p.gdn_u + ((size_t)(item * 2 + dir) * 32) * 128 + (c & 127);
      bf16_t* wp = (bf16_t*)(rec0 + dir * REC_BYTES + REC_WN) + kperm16(c & 127);
      const bf16_t* src = (isu ? v_bf : k_bf) + (c & 127);
      const float* sclv = (isu ? bl : bgl) + dir * 64;
      float x[64];
      LRow row0;
      SolveStep<0>::run(x, row0, Ld, sclv, src + (dir ? 63 * 136 : 0), dir ? -136 : 136, isu, up, wp);
    }
    __syncthreads();
  }
}

DEV int crow(int reg, int hf) { return (reg & 3) + 8 * (reg >> 2) + 4 * hf; }
DEV bf16x8 pack_acc8(const f32x16& x, int s) {
  uint4 v;
  v.x = pack2(x[8 * s + 0], x[8 * s + 1]);
  v.y = pack2(x[8 * s + 2], x[8 * s + 3]);
  v.z = pack2(x[8 * s + 4], x[8 * s + 5]);
  v.w = pack2(x[8 * s + 6], x[8 * s + 7]);
  return __builtin_bit_cast(bf16x8, v);
}
DEV bf16x8 ld_frag(const char* rowp, int kb) { return *(const bf16x8*)(rowp + kb); }

DEV void phase_gdn_scan(const Params& p, int ep, int chain, char* smem) {
  const int tid = fresh_tid(), lane = tid & 63, wid = tid >> 6;
  const int dir = chain & 1, bh = chain >> 1;
  const int b = bh >> 2, hh = bh & 3;
  if (wid >= 4) {
    const int lt = tid - 256;
    uint4 rA[18], rB[18];
    auto gl = [&](uint4 (&rg)[18], int n) {
      const int item = bh * 128 + (dir ? 127 - n : n);
      const __amdgpu_buffer_rsrc_t rr = __builtin_amdgcn_make_buffer_rsrc(
          (void*)(p.gdn_rec + ((size_t)item * 2 + dir) * REC_BYTES), 0, REC_BYTES, 0x00020000);
      const __amdgpu_buffer_rsrc_t ru = __builtin_amdgcn_make_buffer_rsrc(
          (void*)(p.gdn_u + ((size_t)(item * 2 + dir) * 32) * 128), 0, 16384, 0x00020000);
#pragma unroll
      for (int k = 0; k < 14; ++k) {
        const u32x4 v = __builtin_amdgcn_raw_buffer_load_b128(rr, lt * 16, k * 4096, 0);
        rg[k] = make_uint4(v.x, v.y, v.z, v.w);
      }
#pragma unroll
      for (int k = 0; k < 4; ++k) {
        const u32x4 v = __builtin_amdgcn_raw_buffer_load_b128(ru, lt * 16, k * 4096, 0);
        rg[14 + k] = make_uint4(v.x, v.y, v.z, v.w);
      }
    };
    auto st = [&](const uint4 (&rg)[18], int buf) {
      char* base = smem + buf * SC_BUF;
#pragma unroll
      for (int k = 0; k < 14; ++k) {
        const int u = lt + 256 * k;
        int row, c16, off;
        if (k < 4) { row = u >> 4; c16 = u & 15; off = SC_WN + row * 272; }
        else if (k < 8) { row = (u - 1024) >> 4; c16 = (u - 1024) & 15; off = SC_QD + row * 272; }
        else if (k < 10) { row = (u - 2048) >> 3; c16 = (u - 2048) & 7; off = SC_IN + row * 144; }
        else { row = (u - 2560) >> 3; c16 = (u - 2560) & 7; off = SC_KT + row * 144; }
        *(uint4*)(base + off + c16 * 16) = rg[k];
      }
#pragma unroll
      for (int k = 0; k < 4; ++k) *(uint4*)(base + SC_U + (lt + 256 * k) * 16) = rg[14 + k];
    };
    gl(rA, 0);
    st(rA, 0);
    gl(rB, 1);
    gl(rA, 2);
    __syncthreads();
#pragma unroll 1
    for (int n = 0; n < 128; n += 2) {
      st(rB, 1);
      gl(rB, min(n + 3, 127));
      __syncthreads();
      st(rA, 0);
      gl(rA, min(n + 4, 127));
      __syncthreads();
    }
  } else {
    const int w = wid, r = lane & 31, hf = lane >> 5;
    f32x16 S[4];
#pragma unroll
    for (int t4 = 0; t4 < 4; ++t4)
#pragma unroll
      for (int e = 0; e < 16; ++e) S[t4][e] = 0.f;
    __builtin_amdgcn_s_setprio(3);
    const float dlo = p.egl[(bh * 128 + (dir ? 127 - lane : lane)) * 2 + dir];
    const float dhi = p.egl[(bh * 128 + (dir ? 63 - lane : 64 + lane)) * 2 + dir];
    if (tid == 0) __hip_atomic_store(&p.bar[XB_CXCC(chain)], ((unsigned)ep << 4) | xb_xcc_id(), __ATOMIC_RELAXED, __HIP_MEMORY_SCOPE_AGENT);
    __syncthreads();
#pragma unroll 1
    for (int n = 0; n < 128; ++n) {
      if (tid == 0) __hip_atomic_store(&p.bar[XB_PROG(chain)], (unsigned)ep * 1024u + (unsigned)n, __ATOMIC_RELAXED, __HIP_MEMORY_SCOPE_AGENT);
      const char* buf = smem + (n & 1) * SC_BUF;
      const float decay = __uint_as_float(__builtin_amdgcn_readlane(__float_as_uint(n < 64 ? dlo : dhi), n & 63));
      f32x16 vn[2], o[2];
      {
        const unsigned* ul = (const unsigned*)(buf + SC_U) + 32 * w + r;
#pragma unroll
        for (int tm = 0; tm < 2; ++tm)
#pragma unroll
          for (int e2 = 0; e2 < 8; ++e2) {
            const unsigned uu = ul[((32 * tm + crow(2 * e2, hf)) >> 1) * 128];
            vn[tm][2 * e2] = __uint_as_float(uu << 16);
            vn[tm][2 * e2 + 1] = __uint_as_float(uu & 0xffff0000u);
          }
      }
#pragma unroll
      for (int e = 0; e < 16; ++e) { o[0][e] = 0.f; o[1][e] = 0.f; }
      const char* rw0 = buf + SC_WN + r * 272 + hf * 16;
      const char* rq0 = buf + SC_QD + r * 272 + hf * 16;
      const char* ri0 = buf + SC_IN + r * 144 + hf * 16;
      const char* rk0 = buf + SC_KT + r * 144 + hf * 16;
      bf16x8 fA[8], fB[8], sb[4][2];
#define SCAN_LOAD(dst, base, t4a)                                                                        \
  _Pragma("unroll") for (int dt = 0; dt < 2; ++dt) _Pragma("unroll") for (int s = 0; s < 2; ++s)         \
      _Pragma("unroll") for (int tm = 0; tm < 2; ++tm)                                                   \
          dst[dt * 4 + s * 2 + tm] = ld_frag(base + tm * 32 * 272, (32 * ((t4a) + dt) + 16 * s) * 2);
#define SCAN_MMA(acc, f, t4a)                                                                            \
  _Pragma("unroll") for (int dt = 0; dt < 2; ++dt) _Pragma("unroll") for (int s = 0; s < 2; ++s)         \
      _Pragma("unroll") for (int tm = 0; tm < 2; ++tm)                                                   \
          acc[tm] = MFMA32(f[dt * 4 + s * 2 + tm], sb[(t4a) + dt][s], acc[tm]);
#define SCAN_MMA_T(acc, f, t4a)                                                                          \
  _Pragma("unroll") for (int dt = 0; dt < 2; ++dt) _Pragma("unroll") for (int s = 0; s < 2; ++s)         \
      _Pragma("unroll") for (int tm = 0; tm < 2; ++tm)                                                   \
          acc[tm] = MFMA32(sb[(t4a) + dt][s], f[dt * 4 + s * 2 + tm], acc[tm]);
#define SCAN_MIX(nmfma, nds, nvalu)                                                                      \
  _Pragma("unroll") for (int _g = 0; _g < (nmfma); ++_g) {                                               \
    __builtin_amdgcn_sched_group_barrier(0x008, 1, 0);                                                   \
    if (_g < (nds)) __builtin_amdgcn_sched_group_barrier(0x100, 1, 0);                                   \
    __builtin_amdgcn_sched_group_barrier(0x002, (nvalu), 0);                                             \
  }
      SCAN_LOAD(fA, rw0, 0)
      sb[0][0] = pack_acc8(S[0], 0); sb[0][1] = pack_acc8(S[0], 1);
      sb[1][0] = pack_acc8(S[1], 0); sb[1][1] = pack_acc8(S[1], 1);
      __builtin_amdgcn_sched_barrier(0);
      SCAN_MMA(vn, fA, 0)
      SCAN_LOAD(fB, rw0, 2)
      sb[2][0] = pack_acc8(S[2], 0); sb[2][1] = pack_acc8(S[2], 1);
      sb[3][0] = pack_acc8(S[3], 0); sb[3][1] = pack_acc8(S[3], 1);
      SCAN_MIX(8, 8, 2)
      __builtin_amdgcn_sched_barrier(0);
      SCAN_MMA(vn, fB, 2)
      SCAN_LOAD(fA, rq0, 0)
#pragma unroll
      for (int e = 0; e < 16; ++e) S[0][e] *= decay;
      SCAN_MIX(8, 8, 2)
      __builtin_amdgcn_sched_barrier(0);
      SCAN_MMA_T(o, fA, 0)
      SCAN_LOAD(fB, rq0, 2)
#pragma unroll
      for (int e = 0; e < 16; ++e) { S[1][e] *= decay; S[2][e] *= decay; }
      SCAN_MIX(8, 8, 3)
      __builtin_amdgcn_sched_barrier(0);
      bf16x8 fi[6], fk0[4];
      SCAN_MMA_T(o, fB, 2)
      fi[0] = ld_frag(ri0, 0);
      fi[1] = ld_frag(ri0, 32);
#pragma unroll
      for (int q4 = 0; q4 < 4; ++q4) fi[2 + q4] = ld_frag(ri0 + 32 * 144, q4 * 32);
#pragma unroll
      for (int q4 = 0; q4 < 4; ++q4) fk0[q4] = ld_frag(rk0, q4 * 32);
      bf16x8 vb[2][2];
#pragma unroll
      for (int tk = 0; tk < 2; ++tk) {
        vb[tk][0] = pack_acc8(vn[tk], 0);
        vb[tk][1] = pack_acc8(vn[tk], 1);
      }
#pragma unroll
      for (int e = 0; e < 16; ++e) S[3][e] *= decay;
      SCAN_MIX(8, 8, 4)
      __builtin_amdgcn_sched_barrier(0);
#undef SCAN_LOAD
#undef SCAN_MMA
#undef SCAN_MMA_T
      o[0] = MFMA32(vb[0][0], fi[0], o[0]);
      o[1] = MFMA32(vb[0][0], fi[2], o[1]);
      o[0] = MFMA32(vb[0][1], fi[1], o[0]);
      o[1] = MFMA32(vb[0][1], fi[3], o[1]);
      S[0] = MFMA32(fk0[0], vb[0][0], S[0]);
      o[1] = MFMA32(vb[1][0], fi[4], o[1]);
      S[0] = MFMA32(fk0[1], vb[0][1], S[0]);
      o[1] = MFMA32(vb[1][1], fi[5], o[1]);
      S[0] = MFMA32(fk0[2], vb[1][0], S[0]);
      S[0] = MFMA32(fk0[3], vb[1][1], S[0]);
#pragma unroll
      for (int q4 = 0; q4 < 4; ++q4) {
        fA[q4] = ld_frag(rk0 + 32 * 144, q4 * 32);
        fA[4 + q4] = ld_frag(rk0 + 64 * 144, q4 * 32);
      }
      SCAN_MIX(10, 8, 0)
      __builtin_amdgcn_sched_barrier(0);
#pragma unroll
      for (int q4 = 0; q4 < 4; ++q4) {
        S[1] = MFMA32(fA[q4], vb[q4 >> 1][q4 & 1], S[1]);
        S[2] = MFMA32(fA[4 + q4], vb[q4 >> 1][q4 & 1], S[2]);
      }
#pragma unroll
      for (int q4 = 0; q4 < 4; ++q4) fB[q4] = ld_frag(rk0 + 96 * 144, q4 * 32);
      SCAN_MIX(8, 4, 0)
      __builtin_amdgcn_sched_barrier(0);
#pragma unroll
      for (int q4 = 0; q4 < 4; ++q4) S[3] = MFMA32(fB[q4], vb[q4 >> 1][q4 & 1], S[3]);
#undef SCAN_MIX
      {
#pragma unroll
        for (int tn = 0; tn < 2; ++tn) {
          const int pos = 32 * tn + r;
          const int tok = dir ? (b * T + T - 1 - n * 64 - pos) : (b * T + n * 64 + pos);
          unsigned pk[4][2];
#pragma unroll
          for (int g = 0; g < 4; ++g) {
            pk[g][0] = pack2(o[tn][4 * g + 0], o[tn][4 * g + 1]);
            pk[g][1] = pack2(o[tn][4 * g + 2], o[tn][4 * g + 3]);
          }
          uint4 st0, st1;
          {
            auto s0 = __builtin_amdgcn_permlane32_swap(pk[0][0], pk[2][0], false, false);
            auto s1 = __builtin_amdgcn_permlane32_swap(pk[0][1], pk[2][1], false, false);
            st0.x = s0[0]; st0.y = s1[0]; st0.z = s0[1]; st0.w = s1[1];
            auto s2 = __builtin_amdgcn_permlane32_swap(pk[1][0], pk[3][0], false, false);
            auto s3 = __builtin_amdgcn_permlane32_swap(pk[1][1], pk[3][1], false, false);
            st1.x = s2[0]; st1.y = s3[0]; st1.z = s2[1]; st1.w = s3[1];
          }
          bf16_t* op = p.obuf + ((size_t)dir * NTOK + tok) * 512 + hh * 128 + 32 * w + 16 * hf;
          *(uint4*)(op) = st0;
          *(uint4*)(op + 8) = st1;
        }
      }
      __syncthreads();
    }
    __builtin_amdgcn_s_setprio(0);
  }
}

DEV void phase_scan_helper(const Params& p, int ep, int c, int j, char* smem) {
  const int tid = fresh_tid(), lane = tid & 63, wid = tid >> 6;
  volatile unsigned* lprog = (volatile unsigned*)smem;
  const unsigned epoch = (unsigned)ep;
  const int dir = c & 1, bh = c >> 1;
  constexpr unsigned AHEAD = 8u;
  if (tid == 0) lprog[0] = 0u;
  __syncthreads();
  if (wid == 0) {
    unsigned v = 0u, spins = 0u;
    for (;;) {
      v = xb_ld(&p.bar[XB_CXCC(c)]);
      if ((v >> 4) == epoch || ++spins > 200000u) break;
      __builtin_amdgcn_s_sleep(8);
    }
    const bool mine = ((v >> 4) == epoch) && ((v & 15u) == xb_xcc_id());
    if (!mine) {
      if (lane == 0) lprog[0] = 0xffffffffu;
    } else {
      unsigned idle = 0u;
      for (;;) {
        const unsigned g = xb_ld(&p.bar[XB_PROG(c)]);
        const unsigned cur = (g >= epoch * 1024u) ? (g - epoch * 1024u + 1u) : 0u;
        if (lane == 0) lprog[0] = cur + 1u;
        if (cur >= 128u || ++idle > 400000u) break;
        __builtin_amdgcn_s_sleep(16);
      }
      if (lane == 0) lprog[0] = 0xffffffffu;
    }
  } else {
    u32x4 sink = {0u, 0u, 0u, 0u};
    unsigned spins = 0u;
    for (int n = 0; n < 128;) {
      const unsigned s = lprog[0];
      if (s == 0xffffffffu) break;
      if (s == 0u) {
        if (++spins > 4000000u) break;
        __builtin_amdgcn_s_sleep(4);
        continue;
      }
      const unsigned started = s - 1u;
      if ((unsigned)n < started) n = (int)started;
      if (n >= 128) break;
      if ((unsigned)n >= started + AHEAD) {
        if (++spins > 4000000u) break;
        __builtin_amdgcn_s_sleep(4);
        continue;
      }
      const int item = bh * 128 + (dir ? 127 - n : n);
      const char* rec = p.gdn_rec + ((size_t)item * 2 + dir) * REC_BYTES;
      const char* uu = (const char*)(p.gdn_u + ((size_t)(item * 2 + dir) * 32) * 128);
#pragma unroll
      for (int q = 0; q < 4; ++q) {
        const int pc = wid - 1 + 7 * q;
        if (pc < 24) {
          const int piece = 24 * j + pc;
          const char* ptr = (piece < 56 ? rec + piece * 1024 : uu + (piece - 56) * 1024) + lane * 16;
          asm volatile("global_load_dwordx4 %0, %1, off" : "+v"(sink) : "v"(ptr) : "memory");
        }
      }
      ++n;
    }
    asm volatile("s_waitcnt vmcnt(0)" ::: "memory");
    asm volatile("" :: "v"(sink));
  }
  __syncthreads();
}

DEV void phase_gdn_fin(const Params& p, int l, int bid, int nb) {
  const int tid_ = fresh_tid(), lane = tid_ & 63, wid = tid_ >> 6;
  const float* gnw = p.gdn_norm_w + l * 128 + (lane & 15) * 8;
  for (int t = bid * NWAVE + wid; t < NTOK; t += nb * NWAVE) {
    float of[8], ob[8], z[8], o[8];
    unpack8(*(const uint4*)(p.obuf + (size_t)t * 512 + lane * 8), of);
    unpack8(*(const uint4*)(p.obuf + ((size_t)NTOK + t) * 512 + lane * 8), ob);
    unpack8(*(const uint4*)(p.proj + (size_t)t * PROJW + OFF_GZ + lane * 8), z);
    float ss = 0.f;
#pragma unroll
    for (int e = 0; e < 8; ++e) {
      o[e] = of[e] + ob[e];
      ss += o[e] * o[e];
    }
    ss += shx(ss, 1, lane);
    ss += shx(ss, 2, lane);
    ss += shx(ss, 4, lane);
    ss += shx(ss, 8, lane);
    const float rr = rsqrtf(ss * (1.f / 128.f) + EPS);
    const float4 g0 = *(const float4*)(gnw), g1 = *(const float4*)(gnw + 4);
    const float gw[8] = {g0.x, g0.y, g0.z, g0.w, g1.x, g1.y, g1.z, g1.w};
    float res[8];
#pragma unroll
    for (int e = 0; e < 8; ++e) res[e] = o[e] * rr * gw[e] * silu_f(z[e]);
    *(uint4*)(p.y + (size_t)t * DM + 512 + lane * 8) = pack8(res);
  }
}

struct EpiWout {
  static constexpr bool PERM = false;
  const float* xin; float* xout; const float* mod_l;
  DEV void operator()(const f32x4 (&acc)[2][2][4][2], const GUnit& u, int wr, int wc, int fr, int fq) const {
    const int row0 = u.pm * 256 + wr * 64 + fr, col0 = u.pn * 256 + wc * 32 + 4 * fq;
    const float* gate = mod_l + ((u.pm * 256) / T) * 6144 + MOD_GATE1;
    f32x4 gv[2][2];
#pragma unroll
    for (int bj = 0; bj < 2; ++bj)
#pragma unroll
      for (int n = 0; n < 2; ++n) gv[bj][n] = *(const f32x4*)(gate + col0 + bj * G_HALF + n * 16);
#pragma unroll
    for (int ai = 0; ai < 2; ++ai)
#pragma unroll
      for (int m = 0; m < 4; ++m) {
        const size_t ro = (size_t)(row0 + ai * G_HALF + m * 16) * DM + col0;
#pragma unroll
        for (int bj = 0; bj < 2; ++bj)
#pragma unroll
          for (int n = 0; n < 2; ++n) {
            const f32x4 xi = *(const f32x4*)(xin + ro + bj * G_HALF + n * 16);
            *(f32x4*)(xout + ro + bj * G_HALF + n * 16) = xi + gv[bj][n] * acc[ai][bj][m][n];
          }
      }
  }
};

DEV void phase_gemm_wout(const Params& p, int l, const float* xin, int bid, int nb, char* smem) {
  DenseSched S;
  S.A = p.y; S.Bt = p.btout; S.K = DM; S.nM = NTOK / 256; S.nN = DM / 256; S.nwg = S.nM * S.nN; S.G = nb; S.c = bid; S.wv = p.wv;
  EpiWout E;
  E.xin = xin; E.xout = p.xbuf; E.mod_l = p.mod + l * 2 * 6144;
  gemm_phase((LAS unsigned char*)smem, S, E);
}

DEV void phase_consts(const Params& p, int bid, int nb) {
  const int tid = fresh_tid(), lane = tid & 63, wid = tid >> 6;
  for (int g = bid * NTHR + tid; g < DEPTH * DM * 48; g += nb * NTHR) {
    const int n = g % 48, lk = g / 48;
    float v = 0.f;
    if (n < 4) v = p.rg_w[(size_t)lk * 4 + n];
    else if (n < 36) v = p.re_w[(size_t)lk * 32 + (n - 4)];
    p.wcat[g] = v;
  }
  for (int g = bid * NTHR + tid; g < DEPTH * NB * DM; g += nb * NTHR) {
    const int k = g & (DM - 1), lb = g >> 10, l = lb >> 1;
    p.wsc2[g] = p.norm_ffn_w[l * DM + k] * (1.f + p.mod[lb * 6144 + MOD_SCALE2 + k]);
  }
  for (int o = bid * NWAVE + wid; o < DEPTH * NB * 48; o += nb * NWAVE) {
    const int n = o % 48, lb = o / 48, l = lb >> 1;
    float s = 0.f;
    if (n < 36) {
#pragma unroll
      for (int k16 = 0; k16 < DM / 64; ++k16) {
        const int k = lane + 64 * k16;
        const float w = (n < 4) ? p.rg_w[((size_t)l * DM + k) * 4 + n] : p.re_w[((size_t)l * DM + k) * 32 + (n - 4)];
        s += p.mod[lb * 6144 + MOD_SHIFT2 + k] * w;
      }
      s = wave_sum(s, lane);
      s += (n < 4) ? p.rg_b[l * 4 + n] : p.re_b[l * 32 + (n - 4)];
    }
    if (lane == 0) p.c0[o] = s;
  }
}

DEV void phase_router(const Params& p, int l, int bid, int nb, char* smem) {
  float* accb = (float*)smem;
  float* ssqb = accb + 2 * 64 * 49;
  float* rsl = ssqb + 128;
  int* lcnt = (int*)(rsl + 64);
  int* lbase = lcnt + NEXP;
  const int tid = fresh_tid(), lane = tid & 63, wid = tid >> 6, fr = lane & 15, fq = lane >> 4;
  const int tg = wid & 3, kh = wid >> 2;
  int sel_e0 = 0, sel_e1 = 0, sel_r0 = 0, sel_r1 = 0;
  if (tid < NEXP) lcnt[tid] = 0;
  __syncthreads();
  for (int tb = bid; tb < NTOK / 64; tb += nb) {
    const int tok0 = tb * 64;
    const int b = tok0 / T;
    const float* wsc = p.wsc2 + (l * 2 + b) * DM;
    {
      float* Bs = (float*)(smem + 32768);
      const float* xr = p.xbuf + (size_t)(tok0 + tg * 16 + fr) * DM + kh * 512 + fq * 4;
      const float* wv = wsc + kh * 512 + fq * 4;
      const float* wl = p.wcat + (size_t)l * DM * 48;
      f32x4 acc[3];
#pragma unroll
      for (int nt = 0; nt < 3; ++nt) acc[nt] = f32x4{0.f, 0.f, 0.f, 0.f};
      float ssq = 0.f;
      float4 rbv[3], xa[4], wa[4], xn[4], wn[4];
      auto gloadB = [&](int s) {
#pragma unroll
        for (int i = 0; i < 3; ++i) {
          const int idx = tid + NTHR * i, half = idx / 768, r = idx - half * 768, krow = r / 12, c4 = r - krow * 12;
          rbv[i] = *(const float4*)(wl + (size_t)(half * 512 + 64 * s + krow) * 48 + c4 * 4);
        }
      };
      auto storeB = [&](int buf) {
#pragma unroll
        for (int i = 0; i < 3; ++i) {
          const int idx = tid + NTHR * i, half = idx / 768, r = idx - half * 768, krow = r / 12, c4 = r - krow * 12;
          *(float4*)(Bs + ((buf * 2 + half) * 64 + krow) * 48 + c4 * 4) = rbv[i];
        }
      };
      auto gloadA = [&](float4 (&xd)[4], float4 (&wd)[4], int s) {
#pragma unroll
        for (int c = 0; c < 4; ++c) {
          xd[c] = *(const float4*)(xr + 64 * s + c * 16);
          wd[c] = *(const float4*)(wv + 64 * s + c * 16);
        }
      };
      gloadB(0);
      gloadA(xa, wa, 0);
      storeB(0);
      __syncthreads();
#pragma unroll 1
      for (int s = 0; s < 8; ++s) {
        const int sn = min(s + 1, 7);
        gloadB(sn);
        gloadA(xn, wn, sn);
        const float* bt = Bs + (((s & 1) * 2 + kh) * 64 + fq) * 48 + fr;
#pragma unroll
        for (int c = 0; c < 4; ++c) {
          const float4 xv = xa[c], ww = wa[c];
          ssq += xv.x * xv.x + xv.y * xv.y + xv.z * xv.z + xv.w * xv.w;
          const float a0 = xv.x * ww.x, a1 = xv.y * ww.y, a2 = xv.z * ww.z, a3 = xv.w * ww.w;
          const float* bp = bt + (16 * c + 3 * fq) * 48;
#pragma unroll
          for (int nt = 0; nt < 3; ++nt) {
            acc[nt] = __builtin_amdgcn_mfma_f32_16x16x4f32(a0, bp[0 * 48 + nt * 16], acc[nt], 0, 0, 0);
            acc[nt] = __builtin_amdgcn_mfma_f32_16x16x4f32(a1, bp[1 * 48 + nt * 16], acc[nt], 0, 0, 0);
            acc[nt] = __builtin_amdgcn_mfma_f32_16x16x4f32(a2, bp[2 * 48 + nt * 16], acc[nt], 0, 0, 0);
            acc[nt] = __builtin_amdgcn_mfma_f32_16x16x4f32(a3, bp[3 * 48 + nt * 16], acc[nt], 0, 0, 0);
          }
        }
        storeB((s + 1) & 1);
        __syncthreads();
#pragma unroll
        for (int c = 0; c < 4; ++c) { xa[c] = xn[c]; wa[c] = wn[c]; }
      }
      ssq += shx(ssq, 16, lane);
      ssq += shx(ssq, 32, lane);
#pragma unroll
      for (int nt = 0; nt < 3; ++nt)
#pragma unroll
        for (int j = 0; j < 4; ++j) accb[(kh * 64 + tg * 16 + fq * 4 + j) * 49 + nt * 16 + fr] = acc[nt][j];
      if (fq == 0) ssqb[kh * 64 + tg * 16 + fr] = ssq;
    }
    __syncthreads();
    if (tid < 64) {
      const int t = tok0 + tid;
      const float rstd = rsqrtf((ssqb[tid] + ssqb[64 + tid]) * (1.f / DM) + EPS);
      rsl[tid] = rstd;
      const float* c0 = p.c0 + (l * 2 + b) * 48;
      float acc[36];
#pragma unroll
      for (int o = 0; o < 36; ++o) acc[o] = rstd * (accb[tid * 49 + o] + accb[(64 + tid) * 49 + o]) + c0[o];
      int grp = 0;
      float mx = acc[0];
#pragma unroll
      for (int g = 1; g < 4; ++g)
        if (acc[g] > mx) { mx = acc[g]; grp = g; }
      float den = 0.f;
#pragma unroll
      for (int g = 0; g < 4; ++g) den += __expf(acc[g] - mx);
      const float pg_top = 1.f / den;
      float el[8];
#pragma unroll
      for (int j = 0; j < 8; ++j) {
        const float a0 = acc[4 + j], a1 = acc[12 + j], a2 = acc[20 + j], a3 = acc[28 + j];
        el[j] = (grp == 0) ? a0 : (grp == 1) ? a1 : (grp == 2) ? a2 : a3;
      }
      float b0 = -3.0e38f, b1 = -3.0e38f;
      int i0 = 0, i1 = 0;
#pragma unroll
      for (int j = 0; j < 8; ++j)
        if (el[j] > b0) { b0 = el[j]; i0 = j; }
#pragma unroll
      for (int j = 0; j < 8; ++j)
        if (j != i0 && el[j] > b1) { b1 = el[j]; i1 = j; }
      const float ex = __expf(b1 - b0);
      const float g0 = pg_top / (1.f + ex), g1 = pg_top * ex / (1.f + ex);
      const int e0 = grp * 8 + i0, e1 = grp * 8 + i1;
      sel_e0 = e0; sel_e1 = e1;
      sel_r0 = atomicAdd(&lcnt[e0], 1);
      sel_r1 = atomicAdd(&lcnt[e1], 1);
      p.sgate[2 * t] = g0;
      p.sgate[2 * t + 1] = g1;
    }
    __syncthreads();
    if (tid < NEXP) {
      const int c = lcnt[tid];
      lbase[tid] = (c > 0) ? atomicAdd(&p.cnt[l * NEXP + tid], c) : 0;
      lcnt[tid] = 0;
    }
    __syncthreads();
    if (tid < 64) {
      const int t = tok0 + tid;
      p.list[sel_e0 * CAP + lbase[sel_e0] + sel_r0] = 2 * t;
      p.list[sel_e1 * CAP + lbase[sel_e1] + sel_r1] = 2 * t + 1;
    }
    {
      const float* sh = p.mod + (l * 2 + b) * 6144 + MOD_SHIFT2;
#pragma unroll 2
      for (int q = 0; q < 8; ++q) {
        const int tl = wid * 8 + q;
        const float rstd = rsl[tl];
        const float4* xr = (const float4*)(p.xbuf + (size_t)(tok0 + tl) * DM);
#pragma unroll
        for (int i = 0; i < 4; ++i) {
          const int idx = (lane + 64 * i) * 4;
          const float4 xv = xr[lane + 64 * i];
          const float4 w = *(const float4*)(wsc + idx);
          const float4 h = *(const float4*)(sh + idx);
          uint2 pk;
          pk.x = pack2(xv.x * w.x * rstd + h.x, xv.y * w.y * rstd + h.y);
          pk.y = pack2(xv.z * w.z * rstd + h.z, xv.w * w.w * rstd + h.w);
          *(uint2*)(p.act + (size_t)(tok0 + tl) * DM + idx) = pk;
        }
      }
    }
    __syncthreads();
  }
}

struct EpiMoe {
  static constexpr bool PERM = true;
  bf16_t* H; bf16_t* Y; const int* list; const float* sgate;
  DEV void operator()(const f32x4 (&acc)[2][2][4][2], const GUnit& u, int wr, int wc, int fr_, int fq) const {
    int fr = fr_;
    asm volatile("" : "+v"(fr));
    if (!u.ph) {
      const __amdgpu_buffer_rsrc_t rh = __builtin_amdgcn_make_buffer_rsrc((void*)H, 0, 2 * 32768 * DEXP, 0x00020000);
      const int hcol = u.pn * 128 + wc * 32 + 8 * fq;
#pragma unroll
      for (int ai = 0; ai < 2; ++ai)
#pragma unroll
        for (int m = 0; m < 4; ++m) {
          const int rl = ai * G_HALF + wr * 64 + m * 16 + fr;
          if (rl < u.valid) {
            const int slot = list[u.e * CAP + u.pm * 256 + rl];
            float h[8];
#pragma unroll
            for (int n = 0; n < 2; ++n)
#pragma unroll
              for (int j = 0; j < 4; ++j) h[n * 4 + j] = silu_f(acc[ai][0][m][n][j]) * acc[ai][1][m][n][j];
            const uint4 pk = pack8(h);
            const u32x4 pv = {pk.x, pk.y, pk.z, pk.w};
            __builtin_amdgcn_raw_buffer_store_b128(pv, rh, (slot * DEXP + hcol) * 2, 0, 16  );
          }
        }
    } else {
      const int col0 = u.pn * 256 + wc * 32 + 8 * fq;
#pragma unroll
      for (int ai = 0; ai < 2; ++ai)
#pragma unroll
        for (int m = 0; m < 4; ++m) {
          const int rl = ai * G_HALF + wr * 64 + m * 16 + fr;
          if (rl < u.valid) {
            const int slot = list[u.e * CAP + u.pm * 256 + rl];
            const float g = sgate[slot];
#pragma unroll
            for (int bj = 0; bj < 2; ++bj) {
              float yv[8];
#pragma unroll
              for (int n = 0; n < 2; ++n)
#pragma unroll
                for (int j = 0; j < 4; ++j) yv[n * 4 + j] = g * acc[ai][bj][m][n][j];
              *(uint4*)(Y + (size_t)slot * DM + col0 + bj * G_HALF) = pack8(yv);
            }
          }
        }
    }
  }
};

DEV void phase_moe(const Params& p, int l, int bid, int nb, char* smem) {
  MoeSched S;
  S.act = p.act; S.hbuf = p.hbuf; S.bt1 = p.bt1; S.bt2 = p.bt2; S.cnt = p.cnt + l * NEXP; S.list = p.list;
  S.rdy = p.bar + XB_RDY + l * 192; S.tmo = p.bar + XB_TMO; S.G = nb; S.c = bid; S.wv = p.wv;
  EpiMoe E;
  E.H = p.hbuf; E.Y = p.ybuf; E.list = p.list; E.sgate = p.sgate;
  gemm_phase((LAS unsigned char*)smem, S, E);
}

DEV void phase_combine(const Params& p, int l, int bid, int nb) {
  const int tid_ = fresh_tid(), lane = tid_ & 63, wid = tid_ >> 6;
  for (int t = bid * NWAVE + wid; t < NTOK; t += nb * NWAVE) {
    float4* xr = (float4*)(p.xbuf + (size_t)t * DM);
    const int b = t / T;
    const float* md = p.mod + (l * 2 + b) * 6144;
    float4 v[4];
    float ss = 0.f;
#pragma unroll
    for (int i = 0; i < 4; ++i) {
      const int idx = (lane + 64 * i) * 4;
      v[i] = xr[lane + 64 * i];
      const float4 g = *(const float4*)(md + MOD_GATE2 + idx);
      const uint2 ya = *(const uint2*)(p.ybuf + (size_t)(2 * t) * DM + idx);
      const uint2 yb = *(const uint2*)(p.ybuf + (size_t)(2 * t + 1) * DM + idx);
      v[i].x += g.x * (__uint_as_float(ya.x << 16) + __uint_as_float(yb.x << 16));
      v[i].y += g.y * (__uint_as_float(ya.x & 0xffff0000u) + __uint_as_float(yb.x & 0xffff0000u));
      v[i].z += g.z * (__uint_as_float(ya.y << 16) + __uint_as_float(yb.y << 16));
      v[i].w += g.w * (__uint_as_float(ya.y & 0xffff0000u) + __uint_as_float(yb.y & 0xffff0000u));
      ss += v[i].x * v[i].x + v[i].y * v[i].y + v[i].z * v[i].z + v[i].w * v[i].w;
    }
    ss = wave_sum(ss, lane);
    const float rstd = rsqrtf(ss * (1.f / DM) + EPS);
    if (l + 1 < DEPTH) {
#pragma unroll
      for (int i = 0; i < 4; ++i) xr[lane + 64 * i] = v[i];
      const float* md2 = p.mod + ((l + 1) * 2 + b) * 6144;
      norm_mod_store(v, rstd, p.norm_mix_w + (l + 1) * DM, md2 + MOD_SCALE1, md2 + MOD_SHIFT1,
                     p.act + (size_t)t * DM, lane);
    } else {
      float4* orow = (float4*)(p.out + (size_t)t * DM);
#pragma unroll
      for (int i = 0; i < 4; ++i) {
        const float4 w = *(const float4*)(p.final_w + (lane + 64 * i) * 4);
        float4 r;
        r.x = v[i].x * rstd * w.x;
        r.y = v[i].y * rstd * w.y;
        r.z = v[i].z * rstd * w.z;
        r.w = v[i].w * rstd * w.w;
        orow[lane + 64 * i] = r;
      }
    }
  }
}

constexpr size_t ws_align(size_t b) { return (b + 255) & ~(size_t)255; }
constexpr size_t WS_bar = 0;
constexpr size_t WS_mod = WS_bar + ws_align(sizeof(unsigned) * BAR_WORDS_TOTAL);
constexpr size_t WS_btin = WS_mod + ws_align(sizeof(float) * DEPTH * NB * 6144);
constexpr size_t WS_btg = WS_btin + ws_align(2 * (size_t)PROJW * DM);
constexpr size_t WS_btout = WS_btg + ws_align(2 * (size_t)16 * DM);
constexpr size_t WS_bt1 = WS_btout + ws_align(2 * (size_t)DM * DM);
constexpr size_t WS_bt2 = WS_bt1 + ws_align(2 * (size_t)NEXP * 1024 * DM);
constexpr size_t WS_wcat = WS_bt2 + ws_align(2 * (size_t)NEXP * DM * DEXP);
constexpr size_t WS_wsc2 = WS_wcat + ws_align(sizeof(float) * DEPTH * DM * 48);
constexpr size_t WS_c0 = WS_wsc2 + ws_align(sizeof(float) * DEPTH * NB * DM);
constexpr size_t WS_cnt = WS_c0 + ws_align(sizeof(float) * DEPTH * NB * 48);
constexpr size_t WS_xbuf = WS_cnt + ws_align(sizeof(int) * DEPTH * NEXP);
constexpr size_t WS_act = WS_xbuf + ws_align(sizeof(float) * (size_t)NTOK * DM);
constexpr size_t WS_proj = WS_act + ws_align(2 * (size_t)NTOK * DM);
constexpr size_t WS_gates = WS_proj + ws_align(2 * (size_t)NTOK * PROJW);
constexpr size_t WS_y = WS_gates + ws_align(sizeof(float) * (size_t)NTOK * 16);
constexpr size_t WS_list = WS_y + ws_align(2 * (size_t)NTOK * DM);
constexpr size_t WS_sgate = WS_list + ws_align(sizeof(int) * NEXP * CAP);
constexpr size_t WS_egl = WS_sgate + ws_align(sizeof(float) * 2 * NTOK);
constexpr size_t WS_obuf = WS_egl + ws_align(sizeof(float) * 2048);
constexpr size_t WS_gdn_rec = WS_obuf + ws_align(2 * 2 * (size_t)NTOK * 512);
constexpr size_t WS_gdn_u = WS_gdn_rec + ws_align((size_t)2048 * REC_BYTES);
constexpr size_t WS_TOTAL = WS_gdn_u + ws_align(sizeof(unsigned) * (size_t)2048 * 32 * 128);

struct KArgs {
  const float *x, *c, *norm_mix_w, *norm_ffn_w, *w_ada, *b_ada, *w_in, *conv_a_w, *na_rpb, *gdn_conv_w,
      *gdn_a_log, *gdn_dt_bias, *gdn_norm_w, *w_out, *rg_w, *rg_b, *re_w, *re_b, *ew1, *ew3, *ew2, *final_w;
  float* out;
  char* ws;
  int rep[12];
};
DEV Params make_params(const KArgs& a) {
  Params p;
  p.x = a.x; p.c = a.c; p.norm_mix_w = a.norm_mix_w; p.norm_ffn_w = a.norm_ffn_w; p.w_ada = a.w_ada; p.b_ada = a.b_ada;
  p.w_in = a.w_in; p.conv_a_w = a.conv_a_w; p.na_rpb = a.na_rpb; p.gdn_conv_w = a.gdn_conv_w; p.gdn_a_log = a.gdn_a_log;
  p.gdn_dt_bias = a.gdn_dt_bias; p.gdn_norm_w = a.gdn_norm_w; p.w_out = a.w_out; p.rg_w = a.rg_w; p.rg_b = a.rg_b;
  p.re_w = a.re_w; p.re_b = a.re_b; p.ew1 = a.ew1; p.ew3 = a.ew3; p.ew2 = a.ew2; p.final_w = a.final_w;
  p.out = a.out;
  p.bar = (unsigned*)(a.ws + WS_bar);
  p.mod = (float*)(a.ws + WS_mod);
  p.btin = (bf16_t*)(a.ws + WS_btin);
  p.btg = (bf16_t*)(a.ws + WS_btg);
  p.btout = (bf16_t*)(a.ws + WS_btout);
  p.bt1 = (bf16_t*)(a.ws + WS_bt1);
  p.bt2 = (bf16_t*)(a.ws + WS_bt2);
  p.wcat = (float*)(a.ws + WS_wcat);
  p.wsc2 = (float*)(a.ws + WS_wsc2);
  p.c0 = (float*)(a.ws + WS_c0);
  p.cnt = (int*)(a.ws + WS_cnt);
  p.xbuf = (float*)(a.ws + WS_xbuf);
  p.act = (bf16_t*)(a.ws + WS_act);
  p.proj = (bf16_t*)(a.ws + WS_proj);
  p.gates = (float*)(a.ws + WS_gates);
  p.y = (bf16_t*)(a.ws + WS_y);
  p.list = (int*)(a.ws + WS_list);
  p.sgate = (float*)(a.ws + WS_sgate);
  p.egl = (float*)(a.ws + WS_egl);
  p.obuf = (bf16_t*)(a.ws + WS_obuf);
  p.gdn_rec = (char*)(a.ws + WS_gdn_rec);
  p.gdn_u = (unsigned*)(a.ws + WS_gdn_u);
  p.hbuf = (bf16_t*)p.obuf;
  p.ybuf = (bf16_t*)p.gdn_rec;
#pragma unroll
  for (int i = 0; i < 12; ++i) p.rep[i] = a.rep[i];
  p.wv = __builtin_amdgcn_readfirstlane((int)(threadIdx.x >> 6));
  return p;
}

__global__ void __launch_bounds__(NTHR) mega_kernel(KArgs ka) {
  const Params p = make_params(ka);
  __shared__ __attribute__((aligned(16))) char smem[SMEM_BYTES + 16];
  const int bid0 = blockIdx.x, nb = gridDim.x;
  if (fresh_tid() == 0) *(uint4*)(smem + SMEM_BYTES) = make_uint4(0u, 0u, 0u, 0u);
  __syncthreads();
  xcd_barrier_post(p.bar, fresh_tid());
#pragma unroll 1
  for (int rp = 0; rp < p.rep[7]; ++rp) {
    phase_ada(p, bid0, nb, smem);
    convert_win(p, 0, bid0, nb, smem);
  }
  xcd_barrier(p.bar, (volatile LAS unsigned*)(smem + SMEM_BYTES), fresh_tid());
#pragma unroll 1
  for (int rp = 0; rp < p.rep[8]; ++rp) {
    phase_hmix(p, 0, p.x, bid0, nb);
    phase_consts(p, bid0, nb);
  }
  xcd_barrier(p.bar, (volatile LAS unsigned*)(smem + SMEM_BYTES), fresh_tid());
#pragma unroll 1
  for (int l = 0; l < DEPTH; ++l) {
    int lz = l;
    asm volatile("" : "+s"(lz));
    const int bid = bid0 + (lz - l);
#pragma unroll 1
    for (int rp = 0; rp < p.rep[0]; ++rp) phase_gemm_proj(p, l, bid, nb, smem);
    xcd_barrier(p.bar, (volatile LAS unsigned*)(smem + SMEM_BYTES), fresh_tid());
#pragma unroll 1
    for (int rp = 0; rp < p.rep[1]; ++rp) phase_gdn_prep(p, l, bid, nb, smem);
    xcd_barrier(p.bar, (volatile LAS unsigned*)(smem + SMEM_BYTES), fresh_tid());
#pragma unroll 1
    for (int rp = 0; rp < p.rep[2]; ++rp) {
      if (bid < 16) {
        phase_gdn_scan(p, l * 4 + rp + 1, bid, smem);
      } else if (bid < 64) {
        phase_scan_helper(p, l * 4 + rp + 1, (bid - 16) & 15, (bid - 16) >> 4, smem);
      } else {
#pragma unroll 1
        for (int rq = 0; rq < p.rep[6]; ++rq) {
          phase_conv(p, l, bid - 64, nb - 64);
          phase_na(p, l, (bid - 64) * NWAVE + (fresh_tid() >> 6), (nb - 64) * NWAVE);
        }
#pragma unroll 1
        for (int rq = 0; rq < p.rep[10]; ++rq) convert_layer(p, l, bid - 64, nb - 64, smem);
      }
    }
    xcd_barrier(p.bar, (volatile LAS unsigned*)(smem + SMEM_BYTES), fresh_tid());
#pragma unroll 1
    for (int rp = 0; rp < p.rep[5]; ++rp) phase_gdn_fin(p, l, bid, nb);
    xcd_barrier(p.bar, (volatile LAS unsigned*)(smem + SMEM_BYTES), fresh_tid());
#pragma unroll 1
    for (int rp = 0; rp < (l == 0 ? p.rep[9] : 1); ++rp) phase_gemm_wout(p, l, l == 0 ? p.x : p.xbuf, bid, nb, smem);
    xcd_barrier(p.bar, (volatile LAS unsigned*)(smem + SMEM_BYTES), fresh_tid());
    phase_router(p, l, bid, nb, smem);
    xcd_barrier(p.bar, (volatile LAS unsigned*)(smem + SMEM_BYTES), fresh_tid());
    phase_moe(p, l, bid, nb, smem);
    xcd_barrier(p.bar, (volatile LAS unsigned*)(smem + SMEM_BYTES), fresh_tid());
    phase_combine(p, l, bid, nb);
#pragma unroll 1
    for (int rp = 1; rp < p.rep[11]; ++rp) xcd_barrier(p.bar, (volatile LAS unsigned*)(smem + SMEM_BYTES), fresh_tid());
    if (l + 1 < DEPTH) xcd_barrier(p.bar, (volatile LAS unsigned*)(smem + SMEM_BYTES), fresh_tid());
  }
}

extern "C" void kernel_launch(void* const* d_in, const int* in_sizes, int n_in, void* d_out, int out_size,
                              void* d_ws, size_t ws_size, hipStream_t stream) {
  KArgs p{};
  p.x = (const float*)d_in[0];
  p.c = (const float*)d_in[1];
  p.norm_mix_w = (const float*)d_in[2];
  p.norm_ffn_w = (const float*)d_in[3];
  p.w_ada = (const float*)d_in[4];
  p.b_ada = (const float*)d_in[5];
  p.w_in = (const float*)d_in[6];
  p.conv_a_w = (const float*)d_in[7];
  p.na_rpb = (const float*)d_in[8];
  p.gdn_conv_w = (const float*)d_in[9];
  p.gdn_a_log = (const float*)d_in[10];
  p.gdn_dt_bias = (const float*)d_in[11];
  p.gdn_norm_w = (const float*)d_in[12];
  p.w_out = (const float*)d_in[13];
  p.rg_w = (const float*)d_in[14];
  p.rg_b = (const float*)d_in[15];
  p.re_w = (const float*)d_in[16];
  p.re_b = (const float*)d_in[17];
  p.ew1 = (const float*)d_in[18];
  p.ew3 = (const float*)d_in[19];
  p.ew2 = (const float*)d_in[20];
  p.final_w = (const float*)d_in[21];
  p.out = (float*)d_out;
  p.ws = (char*)d_ws;
  if (WS_TOTAL > ws_size) fprintf(stderr, "workspace too small: need %zu have %zu\n", (size_t)WS_TOTAL, ws_size);

  static int grid_blocks = 0;
  if (!grid_blocks) {
    int dev = 0, cus = 0, per_cu = 0;
    (void)hipGetDevice(&dev);
    (void)hipDeviceGetAttribute(&cus, hipDeviceAttributeMultiprocessorCount, dev);
    (void)hipOccupancyMaxActiveBlocksPerMultiprocessor(&per_cu, mega_kernel, NTHR, 0);
    if (per_cu > 1) per_cu = 1;
    if (per_cu < 1) per_cu = 1;
    grid_blocks = cus * per_cu;
  }
  (void)hipMemsetAsync((char*)d_ws + WS_bar, 0, sizeof(unsigned) * BAR_WORDS_TOTAL, stream);
  for (int i = 0; i < 12; ++i) p.rep[i] = 1;
  void* args[] = {&p};
  hipError_t e = hipLaunchCooperativeKernel((void*)mega_kernel, dim3(grid_blocks), dim3(NTHR), args, 0, stream);
  if (e != hipSuccess) fprintf(stderr, "cooperative launch failed: %s (grid %d)\n", hipGetErrorString(e), grid_blocks);
}
```

```cpp
#include <hip/hip_runtime.h>
#include <hip/hip_cooperative_groups.h>
#include <stdint.h>
#include <stdio.h>

#define DEV __device__ __forceinline__
namespace cg = cooperative_groups;

typedef __attribute__((ext_vector_type(8))) short bf16x8;
typedef __attribute__((ext_vector_type(4))) float f32x4;
typedef __attribute__((ext_vector_type(16))) float f32x16;
typedef float f32x2_t __attribute__((ext_vector_type(2)));
typedef __bf16 bf16x2_t __attribute__((ext_vector_type(2)));
typedef unsigned short bf16_t;
typedef unsigned u32x4 __attribute__((ext_vector_type(4)));

constexpr int NTHR = 512;
constexpr int NWAVE = 8;
constexpr int DM = 1024;
constexpr int NB = 2;
constexpr int T = 8192;
constexpr int NTOK = NB * T;
constexpr int DEPTH = 2;
constexpr int DIN = 3600;
constexpr int PROJW = 3584;
constexpr int NEXP = 32;
constexpr int DEXP = 512;
constexpr int CAP = 16384;
constexpr float EPS = 1e-6f;
constexpr int OFF_CB = 0, OFF_CC = 256, OFF_CX = 512, OFF_NQ = 768, OFF_NK = 1024, OFF_NV = 1280,
              OFF_GQKV = 1536, OFF_GZ = 3072;
constexpr int MOD_SHIFT1 = 0, MOD_SCALE1 = 1024, MOD_GATE1 = 2048, MOD_SHIFT2 = 3072, MOD_SCALE2 = 4096,
              MOD_GATE2 = 5120;

constexpr int REC_WN = 0, REC_QD = 16384, REC_IN = 32768, REC_KT = 40960, REC_BYTES = 57344;
constexpr int SC_WN = 0, SC_QD = 17408, SC_IN = 34816, SC_KT = 44032, SC_U = 62464, SC_BUF = 78848;
constexpr int PL_Q = 0, PL_K = 17408, PL_V = 34816, PL_L = 52224, PL_GC = 87040, PL_BETA = 87552, PL_BG = 88064,
              PL_GL = 88576, PL_FQ = 88592  , PL_FK = 89104  ,
              PL_CW = 89616  ;
constexpr int SMEM_BYTES = 2 * SC_BUF;

struct Params {
  const float *x, *c, *norm_mix_w, *norm_ffn_w, *w_ada, *b_ada, *w_in, *conv_a_w, *na_rpb, *gdn_conv_w,
      *gdn_a_log, *gdn_dt_bias, *gdn_norm_w, *w_out, *rg_w, *rg_b, *re_w, *re_b, *ew1, *ew3, *ew2, *final_w;
  float* out;
  float* mod;
  int* cnt;
  float* xbuf;
  bf16_t* act;
  bf16_t* proj;
  float* gates;
  bf16_t* y;
  bf16_t* obuf;
  char* gdn_rec;
  unsigned* gdn_u;
  float* egl;
  bf16_t* hbuf;
  bf16_t* ybuf;
  int* list;
  float* sgate;
  bf16_t* btin;
  bf16_t* btg;
  bf16_t* btout;
  bf16_t* bt1;
  bf16_t* bt2;
  float* wcat;
  float* wsc2;
  float* c0;
  unsigned* bar;
  int rep[12];
  int wv;
};

DEV unsigned pack2(float a, float b) {
  f32x2_t v = {a, b};
  return __builtin_bit_cast(unsigned, __builtin_convertvector(v, bf16x2_t));
}
DEV bf16_t f2bf(float f) { return (bf16_t)(pack2(f, 0.f) & 0xffffu); }
DEV float bf2f(bf16_t h) { return __uint_as_float(((unsigned)h) << 16); }
DEV float silu_f(float x) { return x * __builtin_amdgcn_rcpf(1.f + __expf(-x)); }
DEV float sigmoid_f(float x) { return __builtin_amdgcn_rcpf(1.f + __expf(-x)); }
DEV float softplus_f(float x) { return fmaxf(x, 0.f) + log1pf(__expf(-fabsf(x))); }
DEV float shx(float v, int k, int lane) {
  return __int_as_float(__builtin_amdgcn_ds_bpermute((lane ^ k) << 2, __float_as_int(v)));
}
DEV float wave_sum(float v, int lane) {
#pragma unroll
  for (int o = 32; o > 0; o >>= 1) v += shx(v, o, lane);
  return v;
}
DEV int fresh_tid_w(int wv) {
  unsigned z = 0u;
  asm volatile("" : "+s"(wv), "+v"(z));
  int t = (wv << 6) | (int)__builtin_amdgcn_mbcnt_hi(~0u, __builtin_amdgcn_mbcnt_lo(~0u, z));
  asm volatile("" : "+v"(t));
  return t;
}
#define fresh_tid() fresh_tid_w(p.wv)
DEV void unpack8(uint4 u, float* f) {
  f[0] = __uint_as_float(u.x << 16);
  f[1] = __uint_as_float(u.x & 0xffff0000u);
  f[2] = __uint_as_float(u.y << 16);
  f[3] = __uint_as_float(u.y & 0xffff0000u);
  f[4] = __uint_as_float(u.z << 16);
  f[5] = __uint_as_float(u.z & 0xffff0000u);
  f[6] = __uint_as_float(u.w << 16);
  f[7] = __uint_as_float(u.w & 0xffff0000u);
}
DEV uint4 pack8(const float* f) {
  uint4 r;
  r.x = pack2(f[0], f[1]);
  r.y = pack2(f[2], f[3]);
  r.z = pack2(f[4], f[5]);
  r.w = pack2(f[6], f[7]);
  return r;
}
#define MFMA16(a, b, c) __builtin_amdgcn_mfma_f32_16x16x32_bf16((a), (b), (c), 0, 0, 0)
#define MFMA32(a, b, c) __builtin_amdgcn_mfma_f32_32x32x16_bf16((a), (b), (c), 0, 0, 0)

#define LAS __attribute__((address_space(3)))
#define XB_TMO      128
#define XB_XCNT(j)  (256  + 64 * (j))
#define XB_XSUB(j)  (1280 + 64 * (j))
#define XB_XGEN(j)  (2304 + 64 * (j))
#define XB_TOP      3328
#define XB_TOPGEN   3392
#define XCD_BAR_WORDS 3456
#define XB_PROG(c)   (3456 + 64 * (c))
#define XB_CXCC(c)   (3456 + 1024 + 64 * (c))
#define XB_RDY       (3456 + 2048)
#define BAR_WORDS_TOTAL (3456 + 2048 + 384)
#define XB_SPIN_CAP (1u << 22)

DEV unsigned xb_ld(unsigned* p) { return __hip_atomic_load(p, __ATOMIC_RELAXED, __HIP_MEMORY_SCOPE_AGENT); }
DEV unsigned xb_add(unsigned* p, unsigned v) { return __hip_atomic_fetch_add(p, v, __ATOMIC_RELAXED, __HIP_MEMORY_SCOPE_AGENT); }
DEV unsigned xb_xcc_id() { return (unsigned)__builtin_amdgcn_s_getreg((3 << 11) | 20) & 0xFu; }
#define XB_SPIN(cond, bar) do { unsigned _sp = 0; while (cond) { __builtin_amdgcn_s_sleep(1); \
    if ((++_sp & 255u) == 0u) { if (xb_ld(&(bar)[XB_TMO])) break; if (_sp > XB_SPIN_CAP) { atomicAdd(&(bar)[XB_TMO], 1u); break; } } } } while (0)

DEV void xcd_barrier_post(unsigned* bar, int tid) {
  if (tid == 0) (void)xb_add(&bar[XB_XCNT(xb_xcc_id())], 1u);
}
DEV void xcd_barrier_complete(unsigned* bar, unsigned x, unsigned& nloc, unsigned& nx) {
  const unsigned G = gridDim.x * gridDim.y * gridDim.z;
  unsigned sum, cnt, mine, sp = 0u;
  for (;;) {
    sum = 0u; cnt = 0u; mine = 0u;
#pragma unroll
    for (unsigned j = 0; j < 16; ++j) {
      const unsigned c = xb_ld(&bar[XB_XCNT(j)]);
      sum += c;
      cnt += (c > 0u) ? 1u : 0u;
      mine = (j == x) ? c : mine;
    }
    if (sum == G) break;
    __builtin_amdgcn_s_sleep(1);
    if ((++sp & 255u) == 0u) {
      if (xb_ld(&bar[XB_TMO])) break;
      if (sp > XB_SPIN_CAP) { atomicAdd(&bar[XB_TMO], 1u); break; }
    }
  }
  nloc = mine > 0u ? mine : 1u;
  nx = cnt > 0u ? cnt : 1u;
}
DEV void xcd_barrier(unsigned* bar, volatile LAS unsigned* st, int tid) {
  asm volatile("s_waitcnt vmcnt(0)" ::: "memory");
  __syncthreads();
  if (tid == 0) {
    const unsigned bx = xb_xcc_id();
    __builtin_amdgcn_s_waitcnt(0);
    unsigned nloc = st[0], nx = st[1];
    const unsigned gen = st[2];
    st[2] = gen + 1u;
    if (nloc == 0u) {
      xcd_barrier_complete(bar, bx, nloc, nx);
      st[0] = nloc;
      st[1] = nx;
    }
    const unsigned old = xb_add(&bar[XB_XSUB(bx)], 1u);
    if (old + 1u == (gen + 1u) * nloc) {
      __builtin_amdgcn_fence(__ATOMIC_RELEASE, "agent");
      asm volatile("s_waitcnt vmcnt(0)" ::: "memory");
      const unsigned og = xb_add(&bar[XB_TOP], 1u);
      if (og + 1u == (gen + 1u) * nx) xb_add(&bar[XB_TOPGEN], 1u);
      else XB_SPIN(xb_ld(&bar[XB_TOPGEN]) == gen, bar);
      __builtin_amdgcn_fence(__ATOMIC_ACQUIRE, "agent");
      xb_add(&bar[XB_XGEN(bx)], 1u);
      asm volatile("s_waitcnt vmcnt(0)" ::: "memory");
    } else {
      XB_SPIN(xb_ld(&bar[XB_XGEN(bx)]) == gen, bar);
      __builtin_amdgcn_fence(__ATOMIC_ACQUIRE, "agent");
      asm volatile("s_waitcnt vmcnt(0)" ::: "memory");
    }
  }
  __syncthreads();
}

constexpr int G_BK = 64, G_HALF = 128, G_HTB = G_HALF * G_BK * 2, G_STAGE_BYTES = 8 * G_HTB;
DEV int g_lds_byte(int r, int c) {
  const int st = (r >> 4) * 2 + (c >> 5), rr = r & 15, cc = c & 31, ob = rr * 64 + cc * 2;
  return st * 1024 + (ob ^ (((ob >> 9) & 1) << 5));
}
DEV void g_stage_rc(int b, int& R, int& C) {
  const int st = b / 1024, sb = b % 1024, swz = sb ^ (((sb >> 9) & 1) << 5);
  R = (st >> 1) * 16 + swz / 64;
  C = (st & 1) * 32 + (swz % 64) / 2;
}
DEV int g_perm32(int rho) { const int n = rho >> 4, i = rho & 15; return 8 * (i >> 2) + 4 * n + (i & 3); }

struct GUnit { int pm, pn, e, valid, ph, ridx; };

template <class Epi, class Sched>
DEV void gemm_phase(LAS unsigned char* lds, const Sched& S, const Epi& E) {
  const int tid = fresh_tid_w(S.wv), wid = S.wv, lane = tid & 63, wr = wid >> 2, wc = wid & 3, fr = lane & 15,
            fq = lane >> 4;
  GUnit cur, nxt;
  int ui = 0;
  if (!S.next(0, cur)) return;
  int K = S.kof(cur), nt = K / G_BK;
  unsigned voffB[2];
  auto b_offsets = [&](int Ku) {
    const int tl_ = fresh_tid_w(S.wv);
#pragma unroll
    for (int i = 0; i < 2; ++i) {
      int R, C;
      g_stage_rc(tl_ * 16 + i * 8192, R, C);
      const int Rb = Epi::PERM ? ((R & ~31) + g_perm32(R & 31)) : R;
      voffB[i] = (unsigned)(Rb * Ku + C) * 2u;
    }
  };
  b_offsets(K);
  unsigned vA[2][2];
  auto a_offsets = [&](const GUnit& u) {
    const int tl_ = fresh_tid_w(S.wv);
#pragma unroll
    for (int h = 0; h < 2; ++h)
#pragma unroll
      for (int i = 0; i < 2; ++i) {
        int R, C;
        g_stage_rc(tl_ * 16 + i * 8192, R, C);
        vA[h][i] = S.rowoff(u, h * G_HALF + R) + (unsigned)C * 2u;
      }
  };
  const size_t kstep = (size_t)(G_BK * 2);
  size_t hstep = (size_t)G_HALF * K * 2;
  const unsigned ldsw = (unsigned)wid * 1024u;
  const int aoff = g_lds_byte(wr * 64 + fr, fq * 8), boff = g_lds_byte(wc * 32 + fr, fq * 8);
#define PG8_SA(b, h) (((b) * 2 + (h)) * G_HTB)
#define PG8_SB(b, h) ((4 + (b) * 2 + (h)) * G_HTB)
#define PG8_STAGE(bufoff, gbase, voff) do { _Pragma("unroll") for (int _i = 0; _i < 2; ++_i) \
    __builtin_amdgcn_global_load_lds((const unsigned*)((const char*)(gbase) + (voff)[_i]), (LAS unsigned*)(lds + (bufoff) + ldsw + _i * 8192), 16, 0, 0); } while (0)
#define PG8_LDA(dst, b, h) do { _Pragma("unroll") for (int m = 0; m < 4; ++m) _Pragma("unroll") for (int k = 0; k < 2; ++k) dst[m][k] = *(const LAS bf16x8*)(lds + PG8_SA(b, h) + aoff + m * 2048 + k * 1024); } while (0)
#define PG8_LDB(dst, b, h) do { _Pragma("unroll") for (int n = 0; n < 2; ++n) _Pragma("unroll") for (int k = 0; k < 2; ++k) dst[n][k] = *(const LAS bf16x8*)(lds + PG8_SB(b, h) + boff + n * 2048 + k * 1024); } while (0)
#define PG8_MMA(ai, bj, At, Bt) do { __builtin_amdgcn_s_setprio(1); _Pragma("unroll") for (int m = 0; m < 4; ++m) _Pragma("unroll") for (int n = 0; n < 2; ++n) _Pragma("unroll") for (int k = 0; k < 2; ++k) \
    acc[ai][bj][m][n] = __builtin_amdgcn_mfma_f32_16x16x32_bf16(Bt[n][k], At[m][k], acc[ai][bj][m][n], 0, 0, 0); __builtin_amdgcn_s_setprio(0); } while (0)
#define PG8_WAIT_V(n) asm volatile("s_waitcnt vmcnt(" #n ")" ::: "memory")
#define PG8_WAIT_L(n) asm volatile("s_waitcnt lgkmcnt(" #n ")" ::: "memory")
#define PG8_BAR __builtin_amdgcn_s_barrier()
#define PG8_SCHED __builtin_amdgcn_sched_barrier(0)
  f32x4 acc[2][2][4][2];
#pragma unroll
  for (int a = 0; a < 2; ++a)
#pragma unroll
    for (int b = 0; b < 2; ++b)
#pragma unroll
      for (int m = 0; m < 4; ++m)
#pragma unroll
        for (int n = 0; n < 2; ++n) acc[a][b][m][n] = (f32x4){0.f, 0.f, 0.f, 0.f};
  bf16x8 At[4][2], B0[2][2], B1[2][2];
  const char* gA = S.aptr(cur);
  const char* cB = S.bptr(cur);
  S.a_ready(cur);
  a_offsets(cur);
  PG8_STAGE(PG8_SB(0, 0), cB, voffB); PG8_STAGE(PG8_SA(0, 0), gA, vA[0]); PG8_STAGE(PG8_SB(0, 1), cB + hstep, voffB); PG8_STAGE(PG8_SA(0, 1), gA, vA[1]);
  if (wr == 1) PG8_BAR;
  PG8_WAIT_V(4); PG8_BAR;
  PG8_STAGE(PG8_SB(1, 0), cB + kstep, voffB); PG8_STAGE(PG8_SA(1, 0), gA + kstep, vA[0]); PG8_STAGE(PG8_SB(1, 1), cB + hstep + kstep, voffB);
  PG8_WAIT_V(6); PG8_BAR;
  for (;;) {
    const bool has_next = S.next(ui + 1, nxt);
    const char* nB = has_next ? S.bptr(nxt) : cB;
    for (int t = 0; t < nt; t += 2) {
      const bool last = (t == nt - 2);
      const char* a1 = gA + (size_t)(t + 1) * kstep;
      const char* b2 = last ? nB : cB + (size_t)(t + 2) * kstep;
      const char* b3 = b2 + kstep;
      PG8_LDB(B0, 0, 0); PG8_SCHED; PG8_LDA(At, 0, 0); PG8_STAGE(PG8_SA(1, 1), a1, vA[1]);
      PG8_WAIT_L(8); PG8_BAR; PG8_WAIT_L(0); PG8_MMA(0, 0, At, B0); PG8_BAR; PG8_SCHED;
      if (last && has_next) {
        S.a_ready(nxt);
        a_offsets(nxt);
        gA = S.aptr(nxt);
        const int Kn = S.kof(nxt);
        b_offsets(Kn);
        hstep = (size_t)G_HALF * Kn * 2;
      }
      const char* a2 = last ? gA : gA + (size_t)(t + 2) * kstep;
      const char* a3 = a2 + kstep;
      PG8_LDB(B1, 0, 1); PG8_STAGE(PG8_SB(0, 0), b2, voffB);
      PG8_BAR; PG8_WAIT_L(0); PG8_MMA(0, 1, At, B1); PG8_BAR;
      PG8_LDA(At, 0, 1); PG8_STAGE(PG8_SA(0, 0), a2, vA[0]);
      PG8_BAR; PG8_WAIT_L(0); PG8_MMA(1, 0, At, B0); PG8_BAR; PG8_SCHED;
      PG8_STAGE(PG8_SB(0, 1), b2 + hstep, voffB);
      PG8_WAIT_V(6); PG8_BAR; PG8_MMA(1, 1, At, B1); PG8_BAR;
      PG8_LDB(B0, 1, 0); PG8_SCHED; PG8_LDA(At, 1, 0); PG8_STAGE(PG8_SA(0, 1), a2, vA[1]);
      PG8_WAIT_L(8); PG8_BAR; PG8_WAIT_L(0); PG8_MMA(0, 0, At, B0); PG8_BAR; PG8_SCHED;
      PG8_LDB(B1, 1, 1); PG8_STAGE(PG8_SB(1, 0), b3, voffB);
      PG8_BAR; PG8_WAIT_L(0); PG8_MMA(0, 1, At, B1); PG8_BAR;
      PG8_LDA(At, 1, 1); PG8_STAGE(PG8_SA(1, 0), a3, vA[0]);
      PG8_BAR; PG8_WAIT_L(0); PG8_MMA(1, 0, At, B0); PG8_BAR; PG8_SCHED;
      PG8_STAGE(PG8_SB(1, 1), b3 + hstep, voffB);
      PG8_WAIT_V(6); PG8_BAR; PG8_MMA(1, 1, At, B1); PG8_BAR;
    }
    {
      const int te_ = fresh_tid_w(S.wv), le_ = te_ & 63;
      E(acc, cur, wr, wc, le_ & 15, le_ >> 4);
      S.done(cur, le_);
    }
    if (!has_next) break;
#pragma unroll
    for (int a = 0; a < 2; ++a)
#pragma unroll
      for (int b = 0; b < 2; ++b)
#pragma unroll
        for (int m = 0; m < 4; ++m)
#pragma unroll
          for (int n = 0; n < 2; ++n) acc[a][b][m][n] = (f32x4){0.f, 0.f, 0.f, 0.f};
    cur = nxt; cB = nB; ++ui;
    K = S.kof(cur); nt = K / G_BK;
  }
  PG8_WAIT_V(0);
  if (wr == 0) PG8_BAR;
  PG8_BAR;
#undef PG8_SA
#undef PG8_SB
#undef PG8_STAGE
#undef PG8_LDA
#undef PG8_LDB
#undef PG8_MMA
#undef PG8_WAIT_V
#undef PG8_WAIT_L
#undef PG8_BAR
#undef PG8_SCHED
}

struct DenseSched {
  const bf16_t* A; const bf16_t* Bt; int K, nM, nN, nwg, G, c, wv;
  DEV bool next(int i, GUnit& u) const {
    const long L = (long)i * G + c;
    if (L >= nwg) return false;
    int wgid = (int)L;
    { const int q = nwg / 8, r = nwg % 8, xcd = wgid % 8, off = wgid / 8; wgid = (xcd < r ? xcd * (q + 1) : r * (q + 1) + (xcd - r) * q) + off; }
    const int nig = 8 * nN, gid = wgid / nig, fm = gid * 8;
    u.pm = fm + ((wgid % nig) & 7);
    u.pn = (wgid % nig) >> 3;
    u.e = 0;
    u.valid = 256;
    return true;
  }
  DEV unsigned rowoff(const GUnit& u, int row) const { return (unsigned)((u.pm * 256 + row) * K) * 2u; }
  DEV const char* bptr(const GUnit& u) const { return (const char*)Bt + (size_t)u.pn * 256 * K * 2; }
  DEV const char* aptr(const GUnit&) const { return (const char*)A; }
  DEV int kof(const GUnit&) const { return K; }
  DEV void a_ready(const GUnit&) const {}
  DEV void done(const GUnit&, int) const {}
};
struct MoeSched {
  const bf16_t* act; const bf16_t* hbuf; const bf16_t* bt1; const bf16_t* bt2; const int* cnt; const int* list;
  unsigned* rdy; unsigned* tmo; int G, c, wv;
  DEV bool next(int i, GUnit& u) const {
    const int x = c & 7, ng = G >> 3;
    int L = i * ng + (c >> 3);
    int Ux = 0;
#pragma unroll
    for (int q = 0; q < 4; ++q) Ux += ((cnt[x + 8 * q] + 255) >> 8) * 4;
    u.ph = (L >= Ux) ? 1 : 0;
    if (u.ph) L -= Ux;
    if (L >= Ux) return false;
    int e = x;
#pragma unroll
    for (int q = 0; q < 3; ++q) {
      const int ntl = ((cnt[x + 8 * q] + 255) >> 8) * 4;
      if (e == x + 8 * q && L >= ntl) { L -= ntl; e += 8; }
    }
    int base = 0;
    for (int e2 = 0; e2 < NEXP; ++e2) base += (e2 < e) ? ((cnt[e2] + 255) >> 8) : 0;
    const int cn = cnt[e];
    u.e = e; u.pm = L >> 2; u.pn = L & 3; u.valid = min(256, cn - u.pm * 256); u.ridx = base + u.pm;
    return true;
  }
  DEV unsigned rowoff(const GUnit& u, int row) const {
    const int slot = list[u.e * CAP + u.pm * 256 + min(row, u.valid - 1)];
    return u.ph ? (unsigned)(slot * DEXP) * 2u : (unsigned)((slot >> 1) * DM) * 2u;
  }
  DEV const char* bptr(const GUnit& u) const {
    return (const char*)bt1 + (ptrdiff_t)u.ph * ((const char*)bt2 - (const char*)bt1) +
           (((size_t)u.e * 1024 + u.pn * 256) * (size_t)(DM * 2 >> u.ph));
  }
  DEV const char* aptr(const GUnit& u) const {
    return (const char*)act + (ptrdiff_t)u.ph * ((const char*)hbuf - (const char*)act);
  }
  DEV int kof(const GUnit& u) const { return u.ph ? DEXP : DM; }
  DEV void a_ready(const GUnit& u) const {
    if (u.ph) {
      if (wv == 0) {
        unsigned spins = 0u;
        while (xb_ld(rdy + u.ridx) < 32u) {
          if (++spins > 4000000u) { atomicAdd(tmo, 1u); break; }
          __builtin_amdgcn_s_sleep(2);
        }
        __builtin_amdgcn_fence(__ATOMIC_ACQUIRE, "agent");
        asm volatile("s_waitcnt vmcnt(0)" ::: "memory");
      }
      asm volatile("" ::: "memory");
      __builtin_amdgcn_s_barrier();
      asm volatile("" ::: "memory");
    }
  }
  DEV void done(const GUnit& u, int lane) const {
    if (!u.ph) {
      asm volatile("s_waitcnt vmcnt(0)" ::: "memory");
      if (lane == 0) xb_add(rdy + u.ridx, 1u);
    }
  }
};

DEV void convert_tile(const float* src, int ld, int k0, int n0, bf16_t* dst, int drow0, int dK, float* tl, int tid) {
  {
    const int kk = tid >> 4, n4 = tid & 15;
    const float4 a = *(const float4*)(src + (size_t)(k0 + kk) * ld + n0 + n4 * 4);
    const float4 b = *(const float4*)(src + (size_t)(k0 + kk + 32) * ld + n0 + n4 * 4);
    float* r0 = tl + kk * 65 + n4 * 4;
    r0[0] = a.x; r0[1] = a.y; r0[2] = a.z; r0[3] = a.w;
    float* r1 = tl + (kk + 32) * 65 + n4 * 4;
    r1[0] = b.x; r1[1] = b.y; r1[2] = b.z; r1[3] = b.w;
  }
  __syncthreads();
  {
    const int n = tid >> 3, k8 = tid & 7;
    float v[8];
#pragma unroll
    for (int j = 0; j < 8; ++j) v[j] = tl[(k8 * 8 + j) * 65 + n];
    *(uint4*)(dst + (size_t)(drow0 + n) * dK + k0 + k8 * 8) = pack8(v);
  }
  __syncthreads();
}
DEV void convert_gates(const Params& p, int l, int bid, int nb, int tid) {
  const int bs = bid;
  const int g = bs * NTHR + tid;
  if (g < 16 * DM) {
    const int j = g >> 10, k = g & (DM - 1);
    p.btg[g] = f2bf(p.w_in[((size_t)l * DM + k) * DIN + PROJW + j]);
  }
}
DEV void convert_win(const Params& p, int l, int bid, int nb, char* smem) {
  const int tid = fresh_tid();
  for (int t = bid; t < 16 * 56; t += nb) {
    const int kt = t / 56, ntile = t - kt * 56;
    convert_tile(p.w_in + (size_t)l * DM * DIN, DIN, kt * 64, ntile * 64, p.btin, ntile * 64, DM, (float*)smem, tid);
  }
  convert_gates(p, l, bid, nb, tid);
}
struct CvtDesc { const float* src; bf16_t* dst; int ld, dK, k0, n0, drow0; };
DEV CvtDesc cvt_desc(const Params& p, int l, int t) {
  constexpr int NT_W1 = NEXP * 16 * 8, NT_W2 = NEXP * 8 * 16, NT_WO = 256;
  CvtDesc d;
  if (t < 2 * NT_W1) {
    const int which = t / NT_W1, r = t - which * NT_W1;
    const int e = r >> 7, kt = (r >> 3) & 15, ntile = r & 7;
    d.src = (which ? p.ew3 : p.ew1) + (size_t)(l * NEXP + e) * DM * DEXP;
    d.ld = DEXP; d.k0 = kt * 64; d.n0 = ntile * 64;
    d.dst = p.bt1; d.dK = DM;
    d.drow0 = e * 1024 + 256 * (d.n0 >> 7) + which * 128 + (d.n0 & 127);
  } else if (t < 2 * NT_W1 + NT_W2) {
    const int r = t - 2 * NT_W1;
    const int e = r >> 7, kt = (r >> 4) & 7, ntile = r & 15;
    d.src = p.ew2 + (size_t)(l * NEXP + e) * DEXP * DM;
    d.ld = DM; d.k0 = kt * 64; d.n0 = ntile * 64;
    d.dst = p.bt2; d.dK = DEXP; d.drow0 = e * 1024 + ntile * 64;
  } else {
    const int r = t - 2 * NT_W1 - NT_W2;
    const int kt = r >> 4, ntile = r & 15;
    d.src = p.w_out + (size_t)l * DM * DM;
    d.ld = DM; d.k0 = kt * 64; d.n0 = ntile * 64;
    d.dst = p.btout; d.dK = DM; d.drow0 = ntile * 64;
  }
  return d;
}
DEV void convert_layer(const Params& p, int l, int bid_, int nb, char* smem) {
  const int bid = bid_;
  const int tid = fresh_tid();
  float* tl = (float*)smem;
  constexpr int NT = 2 * (NEXP * 16 * 8) + NEXP * 8 * 16 + 256;
  const int kk = tid >> 4, n4 = tid & 15;
  auto fetch = [&](int t, float4& a, float4& b) {
    const CvtDesc d = cvt_desc(p, l, min(t, NT - 1));
    const float* s = d.src + (size_t)(d.k0 + kk) * d.ld + d.n0 + n4 * 4;
    {
      const f32x4 av = __builtin_nontemporal_load((const f32x4*)(s));
      const f32x4 bv = __builtin_nontemporal_load((const f32x4*)(s + (size_t)32 * d.ld));
      a = make_float4(av[0], av[1], av[2], av[3]);
      b = make_float4(bv[0], bv[1], bv[2], bv[3]);
    }
  };
  float4 a0, b0, a1, b1, a2, b2;
  fetch(bid, a0, b0);
  fetch(bid + nb, a1, b1);
#pragma unroll 1
  for (int t = bid; t < NT; t += nb) {
    fetch(t + 2 * nb, a2, b2);
    const CvtDesc d = cvt_desc(p, l, t);
    {
      float* r0 = tl + kk * 65 + n4 * 4;
      r0[0] = a0.x; r0[1] = a0.y; r0[2] = a0.z; r0[3] = a0.w;
      float* r1 = tl + (kk + 32) * 65 + n4 * 4;
      r1[0] = b0.x; r1[1] = b0.y; r1[2] = b0.z; r1[3] = b0.w;
    }
    __syncthreads();
    {
      const int n = tid >> 3, k8 = tid & 7;
      float v[8];
#pragma unroll
      for (int j = 0; j < 8; ++j) v[j] = tl[(k8 * 8 + j) * 65 + n];
      const uint4 pk = pack8(v);
      const u32x4 pkv = {pk.x, pk.y, pk.z, pk.w};
      __builtin_nontemporal_store(pkv, (u32x4*)(d.dst + (size_t)(d.drow0 + n) * d.dK + d.k0 + k8 * 8));
    }
    __syncthreads();
    a0 = a1; b0 = b1; a1 = a2; b1 = b2;
  }
  if (l + 1 < DEPTH) convert_win(p, l + 1, bid, nb, smem);
}

DEV void phase_ada(const Params& p, int bid, int nb, char* smem) {
  float* cond = (float*)smem;
  float* red = cond + 2 * DM;
  const int tid = fresh_tid(), lane = tid & 63, wid = tid >> 6;
  for (int i = tid; i < 2 * DM; i += NTHR) cond[i] = silu_f(p.c[i]);
  __syncthreads();
  for (int item = bid; item < DEPTH * 96; item += nb) {
    const int l = item / 96, j = (item - l * 96) * 64 + lane;
    const float* w = p.w_ada + ((size_t)l * DM + wid * 128) * 6144 + j;
    float a0 = 0.f, a1 = 0.f;
#pragma unroll 16
    for (int k = 0; k < 128; ++k) {
      const float wv = w[(size_t)k * 6144];
      a0 += cond[wid * 128 + k] * wv;
      a1 += cond[DM + wid * 128 + k] * wv;
    }
    red[(wid * 2 + 0) * 64 + lane] = a0;
    red[(wid * 2 + 1) * 64 + lane] = a1;
    __syncthreads();
    if (wid < 2) {
      float s = p.b_ada[l * 6144 + j];
#pragma unroll
      for (int w8 = 0; w8 < 8; ++w8) s += red[(w8 * 2 + wid) * 64 + lane];
      p.mod[(l * 2 + wid) * 6144 + j] = s;
    }
    __syncthreads();
  }
  if (bid == 0 && tid < DEPTH * NEXP) p.cnt[tid] = 0;
}

DEV void norm_mod_store(const float4 (&v)[4], float rstd, const float* nw, const float* sc, const float* sh,
                        bf16_t* dst, int lane) {
#pragma unroll
  for (int i = 0; i < 4; ++i) {
    const int idx = (lane + 64 * i) * 4;
    const float4 w = *(const float4*)(nw + idx);
    const float4 s = *(const float4*)(sc + idx);
    const float4 h = *(const float4*)(sh + idx);
    const float r0 = v[i].x * rstd * w.x * (1.f + s.x) + h.x;
    const float r1 = v[i].y * rstd * w.y * (1.f + s.y) + h.y;
    const float r2 = v[i].z * rstd * w.z * (1.f + s.z) + h.z;
    const float r3 = v[i].w * rstd * w.w * (1.f + s.w) + h.w;
    uint2 pk;
    pk.x = pack2(r0, r1);
    pk.y = pack2(r2, r3);
    *(uint2*)(dst + idx) = pk;
  }
}

DEV void phase_hmix(const Params& p, int l, const float* xin, int bid, int nb) {
  const int tid_ = fresh_tid(), lane = tid_ & 63, wid = tid_ >> 6;
  for (int t = bid * NWAVE + wid; t < NTOK; t += nb * NWAVE) {
    const float4* xr = (const float4*)(xin + (size_t)t * DM);
    float4 v[4];
    float ss = 0.f;
#pragma unroll
    for (int i = 0; i < 4; ++i) {
      v[i] = xr[lane + 64 * i];
      ss += v[i].x * v[i].x + v[i].y * v[i].y + v[i].z * v[i].z + v[i].w * v[i].w;
    }
    ss = wave_sum(ss, lane);
    const float rstd = rsqrtf(ss * (1.f / DM) + EPS);
    const int b = t / T;
    const float* md = p.mod + (l * 2 + b) * 6144;
    norm_mod_store(v, rstd, p.norm_mix_w + l * DM, md + MOD_SCALE1, md + MOD_SHIFT1, p.act + (size_t)t * DM, lane);
  }
}

struct EpiProj {
  static constexpr bool PERM = true;
  bf16_t* O;
  DEV void operator()(const f32x4 (&acc)[2][2][4][2], const GUnit& u, int wr, int wc, int fr, int fq) const {
    const int row0 = u.pm * 256 + wr * 64 + fr, col0 = u.pn * 256 + wc * 32 + 8 * fq;
#pragma unroll
    for (int ai = 0; ai < 2; ++ai)
#pragma unroll
      for (int m = 0; m < 4; ++m) {
        bf16_t* rowp = O + (size_t)(row0 + ai * G_HALF + m * 16) * PROJW + col0;
#pragma unroll
        for (int bj = 0; bj < 2; ++bj) {
          const f32x4 v0 = acc[ai][bj][m][0], v1 = acc[ai][bj][m][1];
          uint4 w;
          w.x = pack2(v0[0], v0[1]); w.y = pack2(v0[2], v0[3]); w.z = pack2(v1[0], v1[1]); w.w = pack2(v1[2], v1[3]);
          *(uint4*)(rowp + bj * G_HALF) = w;
        }
      }
  }
};

DEV void phase_gemm_proj(const Params& p, int l, int bid, int nb, char* smem) {
  DenseSched S;
  S.A = p.act; S.Bt = p.btin; S.K = DM; S.nM = NTOK / 256; S.nN = PROJW / 256; S.nwg = S.nM * S.nN; S.G = nb; S.c = bid; S.wv = p.wv;
  EpiProj E;
  E.O = p.proj;
  gemm_phase((LAS unsigned char*)smem, S, E);
  const int tid = fresh_tid(), lane = tid & 63, wid = tid >> 6, fr = lane & 15, fq = lane >> 4;
  for (int tb = bid; tb < NTOK / 64; tb += nb) {
    if (wid < 4) {
      const int tok0 = tb * 64 + wid * 16;
      const bf16_t* ap = p.act + (size_t)(tok0 + fr) * DM + fq * 8;
      const bf16_t* bp = p.btg + (size_t)fr * DM + fq * 8;
      f32x4 acc = {0.f, 0.f, 0.f, 0.f};
#pragma unroll 8
      for (int ks = 0; ks < DM / 32; ++ks)
        acc = MFMA16(*(const bf16x8*)(ap + ks * 32), *(const bf16x8*)(bp + ks * 32), acc);
#pragma unroll
      for (int j = 0; j < 4; ++j) p.gates[(size_t)(tok0 + fq * 4 + j) * 16 + fr] = acc[j];
    }
  }
}

DEV void phase_conv(const Params& p, int l, int bid, int nb) {
  const float* w = p.conv_a_w + l * 768;
  const int bs = bid;
  for (int g = bs * NTHR + fresh_tid(); g < NTOK * 32; g += nb * NTHR) {
    const int t = g >> 5, c = (g & 31) * 8;
    const int tl = t & (T - 1);
    const bf16_t* r = p.proj + (size_t)t * PROJW + c;
    float cb[8], cc[8], cx[8], s[8], wk[8];
    unpack8(*(const uint4*)(r + OFF_CB), cb);
    unpack8(*(const uint4*)(r + OFF_CC), cc);
    unpack8(*(const uint4*)(r + OFF_CX), cx);
    {
      const float4 w0 = *(const float4*)(w + 256 + c), w1 = *(const float4*)(w + 256 + c + 4);
      wk[0] = w0.x; wk[1] = w0.y; wk[2] = w0.z; wk[3] = w0.w; wk[4] = w1.x; wk[5] = w1.y; wk[6] = w1.z; wk[7] = w1.w;
    }
#pragma unroll
    for (int e = 0; e < 8; ++e) s[e] = wk[e] * cc[e] * cx[e];
    if (tl > 0) {
      unpack8(*(const uint4*)(r + OFF_CC - PROJW), cc);
      unpack8(*(const uint4*)(r + OFF_CX - PROJW), cx);
      const float4 w0 = *(const float4*)(w + c), w1 = *(const float4*)(w + c + 4);
      wk[0] = w0.x; wk[1] = w0.y; wk[2] = w0.z; wk[3] = w0.w; wk[4] = w1.x; wk[5] = w1.y; wk[6] = w1.z; wk[7] = w1.w;
#pragma unroll
      for (int e = 0; e < 8; ++e) s[e] += wk[e] * cc[e] * cx[e];
    }
    if (tl < T - 1) {
      unpack8(*(const uint4*)(r + OFF_CC + PROJW), cc);
      unpack8(*(const uint4*)(r + OFF_CX + PROJW), cx);
      const float4 w0 = *(const float4*)(w + 512 + c), w1 = *(const float4*)(w + 512 + c + 4);
      wk[0] = w0.x; wk[1] = w0.y; wk[2] = w0.z; wk[3] = w0.w; wk[4] = w1.x; wk[5] = w1.y; wk[6] = w1.z; wk[7] = w1.w;
#pragma unroll
      for (int e = 0; e < 8; ++e) s[e] += wk[e] * cc[e] * cx[e];
    }
#pragma unroll
    for (int e = 0; e < 8; ++e) s[e] *= cb[e];
    *(uint4*)(p.y + (size_t)t * DM + c) = pack8(s);
  }
}

DEV void phase_na(const Params& p, int l, int wgid, int nwg) {
  const int tid_ = fresh_tid(), lane = tid_ & 63, fr = lane & 15, fq = lane >> 4;
  for (int item = wgid; item < NB * 128 * 4 * 4; item += nwg) {
    const int qg = item & 3, h = (item >> 2) & 3, r = (item >> 4) & 127, b = item >> 11;
    const int rs = min(max(r - 4, 0), 120);
    const int kc0 = (qg == 0) ? 0 : (qg == 1) ? 8 : (qg == 2) ? 24 : 32;
    const int c = qg * 16 + fr;
    const int cs = min(max(c - 8, 0), 48);
    const size_t tq = (size_t)b * T + r * 64 + c;
    bf16x8 bq[2];
#pragma unroll
    for (int ks = 0; ks < 2; ++ks)
      bq[ks] = *(const bf16x8*)(p.proj + tq * PROJW + OFF_NQ + h * 64 + ks * 32 + fq * 8);
    f32x4 sc[16];
#pragma unroll
    for (int tt = 0; tt < 16; ++tt) {
      const int i = tt >> 1, half = tt & 1;
      const size_t kt = (size_t)b * T + (rs + i) * 64 + kc0 + half * 16 + fr;
      const bf16_t* kp = p.proj + kt * PROJW + OFF_NK + h * 64 + fq * 8;
      const bf16x8 a0 = *(const bf16x8*)(kp);
      const bf16x8 a1 = *(const bf16x8*)(kp + 32);
      f32x4 z = {0.f, 0.f, 0.f, 0.f};
      z = MFMA16(a0, bq[0], z);
      sc[tt] = MFMA16(a1, bq[1], z);
    }
    const float* rpb = p.na_rpb + (size_t)(l * 4 + h) * 465;
    float mx = -3.0e38f;
#pragma unroll
    for (int tt = 0; tt < 16; ++tt) {
      const int i = tt >> 1, half = tt & 1;
      const int dr = rs + i - r + 7;
#pragma unroll
      for (int j = 0; j < 4; ++j) {
        const int kcol = kc0 + half * 16 + fq * 4 + j;
        const bool valid = (kcol >= cs) && (kcol < cs + 16);
        const int dc = valid ? (kcol - c + 15) : 0;
        const float s = valid ? (sc[tt][j] * 0.125f + rpb[dr * 31 + dc]) : -3.0e38f;
        sc[tt][j] = s;
        mx = fmaxf(mx, s);
      }
    }
    mx = fmaxf(mx, shx(mx, 16, lane));
    mx = fmaxf(mx, shx(mx, 32, lane));
    float sum = 0.f;
#pragma unroll
    for (int tt = 0; tt < 16; ++tt)
#pragma unroll
      for (int j = 0; j < 4; ++j) {
        const float s = sc[tt][j];
        const float e = (s > -1.0e38f) ? __expf(s - mx) : 0.f;
        sc[tt][j] = e;
        sum += e;
      }
    sum += shx(sum, 16, lane);
    sum += shx(sum, 32, lane);
    const float inv = 1.f / sum;
    f32x4 oacc[4];
#pragma unroll
    for (int nt = 0; nt < 4; ++nt) oacc[nt] = f32x4{0.f, 0.f, 0.f, 0.f};
#pragma unroll
    for (int i = 0; i < 8; ++i) {
      uint4 pu;
      pu.x = pack2(sc[2 * i][0] * inv, sc[2 * i][1] * inv);
      pu.y = pack2(sc[2 * i][2] * inv, sc[2 * i][3] * inv);
      pu.z = pack2(sc[2 * i + 1][0] * inv, sc[2 * i + 1][1] * inv);
      pu.w = pack2(sc[2 * i + 1][2] * inv, sc[2 * i + 1][3] * inv);
      const bf16x8 pa = __builtin_bit_cast(bf16x8, pu);
      const bf16_t* vb = p.proj + ((size_t)b * T + (rs + i) * 64 + kc0 + fq * 4) * PROJW + OFF_NV + h * 64 + fr * 4;
      uint2 wv[8];
#pragma unroll
      for (int j = 0; j < 8; ++j) wv[j] = *(const uint2*)(vb + (size_t)(j < 4 ? j : 12 + j) * PROJW);
#pragma unroll
      for (int t = 0; t < 4; ++t) {
        uint4 bu;
        const unsigned sel = (t & 1) ? 0x07060302u : 0x05040100u;
#define NA_E(j) ((t & 2) ? wv[j].y : wv[j].x)
        bu.x = __builtin_amdgcn_perm(NA_E(1), NA_E(0), sel);
        bu.y = __builtin_amdgcn_perm(NA_E(3), NA_E(2), sel);
        bu.z = __builtin_amdgcn_perm(NA_E(5), NA_E(4), sel);
        bu.w = __builtin_amdgcn_perm(NA_E(7), NA_E(6), sel);
#undef NA_E
        oacc[t] = MFMA16(pa, __builtin_bit_cast(bf16x8, bu), oacc[t]);
      }
    }
#pragma unroll
    for (int j = 0; j < 4; ++j) {
      uint2 st;
      st.x = pack2(oacc[0][j], oacc[1][j]);
      st.y = pack2(oacc[2][j], oacc[3][j]);
      *(uint2*)(p.y + ((size_t)b * T + r * 64 + qg * 16 + fq * 4 + j) * DM + 256 + h * 64 + fr * 4) = st;
    }
  }
}

DEV void fmac1(float& acc, float a, float b) { asm("v_fmac_f32 %0, %1, %2" : "+v"(acc) : "v"(a), "v"(b)); }
struct LRow { float4 v[8]; };
template <int POS>
struct SolveStep {
  static DEV void run(float (&x)[64], LRow& row, const float* Ld, const float* sclv, const bf16_t* srcq, int sstep,
                      bool isu, unsigned* up, bf16_t* wp) {
    float s0 = 0.f, s1 = 0.f, s2 = 0.f, s3 = 0.f;
    float4 hi[8];
#pragma unroll
    for (int j4 = 8; j4 < (POS + 3) / 4; ++j4) hi[j4 - 8] = *(const float4*)(Ld + POS * 68 + j4 * 4);
#pragma unroll
    for (int j4 = 0; j4 < 8; ++j4) {
      if (j4 < (POS + 3) / 4) {
        const float4 lv = row.v[j4];
        fmac1(s0, lv.x, x[j4 * 4]);
        if (j4 * 4 + 1 < POS) fmac1(s1, lv.y, x[j4 * 4 + 1]);
        if (j4 * 4 + 2 < POS) fmac1(s2, lv.z, x[j4 * 4 + 2]);
        if (j4 * 4 + 3 < POS) fmac1(s3, lv.w, x[j4 * 4 + 3]);
      }
      if (POS + 1 < 64 && j4 < (POS + 4) / 4) row.v[j4] = *(const float4*)(Ld + (POS + 1) * 68 + j4 * 4);
    }
#pragma unroll
    for (int j4 = 8; j4 < (POS + 3) / 4; ++j4) {
      const float4 lv = hi[j4 - 8];
      fmac1(s0, lv.x, x[j4 * 4]);
      if (j4 * 4 + 1 < POS) fmac1(s1, lv.y, x[j4 * 4 + 1]);
      if (j4 * 4 + 2 < POS) fmac1(s2, lv.z, x[j4 * 4 + 2]);
      if (j4 * 4 + 3 < POS) fmac1(s3, lv.w, x[j4 * 4 + 3]);
    }
    const float a = sclv[POS] * bf2f(srcq[0]) - ((s0 + s1) + (s2 + s3));
    x[POS] = a;
    if (isu) {
      if (POS & 1) up[(POS >> 1) * 128] = pack2(x[POS - 1], a);
    } else {
      wp[POS * 128] = f2bf(-a);
    }
    asm volatile("" ::: "memory");
    SolveStep<POS + 1>::run(x, row, Ld, sclv, srcq + sstep, sstep, isu, up, wp);
  }
};
template <>
struct SolveStep<64> {
  static DEV void run(float (&)[64], LRow&, const float*, const float*, const bf16_t*, int, bool, unsigned*, bf16_t*) {}
};

DEV int kperm16(int k) { const int s = (k >> 2) & 3; return (k & ~15) | ((((s & 1) << 1) | (s >> 1)) << 2) | (k & 3); }

DEV void phase_gdn_prep(const Params& p, int l, int bid, int nb, char* smem) {
  const int tid = fresh_tid(), lane = tid & 63;
  bf16_t* q_bf = (bf16_t*)(smem + PL_Q);
  bf16_t* k_bf = (bf16_t*)(smem + PL_K);
  bf16_t* v_bf = (bf16_t*)(smem + PL_V);
  float* Lm = (float*)(smem + PL_L);
  float* gcl = (float*)(smem + PL_GC);
  float* bl = (float*)(smem + PL_BETA);
  float* bgl = (float*)(smem + PL_BG);
  float* fql = (float*)(smem + PL_FQ);
  float* fkl = (float*)(smem + PL_FK);
  float* cwl = (float*)(smem + PL_CW);
  {
    const float* cw = p.gdn_conv_w + l * 4608;
    for (int i = tid; i < 1152; i += NTHR) *(float4*)(cwl + i * 4) = *(const float4*)(cw + i * 4);
  }
  __syncthreads();
  for (int item = bid; item < 1024; item += nb) {
    const int b = item >> 9, h = (item >> 7) & 3, n = item & 127;
    const int t0 = b * T + n * 64;
    char* rec0 = p.gdn_rec + (size_t)item * 2 * REC_BYTES;
    float ga = 0.f, gb = 0.f, galog = 0.f, gdt = 0.f;
    if (tid < 128) {
      const int dir = tid >> 6;
      const int i = dir ? 63 - lane : lane;
      const size_t t = (size_t)t0 + i;
      ga = p.gates[t * 16 + dir * 4 + h];
      gb = p.gates[t * 16 + 8 + dir * 4 + h];
      galog = p.gdn_a_log[l * 8 + dir * 4 + h];
      gdt = p.gdn_dt_bias[l * 8 + dir * 4 + h];
    }
    uint4 raw[3][3][2];
    {
      const int i = tid >> 3, oc = tid & 7, d0 = oc * 16;
      const int tl = n * 64 + i;
      const bf16_t* rowp = p.proj + (size_t)(t0 + i) * PROJW + OFF_GQKV + h * 128 + d0;
      const int dm = (tl > 0) ? -PROJW : 0, dp = (tl < T - 1) ? PROJW : 0;
#pragma unroll
      for (int m = 0; m < 3; ++m) {
        const bf16_t* rp = rowp + m * 512;
        raw[m][0][0] = *(const uint4*)(rp + dm);
        raw[m][0][1] = *(const uint4*)(rp + dm + 8);
        raw[m][1][0] = *(const uint4*)(rp);
        raw[m][1][1] = *(const uint4*)(rp + 8);
        raw[m][2][0] = *(const uint4*)(rp + dp);
        raw[m][2][1] = *(const uint4*)(rp + dp + 8);
      }
    }
    if (tid < 128) {
      const int dir = tid >> 6;
      const float g = -__expf(galog) * softplus_f(ga + gdt);
      const float beta = sigmoid_f(gb);
      float cs = g;
#pragma unroll
      for (int o = 1; o < 64; o <<= 1) {
        const float v = __int_as_float(__builtin_amdgcn_ds_bpermute((lane - o) << 2, __float_as_int(cs)));
        if (lane >= o) cs += v;
      }
      const float last = __uint_as_float(__builtin_amdgcn_readlane(__float_as_uint(cs), 63));
      const float ec = __expf(cs);
      gcl[dir * 64 + lane] = cs;
      bl[dir * 64 + lane] = beta;
      bgl[dir * 64 + lane] = beta * ec;
      fql[dir * 64 + lane] = ec;
      fkl[dir * 64 + lane] = __expf(last - cs);
      if (lane == 0) p.egl[item * 2 + dir] = __expf(last);
    }
    float valq[16], valk[16];
    {
      int tA = tid;
      asm volatile("" : "+v"(tA));
      const int i = tA >> 3, oc = tA & 7, d0 = oc * 16;
      const int tl = n * 64 + i;
      const float zm = (tl > 0) ? 1.f : 0.f, zp = (tl < T - 1) ? 1.f : 0.f;
#pragma unroll
      for (int m = 0; m < 3; ++m) {
        float x0[16], x1[16], x2[16], val[16];
        unpack8(raw[m][0][0], x0);
        unpack8(raw[m][0][1], x0 + 8);
        unpack8(raw[m][1][0], x1);
        unpack8(raw[m][1][1], x1 + 8);
        unpack8(raw[m][2][0], x2);
        unpack8(raw[m][2][1], x2 + 8);
        const float* cwm = cwl + m * 512 + h * 128 + d0;
        float ss = 0.f;
#pragma unroll
        for (int e4 = 0; e4 < 4; ++e4) {
          const float4 w0 = *(const float4*)(cwm + e4 * 4), w1 = *(const float4*)(cwm + 1536 + e4 * 4),
                       w2 = *(const float4*)(cwm + 3072 + e4 * 4);
          const float w0a[4] = {w0.x * zm, w0.y * zm, w0.z * zm, w0.w * zm};
          const float w1a[4] = {w1.x, w1.y, w1.z, w1.w};
          const float w2a[4] = {w2.x * zp, w2.y * zp, w2.z * zp, w2.w * zp};
#pragma unroll
          for (int j = 0; j < 4; ++j) {
            const int e = e4 * 4 + j;
            val[e] = silu_f(w0a[j] * x0[e] + w1a[j] * x1[e] + w2a[j] * x2[e]);
            ss += val[e] * val[e];
          }
        }
        if (m < 2) {
          ss += shx(ss, 1, lane);
          ss += shx(ss, 2, lane);
          ss += shx(ss, 4, lane);
          float sc = rsqrtf(ss + EPS);
          if (m == 0) sc *= 0.08838834764831845f;
#pragma unroll
          for (int e = 0; e < 16; ++e) val[e] *= sc;
        }
        bf16_t* dst = (m == 0 ? q_bf : (m == 1 ? k_bf : v_bf)) + i * 136 + d0;
        *(uint4*)(dst) = pack8(val);
        *(uint4*)(dst + 8) = pack8(val + 8);
        if (m == 0) {
#pragma unroll
          for (int e = 0; e < 16; ++e) valq[e] = val[e];
        }
        if (m == 1) {
#pragma unroll
          for (int e = 0; e < 16; ++e) valk[e] = val[e];
        }
      }
    }
    __syncthreads();
    {
      int tA = tid;
      asm volatile("" : "+v"(tA));
      const int i = tA >> 3, oc = tA & 7, d0 = oc * 16;
#pragma unroll
      for (int dir = 0; dir < 2; ++dir) {
        const int pos = dir ? 63 - i : i;
        const float f = fql[dir * 64 + pos];
        float tmp[16];
#pragma unroll
        for (int e = 0; e < 16; ++e) tmp[kperm16(e)] = valq[e] * f;
        bf16_t* qd = (bf16_t*)(rec0 + dir * REC_BYTES + REC_QD) + pos * 128 + d0;
        *(uint4*)(qd) = pack8(tmp);
        *(uint4*)(qd + 8) = pack8(tmp + 8);
      }
#pragma unroll
      for (int dir = 0; dir < 2; ++dir) {
        const int pos = dir ? 63 - i : i;
        const float f = fkl[dir * 64 + pos];
        bf16_t* kt = (bf16_t*)(rec0 + dir * REC_BYTES + REC_KT) + d0 * 64 + kperm16(pos);
#pragma unroll
        for (int e = 0; e < 16; ++e) kt[e * 64] = f2bf(valk[e] * f);
      }
    }
    {
      int tB = tid;
      asm volatile("" : "+v"(tB));
      const int laneB = tB & 63, widB = tB >> 6, fr = laneB & 15, fq = laneB >> 4;
      const int mat = __builtin_amdgcn_readfirstlane(widB >> 2), rtile = widB & 3;
      const bf16_t* asrc = mat ? q_bf : k_bf;
      bf16x8 af[4];
#pragma unroll
      for (int ks = 0; ks < 4; ++ks) af[ks] = *(const bf16x8*)(asrc + (rtile * 16 + fr) * 136 + ks * 32 + fq * 8);
#pragma unroll
      for (int nt = 0; nt < 4; ++nt) {
        f32x4 acc = {0.f, 0.f, 0.f, 0.f};
#pragma unroll
        for (int ks = 0; ks < 4; ++ks) {
          const bf16x8 bfrag = *(const bf16x8*)(k_bf + (nt * 16 + fr) * 136 + ks * 32 + fq * 8);
          acc = MFMA16(af[ks], bfrag, acc);
        }
#pragma unroll
        for (int j = 0; j < 4; ++j) {
          const int i = rtile * 16 + fq * 4 + j, jj = nt * 16 + fr;
          const float G = acc[j];
#pragma unroll
          for (int dir = 0; dir < 2; ++dir) {
            const int pi = dir ? 63 - i : i, pj = dir ? 63 - jj : jj;
            const float dec = __expf(fminf(gcl[dir * 64 + pi] - gcl[dir * 64 + pj], 0.f));
            if (mat == 0)
              Lm[(dir * 64 + pi) * 68 + pj] = (pi > pj) ? bl[dir * 64 + pi] * G * dec : 0.f;
            else
              *((bf16_t*)(rec0 + dir * REC_BYTES + REC_IN) + pi * 64 + kperm16(pj)) = f2bf((pi >= pj) ? G * dec : 0.f);
          }
        }
      }
    }
    __syncthreads();
    {
      int tC = tid;
      asm volatile("" : "+v"(tC));
      const int dir = tC >> 8, c = tC & 255;
      const float* Ld = Lm + dir * 64 * 68;
      const bool isu = __builtin_amdgcn_readfirstlane((int)(c < 128)) != 0;
      unsigned* up = p.gdn_u + ((size_t)(item * 2 + dir) * 32) * 128 + (c & 127);
      bf16_t* wp = (bf16_t*)(rec0 + dir * REC_BYTES + REC_WN) + kperm16(c & 127);
      const bf16_t* src = (isu ? v_bf : k_bf) + (c & 127);
      const float* sclv = (isu ? bl : bgl) + dir * 64;
      float x[64];
      LRow row0;
      SolveStep<0>::run(x, row0, Ld, sclv, src + (dir ? 63 * 136 : 0), dir ? -136 : 136, isu, up, wp);
    }
    __syncthreads();
  }
}

DEV int crow(int reg, int hf) { return (reg & 3) + 8 * (reg >> 2) + 4 * hf; }
DEV bf16x8 pack_acc8(const f32x16& x, int s) {
  uint4 v;
  v.x = pack2(x[8 * s + 0], x[8 * s + 1]);
  v.y = pack2(x[8 * s + 2], x[8 * s + 3]);
  v.z = pack2(x[8 * s + 4], x[8 * s + 5]);
  v.w = pack2(x[8 * s + 6], x[8 * s + 7]);
  return __builtin_bit_cast(bf16x8, v);
}
DEV bf16x8 ld_frag(const char* rowp, int kb) { return *(const bf16x8*)(rowp + kb); }

DEV void phase_gdn_scan(const Params& p, int ep, int chain, char* smem) {
  const int tid = fresh_tid(), lane = tid & 63, wid = tid >> 6;
  const int dir = chain & 1, bh = chain >> 1;
  const int b = bh >> 2, hh = bh & 3;
  if (wid >= 4) {
    const int lt = tid - 256;
    uint4 rA[18], rB[18];
    auto gl = [&](uint4 (&rg)[18], int n) {
      const int item = bh * 128 + (dir ? 127 - n : n);
      const __amdgpu_buffer_rsrc_t rr = __builtin_amdgcn_make_buffer_rsrc(
          (void*)(p.gdn_rec + ((size_t)item * 2 + dir) * REC_BYTES), 0, REC_BYTES, 0x00020000);
      const __amdgpu_buffer_rsrc_t ru = __builtin_amdgcn_make_buffer_rsrc(
          (void*)(p.gdn_u + ((size_t)(item * 2 + dir) * 32) * 128), 0, 16384, 0x00020000);
#pragma unroll
      for (int k = 0; k < 14; ++k) {
        const u32x4 v = __builtin_amdgcn_raw_buffer_load_b128(rr, lt * 16, k * 4096, 0);
        rg[k] = make_uint4(v.x, v.y, v.z, v.w);
      }
#pragma unroll
      for (int k = 0; k < 4; ++k) {
        const u32x4 v = __builtin_amdgcn_raw_buffer_load_b128(ru, lt * 16, k * 4096, 0);
        rg[14 + k] = make_uint4(v.x, v.y, v.z, v.w);
      }
    };
    auto st = [&](const uint4 (&rg)[18], int buf) {
      char* base = smem + buf * SC_BUF;
#pragma unroll
      for (int k = 0; k < 14; ++k) {
        const int u = lt + 256 * k;
        int row, c16, off;
        if (k < 4) { row = u >> 4; c16 = u & 15; off = SC_WN + row * 272; }
        else if (k < 8) { row = (u - 1024) >> 4; c16 = (u - 1024) & 15; off = SC_QD + row * 272; }
        else if (k < 10) { row = (u - 2048) >> 3; c16 = (u - 2048) & 7; off = SC_IN + row * 144; }
        else { row = (u - 2560) >> 3; c16 = (u - 2560) & 7; off = SC_KT + row * 144; }
        *(uint4*)(base + off + c16 * 16) = rg[k];
      }
#pragma unroll
      for (int k = 0; k < 4; ++k) *(uint4*)(base + SC_U + (lt + 256 * k) * 16) = rg[14 + k];
    };
    gl(rA, 0);
    st(rA, 0);
    gl(rB, 1);
    gl(rA, 2);
    __syncthreads();
#pragma unroll 1
    for (int n = 0; n < 128; n += 2) {
      st(rB, 1);
      gl(rB, min(n + 3, 127));
      __syncthreads();
      st(rA, 0);
      gl(rA, min(n + 4, 127));
      __syncthreads();
    }
  } else {
    const int w = wid, r = lane & 31, hf = lane >> 5;
    f32x16 S[4];
#pragma unroll
    for (int t4 = 0; t4 < 4; ++t4)
#pragma unroll
      for (int e = 0; e < 16; ++e) S[t4][e] = 0.f;
    __builtin_amdgcn_s_setprio(3);
    const float dlo = p.egl[(bh * 128 + (dir ? 127 - lane : lane)) * 2 + dir];
    const float dhi = p.egl[(bh * 128 + (dir ? 63 - lane : 64 + lane)) * 2 + dir];
    if (tid == 0) __hip_atomic_store(&p.bar[XB_CXCC(chain)], ((unsigned)ep << 4) | xb_xcc_id(), __ATOMIC_RELAXED, __HIP_MEMORY_SCOPE_AGENT);
    __syncthreads();
#pragma unroll 1
    for (int n = 0; n < 128; ++n) {
      if (tid == 0) __hip_atomic_store(&p.bar[XB_PROG(chain)], (unsigned)ep * 1024u + (unsigned)n, __ATOMIC_RELAXED, __HIP_MEMORY_SCOPE_AGENT);
      const char* buf = smem + (n & 1) * SC_BUF;
      const float decay = __uint_as_float(__builtin_amdgcn_readlane(__float_as_uint(n < 64 ? dlo : dhi), n & 63));
      f32x16 vn[2], o[2];
      {
        const unsigned* ul = (const unsigned*)(buf + SC_U) + 32 * w + r;
#pragma unroll
        for (int tm = 0; tm < 2; ++tm)
#pragma unroll
          for (int e2 = 0; e2 < 8; ++e2) {
            const unsigned uu = ul[((32 * tm + crow(2 * e2, hf)) >> 1) * 128];
            vn[tm][2 * e2] = __uint_as_float(uu << 16);
            vn[tm][2 * e2 + 1] = __uint_as_float(uu & 0xffff0000u);
          }
      }
#pragma unroll
      for (int e = 0; e < 16; ++e) { o[0][e] = 0.f; o[1][e] = 0.f; }
      const char* rw0 = buf + SC_WN + r * 272 + hf * 16;
      const char* rq0 = buf + SC_QD + r * 272 + hf * 16;
      const char* ri0 = buf + SC_IN + r * 144 + hf * 16;
      const char* rk0 = buf + SC_KT + r * 144 + hf * 16;
      bf16x8 fA[8], fB[8], sb[4][2];
#define SCAN_LOAD(dst, base, t4a)                                                                        \
  _Pragma("unroll") for (int dt = 0; dt < 2; ++dt) _Pragma("unroll") for (int s = 0; s < 2; ++s)         \
      _Pragma("unroll") for (int tm = 0; tm < 2; ++tm)                                                   \
          dst[dt * 4 + s * 2 + tm] = ld_frag(base + tm * 32 * 272, (32 * ((t4a) + dt) + 16 * s) * 2);
#define SCAN_MMA(acc, f, t4a)                                                                            \
  _Pragma("unroll") for (int dt = 0; dt < 2; ++dt) _Pragma("unroll") for (int s = 0; s < 2; ++s)         \
      _Pragma("unroll") for (int tm = 0; tm < 2; ++tm)                                                   \
          acc[tm] = MFMA32(f[dt * 4 + s * 2 + tm], sb[(t4a) + dt][s], acc[tm]);
#define SCAN_MMA_T(acc, f, t4a)                                                                          \
  _Pragma("unroll") for (int dt = 0; dt < 2; ++dt) _Pragma("unroll") for (int s = 0; s < 2; ++s)         \
      _Pragma("unroll") for (int tm = 0; tm < 2; ++tm)                                                   \
          acc[tm] = MFMA32(sb[(t4a) + dt][s], f[dt * 4 + s * 2 + tm], acc[tm]);
#define SCAN_MIX(nmfma, nds, nvalu)                                                                      \
  _Pragma("unroll") for (int _g = 0; _g < (nmfma); ++_g) {                                               \
    __builtin_amdgcn_sched_group_barrier(0x008, 1, 0);                                                   \
    if (_g < (nds)) __builtin_amdgcn_sched_group_barrier(0x100, 1, 0);                                   \
    __builtin_amdgcn_sched_group_barrier(0x002, (nvalu), 0);                                             \
  }
      SCAN_LOAD(fA, rw0, 0)
      sb[0][0] = pack_acc8(S[0], 0); sb[0][1] = pack_acc8(S[0], 1);
      sb[1][0] = pack_acc8(S[1], 0); sb[1][1] = pack_acc8(S[1], 1);
      __builtin_amdgcn_sched_barrier(0);
      SCAN_MMA(vn, fA, 0)
      SCAN_LOAD(fB, rw0, 2)
      sb[2][0] = pack_acc8(S[2], 0); sb[2][1] = pack_acc8(S[2], 1);
      sb[3][0] = pack_acc8(S[3], 0); sb[3][1] = pack_acc8(S[3], 1);
      SCAN_MIX(8, 8, 2)
      __builtin_amdgcn_sched_barrier(0);
      SCAN_MMA(vn, fB, 2)
      SCAN_LOAD(fA, rq0, 0)
#pragma unroll
      for (int e = 0; e < 16; ++e) S[0][e] *= decay;
      SCAN_MIX(8, 8, 2)
      __builtin_amdgcn_sched_barrier(0);
      SCAN_MMA_T(o, fA, 0)
      SCAN_LOAD(fB, rq0, 2)
#pragma unroll
      for (int e = 0; e < 16; ++e) { S[1][e] *= decay; S[2][e] *= decay; }
      SCAN_MIX(8, 8, 3)
      __builtin_amdgcn_sched_barrier(0);
      bf16x8 fi[6], fk0[4];
      SCAN_MMA_T(o, fB, 2)
      fi[0] = ld_frag(ri0, 0);
      fi[1] = ld_frag(ri0, 32);
#pragma unroll
      for (int q4 = 0; q4 < 4; ++q4) fi[2 + q4] = ld_frag(ri0 + 32 * 144, q4 * 32);
#pragma unroll
      for (int q4 = 0; q4 < 4; ++q4) fk0[q4] = ld_frag(rk0, q4 * 32);
      bf16x8 vb[2][2];
#pragma unroll
      for (int tk = 0; tk < 2; ++tk) {
        vb[tk][0] = pack_acc8(vn[tk], 0);
        vb[tk][1] = pack_acc8(vn[tk], 1);
      }
#pragma unroll
      for (int e = 0; e < 16; ++e) S[3][e] *= decay;
      SCAN_MIX(8, 8, 4)
      __builtin_amdgcn_sched_barrier(0);
#undef SCAN_LOAD
#undef SCAN_MMA
#undef SCAN_MMA_T
      o[0] = MFMA32(vb[0][0], fi[0], o[0]);
      o[1] = MFMA32(vb[0][0], fi[2], o[1]);
      o[0] = MFMA32(vb[0][1], fi[1], o[0]);
      o[1] = MFMA32(vb[0][1], fi[3], o[1]);
      S[0] = MFMA32(fk0[0], vb[0][0], S[0]);
      o[1] = MFMA32(vb[1][0], fi[4], o[1]);
      S[0] = MFMA32(fk0[1], vb[0][1], S[0]);
      o[1] = MFMA32(vb[1][1], fi[5], o[1]);
      S[0] = MFMA32(fk0[2], vb[1][0], S[0]);
      S[0] = MFMA32(fk0[3], vb[1][1], S[0]);
#pragma unroll
      for (int q4 = 0; q4 < 4; ++q4) {
        fA[q4] = ld_frag(rk0 + 32 * 144, q4 * 32);
        fA[4 + q4] = ld_frag(rk0 + 64 * 144, q4 * 32);
      }
      SCAN_MIX(10, 8, 0)
      __builtin_amdgcn_sched_barrier(0);
#pragma unroll
      for (int q4 = 0; q4 < 4; ++q4) {
        S[1] = MFMA32(fA[q4], vb[q4 >> 1][q4 & 1], S[1]);
        S[2] = MFMA32(fA[4 + q4], vb[q4 >> 1][q4 & 1], S[2]);
      }
#pragma unroll
      for (int q4 = 0; q4 < 4; ++q4) fB[q4] = ld_frag(rk0 + 96 * 144, q4 * 32);
      SCAN_MIX(8, 4, 0)
      __builtin_amdgcn_sched_barrier(0);
#pragma unroll
      for (int q4 = 0; q4 < 4; ++q4) S[3] = MFMA32(fB[q4], vb[q4 >> 1][q4 & 1], S[3]);
#undef SCAN_MIX
      {
#pragma unroll
        for (int tn = 0; tn < 2; ++tn) {
          const int pos = 32 * tn + r;
          const int tok = dir ? (b * T + T - 1 - n * 64 - pos) : (b * T + n * 64 + pos);
          unsigned pk[4][2];
#pragma unroll
          for (int g = 0; g < 4; ++g) {
            pk[g][0] = pack2(o[tn][4 * g + 0], o[tn][4 * g + 1]);
            pk[g][1] = pack2(o[tn][4 * g + 2], o[tn][4 * g + 3]);
          }
          uint4 st0, st1;
          {
            auto s0 = __builtin_amdgcn_permlane32_swap(pk[0][0], pk[2][0], false, false);
            auto s1 = __builtin_amdgcn_permlane32_swap(pk[0][1], pk[2][1], false, false);
            st0.x = s0[0]; st0.y = s1[0]; st0.z = s0[1]; st0.w = s1[1];
            auto s2 = __builtin_amdgcn_permlane32_swap(pk[1][0], pk[3][0], false, false);
            auto s3 = __builtin_amdgcn_permlane32_swap(pk[1][1], pk[3][1], false, false);
            st1.x = s2[0]; st1.y = s3[0]; st1.z = s2[1]; st1.w = s3[1];
          }
          bf16_t* op = p.obuf + ((size_t)dir * NTOK + tok) * 512 + hh * 128 + 32 * w + 16 * hf;
          *(uint4*)(op) = st0;
          *(uint4*)(op + 8) = st1;
        }
      }
      __syncthreads();
    }
    __builtin_amdgcn_s_setprio(0);
  }
}

DEV void phase_scan_helper(const Params& p, int ep, int c, int j, char* smem) {
  const int tid = fresh_tid(), lane = tid & 63, wid = tid >> 6;
  volatile unsigned* lprog = (volatile unsigned*)smem;
  const unsigned epoch = (unsigned)ep;
  const int dir = c & 1, bh = c >> 1;
  constexpr unsigned AHEAD = 8u;
  if (tid == 0) lprog[0] = 0u;
  __syncthreads();
  if (wid == 0) {
    unsigned v = 0u, spins = 0u;
    for (;;) {
      v = xb_ld(&p.bar[XB_CXCC(c)]);
      if ((v >> 4) == epoch || ++spins > 200000u) break;
      __builtin_amdgcn_s_sleep(8);
    }
    const bool mine = ((v >> 4) == epoch) && ((v & 15u) == xb_xcc_id());
    if (!mine) {
      if (lane == 0) lprog[0] = 0xffffffffu;
    } else {
      unsigned idle = 0u;
      for (;;) {
        const unsigned g = xb_ld(&p.bar[XB_PROG(c)]);
        const unsigned cur = (g >= epoch * 1024u) ? (g - epoch * 1024u + 1u) : 0u;
        if (lane == 0) lprog[0] = cur + 1u;
        if (cur >= 128u || ++idle > 400000u) break;
        __builtin_amdgcn_s_sleep(16);
      }
      if (lane == 0) lprog[0] = 0xffffffffu;
    }
  } else {
    u32x4 sink = {0u, 0u, 0u, 0u};
    unsigned spins = 0u;
    for (int n = 0; n < 128;) {
      const unsigned s = lprog[0];
      if (s == 0xffffffffu) break;
      if (s == 0u) {
        if (++spins > 4000000u) break;
        __builtin_amdgcn_s_sleep(4);
        continue;
      }
      const unsigned started = s - 1u;
      if ((unsigned)n < started) n = (int)started;
      if (n >= 128) break;
      if ((unsigned)n >= started + AHEAD) {
        if (++spins > 4000000u) break;
        __builtin_amdgcn_s_sleep(4);
        continue;
      }
      const int item = bh * 128 + (dir ? 127 - n : n);
      const char* rec = p.gdn_rec + ((size_t)item * 2 + dir) * REC_BYTES;
      const char* uu = (const char*)(p.gdn_u + ((size_t)(item * 2 + dir) * 32) * 128);
#pragma unroll
      for (int q = 0; q < 4; ++q) {
        const int pc = wid - 1 + 7 * q;
        if (pc < 24) {
          const int piece = 24 * j + pc;
          const char* ptr = (piece < 56 ? rec + piece * 1024 : uu + (piece - 56) * 1024) + lane * 16;
          asm volatile("global_load_dwordx4 %0, %1, off" : "+v"(sink) : "v"(ptr) : "memory");
        }
      }
      ++n;
    }
    asm volatile("s_waitcnt vmcnt(0)" ::: "memory");
    asm volatile("" :: "v"(sink));
  }
  __syncthreads();
}

DEV void phase_gdn_fin(const Params& p, int l, int bid, int nb) {
  const int tid_ = fresh_tid(), lane = tid_ & 63, wid = tid_ >> 6;
  const float* gnw = p.gdn_norm_w + l * 128 + (lane & 15) * 8;
  for (int t = bid * NWAVE + wid; t < NTOK; t += nb * NWAVE) {
    float of[8], ob[8], z[8], o[8];
    unpack8(*(const uint4*)(p.obuf + (size_t)t * 512 + lane * 8), of);
    unpack8(*(const uint4*)(p.obuf + ((size_t)NTOK + t) * 512 + lane * 8), ob);
    unpack8(*(const uint4*)(p.proj + (size_t)t * PROJW + OFF_GZ + lane * 8), z);
    float ss = 0.f;
#pragma unroll
    for (int e = 0; e < 8; ++e) {
      o[e] = of[e] + ob[e];
      ss += o[e] * o[e];
    }
    ss += shx(ss, 1, lane);
    ss += shx(ss, 2, lane);
    ss += shx(ss, 4, lane);
    ss += shx(ss, 8, lane);
    const float rr = rsqrtf(ss * (1.f / 128.f) + EPS);
    const float4 g0 = *(const float4*)(gnw), g1 = *(const float4*)(gnw + 4);
    const float gw[8] = {g0.x, g0.y, g0.z, g0.w, g1.x, g1.y, g1.z, g1.w};
    float res[8];
#pragma unroll
    for (int e = 0; e < 8; ++e) res[e] = o[e] * rr * gw[e] * silu_f(z[e]);
    *(uint4*)(p.y + (size_t)t * DM + 512 + lane * 8) = pack8(res);
  }
}

struct EpiWout {
  static constexpr bool PERM = false;
  const float* xin; float* xout; const float* mod_l;
  DEV void operator()(const f32x4 (&acc)[2][2][4][2], const GUnit& u, int wr, int wc, int fr, int fq) const {
    const int row0 = u.pm * 256 + wr * 64 + fr, col0 = u.pn * 256 + wc * 32 + 4 * fq;
    const float* gate = mod_l + ((u.pm * 256) / T) * 6144 + MOD_GATE1;
    f32x4 gv[2][2];
#pragma unroll
    for (int bj = 0; bj < 2; ++bj)
#pragma unroll
      for (int n = 0; n < 2; ++n) gv[bj][n] = *(const f32x4*)(gate + col0 + bj * G_HALF + n * 16);
#pragma unroll
    for (int ai = 0; ai < 2; ++ai)
#pragma unroll
      for (int m = 0; m < 4; ++m) {
        const size_t ro = (size_t)(row0 + ai * G_HALF + m * 16) * DM + col0;
#pragma unroll
        for (int bj = 0; bj < 2; ++bj)
#pragma unroll
          for (int n = 0; n < 2; ++n) {
            const f32x4 xi = *(const f32x4*)(xin + ro + bj * G_HALF + n * 16);
            *(f32x4*)(xout + ro + bj * G_HALF + n * 16) = xi + gv[bj][n] * acc[ai][bj][m][n];
          }
      }
  }
};

DEV void phase_gemm_wout(const Params& p, int l, const float* xin, int bid, int nb, char* smem) {
  DenseSched S;
  S.A = p.y; S.Bt = p.btout; S.K = DM; S.nM = NTOK / 256; S.nN = DM / 256; S.nwg = S.nM * S.nN; S.G = nb; S.c = bid; S.wv = p.wv;
  EpiWout E;
  E.xin = xin; E.xout = p.xbuf; E.mod_l = p.mod + l * 2 * 6144;
  gemm_phase((LAS unsigned char*)smem, S, E);
}

DEV void phase_consts(const Params& p, int bid, int nb) {
  const int tid = fresh_tid(), lane = tid & 63, wid = tid >> 6;
  for (int g = bid * NTHR + tid; g < DEPTH * DM * 48; g += nb * NTHR) {
    const int n = g % 48, lk = g / 48;
    float v = 0.f;
    if (n < 4) v = p.rg_w[(size_t)lk * 4 + n];
    else if (n < 36) v = p.re_w[(size_t)lk * 32 + (n - 4)];
    p.wcat[g] = v;
  }
  for (int g = bid * NTHR + tid; g < DEPTH * NB * DM; g += nb * NTHR) {
    const int k = g & (DM - 1), lb = g >> 10, l = lb >> 1;
    p.wsc2[g] = p.norm_ffn_w[l * DM + k] * (1.f + p.mod[lb * 6144 + MOD_SCALE2 + k]);
  }
  for (int o = bid * NWAVE + wid; o < DEPTH * NB * 48; o += nb * NWAVE) {
    const int n = o % 48, lb = o / 48, l = lb >> 1;
    float s = 0.f;
    if (n < 36) {
#pragma unroll
      for (int k16 = 0; k16 < DM / 64; ++k16) {
        const int k = lane + 64 * k16;
        const float w = (n < 4) ? p.rg_w[((size_t)l * DM + k) * 4 + n] : p.re_w[((size_t)l * DM + k) * 32 + (n - 4)];
        s += p.mod[lb * 6144 + MOD_SHIFT2 + k] * w;
      }
      s = wave_sum(s, lane);
      s += (n < 4) ? p.rg_b[l * 4 + n] : p.re_b[l * 32 + (n - 4)];
    }
    if (lane == 0) p.c0[o] = s;
  }
}

DEV void phase_router(const Params& p, int l, int bid, int nb, char* smem) {
  float* accb = (float*)smem;
  float* ssqb = accb + 2 * 64 * 49;
  float* rsl = ssqb + 128;
  int* lcnt = (int*)(rsl + 64);
  int* lbase = lcnt + NEXP;
  const int tid = fresh_tid(), lane = tid & 63, wid = tid >> 6, fr = lane & 15, fq = lane >> 4;
  const int tg = wid & 3, kh = wid >> 2;
  int sel_e0 = 0, sel_e1 = 0, sel_r0 = 0, sel_r1 = 0;
  if (tid < NEXP) lcnt[tid] = 0;
  __syncthreads();
  for (int tb = bid; tb < NTOK / 64; tb += nb) {
    const int tok0 = tb * 64;
    const int b = tok0 / T;
    const float* wsc = p.wsc2 + (l * 2 + b) * DM;
    {
      float* Bs = (float*)(smem + 32768);
      const float* xr = p.xbuf + (size_t)(tok0 + tg * 16 + fr) * DM + kh * 512 + fq * 4;
      const float* wv = wsc + kh * 512 + fq * 4;
      const float* wl = p.wcat + (size_t)l * DM * 48;
      f32x4 acc[3];
#pragma unroll
      for (int nt = 0; nt < 3; ++nt) acc[nt] = f32x4{0.f, 0.f, 0.f, 0.f};
      float ssq = 0.f;
      float4 rbv[3], xa[4], wa[4], xn[4], wn[4];
      auto gloadB = [&](int s) {
#pragma unroll
        for (int i = 0; i < 3; ++i) {
          const int idx = tid + NTHR * i, half = idx / 768, r = idx - half * 768, krow = r / 12, c4 = r - krow * 12;
          rbv[i] = *(const float4*)(wl + (size_t)(half * 512 + 64 * s + krow) * 48 + c4 * 4);
        }
      };
      auto storeB = [&](int buf) {
#pragma unroll
        for (int i = 0; i < 3; ++i) {
          const int idx = tid + NTHR * i, half = idx / 768, r = idx - half * 768, krow = r / 12, c4 = r - krow * 12;
          *(float4*)(Bs + ((buf * 2 + half) * 64 + krow) * 48 + c4 * 4) = rbv[i];
        }
      };
      auto gloadA = [&](float4 (&xd)[4], float4 (&wd)[4], int s) {
#pragma unroll
        for (int c = 0; c < 4; ++c) {
          xd[c] = *(const float4*)(xr + 64 * s + c * 16);
          wd[c] = *(const float4*)(wv + 64 * s + c * 16);
        }
      };
      gloadB(0);
      gloadA(xa, wa, 0);
      storeB(0);
      __syncthreads();
#pragma unroll 1
      for (int s = 0; s < 8; ++s) {
        const int sn = min(s + 1, 7);
        gloadB(sn);
        gloadA(xn, wn, sn);
        const float* bt = Bs + (((s & 1) * 2 + kh) * 64 + fq) * 48 + fr;
#pragma unroll
        for (int c = 0; c < 4; ++c) {
          const float4 xv = xa[c], ww = wa[c];
          ssq += xv.x * xv.x + xv.y * xv.y + xv.z * xv.z + xv.w * xv.w;
          const float a0 = xv.x * ww.x, a1 = xv.y * ww.y, a2 = xv.z * ww.z, a3 = xv.w * ww.w;
          const float* bp = bt + (16 * c + 3 * fq) * 48;
#pragma unroll
          for (int nt = 0; nt < 3; ++nt) {
            acc[nt] = __builtin_amdgcn_mfma_f32_16x16x4f32(a0, bp[0 * 48 + nt * 16], acc[nt], 0, 0, 0);
            acc[nt] = __builtin_amdgcn_mfma_f32_16x16x4f32(a1, bp[1 * 48 + nt * 16], acc[nt], 0, 0, 0);
            acc[nt] = __builtin_amdgcn_mfma_f32_16x16x4f32(a2, bp[2 * 48 + nt * 16], acc[nt], 0, 0, 0);
            acc[nt] = __builtin_amdgcn_mfma_f32_16x16x4f32(a3, bp[3 * 48 + nt * 16], acc[nt], 0, 0, 0);
          }
        }
        storeB((s + 1) & 1);
        __syncthreads();
#pragma unroll
        for (int c = 0; c < 4; ++c) { xa[c] = xn[c]; wa[c] = wn[c]; }
      }
      ssq += shx(ssq, 16, lane);
      ssq += shx(ssq, 32, lane);
#pragma unroll
      for (int nt = 0; nt < 3; ++nt)
#pragma unroll
        for (int j = 0; j < 4; ++j) accb[(kh * 64 + tg * 16 + fq * 4 + j) * 49 + nt * 16 + fr] = acc[nt][j];
      if (fq == 0) ssqb[kh * 64 + tg * 16 + fr] = ssq;
    }
    __syncthreads();
    if (tid < 64) {
      const int t = tok0 + tid;
      const float rstd = rsqrtf((ssqb[tid] + ssqb[64 + tid]) * (1.f / DM) + EPS);
      rsl[tid] = rstd;
      const float* c0 = p.c0 + (l * 2 + b) * 48;
      float acc[36];
#pragma unroll
      for (int o = 0; o < 36; ++o) acc[o] = rstd * (accb[tid * 49 + o] + accb[(64 + tid) * 49 + o]) + c0[o];
      int grp = 0;
      float mx = acc[0];
#pragma unroll
      for (int g = 1; g < 4; ++g)
        if (acc[g] > mx) { mx = acc[g]; grp = g; }
      float den = 0.f;
#pragma unroll
      for (int g = 0; g < 4; ++g) den += __expf(acc[g] - mx);
      const float pg_top = 1.f / den;
      float el[8];
#pragma unroll
      for (int j = 0; j < 8; ++j) {
        const float a0 = acc[4 + j], a1 = acc[12 + j], a2 = acc[20 + j], a3 = acc[28 + j];
        el[j] = (grp == 0) ? a0 : (grp == 1) ? a1 : (grp == 2) ? a2 : a3;
      }
      float b0 = -3.0e38f, b1 = -3.0e38f;
      int i0 = 0, i1 = 0;
#pragma unroll
      for (int j = 0; j < 8; ++j)
        if (el[j] > b0) { b0 = el[j]; i0 = j; }
#pragma unroll
      for (int j = 0; j < 8; ++j)
        if (j != i0 && el[j] > b1) { b1 = el[j]; i1 = j; }
      const float ex = __expf(b1 - b0);
      const float g0 = pg_top / (1.f + ex), g1 = pg_top * ex / (1.f + ex);
      const int e0 = grp * 8 + i0, e1 = grp * 8 + i1;
      sel_e0 = e0; sel_e1 = e1;
      sel_r0 = atomicAdd(&lcnt[e0], 1);
      sel_r1 = atomicAdd(&lcnt[e1], 1);
      p.sgate[2 * t] = g0;
      p.sgate[2 * t + 1] = g1;
    }
    __syncthreads();
    if (tid < NEXP) {
      const int c = lcnt[tid];
      lbase[tid] = (c > 0) ? atomicAdd(&p.cnt[l * NEXP + tid], c) : 0;
      lcnt[tid] = 0;
    }
    __syncthreads();
    if (tid < 64) {
      const int t = tok0 + tid;
      p.list[sel_e0 * CAP + lbase[sel_e0] + sel_r0] = 2 * t;
      p.list[sel_e1 * CAP + lbase[sel_e1] + sel_r1] = 2 * t + 1;
    }
    {
      const float* sh = p.mod + (l * 2 + b) * 6144 + MOD_SHIFT2;
#pragma unroll 2
      for (int q = 0; q < 8; ++q) {
        const int tl = wid * 8 + q;
        const float rstd = rsl[tl];
        const float4* xr = (const float4*)(p.xbuf + (size_t)(tok0 + tl) * DM);
#pragma unroll
        for (int i = 0; i < 4; ++i) {
          const int idx = (lane + 64 * i) * 4;
          const float4 xv = xr[lane + 64 * i];
          const float4 w = *(const float4*)(wsc + idx);
          const float4 h = *(const float4*)(sh + idx);
          uint2 pk;
          pk.x = pack2(xv.x * w.x * rstd + h.x, xv.y * w.y * rstd + h.y);
          pk.y = pack2(xv.z * w.z * rstd + h.z, xv.w * w.w * rstd + h.w);
          *(uint2*)(p.act + (size_t)(tok0 + tl) * DM + idx) = pk;
        }
      }
    }
    __syncthreads();
  }
}

struct EpiMoe {
  static constexpr bool PERM = true;
  bf16_t* H; bf16_t* Y; const int* list; const float* sgate;
  DEV void operator()(const f32x4 (&acc)[2][2][4][2], const GUnit& u, int wr, int wc, int fr_, int fq) const {
    int fr = fr_;
    asm volatile("" : "+v"(fr));
    if (!u.ph) {
      const __amdgpu_buffer_rsrc_t rh = __builtin_amdgcn_make_buffer_rsrc((void*)H, 0, 2 * 32768 * DEXP, 0x00020000);
      const int hcol = u.pn * 128 + wc * 32 + 8 * fq;
#pragma unroll
      for (int ai = 0; ai < 2; ++ai)
#pragma unroll
        for (int m = 0; m < 4; ++m) {
          const int rl = ai * G_HALF + wr * 64 + m * 16 + fr;
          if (rl < u.valid) {
            const int slot = list[u.e * CAP + u.pm * 256 + rl];
            float h[8];
#pragma unroll
            for (int n = 0; n < 2; ++n)
#pragma unroll
              for (int j = 0; j < 4; ++j) h[n * 4 + j] = silu_f(acc[ai][0][m][n][j]) * acc[ai][1][m][n][j];
            const uint4 pk = pack8(h);
            const u32x4 pv = {pk.x, pk.y, pk.z, pk.w};
            __builtin_amdgcn_raw_buffer_store_b128(pv, rh, (slot * DEXP + hcol) * 2, 0, 16  );
          }
        }
    } else {
      const int col0 = u.pn * 256 + wc * 32 + 8 * fq;
#pragma unroll
      for (int ai = 0; ai < 2; ++ai)
#pragma unroll
        for (int m = 0; m < 4; ++m) {
          const int rl = ai * G_HALF + wr * 64 + m * 16 + fr;
          if (rl < u.valid) {
            const int slot = list[u.e * CAP + u.pm * 256 + rl];
            const float g = sgate[slot];
#pragma unroll
            for (int bj = 0; bj < 2; ++bj) {
              float yv[8];
#pragma unroll
              for (int n = 0; n < 2; ++n)
#pragma unroll
                for (int j = 0; j < 4; ++j) yv[n * 4 + j] = g * acc[ai][bj][m][n][j];
              *(uint4*)(Y + (size_t)slot * DM + col0 + bj * G_HALF) = pack8(yv);
            }
          }
        }
    }
  }
};

DEV void phase_moe(const Params& p, int l, int bid, int nb, char* smem) {
  MoeSched S;
  S.act = p.act; S.hbuf = p.hbuf; S.bt1 = p.bt1; S.bt2 = p.bt2; S.cnt = p.cnt + l * NEXP; S.list = p.list;
  S.rdy = p.bar + XB_RDY + l * 192; S.tmo = p.bar + XB_TMO; S.G = nb; S.c = bid; S.wv = p.wv;
  EpiMoe E;
  E.H = p.hbuf; E.Y = p.ybuf; E.list = p.list; E.sgate = p.sgate;
  gemm_phase((LAS unsigned char*)smem, S, E);
}

DEV void phase_combine(const Params& p, int l, int bid, int nb) {
  const int tid_ = fresh_tid(), lane = tid_ & 63, wid = tid_ >> 6;
  for (int t = bid * NWAVE + wid; t < NTOK; t += nb * NWAVE) {
    float4* xr = (float4*)(p.xbuf + (size_t)t * DM);
    const int b = t / T;
    const float* md = p.mod + (l * 2 + b) * 6144;
    float4 v[4];
    float ss = 0.f;
#pragma unroll
    for (int i = 0; i < 4; ++i) {
      const int idx = (lane + 64 * i) * 4;
      v[i] = xr[lane + 64 * i];
      const float4 g = *(const float4*)(md + MOD_GATE2 + idx);
      const uint2 ya = *(const uint2*)(p.ybuf + (size_t)(2 * t) * DM + idx);
      const uint2 yb = *(const uint2*)(p.ybuf + (size_t)(2 * t + 1) * DM + idx);
      v[i].x += g.x * (__uint_as_float(ya.x << 16) + __uint_as_float(yb.x << 16));
      v[i].y += g.y * (__uint_as_float(ya.x & 0xffff0000u) + __uint_as_float(yb.x & 0xffff0000u));
      v[i].z += g.z * (__uint_as_float(ya.y << 16) + __uint_as_float(yb.y << 16));
      v[i].w += g.w * (__uint_as_float(ya.y & 0xffff0000u) + __uint_as_float(yb.y & 0xffff0000u));
      ss += v[i].x * v[i].x + v[i].y * v[i].y + v[i].z * v[i].z + v[i].w * v[i].w;
    }
    ss = wave_sum(ss, lane);
    const float rstd = rsqrtf(ss * (1.f / DM) + EPS);
    if (l + 1 < DEPTH) {
#pragma unroll
      for (int i = 0; i < 4; ++i) xr[lane + 64 * i] = v[i];
      const float* md2 = p.mod + ((l + 1) * 2 + b) * 6144;
      norm_mod_store(v, rstd, p.norm_mix_w + (l + 1) * DM, md2 + MOD_SCALE1, md2 + MOD_SHIFT1,
                     p.act + (size_t)t * DM, lane);
    } else {
      float4* orow = (float4*)(p.out + (size_t)t * DM);
#pragma unroll
      for (int i = 0; i < 4; ++i) {
        const float4 w = *(const float4*)(p.final_w + (lane + 64 * i) * 4);
        float4 r;
        r.x = v[i].x * rstd * w.x;
        r.y = v[i].y * rstd * w.y;
        r.z = v[i].z * rstd * w.z;
        r.w = v[i].w * rstd * w.w;
        orow[lane + 64 * i] = r;
      }
    }
  }
}

constexpr size_t ws_align(size_t b) { return (b + 255) & ~(size_t)255; }
constexpr size_t WS_bar = 0;
constexpr size_t WS_mod = WS_bar + ws_align(sizeof(unsigned) * BAR_WORDS_TOTAL);
constexpr size_t WS_btin = WS_mod + ws_align(sizeof(float) * DEPTH * NB * 6144);
constexpr size_t WS_btg = WS_btin + ws_align(2 * (size_t)PROJW * DM);
constexpr size_t WS_btout = WS_btg + ws_align(2 * (size_t)16 * DM);
constexpr size_t WS_bt1 = WS_btout + ws_align(2 * (size_t)DM * DM);
constexpr size_t WS_bt2 = WS_bt1 + ws_align(2 * (size_t)NEXP * 1024 * DM);
constexpr size_t WS_wcat = WS_bt2 + ws_align(2 * (size_t)NEXP * DM * DEXP);
constexpr size_t WS_wsc2 = WS_wcat + ws_align(sizeof(float) * DEPTH * DM * 48);
constexpr size_t WS_c0 = WS_wsc2 + ws_align(sizeof(float) * DEPTH * NB * DM);
constexpr size_t WS_cnt = WS_c0 + ws_align(sizeof(float) * DEPTH * NB * 48);
constexpr size_t WS_xbuf = WS_cnt + ws_align(sizeof(int) * DEPTH * NEXP);
constexpr size_t WS_act = WS_xbuf + ws_align(sizeof(float) * (size_t)NTOK * DM);
constexpr size_t WS_proj = WS_act + ws_align(2 * (size_t)NTOK * DM);
constexpr size_t WS_gates = WS_proj + ws_align(2 * (size_t)NTOK * PROJW);
constexpr size_t WS_y = WS_gates + ws_align(sizeof(float) * (size_t)NTOK * 16);
constexpr size_t WS_list = WS_y + ws_align(2 * (size_t)NTOK * DM);
constexpr size_t WS_sgate = WS_list + ws_align(sizeof(int) * NEXP * CAP);
constexpr size_t WS_egl = WS_sgate + ws_align(sizeof(float) * 2 * NTOK);
constexpr size_t WS_obuf = WS_egl + ws_align(sizeof(float) * 2048);
constexpr size_t WS_gdn_rec = WS_obuf + ws_align(2 * 2 * (size_t)NTOK * 512);
constexpr size_t WS_gdn_u = WS_gdn_rec + ws_align((size_t)2048 * REC_BYTES);
constexpr size_t WS_TOTAL = WS_gdn_u + ws_align(sizeof(unsigned) * (size_t)2048 * 32 * 128);

struct KArgs {
  const float *x, *c, *norm_mix_w, *norm_ffn_w, *w_ada, *b_ada, *w_in, *conv_a_w, *na_rpb, *gdn_conv_w,
      *gdn_a_log, *gdn_dt_bias, *gdn_norm_w, *w_out, *rg_w, *rg_b, *re_w, *re_b, *ew1, *ew3, *ew2, *final_w;
  float* out;
  char* ws;
  int rep[12];
};
DEV Params make_params(const KArgs& a) {
  Params p;
  p.x = a.x; p.c = a.c; p.norm_mix_w = a.norm_mix_w; p.norm_ffn_w = a.norm_ffn_w; p.w_ada = a.w_ada; p.b_ada = a.b_ada;
  p.w_in = a.w_in; p.conv_a_w = a.conv_a_w; p.na_rpb = a.na_rpb; p.gdn_conv_w = a.gdn_conv_w; p.gdn_a_log = a.gdn_a_log;
  p.gdn_dt_bias = a.gdn_dt_bias; p.gdn_norm_w = a.gdn_norm_w; p.w_out = a.w_out; p.rg_w = a.rg_w; p.rg_b = a.rg_b;
  p.re_w = a.re_w; p.re_b = a.re_b; p.ew1 = a.ew1; p.ew3 = a.ew3; p.ew2 = a.ew2; p.final_w = a.final_w;
  p.out = a.out;
  p.bar = (unsigned*)(a.ws + WS_bar);
  p.mod = (float*)(a.ws + WS_mod);
  p.btin = (bf16_t*)(a.ws + WS_btin);
  p.btg = (bf16_t*)(a.ws + WS_btg);
  p.btout = (bf16_t*)(a.ws + WS_btout);
  p.bt1 = (bf16_t*)(a.ws + WS_bt1);
  p.bt2 = (bf16_t*)(a.ws + WS_bt2);
  p.wcat = (float*)(a.ws + WS_wcat);
  p.wsc2 = (float*)(a.ws + WS_wsc2);
  p.c0 = (float*)(a.ws + WS_c0);
  p.cnt = (int*)(a.ws + WS_cnt);
  p.xbuf = (float*)(a.ws + WS_xbuf);
  p.act = (bf16_t*)(a.ws + WS_act);
  p.proj = (bf16_t*)(a.ws + WS_proj);
  p.gates = (float*)(a.ws + WS_gates);
  p.y = (bf16_t*)(a.ws + WS_y);
  p.list = (int*)(a.ws + WS_list);
  p.sgate = (float*)(a.ws + WS_sgate);
  p.egl = (float*)(a.ws + WS_egl);
  p.obuf = (bf16_t*)(a.ws + WS_obuf);
  p.gdn_rec = (char*)(a.ws + WS_gdn_rec);
  p.gdn_u = (unsigned*)(a.ws + WS_gdn_u);
  p.hbuf = (bf16_t*)p.obuf;
  p.ybuf = (bf16_t*)p.gdn_rec;
#pragma unroll
  for (int i = 0; i < 12; ++i) p.rep[i] = a.rep[i];
  p.wv = __builtin_amdgcn_readfirstlane((int)(threadIdx.x >> 6));
  return p;
}

__global__ void __launch_bounds__(NTHR) mega_kernel(KArgs ka) {
  const Params p = make_params(ka);
  __shared__ __attribute__((aligned(16))) char smem[SMEM_BYTES + 16];
  const int bid0 = blockIdx.x, nb = gridDim.x;
  if (fresh_tid() == 0) *(uint4*)(smem + SMEM_BYTES) = make_uint4(0u, 0u, 0u, 0u);
  __syncthreads();
  xcd_barrier_post(p.bar, fresh_tid());
#pragma unroll 1
  for (int rp = 0; rp < p.rep[7]; ++rp) {
    phase_ada(p, bid0, nb, smem);
    convert_win(p, 0, bid0, nb, smem);
  }
  xcd_barrier(p.bar, (volatile LAS unsigned*)(smem + SMEM_BYTES), fresh_tid());
#pragma unroll 1
  for (int rp = 0; rp < p.rep[8]; ++rp) {
    phase_hmix(p, 0, p.x, bid0, nb);
    phase_consts(p, bid0, nb);
  }
  xcd_barrier(p.bar, (volatile LAS unsigned*)(smem + SMEM_BYTES), fresh_tid());
#pragma unroll 1
  for (int l = 0; l < DEPTH; ++l) {
    int lz = l;
    asm volatile("" : "+s"(lz));
    const int bid = bid0 + (lz - l);
#pragma unroll 1
    for (int rp = 0; rp < p.rep[0]; ++rp) phase_gemm_proj(p, l, bid, nb, smem);
    xcd_barrier(p.bar, (volatile LAS unsigned*)(smem + SMEM_BYTES), fresh_tid());
#pragma unroll 1
    for (int rp = 0; rp < p.rep[1]; ++rp) phase_gdn_prep(p, l, bid, nb, smem);
    xcd_barrier(p.bar, (volatile LAS unsigned*)(smem + SMEM_BYTES), fresh_tid());
#pragma unroll 1
    for (int rp = 0; rp < p.rep[2]; ++rp) {
      if (bid < 16) {
        phase_gdn_scan(p, l * 4 + rp + 1, bid, smem);
      } else if (bid < 64) {
        phase_scan_helper(p, l * 4 + rp + 1, (bid - 16) & 15, (bid - 16) >> 4, smem);
      } else {
#pragma unroll 1
        for (int rq = 0; rq < p.rep[6]; ++rq) {
          phase_conv(p, l, bid - 64, nb - 64);
          phase_na(p, l, (bid - 64) * NWAVE + (fresh_tid() >> 6), (nb - 64) * NWAVE);
        }
#pragma unroll 1
        for (int rq = 0; rq < p.rep[10]; ++rq) convert_layer(p, l, bid - 64, nb - 64, smem);
      }
    }
    xcd_barrier(p.bar, (volatile LAS unsigned*)(smem + SMEM_BYTES), fresh_tid());
#pragma unroll 1
    for (int rp = 0; rp < p.rep[5]; ++rp) phase_gdn_fin(p, l, bid, nb);
    xcd_barrier(p.bar, (volatile LAS unsigned*)(smem + SMEM_BYTES), fresh_tid());
#pragma unroll 1
    for (int rp = 0; rp < (l == 0 ? p.rep[9] : 1); ++rp) phase_gemm_wout(p, l, l == 0 ? p.x : p.xbuf, bid, nb, smem);
    xcd_barrier(p.bar, (volatile LAS unsigned*)(smem + SMEM_BYTES), fresh_tid());
    phase_router(p, l, bid, nb, smem);
    xcd_barrier(p.bar, (volatile LAS unsigned*)(smem + SMEM_BYTES), fresh_tid());
    phase_moe(p, l, bid, nb, smem);
    xcd_barrier(p.bar, (volatile LAS unsigned*)(smem + SMEM_BYTES), fresh_tid());
    phase_combine(p, l, bid, nb);
#pragma unroll 1
    for (int rp = 1; rp < p.rep[11]; ++rp) xcd_barrier(p.bar, (volatile LAS unsigned*)(smem + SMEM_BYTES), fresh_tid());
    if (l + 1 < DEPTH) xcd_barrier(p.bar, (volatile LAS unsigned*)(smem + SMEM_BYTES), fresh_tid());
  }
}

extern "C" void kernel_launch(void* const* d_in, const int* in_sizes, int n_in, void* d_out, int out_size,
                              void* d_ws, size_t ws_size, hipStream_t stream) {
  KArgs p{};
  p.x = (const float*)d_in[0];
  p.c = (const float*)d_in[1];
  p.norm_mix_w = (const float*)d_in[2];
  p.norm_ffn_w = (const float*)d_in[3];
  p.w_ada = (const float*)d_in[4];
  p.b_ada = (const float*)d_in[5];
  p.w_in = (const float*)d_in[6];
  p.conv_a_w = (const float*)d_in[7];
  p.na_rpb = (const float*)d_in[8];
  p.gdn_conv_w = (const float*)d_in[9];
  p.gdn_a_log = (const float*)d_in[10];
  p.gdn_dt_bias = (const float*)d_in[11];
  p.gdn_norm_w = (const float*)d_in[12];
  p.w_out = (const float*)d_in[13];
  p.rg_w = (const float*)d_in[14];
  p.rg_b = (const float*)d_in[15];
  p.re_w = (const float*)d_in[16];
  p.re_b = (const float*)d_in[17];
  p.ew1 = (const float*)d_in[18];
  p.ew3 = (const float*)d_in[19];
  p.ew2 = (const float*)d_in[20];
  p.final_w = (const float*)d_in[21];
  p.out = (float*)d_out;
  p.ws = (char*)d_ws;
  if (WS_TOTAL > ws_size) fprintf(stderr, "workspace too small: need %zu have %zu\n", (size_t)WS_TOTAL, ws_size);

  static int grid_blocks = 0;
  if (!grid_blocks) {
    int dev = 0, cus = 0, per_cu = 0;
    (void)hipGetDevice(&dev);
    (void)hipDeviceGetAttribute(&cus, hipDeviceAttributeMultiprocessorCount, dev);
    (void)hipOccupancyMaxActiveBlocksPerMultiprocessor(&per_cu, mega_kernel, NTHR, 0);
    if (per_cu > 1) per_cu = 1;
    if (per_cu < 1) per_cu = 1;
    grid_blocks = cus * per_cu;
  }
  (void)hipMemsetAsync((char*)d_ws + WS_bar, 0, sizeof(unsigned) * BAR_WORDS_TOTAL, stream);
  for (int i = 0; i < 12; ++i) p.rep[i] = 1;
  void* args[] = {&p};
  hipError_t e = hipLaunchCooperativeKernel((void*)mega_kernel, dim3(grid_blocks), dim3(NTHR), args, 0, stream);
  if (e != hipSuccess) fprintf(stderr, "cooperative launch failed: %s (grid %d)\n", hipGetErrorString(e), grid_blocks);
}
```

```cpp
#include <hip/hip_runtime.h>
#include <hip/hip_cooperative_groups.h>
#include <stdint.h>
#include <stdio.h>

#define DEV __device__ __forceinline__
namespace cg = cooperative_groups;

typedef __attribute__((ext_vector_type(8))) short bf16x8;
typedef __attribute__((ext_vector_type(4))) float f32x4;
typedef __attribute__((ext_vector_type(16))) float f32x16;
typedef float f32x2_t __attribute__((ext_vector_type(2)));
typedef __bf16 bf16x2_t __attribute__((ext_vector_type(2)));
typedef unsigned short bf16_t;
typedef unsigned u32x4 __attribute__((ext_vector_type(4)));

constexpr int NTHR = 512;
constexpr int NWAVE = 8;
constexpr int DM = 1024;
constexpr int NB = 2;
constexpr int T = 8192;
constexpr int NTOK = NB * T;
constexpr int DEPTH = 2;
constexpr int DIN = 3600;
constexpr int PROJW = 3584;
constexpr int NEXP = 32;
constexpr int DEXP = 512;
constexpr int CAP = 16384;
constexpr float EPS = 1e-6f;
constexpr int OFF_CB = 0, OFF_CC = 256, OFF_CX = 512, OFF_NQ = 768, OFF_NK = 1024, OFF_NV = 1280,
              OFF_GQKV = 1536, OFF_GZ = 3072;
constexpr int MOD_SHIFT1 = 0, MOD_SCALE1 = 1024, MOD_GATE1 = 2048, MOD_SHIFT2 = 3072, MOD_SCALE2 = 4096,
              MOD_GATE2 = 5120;

constexpr int REC_WN = 0, REC_QD = 16384, REC_IN = 32768, REC_KT = 40960, REC_BYTES = 57344;
constexpr int SC_WN = 0, SC_QD = 17408, SC_IN = 34816, SC_KT = 44032, SC_U = 62464, SC_BUF = 78848;
constexpr int PL_Q = 0, PL_K = 17408, PL_V = 34816, PL_L = 52224, PL_GC = 87040, PL_BETA = 87552, PL_BG = 88064,
              PL_GL = 88576, PL_FQ = 88592  , PL_FK = 89104  ,
              PL_CW = 89616  ;
constexpr int SMEM_BYTES = 2 * SC_BUF;

struct Params {
  const float *x, *c, *norm_mix_w, *norm_ffn_w, *w_ada, *b_ada, *w_in, *conv_a_w, *na_rpb, *gdn_conv_w,
      *gdn_a_log, *gdn_dt_bias, *gdn_norm_w, *w_out, *rg_w, *rg_b, *re_w, *re_b, *ew1, *ew3, *ew2, *final_w;
  float* out;
  float* mod;
  int* cnt;
  float* xbuf;
  bf16_t* act;
  bf16_t* proj;
  float* gates;
  bf16_t* y;
  bf16_t* obuf;
  char* gdn_rec;
  unsigned* gdn_u;
  float* egl;
  bf16_t* hbuf;
  bf16_t* ybuf;
  int* list;
  float* sgate;
  bf16_t* btin;
  bf16_t* btg;
  bf16_t* btout;
  bf16_t* bt1;
  bf16_t* bt2;
  float* wcat;
  float* wsc2;
  float* c0;
  unsigned* bar;
  int rep[12];
  int wv;
};

DEV unsigned pack2(float a, float b) {
  f32x2_t v = {a, b};
  return __builtin_bit_cast(unsigned, __builtin_convertvector(v, bf16x2_t));
}
DEV bf16_t f2bf(float f) { return (bf16_t)(pack2(f, 0.f) & 0xffffu); }
DEV float bf2f(bf16_t h) { return __uint_as_float(((unsigned)h) << 16); }
DEV float silu_f(float x) { return x * __builtin_amdgcn_rcpf(1.f + __expf(-x)); }
DEV float sigmoid_f(float x) { return __builtin_amdgcn_rcpf(1.f + __expf(-x)); }
DEV float softplus_f(float x) { return fmaxf(x, 0.f) + log1pf(__expf(-fabsf(x))); }
DEV float shx(float v, int k, int lane) {
  return __int_as_float(__builtin_amdgcn_ds_bpermute((lane ^ k) << 2, __float_as_int(v)));
}
DEV float wave_sum(float v, int lane) {
#pragma unroll
  for (int o = 32; o > 0; o >>= 1) v += shx(v, o, lane);
  return v;
}
DEV int fresh_tid_w(int wv) {
  unsigned z = 0u;
  asm volatile("" : "+s"(wv), "+v"(z));
  int t = (wv << 6) | (int)__builtin_amdgcn_mbcnt_hi(~0u, __builtin_amdgcn_mbcnt_lo(~0u, z));
  asm volatile("" : "+v"(t));
  return t;
}
#define fresh_tid() fresh_tid_w(p.wv)
DEV void unpack8(uint4 u, float* f) {
  f[0] = __uint_as_float(u.x << 16);
  f[1] = __uint_as_float(u.x & 0xffff0000u);
  f[2] = __uint_as_float(u.y << 16);
  f[3] = __uint_as_float(u.y & 0xffff0000u);
  f[4] = __uint_as_float(u.z << 16);
  f[5] = __uint_as_float(u.z & 0xffff0000u);
  f[6] = __uint_as_float(u.w << 16);
  f[7] = __uint_as_float(u.w & 0xffff0000u);
}
DEV uint4 pack8(const float* f) {
  uint4 r;
  r.x = pack2(f[0], f[1]);
  r.y = pack2(f[2], f[3]);
  r.z = pack2(f[4], f[5]);
  r.w = pack2(f[6], f[7]);
  return r;
}
#define MFMA16(a, b, c) __builtin_amdgcn_mfma_f32_16x16x32_bf16((a), (b), (c), 0, 0, 0)
#define MFMA32(a, b, c) __builtin_amdgcn_mfma_f32_32x32x16_bf16((a), (b), (c), 0, 0, 0)

#define LAS __attribute__((address_space(3)))
#define XB_TMO      128
#define XB_XCNT(j)  (256  + 64 * (j))
#define XB_XSUB(j)  (1280 + 64 * (j))
#define XB_XGEN(j)  (2304 + 64 * (j))
#define XB_TOP      3328
#define XB_TOPGEN   3392
#define XCD_BAR_WORDS 3456
#define XB_PROG(c)   (3456 + 64 * (c))
#define XB_CXCC(c)   (3456 + 1024 + 64 * (c))
#define XB_RDY       (3456 + 2048)
#define BAR_WORDS_TOTAL (3456 + 2048 + 384)
#define XB_SPIN_CAP (1u << 22)

DEV unsigned xb_ld(unsigned* p) { return __hip_atomic_load(p, __ATOMIC_RELAXED, __HIP_MEMORY_SCOPE_AGENT); }
DEV unsigned xb_add(unsigned* p, unsigned v) { return __hip_atomic_fetch_add(p, v, __ATOMIC_RELAXED, __HIP_MEMORY_SCOPE_AGENT); }
DEV unsigned xb_xcc_id() { return (unsigned)__builtin_amdgcn_s_getreg((3 << 11) | 20) & 0xFu; }
#define XB_SPIN(cond, bar) do { unsigned _sp = 0; while (cond) { __builtin_amdgcn_s_sleep(1); \
    if ((++_sp & 255u) == 0u) { if (xb_ld(&(bar)[XB_TMO])) break; if (_sp > XB_SPIN_CAP) { atomicAdd(&(bar)[XB_TMO], 1u); break; } } } } while (0)

DEV void xcd_barrier_post(unsigned* bar, int tid) {
  if (tid == 0) (void)xb_add(&bar[XB_XCNT(xb_xcc_id())], 1u);
}
DEV void xcd_barrier_complete(unsigned* bar, unsigned x, unsigned& nloc, unsigned& nx) {
  const unsigned G = gridDim.x * gridDim.y * gridDim.z;
  unsigned sum, cnt, mine, sp = 0u;
  for (;;) {
    sum = 0u; cnt = 0u; mine = 0u;
#pragma unroll
    for (unsigned j = 0; j < 16; ++j) {
      const unsigned c = xb_ld(&bar[XB_XCNT(j)]);
      sum += c;
      cnt += (c > 0u) ? 1u : 0u;
      mine = (j == x) ? c : mine;
    }
    if (sum == G) break;
    __builtin_amdgcn_s_sleep(1);
    if ((++sp & 255u) == 0u) {
      if (xb_ld(&bar[XB_TMO])) break;
      if (sp > XB_SPIN_CAP) { atomicAdd(&bar[XB_TMO], 1u); break; }
    }
  }
  nloc = mine > 0u ? mine : 1u;
  nx = cnt > 0u ? cnt : 1u;
}
DEV void xcd_barrier(unsigned* bar, volatile LAS unsigned* st, int tid) {
  asm volatile("s_waitcnt vmcnt(0)" ::: "memory");
  __syncthreads();
  if (tid == 0) {
    const unsigned bx = xb_xcc_id();
    __builtin_amdgcn_s_waitcnt(0);
    unsigned nloc = st[0], nx = st[1];
    const unsigned gen = st[2];
    st[2] = gen + 1u;
    if (nloc == 0u) {
      xcd_barrier_complete(bar, bx, nloc, nx);
      st[0] = nloc;
      st[1] = nx;
    }
    const unsigned old = xb_add(&bar[XB_XSUB(bx)], 1u);
    if (old + 1u == (gen + 1u) * nloc) {
      __builtin_amdgcn_fence(__ATOMIC_RELEASE, "agent");
      asm volatile("s_waitcnt vmcnt(0)" ::: "memory");
      const unsigned og = xb_add(&bar[XB_TOP], 1u);
      if (og + 1u == (gen + 1u) * nx) xb_add(&bar[XB_TOPGEN], 1u);
      else XB_SPIN(xb_ld(&bar[XB_TOPGEN]) == gen, bar);
      __builtin_amdgcn_fence(__ATOMIC_ACQUIRE, "agent");
      xb_add(&bar[XB_XGEN(bx)], 1u);
      asm volatile("s_waitcnt vmcnt(0)" ::: "memory");
    } else {
      XB_SPIN(xb_ld(&bar[XB_XGEN(bx)]) == gen, bar);
      __builtin_amdgcn_fence(__ATOMIC_ACQUIRE, "agent");
      asm volatile("s_waitcnt vmcnt(0)" ::: "memory");
    }
  }
  __syncthreads();
}

constexpr int G_BK = 64, G_HALF = 128, G_HTB = G_HALF * G_BK * 2, G_STAGE_BYTES = 8 * G_HTB;
DEV int g_lds_byte(int r, int c) {
  const int st = (r >> 4) * 2 + (c >> 5), rr = r & 15, cc = c & 31, ob = rr * 64 + cc * 2;
  return st * 1024 + (ob ^ (((ob >> 9) & 1) << 5));
}
DEV void g_stage_rc(int b, int& R, int& C) {
  const int st = b / 1024, sb = b % 1024, swz = sb ^ (((sb >> 9) & 1) << 5);
  R = (st >> 1) * 16 + swz / 64;
  C = (st & 1) * 32 + (swz % 64) / 2;
}
DEV int g_perm32(int rho) { const int n = rho >> 4, i = rho & 15; return 8 * (i >> 2) + 4 * n + (i & 3); }

struct GUnit { int pm, pn, e, valid, ph, ridx; };

template <class Epi, class Sched>
DEV void gemm_phase(LAS unsigned char* lds, const Sched& S, const Epi& E) {
  const int tid = fresh_tid_w(S.wv), wid = S.wv, lane = tid & 63, wr = wid >> 2, wc = wid & 3, fr = lane & 15,
            fq = lane >> 4;
  GUnit cur, nxt;
  int ui = 0;
  if (!S.next(0, cur)) return;
  int K = S.kof(cur), nt = K / G_BK;
  unsigned voffB[2];
  auto b_offsets = [&](int Ku) {
    const int tl_ = fresh_tid_w(S.wv);
#pragma unroll
    for (int i = 0; i < 2; ++i) {
      int R, C;
      g_stage_rc(tl_ * 16 + i * 8192, R, C);
      const int Rb = Epi::PERM ? ((R & ~31) + g_perm32(R & 31)) : R;
      voffB[i] = (unsigned)(Rb * Ku + C) * 2u;
    }
  };
  b_offsets(K);
  unsigned vA[2][2];
  auto a_offsets = [&](const GUnit& u) {
    const int tl_ = fresh_tid_w(S.wv);
#pragma unroll
    for (int h = 0; h < 2; ++h)
#pragma unroll
      for (int i = 0; i < 2; ++i) {
        int R, C;
        g_stage_rc(tl_ * 16 + i * 8192, R, C);
        vA[h][i] = S.rowoff(u, h * G_HALF + R) + (unsigned)C * 2u;
      }
  };
  const size_t kstep = (size_t)(G_BK * 2);
  size_t hstep = (size_t)G_HALF * K * 2;
  const unsigned ldsw = (unsigned)wid * 1024u;
  const int aoff = g_lds_byte(wr * 64 + fr, fq * 8), boff = g_lds_byte(wc * 32 + fr, fq * 8);
#define PG8_SA(b, h) (((b) * 2 + (h)) * G_HTB)
#define PG8_SB(b, h) ((4 + (b) * 2 + (h)) * G_HTB)
#define PG8_STAGE(bufoff, gbase, voff) do { _Pragma("unroll") for (int _i = 0; _i < 2; ++_i) \
    __builtin_amdgcn_global_load_lds((const unsigned*)((const char*)(gbase) + (voff)[_i]), (LAS unsigned*)(lds + (bufoff) + ldsw + _i * 8192), 16, 0, 0); } while (0)
#define PG8_LDA(dst, b, h) do { _Pragma("unroll") for (int m = 0; m < 4; ++m) _Pragma("unroll") for (int k = 0; k < 2; ++k) dst[m][k] = *(const LAS bf16x8*)(lds + PG8_SA(b, h) + aoff + m * 2048 + k * 1024); } while (0)
#define PG8_LDB(dst, b, h) do { _Pragma("unroll") for (int n = 0; n < 2; ++n) _Pragma("unroll") for (int k = 0; k < 2; ++k) dst[n][k] = *(const LAS bf16x8*)(lds + PG8_SB(b, h) + boff + n * 2048 + k * 1024); } while (0)
#define PG8_MMA(ai, bj, At, Bt) do { __builtin_amdgcn_s_setprio(1); _Pragma("unroll") for (int m = 0; m < 4; ++m) _Pragma("unroll") for (int n = 0; n < 2; ++n) _Pragma("unroll") for (int k = 0; k < 2; ++k) \
    acc[ai][bj][m][n] = __builtin_amdgcn_mfma_f32_16x16x32_bf16(Bt[n][k], At[m][k], acc[ai][bj][m][n], 0, 0, 0); __builtin_amdgcn_s_setprio(0); } while (0)
#define PG8_WAIT_V(n) asm volatile("s_waitcnt vmcnt(" #n ")" ::: "memory")
#define PG8_WAIT_L(n) asm volatile("s_waitcnt lgkmcnt(" #n ")" ::: "memory")
#define PG8_BAR __builtin_amdgcn_s_barrier()
#define PG8_SCHED __builtin_amdgcn_sched_barrier(0)
  f32x4 acc[2][2][4][2];
#pragma unroll
  for (int a = 0; a < 2; ++a)
#pragma unroll
    for (int b = 0; b < 2; ++b)
#pragma unroll
      for (int m = 0; m < 4; ++m)
#pragma unroll
        for (int n = 0; n < 2; ++n) acc[a][b][m][n] = (f32x4){0.f, 0.f, 0.f, 0.f};
  bf16x8 At[4][2], B0[2][2], B1[2][2];
  const char* gA = S.aptr(cur);
  const char* cB = S.bptr(cur);
  S.a_ready(cur);
  a_offsets(cur);
  PG8_STAGE(PG8_SB(0, 0), cB, voffB); PG8_STAGE(PG8_SA(0, 0), gA, vA[0]); PG8_STAGE(PG8_SB(0, 1), cB + hstep, voffB); PG8_STAGE(PG8_SA(0, 1), gA, vA[1]);
  if (wr == 1) PG8_BAR;
  PG8_WAIT_V(4); PG8_BAR;
  PG8_STAGE(PG8_SB(1, 0), cB + kstep, voffB); PG8_STAGE(PG8_SA(1, 0), gA + kstep, vA[0]); PG8_STAGE(PG8_SB(1, 1), cB + hstep + kstep, voffB);
  PG8_WAIT_V(6); PG8_BAR;
  for (;;) {
    const bool has_next = S.next(ui + 1, nxt);
    const char* nB = has_next ? S.bptr(nxt) : cB;
    for (int t = 0; t < nt; t += 2) {
      const bool last = (t == nt - 2);
      const char* a1 = gA + (size_t)(t + 1) * kstep;
      const char* b2 = last ? nB : cB + (size_t)(t + 2) * kstep;
      const char* b3 = b2 + kstep;
      PG8_LDB(B0, 0, 0); PG8_SCHED; PG8_LDA(At, 0, 0); PG8_STAGE(PG8_SA(1, 1), a1, vA[1]);
      PG8_WAIT_L(8); PG8_BAR; PG8_WAIT_L(0); PG8_MMA(0, 0, At, B0); PG8_BAR; PG8_SCHED;
      if (last && has_next) {
        S.a_ready(nxt);
        a_offsets(nxt);
        gA = S.aptr(nxt);
        const int Kn = S.kof(nxt);
        b_offsets(Kn);
        hstep = (size_t)G_HALF * Kn * 2;
      }
      const char* a2 = last ? gA : gA + (size_t)(t + 2) * kstep;
      const char* a3 = a2 + kstep;
      PG8_LDB(B1, 0, 1); PG8_STAGE(PG8_SB(0, 0), b2, voffB);
      PG8_BAR; PG8_WAIT_L(0); PG8_MMA(0, 1, At, B1); PG8_BAR;
      PG8_LDA(At, 0, 1); PG8_STAGE(PG8_SA(0, 0), a2, vA[0]);
      PG8_BAR; PG8_WAIT_L(0); PG8_MMA(1, 0, At, B0); PG8_BAR; PG8_SCHED;
      PG8_STAGE(PG8_SB(0, 1), b2 + hstep, voffB);
      PG8_WAIT_V(6); PG8_BAR; PG8_MMA(1, 1, At, B1); PG8_BAR;
      PG8_LDB(B0, 1, 0); PG8_SCHED; PG8_LDA(At, 1, 0); PG8_STAGE(PG8_SA(0, 1), a2, vA[1]);
      PG8_WAIT_L(8); PG8_BAR; PG8_WAIT_L(0); PG8_MMA(0, 0, At, B0); PG8_BAR; PG8_SCHED;
      PG8_LDB(B1, 1, 1); PG8_STAGE(PG8_SB(1, 0), b3, voffB);
      PG8_BAR; PG8_WAIT_L(0); PG8_MMA(0, 1, At, B1); PG8_BAR;
      PG8_LDA(At, 1, 1); PG8_STAGE(PG8_SA(1, 0), a3, vA[0]);
      PG8_BAR; PG8_WAIT_L(0); PG8_MMA(1, 0, At, B0); PG8_BAR; PG8_SCHED;
      PG8_STAGE(PG8_SB(1, 1), b3 + hstep, voffB);
      PG8_WAIT_V(6); PG8_BAR; PG8_MMA(1, 1, At, B1); PG8_BAR;
    }
    {
      const int te_ = fresh_tid_w(S.wv), le_ = te_ & 63;
      E(acc, cur, wr, wc, le_ & 15, le_ >> 4);
      S.done(cur, le_);
    }
    if (!has_next) break;
#pragma unroll
    for (int a = 0; a < 2; ++a)
#pragma unroll
      for (int b = 0; b < 2; ++b)
#pragma unroll
        for (int m = 0; m < 4; ++m)
#pragma unroll
          for (int n = 0; n < 2; ++n) acc[a][b][m][n] = (f32x4){0.f, 0.f, 0.f, 0.f};
    cur = nxt; cB = nB; ++ui;
    K = S.kof(cur); nt = K / G_BK;
  }
  PG8_WAIT_V(0);
  if (wr == 0) PG8_BAR;
  PG8_BAR;
#undef PG8_SA
#undef PG8_SB
#undef PG8_STAGE
#undef PG8_LDA
#undef PG8_LDB
#undef PG8_MMA
#undef PG8_WAIT_V
#undef PG8_WAIT_L
#undef PG8_BAR
#undef PG8_SCHED
}

struct DenseSched {
  const bf16_t* A; const bf16_t* Bt; int K, nM, nN, nwg, G, c, wv;
  DEV bool next(int i, GUnit& u) const {
    const long L = (long)i * G + c;
    if (L >= nwg) return false;
    int wgid = (int)L;
    { const int q = nwg / 8, r = nwg % 8, xcd = wgid % 8, off = wgid / 8; wgid = (xcd < r ? xcd * (q + 1) : r * (q + 1) + (xcd - r) * q) + off; }
    const int nig = 8 * nN, gid = wgid / nig, fm = gid * 8;
    u.pm = fm + ((wgid % nig) & 7);
    u.pn = (wgid % nig) >> 3;
    u.e = 0;
    u.valid = 256;
    return true;
  }
  DEV unsigned rowoff(const GUnit& u, int row) const { return (unsigned)((u.pm * 256 + row) * K) * 2u; }
  DEV const char* bptr(const GUnit& u) const { return (const char*)Bt + (size_t)u.pn * 256 * K * 2; }
  DEV const char* aptr(const GUnit&) const { return (const char*)A; }
  DEV int kof(const GUnit&) const { return K; }
  DEV void a_ready(const GUnit&) const {}
  DEV void done(const GUnit&, int) const {}
};
struct MoeSched {
  const bf16_t* act; const bf16_t* hbuf; const bf16_t* bt1; const bf16_t* bt2; const int* cnt; const int* list;
  unsigned* rdy; unsigned* tmo; int G, c, wv;
  DEV bool next(int i, GUnit& u) const {
    const int x = c & 7, ng = G >> 3;
    int L = i * ng + (c >> 3);
    int Ux = 0;
#pragma unroll
    for (int q = 0; q < 4; ++q) Ux += ((cnt[x + 8 * q] + 255) >> 8) * 4;
    u.ph = (L >= Ux) ? 1 : 0;
    if (u.ph) L -= Ux;
    if (L >= Ux) return false;
    int e = x;
#pragma unroll
    for (int q = 0; q < 3; ++q) {
      const int ntl = ((cnt[x + 8 * q] + 255) >> 8) * 4;
      if (e == x + 8 * q && L >= ntl) { L -= ntl; e += 8; }
    }
    int base = 0;
    for (int e2 = 0; e2 < NEXP; ++e2) base += (e2 < e) ? ((cnt[e2] + 255) >> 8) : 0;
    const int cn = cnt[e];
    u.e = e; u.pm = L >> 2; u.pn = L & 3; u.valid = min(256, cn - u.pm * 256); u.ridx = base + u.pm;
    return true;
  }
  DEV unsigned rowoff(const GUnit& u, int row) const {
    const int slot = list[u.e * CAP + u.pm * 256 + min(row, u.valid - 1)];
    return u.ph ? (unsigned)(slot * DEXP) * 2u : (unsigned)((slot >> 1) * DM) * 2u;
  }
  DEV const char* bptr(const GUnit& u) const {
    return (const char*)bt1 + (ptrdiff_t)u.ph * ((const char*)bt2 - (const char*)bt1) +
           (((size_t)u.e * 1024 + u.pn * 256) * (size_t)(DM * 2 >> u.ph));
  }
  DEV const char* aptr(const GUnit& u) const {
    return (const char*)act + (ptrdiff_t)u.ph * ((const char*)hbuf - (const char*)act);
  }
  DEV int kof(const GUnit& u) const { return u.ph ? DEXP : DM; }
  DEV void a_ready(const GUnit& u) const {
    if (u.ph) {
      if (wv == 0) {
        unsigned spins = 0u;
        while (xb_ld(rdy + u.ridx) < 32u) {
          if (++spins > 4000000u) { atomicAdd(tmo, 1u); break; }
          __builtin_amdgcn_s_sleep(2);
        }
        __builtin_amdgcn_fence(__ATOMIC_ACQUIRE, "agent");
        asm volatile("s_waitcnt vmcnt(0)" ::: "memory");
      }
      asm volatile("" ::: "memory");
      __builtin_amdgcn_s_barrier();
      asm volatile("" ::: "memory");
    }
  }
  DEV void done(const GUnit& u, int lane) const {
    if (!u.ph) {
      asm volatile("s_waitcnt vmcnt(0)" ::: "memory");
      if (lane == 0) xb_add(rdy + u.ridx, 1u);
    }
  }
};

DEV void convert_tile(const float* src, int ld, int k0, int n0, bf16_t* dst, int drow0, int dK, float* tl, int tid) {
  {
    const int kk = tid >> 4, n4 = tid & 15;
    const float4 a = *(const float4*)(src + (size_t)(k0 + kk) * ld + n0 + n4 * 4);
    const float4 b = *(const float4*)(src + (size_t)(k0 + kk + 32) * ld + n0 + n4 * 4);
    float* r0 = tl + kk * 65 + n4 * 4;
    r0[0] = a.x; r0[1] = a.y; r0[2] = a.z; r0[3] = a.w;
    float* r1 = tl + (kk + 32) * 65 + n4 * 4;
    r1[0] = b.x; r1[1] = b.y; r1[2] = b.z; r1[3] = b.w;
  }
  __syncthreads();
  {
    const int n = tid >> 3, k8 = tid & 7;
    float v[8];
#pragma unroll
    for (int j = 0; j < 8; ++j) v[j] = tl[(k8 * 8 + j) * 65 + n];
    *(uint4*)(dst + (size_t)(drow0 + n) * dK + k0 + k8 * 8) = pack8(v);
  }
  __syncthreads();
}
DEV void convert_gates(const Params& p, int l, int bid, int nb, int tid) {
  const int bs = bid;
  const int g = bs * NTHR + tid;
  if (g < 16 * DM) {
    const int j = g >> 10, k = g & (DM - 1);
    p.btg[g] = f2bf(p.w_in[((size_t)l * DM + k) * DIN + PROJW + j]);
  }
}
DEV void convert_win(const Params& p, int l, int bid, int nb, char* smem) {
  const int tid = fresh_tid();
  for (int t = bid; t < 16 * 56; t += nb) {
    const int kt = t / 56, ntile = t - kt * 56;
    convert_tile(p.w_in + (size_t)l * DM * DIN, DIN, kt * 64, ntile * 64, p.btin, ntile * 64, DM, (float*)smem, tid);
  }
  convert_gates(p, l, bid, nb, tid);
}
struct CvtDesc { const float* src; bf16_t* dst; int ld, dK, k0, n0, drow0; };
DEV CvtDesc cvt_desc(const Params& p, int l, int t) {
  constexpr int NT_W1 = NEXP * 16 * 8, NT_W2 = NEXP * 8 * 16, NT_WO = 256;
  CvtDesc d;
  if (t < 2 * NT_W1) {
    const int which = t / NT_W1, r = t - which * NT_W1;
    const int e = r >> 7, kt = (r >> 3) & 15, ntile = r & 7;
    d.src = (which ? p.ew3 : p.ew1) + (size_t)(l * NEXP + e) * DM * DEXP;
    d.ld = DEXP; d.k0 = kt * 64; d.n0 = ntile * 64;
    d.dst = p.bt1; d.dK = DM;
    d.drow0 = e * 1024 + 256 * (d.n0 >> 7) + which * 128 + (d.n0 & 127);
  } else if (t < 2 * NT_W1 + NT_W2) {
    const int r = t - 2 * NT_W1;
    const int e = r >> 7, kt = (r >> 4) & 7, ntile = r & 15;
    d.src = p.ew2 + (size_t)(l * NEXP + e) * DEXP * DM;
    d.ld = DM; d.k0 = kt * 64; d.n0 = ntile * 64;
    d.dst = p.bt2; d.dK = DEXP; d.drow0 = e * 1024 + ntile * 64;
  } else {
    const int r = t - 2 * NT_W1 - NT_W2;
    const int kt = r >> 4, ntile = r & 15;
    d.src = p.w_out + (size_t)l * DM * DM;
    d.ld = DM; d.k0 = kt * 64; d.n0 = ntile * 64;
    d.dst = p.btout; d.dK = DM; d.drow0 = ntile * 64;
  }
  return d;
}
DEV void convert_layer(const Params& p, int l, int bid_, int nb, char* smem) {
  const int bid = bid_;
  const int tid = fresh_tid();
  float* tl = (float*)smem;
  constexpr int NT = 2 * (NEXP * 16 * 8) + NEXP * 8 * 16 + 256;
  const int kk = tid >> 4, n4 = tid & 15;
  auto fetch = [&](int t, float4& a, float4& b) {
    const CvtDesc d = cvt_desc(p, l, min(t, NT - 1));
    const float* s = d.src + (size_t)(d.k0 + kk) * d.ld + d.n0 + n4 * 4;
    {
      const f32x4 av = __builtin_nontemporal_load((const f32x4*)(s));
      const f32x4 bv = __builtin_nontemporal_load((const f32x4*)(s + (size_t)32 * d.ld));
      a = make_float4(av[0], av[1], av[2], av[3]);
      b = make_float4(bv[0], bv[1], bv[2], bv[3]);
    }
  };
  float4 a0, b0, a1, b1, a2, b2;
  fetch(bid, a0, b0);
  fetch(bid + nb, a1, b1);
#pragma unroll 1
  for (int t = bid; t < NT; t += nb) {
    fetch(t + 2 * nb, a2, b2);
    const CvtDesc d = cvt_desc(p, l, t);
    {
      float* r0 = tl + kk * 65 + n4 * 4;
      r0[0] = a0.x; r0[1] = a0.y; r0[2] = a0.z; r0[3] = a0.w;
      float* r1 = tl + (kk + 32) * 65 + n4 * 4;
      r1[0] = b0.x; r1[1] = b0.y; r1[2] = b0.z; r1[3] = b0.w;
    }
    __syncthreads();
    {
      const int n = tid >> 3, k8 = tid & 7;
      float v[8];
#pragma unroll
      for (int j = 0; j < 8; ++j) v[j] = tl[(k8 * 8 + j) * 65 + n];
      const uint4 pk = pack8(v);
      const u32x4 pkv = {pk.x, pk.y, pk.z, pk.w};
      __builtin_nontemporal_store(pkv, (u32x4*)(d.dst + (size_t)(d.drow0 + n) * d.dK + d.k0 + k8 * 8));
    }
    __syncthreads();
    a0 = a1; b0 = b1; a1 = a2; b1 = b2;
  }
  if (l + 1 < DEPTH) convert_win(p, l + 1, bid, nb, smem);
}

DEV void phase_ada(const Params& p, int bid, int nb, char* smem) {
  float* cond = (float*)smem;
  float* red = cond + 2 * DM;
  const int tid = fresh_tid(), lane = tid & 63, wid = tid >> 6;
  for (int i = tid; i < 2 * DM; i += NTHR) cond[i] = silu_f(p.c[i]);
  __syncthreads();
  for (int item = bid; item < DEPTH * 96; item += nb) {
    const int l = item / 96, j = (item - l * 96) * 64 + lane;
    const float* w = p.w_ada + ((size_t)l * DM + wid * 128) * 6144 + j;
    float a0 = 0.f, a1 = 0.f;
#pragma unroll 16
    for (int k = 0; k < 128; ++k) {
      const float wv = w[(size_t)k * 6144];
      a0 += cond[wid * 128 + k] * wv;
      a1 += cond[DM + wid * 128 + k] * wv;
    }
    red[(wid * 2 + 0) * 64 + lane] = a0;
    red[(wid * 2 + 1) * 64 + lane] = a1;
    __syncthreads();
    if (wid < 2) {
      float s = p.b_ada[l * 6144 + j];
#pragma unroll
      for (int w8 = 0; w8 < 8; ++w8) s += red[(w8 * 2 + wid) * 64 + lane];
      p.mod[(l * 2 + wid) * 6144 + j] = s;
    }
    __syncthreads();
  }
  if (bid == 0 && tid < DEPTH * NEXP) p.cnt[tid] = 0;
}

DEV void norm_mod_store(const float4 (&v)[4], float rstd, const float* nw, const float* sc, const float* sh,
                        bf16_t* dst, int lane) {
#pragma unroll
  for (int i = 0; i < 4; ++i) {
    const int idx = (lane + 64 * i) * 4;
    const float4 w = *(const float4*)(nw + idx);
    const float4 s = *(const float4*)(sc + idx);
    const float4 h = *(const float4*)(sh + idx);
    const float r0 = v[i].x * rstd * w.x * (1.f + s.x) + h.x;
    const float r1 = v[i].y * rstd * w.y * (1.f + s.y) + h.y;
    const float r2 = v[i].z * rstd * w.z * (1.f + s.z) + h.z;
    const float r3 = v[i].w * rstd * w.w * (1.f + s.w) + h.w;
    uint2 pk;
    pk.x = pack2(r0, r1);
    pk.y = pack2(r2, r3);
    *(uint2*)(dst + idx) = pk;
  }
}

DEV void phase_hmix(const Params& p, int l, const float* xin, int bid, int nb) {
  const int tid_ = fresh_tid(), lane = tid_ & 63, wid = tid_ >> 6;
  for (int t = bid * NWAVE + wid; t < NTOK; t += nb * NWAVE) {
    const float4* xr = (const float4*)(xin + (size_t)t * DM);
    float4 v[4];
    float ss = 0.f;
#pragma unroll
    for (int i = 0; i < 4; ++i) {
      v[i] = xr[lane + 64 * i];
      ss += v[i].x * v[i].x + v[i].y * v[i].y + v[i].z * v[i].z + v[i].w * v[i].w;
    }
    ss = wave_sum(ss, lane);
    const float rstd = rsqrtf(ss * (1.f / DM) + EPS);
    const int b = t / T;
    const float* md = p.mod + (l * 2 + b) * 6144;
    norm_mod_store(v, rstd, p.norm_mix_w + l * DM, md + MOD_SCALE1, md + MOD_SHIFT1, p.act + (size_t)t * DM, lane);
  }
}

struct EpiProj {
  static constexpr bool PERM = true;
  bf16_t* O;
  DEV void operator()(const f32x4 (&acc)[2][2][4][2], const GUnit& u, int wr, int wc, int fr, int fq) const {
    const int row0 = u.pm * 256 + wr * 64 + fr, col0 = u.pn * 256 + wc * 32 + 8 * fq;
#pragma unroll
    for (int ai = 0; ai < 2; ++ai)
#pragma unroll
      for (int m = 0; m < 4; ++m) {
        bf16_t* rowp = O + (size_t)(row0 + ai * G_HALF + m * 16) * PROJW + col0;
#pragma unroll
        for (int bj = 0; bj < 2; ++bj) {
          const f32x4 v0 = acc[ai][bj][m][0], v1 = acc[ai][bj][m][1];
          uint4 w;
          w.x = pack2(v0[0], v0[1]); w.y = pack2(v0[2], v0[3]); w.z = pack2(v1[0], v1[1]); w.w = pack2(v1[2], v1[3]);
          *(uint4*)(rowp + bj * G_HALF) = w;
        }
      }
  }
};

DEV void phase_gemm_proj(const Params& p, int l, int bid, int nb, char* smem) {
  DenseSched S;
  S.A = p.act; S.Bt = p.btin; S.K = DM; S.nM = NTOK / 256; S.nN = PROJW / 256; S.nwg = S.nM * S.nN; S.G = nb; S.c = bid; S.wv = p.wv;
  EpiProj E;
  E.O = p.proj;
  gemm_phase((LAS unsigned char*)smem, S, E);
  const int tid = fresh_tid(), lane = tid & 63, wid = tid >> 6, fr = lane & 15, fq = lane >> 4;
  for (int tb = bid; tb < NTOK / 64; tb += nb) {
    if (wid < 4) {
      const int tok0 = tb * 64 + wid * 16;
      const bf16_t* ap = p.act + (size_t)(tok0 + fr) * DM + fq * 8;
      const bf16_t* bp = p.btg + (size_t)fr * DM + fq * 8;
      f32x4 acc = {0.f, 0.f, 0.f, 0.f};
#pragma unroll 8
      for (int ks = 0; ks < DM / 32; ++ks)
        acc = MFMA16(*(const bf16x8*)(ap + ks * 32), *(const bf16x8*)(bp + ks * 32), acc);
#pragma unroll
      for (int j = 0; j < 4; ++j) p.gates[(size_t)(tok0 + fq * 4 + j) * 16 + fr] = acc[j];
    }
  }
}

DEV void phase_conv(const Params& p, int l, int bid, int nb) {
  const float* w = p.conv_a_w + l * 768;
  const int bs = bid;
  for (int g = bs * NTHR + fresh_tid(); g < NTOK * 32; g += nb * NTHR) {
    const int t = g >> 5, c = (g & 31) * 8;
    const int tl = t & (T - 1);
    const bf16_t* r = p.proj + (size_t)t * PROJW + c;
    float cb[8], cc[8], cx[8], s[8], wk[8];
    unpack8(*(const uint4*)(r + OFF_CB), cb);
    unpack8(*(const uint4*)(r + OFF_CC), cc);
    unpack8(*(const uint4*)(r + OFF_CX), cx);
    {
      const float4 w0 = *(const float4*)(w + 256 + c), w1 = *(const float4*)(w + 256 + c + 4);
      wk[0] = w0.x; wk[1] = w0.y; wk[2] = w0.z; wk[3] = w0.w; wk[4] = w1.x; wk[5] = w1.y; wk[6] = w1.z; wk[7] = w1.w;
    }
#pragma unroll
    for (int e = 0; e < 8; ++e) s[e] = wk[e] * cc[e] * cx[e];
    if (tl > 0) {
      unpack8(*(const uint4*)(r + OFF_CC - PROJW), cc);
      unpack8(*(const uint4*)(r + OFF_CX - PROJW), cx);
      const float4 w0 = *(const float4*)(w + c), w1 = *(const float4*)(w + c + 4);
      wk[0] = w0.x; wk[1] = w0.y; wk[2] = w0.z; wk[3] = w0.w; wk[4] = w1.x; wk[5] = w1.y; wk[6] = w1.z; wk[7] = w1.w;
#pragma unroll
      for (int e = 0; e < 8; ++e) s[e] += wk[e] * cc[e] * cx[e];
    }
    if (tl < T - 1) {
      unpack8(*(const uint4*)(r + OFF_CC + PROJW), cc);
      unpack8(*(const uint4*)(r + OFF_CX + PROJW), cx);
      const float4 w0 = *(const float4*)(w + 512 + c), w1 = *(const float4*)(w + 512 + c + 4);
      wk[0] = w0.x; wk[1] = w0.y; wk[2] = w0.z; wk[3] = w0.w; wk[4] = w1.x; wk[5] = w1.y; wk[6] = w1.z; wk[7] = w1.w;
#pragma unroll
      for (int e = 0; e < 8; ++e) s[e] += wk[e] * cc[e] * cx[e];
    }
#pragma unroll
    for (int e = 0; e < 8; ++e) s[e] *= cb[e];
    *(uint4*)(p.y + (size_t)t * DM + c) = pack8(s);
  }
}

DEV void phase_na(const Params& p, int l, int wgid, int nwg) {
  const int tid_ = fresh_tid(), lane = tid_ & 63, fr = lane & 15, fq = lane >> 4;
  for (int item = wgid; item < NB * 128 * 4 * 4; item += nwg) {
    const int qg = item & 3, h = (item >> 2) & 3, r = (item >> 4) & 127, b = item >> 11;
    const int rs = min(max(r - 4, 0), 120);
    const int kc0 = (qg == 0) ? 0 : (qg == 1) ? 8 : (qg == 2) ? 24 : 32;
    const int c = qg * 16 + fr;
    const int cs = min(max(c - 8, 0), 48);
    const size_t tq = (size_t)b * T + r * 64 + c;
    bf16x8 bq[2];
#pragma unroll
    for (int ks = 0; ks < 2; ++ks)
      bq[ks] = *(const bf16x8*)(p.proj + tq * PROJW + OFF_NQ + h * 64 + ks * 32 + fq * 8);
    f32x4 sc[16];
#pragma unroll
    for (int tt = 0; tt < 16; ++tt) {
      const int i = tt >> 1, half = tt & 1;
      const size_t kt = (size_t)b * T + (rs + i) * 64 + kc0 + half * 16 + fr;
      const bf16_t* kp = p.proj + kt * PROJW + OFF_NK + h * 64 + fq * 8;
      const bf16x8 a0 = *(const bf16x8*)(kp);
      const bf16x8 a1 = *(const bf16x8*)(kp + 32);
      f32x4 z = {0.f, 0.f, 0.f, 0.f};
      z = MFMA16(a0, bq[0], z);
      sc[tt] = MFMA16(a1, bq[1], z);
    }
    const float* rpb = p.na_rpb + (size_t)(l * 4 + h) * 465;
    float mx = -3.0e38f;
#pragma unroll
    for (int tt = 0; tt < 16; ++tt) {
      const int i = tt >> 1, half = tt & 1;
      const int dr = rs + i - r + 7;
#pragma unroll
      for (int j = 0; j < 4; ++j) {
        const int kcol = kc0 + half * 16 + fq * 4 + j;
        const bool valid = (kcol >= cs) && (kcol < cs + 16);
        const int dc = valid ? (kcol - c + 15) : 0;
        const float s = valid ? (sc[tt][j] * 0.125f + rpb[dr * 31 + dc]) : -3.0e38f;
        sc[tt][j] = s;
        mx = fmaxf(mx, s);
      }
    }
    mx = fmaxf(mx, shx(mx, 16, lane));
    mx = fmaxf(mx, shx(mx, 32, lane));
    float sum = 0.f;
#pragma unroll
    for (int tt = 0; tt < 16; ++tt)
#pragma unroll
      for (int j = 0; j < 4; ++j) {
        const float s = sc[tt][j];
        const float e = (s > -1.0e38f) ? __expf(s - mx) : 0.f;
        sc[tt][j] = e;
        sum += e;
      }
    sum += shx(sum, 16, lane);
    sum += shx(sum, 32, lane);
    const float inv = 1.f / sum;
    f32x4 oacc[4];
#pragma unroll
    for (int nt = 0; nt < 4; ++nt) oacc[nt] = f32x4{0.f, 0.f, 0.f, 0.f};
#pragma unroll
    for (int i = 0; i < 8; ++i) {
      uint4 pu;
      pu.x = pack2(sc[2 * i][0] * inv, sc[2 * i][1] * inv);
      pu.y = pack2(sc[2 * i][2] * inv, sc[2 * i][3] * inv);
      pu.z = pack2(sc[2 * i + 1][0] * inv, sc[2 * i + 1][1] * inv);
      pu.w = pack2(sc[2 * i + 1][2] * inv, sc[2 * i + 1][3] * inv);
      const bf16x8 pa = __builtin_bit_cast(bf16x8, pu);
      const bf16_t* vb = p.proj + ((size_t)b * T + (rs + i) * 64 + kc0 + fq * 4) * PROJW + OFF_NV + h * 64 + fr * 4;
      uint2 wv[8];
#pragma unroll
      for (int j = 0; j < 8; ++j) wv[j] = *(const uint2*)(vb + (size_t)(j < 4 ? j : 12 + j) * PROJW);
#pragma unroll
      for (int t = 0; t < 4; ++t) {
        uint4 bu;
        const unsigned sel = (t & 1) ? 0x07060302u : 0x05040100u;
#define NA_E(j) ((t & 2) ? wv[j].y : wv[j].x)
        bu.x = __builtin_amdgcn_perm(NA_E(1), NA_E(0), sel);
        bu.y = __builtin_amdgcn_perm(NA_E(3), NA_E(2), sel);
        bu.z = __builtin_amdgcn_perm(NA_E(5), NA_E(4), sel);
        bu.w = __builtin_amdgcn_perm(NA_E(7), NA_E(6), sel);
#undef NA_E
        oacc[t] = MFMA16(pa, __builtin_bit_cast(bf16x8, bu), oacc[t]);
      }
    }
#pragma unroll
    for (int j = 0; j < 4; ++j) {
      uint2 st;
      st.x = pack2(oacc[0][j], oacc[1][j]);
      st.y = pack2(oacc[2][j], oacc[3][j]);
      *(uint2*)(p.y + ((size_t)b * T + r * 64 + qg * 16 + fq * 4 + j) * DM + 256 + h * 64 + fr * 4) = st;
    }
  }
}

DEV void fmac1(float& acc, float a, float b) { asm("v_fmac_f32 %0, %1, %2" : "+v"(acc) : "v"(a), "v"(b)); }
struct LRow { float4 v[8]; };
template <int POS>
struct SolveStep {
  static DEV void run(float (&x)[64], LRow& row, const float* Ld, const float* sclv, const bf16_t* srcq, int sstep,
                      bool isu, unsigned* up, bf16_t* wp) {
    float s0 = 0.f, s1 = 0.f, s2 = 0.f, s3 = 0.f;
    float4 hi[8];
#pragma unroll
    for (int j4 = 8; j4 < (POS + 3) / 4; ++j4) hi[j4 - 8] = *(const float4*)(Ld + POS * 68 + j4 * 4);
#pragma unroll
    for (int j4 = 0; j4 < 8; ++j4) {
      if (j4 < (POS + 3) / 4) {
        const float4 lv = row.v[j4];
        fmac1(s0, lv.x, x[j4 * 4]);
        if (j4 * 4 + 1 < POS) fmac1(s1, lv.y, x[j4 * 4 + 1]);
        if (j4 * 4 + 2 < POS) fmac1(s2, lv.z, x[j4 * 4 + 2]);
        if (j4 * 4 + 3 < POS) fmac1(s3, lv.w, x[j4 * 4 + 3]);
      }
      if (POS + 1 < 64 && j4 < (POS + 4) / 4) row.v[j4] = *(const float4*)(Ld + (POS + 1) * 68 + j4 * 4);
    }
#pragma unroll
    for (int j4 = 8; j4 < (POS + 3) / 4; ++j4) {
      const float4 lv = hi[j4 - 8];
      fmac1(s0, lv.x, x[j4 * 4]);
      if (j4 * 4 + 1 < POS) fmac1(s1, lv.y, x[j4 * 4 + 1]);
      if (j4 * 4 + 2 < POS) fmac1(s2, lv.z, x[j4 * 4 + 2]);
      if (j4 * 4 + 3 < POS) fmac1(s3, lv.w, x[j4 * 4 + 3]);
    }
    const float a = sclv[POS] * bf2f(srcq[0]) - ((s0 + s1) + (s2 + s3));
    x[POS] = a;
    if (isu) {
      if (POS & 1) up[(POS >> 1) * 128] = pack2(x[POS - 1], a);
    } else {
      wp[POS * 128] = f2bf(-a);
    }
    asm volatile("" ::: "memory");
    SolveStep<POS + 1>::run(x, row, Ld, sclv, srcq + sstep, sstep, isu, up, wp);
  }
};
template <>
struct SolveStep<64> {
  static DEV void run(float (&)[64], LRow&, const float*, const float*, const bf16_t*, int, bool, unsigned*, bf16_t*) {}
};

DEV int kperm16(int k) { const int s = (k >> 2) & 3; return (k & ~15) | ((((s & 1) << 1) | (s >> 1)) << 2) | (k & 3); }

DEV void phase_gdn_prep(const Params& p, int l, int bid, int nb, char* smem) {
  const int tid = fresh_tid(), lane = tid & 63;
  bf16_t* q_bf = (bf16_t*)(smem + PL_Q);
  bf16_t* k_bf = (bf16_t*)(smem + PL_K);
  bf16_t* v_bf = (bf16_t*)(smem + PL_V);
  float* Lm = (float*)(smem + PL_L);
  float* gcl = (float*)(smem + PL_GC);
  float* bl = (float*)(smem + PL_BETA);
  float* bgl = (float*)(smem + PL_BG);
  float* fql = (float*)(smem + PL_FQ);
  float* fkl = (float*)(smem + PL_FK);
  float* cwl = (float*)(smem + PL_CW);
  {
    const float* cw = p.gdn_conv_w + l * 4608;
    for (int i = tid; i < 1152; i += NTHR) *(float4*)(cwl + i * 4) = *(const float4*)(cw + i * 4);
  }
  __syncthreads();
  for (int item = bid; item < 1024; item += nb) {
    const int b = item >> 9, h = (item >> 7) & 3, n = item & 127;
    const int t0 = b * T + n * 64;
    char* rec0 = p.gdn_rec + (size_t)item * 2 * REC_BYTES;
    float ga = 0.f, gb = 0.f, galog = 0.f, gdt = 0.f;
    if (tid < 128) {
      const int dir = tid >> 6;
      const int i = dir ? 63 - lane : lane;
      const size_t t = (size_t)t0 + i;
      ga = p.gates[t * 16 + dir * 4 + h];
      gb = p.gates[t * 16 + 8 + dir * 4 + h];
      galog = p.gdn_a_log[l * 8 + dir * 4 + h];
      gdt = p.gdn_dt_bias[l * 8 + dir * 4 + h];
    }
    uint4 raw[3][3][2];
    {
      const int i = tid >> 3, oc = tid & 7, d0 = oc * 16;
      const int tl = n * 64 + i;
      const bf16_t* rowp = p.proj + (size_t)(t0 + i) * PROJW + OFF_GQKV + h * 128 + d0;
      const int dm = (tl > 0) ? -PROJW : 0, dp = (tl < T - 1) ? PROJW : 0;
#pragma unroll
      for (int m = 0; m < 3; ++m) {
        const bf16_t* rp = rowp + m * 512;
        raw[m][0][0] = *(const uint4*)(rp + dm);
        raw[m][0][1] = *(const uint4*)(rp + dm + 8);
        raw[m][1][0] = *(const uint4*)(rp);
        raw[m][1][1] = *(const uint4*)(rp + 8);
        raw[m][2][0] = *(const uint4*)(rp + dp);
        raw[m][2][1] = *(const uint4*)(rp + dp + 8);
      }
    }
    if (tid < 128) {
      const int dir = tid >> 6;
      const float g = -__expf(galog) * softplus_f(ga + gdt);
      const float beta = sigmoid_f(gb);
      float cs = g;
#pragma unroll
      for (int o = 1; o < 64; o <<= 1) {
        const float v = __int_as_float(__builtin_amdgcn_ds_bpermute((lane - o) << 2, __float_as_int(cs)));
        if (lane >= o) cs += v;
      }
      const float last = __uint_as_float(__builtin_amdgcn_readlane(__float_as_uint(cs), 63));
      const float ec = __expf(cs);
      gcl[dir * 64 + lane] = cs;
      bl[dir * 64 + lane] = beta;
      bgl[dir * 64 + lane] = beta * ec;
      fql[dir * 64 + lane] = ec;
      fkl[dir * 64 + lane] = __expf(last - cs);
      if (lane == 0) p.egl[item * 2 + dir] = __expf(last);
    }
    float valq[16], valk[16];
    {
      int tA = tid;
      asm volatile("" : "+v"(tA));
      const int i = tA >> 3, oc = tA & 7, d0 = oc * 16;
      const int tl = n * 64 + i;
      const float zm = (tl > 0) ? 1.f : 0.f, zp = (tl < T - 1) ? 1.f : 0.f;
#pragma unroll
      for (int m = 0; m < 3; ++m) {
        float x0[16], x1[16], x2[16], val[16];
        unpack8(raw[m][0][0], x0);
        unpack8(raw[m][0][1], x0 + 8);
        unpack8(raw[m][1][0], x1);
        unpack8(raw[m][1][1], x1 + 8);
        unpack8(raw[m][2][0], x2);
        unpack8(raw[m][2][1], x2 + 8);
        const float* cwm = cwl + m * 512 + h * 128 + d0;
        float ss = 0.f;
#pragma unroll
        for (int e4 = 0; e4 < 4; ++e4) {
          const float4 w0 = *(const float4*)(cwm + e4 * 4), w1 = *(const float4*)(cwm + 1536 + e4 * 4),
                       w2 = *(const float4*)(cwm + 3072 + e4 * 4);
          const float w0a[4] = {w0.x * zm, w0.y * zm, w0.z * zm, w0.w * zm};
          const float w1a[4] = {w1.x, w1.y, w1.z, w1.w};
          const float w2a[4] = {w2.x * zp, w2.y * zp, w2.z * zp, w2.w * zp};
#pragma unroll
          for (int j = 0; j < 4; ++j) {
            const int e = e4 * 4 + j;
            val[e] = silu_f(w0a[j] * x0[e] + w1a[j] * x1[e] + w2a[j] * x2[e]);
            ss += val[e] * val[e];
          }
        }
        if (m < 2) {
          ss += shx(ss, 1, lane);
          ss += shx(ss, 2, lane);
          ss += shx(ss, 4, lane);
          float sc = rsqrtf(ss + EPS);
          if (m == 0) sc *= 0.08838834764831845f;
#pragma unroll
          for (int e = 0; e < 16; ++e) val[e] *= sc;
        }
        bf16_t* dst = (m == 0 ? q_bf : (m == 1 ? k_bf : v_bf)) + i * 136 + d0;
        *(uint4*)(dst) = pack8(val);
        *(uint4*)(dst + 8) = pack8(val + 8);
        if (m == 0) {
#pragma unroll
          for (int e = 0; e < 16; ++e) valq[e] = val[e];
        }
        if (m == 1) {
#pragma unroll
          for (int e = 0; e < 16; ++e) valk[e] = val[e];
        }
      }
    }
    __syncthreads();
    {
      int tA = tid;
      asm volatile("" : "+v"(tA));
      const int i = tA >> 3, oc = tA & 7, d0 = oc * 16;
#pragma unroll
      for (int dir = 0; dir < 2; ++dir) {
        const int pos = dir ? 63 - i : i;
        const float f = fql[dir * 64 + pos];
        float tmp[16];
#pragma unroll
        for (int e = 0; e < 16; ++e) tmp[kperm16(e)] = valq[e] * f;
        bf16_t* qd = (bf16_t*)(rec0 + dir * REC_BYTES + REC_QD) + pos * 128 + d0;
        *(uint4*)(qd) = pack8(tmp);
        *(uint4*)(qd + 8) = pack8(tmp + 8);
      }
      const int d = tA & 127;
#pragma unroll
      for (int k = 0; k < 4; ++k) {
        const int du = (tA >> 7) + 4 * k, dir = du >> 3, U = du & 7;
        const int p0 = 16 * (U >> 1) + 4 * (U & 1);
        const float4 fa = *(const float4*)(fkl + dir * 64 + p0), fb = *(const float4*)(fkl + dir * 64 + p0 + 8);
        const float ff[8] = {fa.x, fa.y, fa.z, fa.w, fb.x, fb.y, fb.z, fb.w};
        float o[8];
#pragma unroll
        for (int e = 0; e < 8; ++e) {
          const int pp = p0 + (e & 3) + 8 * (e >> 2);
          const int tok = dir ? 63 - pp : pp;
          o[e] = bf2f(k_bf[tok * 136 + d]) * ff[e];
        }
        *(uint4*)((bf16_t*)(rec0 + dir * REC_BYTES + REC_KT) + d * 64 + U * 8) = pack8(o);
      }
    }
    {
      int tB = tid;
      asm volatile("" : "+v"(tB));
      const int laneB = tB & 63, widB = tB >> 6, fr = laneB & 15, fq = laneB >> 4;
      const int mat = __builtin_amdgcn_readfirstlane(widB >> 2), rtile = widB & 3;
      const bf16_t* bsrc = mat ? q_bf : k_bf;
      const int i = rtile * 16 + fr;
      bf16x8 bf_[4];
#pragma unroll
      for (int ks = 0; ks < 4; ++ks) bf_[ks] = *(const bf16x8*)(bsrc + i * 136 + ks * 32 + fq * 8);
      const float gi0 = gcl[i], gi1 = gcl[64 + 63 - i];
      float4 gj0[4], gj1[4];
#pragma unroll
      for (int nt = 0; nt < 4; ++nt) {
        gj0[nt] = *(const float4*)(gcl + nt * 16 + fq * 4);
        gj1[nt] = *(const float4*)(gcl + 64 + 60 - (nt * 16 + fq * 4));
      }
      const float be0 = bl[i], be1 = bl[64 + 63 - i];
      f32x4 acc[4];
#pragma unroll
      for (int nt = 0; nt < 4; ++nt) {
        acc[nt] = f32x4{0.f, 0.f, 0.f, 0.f};
#pragma unroll
        for (int ks = 0; ks < 4; ++ks) {
          const bf16x8 afrag = *(const bf16x8*)(k_bf + (nt * 16 + fr) * 136 + ks * 32 + fq * 8);
          acc[nt] = MFMA16(afrag, bf_[ks], acc[nt]);
        }
      }
#pragma unroll
      for (int nt = 0; nt < 4; ++nt) {
        const int jj = nt * 16 + fq * 4;
        const float g0[4] = {gj0[nt].x, gj0[nt].y, gj0[nt].z, gj0[nt].w};
        const float g1[4] = {gj1[nt].x, gj1[nt].y, gj1[nt].z, gj1[nt].w};
        float v0[4], v1[4];
#pragma unroll
        for (int j = 0; j < 4; ++j) {
          const float G0 = acc[nt][j], G1 = acc[nt][3 - j];
          const float d0v = __expf(fminf(gi0 - g0[j], 0.f)), d1v = __expf(fminf(gi1 - g1[j], 0.f));
          if (mat == 0) {
            v0[j] = (i > jj + j) ? be0 * G0 * d0v : 0.f;
            v1[j] = (63 - i > 60 - jj + j) ? be1 * G1 * d1v : 0.f;
          } else {
            v0[j] = (i >= jj + j) ? G0 * d0v : 0.f;
            v1[j] = (63 - i >= 60 - jj + j) ? G1 * d1v : 0.f;
          }
        }
        if (mat == 0) {
          *(float4*)(Lm + i * 68 + jj) = make_float4(v0[0], v0[1], v0[2], v0[3]);
          *(float4*)(Lm + (64 + 63 - i) * 68 + 60 - jj) = make_float4(v1[0], v1[1], v1[2], v1[3]);
        } else {
          uint2 s0, s1;
          s0.x = pack2(v0[0], v0[1]); s0.y = pack2(v0[2], v0[3]);
          s1.x = pack2(v1[0], v1[1]); s1.y = pack2(v1[2], v1[3]);
          *(uint2*)((bf16_t*)(rec0 + REC_IN) + i * 64 + kperm16(jj)) = s0;
          *(uint2*)((bf16_t*)(rec0 + REC_BYTES + REC_IN) + (63 - i) * 64 + kperm16(60 - jj)) = s1;
        }
      }
    }
    __syncthreads();
    {
      int tC = tid;
      asm volatile("" : "+v"(tC));
      const int dir = tC >> 8, c = tC & 255;
      const float* Ld = Lm + dir * 64 * 68;
      const bool isu = __builtin_amdgcn_readfirstlane((int)(c < 128)) != 0;
      unsigned* up = p.gdn_u + ((size_t)(item * 2 + dir) * 32) * 128 + (c & 127);
      bf16_t* wp = (bf16_t*)(rec0 + dir * REC_BYTES + REC_WN) + kperm16(c & 127);
      const bf16_t* src = (isu ? v_bf : k_bf) + (c & 127);
      const float* sclv = (isu ? bl : bgl) + dir * 64;
      float x[64];
      LRow row0;
      SolveStep<0>::run(x, row0, Ld, sclv, src + (dir ? 63 * 136 : 0), dir ? -136 : 136, isu, up, wp);
    }
    __syncthreads();
  }
}

DEV int crow(int reg, int hf) { return (reg & 3) + 8 * (reg >> 2) + 4 * hf; }
DEV bf16x8 pack_acc8(const f32x16& x, int s) {
  uint4 v;
  v.x = pack2(x[8 * s + 0], x[8 * s + 1]);
  v.y = pack2(x[8 * s + 2], x[8 * s + 3]);
  v.z = pack2(x[8 * s + 4], x[8 * s + 5]);
  v.w = pack2(x[8 * s + 6], x[8 * s + 7]);
  return __builtin_bit_cast(bf16x8, v);
}
DEV bf16x8 ld_frag(const char* rowp, int kb) { return *(const bf16x8*)(rowp + kb); }

DEV void phase_gdn_scan(const Params& p, int ep, int chain, char* smem) {
  const int tid = fresh_tid(), lane = tid & 63, wid = tid >> 6;
  const int dir = chain & 1, bh = chain >> 1;
  const int b = bh >> 2, hh = bh & 3;
  if (wid >= 4) {
    const int lt = tid - 256;
    uint4 rA[18], rB[18];
    auto gl = [&](uint4 (&rg)[18], int n) {
      const int item = bh * 128 + (dir ? 127 - n : n);
      const __amdgpu_buffer_rsrc_t rr = __builtin_amdgcn_make_buffer_rsrc(
          (void*)(p.gdn_rec + ((size_t)item * 2 + dir) * REC_BYTES), 0, REC_BYTES, 0x00020000);
      const __amdgpu_buffer_rsrc_t ru = __builtin_amdgcn_make_buffer_rsrc(
          (void*)(p.gdn_u + ((size_t)(item * 2 + dir) * 32) * 128), 0, 16384, 0x00020000);
#pragma unroll
      for (int k = 0; k < 14; ++k) {
        const u32x4 v = __builtin_amdgcn_raw_buffer_load_b128(rr, lt * 16, k * 4096, 0);
        rg[k] = make_uint4(v.x, v.y, v.z, v.w);
      }
#pragma unroll
      for (int k = 0; k < 4; ++k) {
        const u32x4 v = __builtin_amdgcn_raw_buffer_load_b128(ru, lt * 16, k * 4096, 0);
        rg[14 + k] = make_uint4(v.x, v.y, v.z, v.w);
      }
    };
    auto st = [&](const uint4 (&rg)[18], int buf) {
      char* base = smem + buf * SC_BUF;
#pragma unroll
      for (int k = 0; k < 14; ++k) {
        const int u = lt + 256 * k;
        int row, c16, off;
        if (k < 4) { row = u >> 4; c16 = u & 15; off = SC_WN + row * 272; }
        else if (k < 8) { row = (u - 1024) >> 4; c16 = (u - 1024) & 15; off = SC_QD + row * 272; }
        else if (k < 10) { row = (u - 2048) >> 3; c16 = (u - 2048) & 7; off = SC_IN + row * 144; }
        else { row = (u - 2560) >> 3; c16 = (u - 2560) & 7; off = SC_KT + row * 144; }
        *(uint4*)(base + off + c16 * 16) = rg[k];
      }
#pragma unroll
      for (int k = 0; k < 4; ++k) *(uint4*)(base + SC_U + (lt + 256 * k) * 16) = rg[14 + k];
    };
    gl(rA, 0);
    st(rA, 0);
    gl(rB, 1);
    gl(rA, 2);
    __syncthreads();
#pragma unroll 1
    for (int n = 0; n < 128; n += 2) {
      st(rB, 1);
      gl(rB, min(n + 3, 127));
      __syncthreads();
      st(rA, 0);
      gl(rA, min(n + 4, 127));
      __syncthreads();
    }
  } else {
    const int w = wid, r = lane & 31, hf = lane >> 5;
    f32x16 S[4];
#pragma unroll
    for (int t4 = 0; t4 < 4; ++t4)
#pragma unroll
      for (int e = 0; e < 16; ++e) S[t4][e] = 0.f;
    __builtin_amdgcn_s_setprio(3);
    const float dlo = p.egl[(bh * 128 + (dir ? 127 - lane : lane)) * 2 + dir];
    const float dhi = p.egl[(bh * 128 + (dir ? 63 - lane : 64 + lane)) * 2 + dir];
    if (tid == 0) __hip_atomic_store(&p.bar[XB_CXCC(chain)], ((unsigned)ep << 4) | xb_xcc_id(), __ATOMIC_RELAXED, __HIP_MEMORY_SCOPE_AGENT);
    __syncthreads();
#pragma unroll 1
    for (int n = 0; n < 128; ++n) {
      if (tid == 0) __hip_atomic_store(&p.bar[XB_PROG(chain)], (unsigned)ep * 1024u + (unsigned)n, __ATOMIC_RELAXED, __HIP_MEMORY_SCOPE_AGENT);
      const char* buf = smem + (n & 1) * SC_BUF;
      const float decay = __uint_as_float(__builtin_amdgcn_readlane(__float_as_uint(n < 64 ? dlo : dhi), n & 63));
      f32x16 vn[2], o[2];
      {
        const unsigned* ul = (const unsigned*)(buf + SC_U) + 32 * w + r;
#pragma unroll
        for (int tm = 0; tm < 2; ++tm)
#pragma unroll
          for (int e2 = 0; e2 < 8; ++e2) {
            const unsigned uu = ul[((32 * tm + crow(2 * e2, hf)) >> 1) * 128];
            vn[tm][2 * e2] = __uint_as_float(uu << 16);
            vn[tm][2 * e2 + 1] = __uint_as_float(uu & 0xffff0000u);
          }
      }
#pragma unroll
      for (int e = 0; e < 16; ++e) { o[0][e] = 0.f; o[1][e] = 0.f; }
      const char* rw0 = buf + SC_WN + r * 272 + hf * 16;
      const char* rq0 = buf + SC_QD + r * 272 + hf * 16;
      const char* ri0 = buf + SC_IN + r * 144 + hf * 16;
      const char* rk0 = buf + SC_KT + r * 144 + hf * 16;
      bf16x8 fA[8], fB[8], sb[4][2];
#define SCAN_LOAD(dst, base, t4a)                                                                        \
  _Pragma("unroll") for (int dt = 0; dt < 2; ++dt) _Pragma("unroll") for (int s = 0; s < 2; ++s)         \
      _Pragma("unroll") for (int tm = 0; tm < 2; ++tm)                                                   \
          dst[dt * 4 + s * 2 + tm] = ld_frag(base + tm * 32 * 272, (32 * ((t4a) + dt) + 16 * s) * 2);
#define SCAN_MMA(acc, f, t4a)                                                                            \
  _Pragma("unroll") for (int dt = 0; dt < 2; ++dt) _Pragma("unroll") for (int s = 0; s < 2; ++s)         \
      _Pragma("unroll") for (int tm = 0; tm < 2; ++tm)                                                   \
          acc[tm] = MFMA32(f[dt * 4 + s * 2 + tm], sb[(t4a) + dt][s], acc[tm]);
#define SCAN_MMA_T(acc, f, t4a)                                                                          \
  _Pragma("unroll") for (int dt = 0; dt < 2; ++dt) _Pragma("unroll") for (int s = 0; s < 2; ++s)         \
      _Pragma("unroll") for (int tm = 0; tm < 2; ++tm)                                                   \
          acc[tm] = MFMA32(sb[(t4a) + dt][s], f[dt * 4 + s * 2 + tm], acc[tm]);
#define SCAN_MIX(nmfma, nds, nvalu)                                                                      \
  _Pragma("unroll") for (int _g = 0; _g < (nmfma); ++_g) {                                               \
    __builtin_amdgcn_sched_group_barrier(0x008, 1, 0);                                                   \
    if (_g < (nds)) __builtin_amdgcn_sched_group_barrier(0x100, 1, 0);                                   \
    __builtin_amdgcn_sched_group_barrier(0x002, (nvalu), 0);                                             \
  }
      SCAN_LOAD(fA, rw0, 0)
      sb[0][0] = pack_acc8(S[0], 0); sb[0][1] = pack_acc8(S[0], 1);
      sb[1][0] = pack_acc8(S[1], 0); sb[1][1] = pack_acc8(S[1], 1);
      __builtin_amdgcn_sched_barrier(0);
      SCAN_MMA(vn, fA, 0)
      SCAN_LOAD(fB, rw0, 2)
      sb[2][0] = pack_acc8(S[2], 0); sb[2][1] = pack_acc8(S[2], 1);
      sb[3][0] = pack_acc8(S[3], 0); sb[3][1] = pack_acc8(S[3], 1);
      SCAN_MIX(8, 8, 2)
      __builtin_amdgcn_sched_barrier(0);
      SCAN_MMA(vn, fB, 2)
      SCAN_LOAD(fA, rq0, 0)
#pragma unroll
      for (int e = 0; e < 16; ++e) S[0][e] *= decay;
      SCAN_MIX(8, 8, 2)
      __builtin_amdgcn_sched_barrier(0);
      SCAN_MMA_T(o, fA, 0)
      SCAN_LOAD(fB, rq0, 2)
#pragma unroll
      for (int e = 0; e < 16; ++e) { S[1][e] *= decay; S[2][e] *= decay; }
      SCAN_MIX(8, 8, 3)
      __builtin_amdgcn_sched_barrier(0);
      bf16x8 fi[6], fk0[4];
      SCAN_MMA_T(o, fB, 2)
      fi[0] = ld_frag(ri0, 0);
      fi[1] = ld_frag(ri0, 32);
#pragma unroll
      for (int q4 = 0; q4 < 4; ++q4) fi[2 + q4] = ld_frag(ri0 + 32 * 144, q4 * 32);
#pragma unroll
      for (int q4 = 0; q4 < 4; ++q4) fk0[q4] = ld_frag(rk0, q4 * 32);
      bf16x8 vb[2][2];
#pragma unroll
      for (int tk = 0; tk < 2; ++tk) {
        vb[tk][0] = pack_acc8(vn[tk], 0);
        vb[tk][1] = pack_acc8(vn[tk], 1);
      }
#pragma unroll
      for (int e = 0; e < 16; ++e) S[3][e] *= decay;
      SCAN_MIX(8, 8, 4)
      __builtin_amdgcn_sched_barrier(0);
#undef SCAN_LOAD
#undef SCAN_MMA
#undef SCAN_MMA_T
      o[0] = MFMA32(vb[0][0], fi[0], o[0]);
      o[1] = MFMA32(vb[0][0], fi[2], o[1]);
      o[0] = MFMA32(vb[0][1], fi[1], o[0]);
      o[1] = MFMA32(vb[0][1], fi[3], o[1]);
      S[0] = MFMA32(fk0[0], vb[0][0], S[0]);
      o[1] = MFMA32(vb[1][0], fi[4], o[1]);
      S[0] = MFMA32(fk0[1], vb[0][1], S[0]);
      o[1] = MFMA32(vb[1][1], fi[5], o[1]);
      S[0] = MFMA32(fk0[2], vb[1][0], S[0]);
      S[0] = MFMA32(fk0[3], vb[1][1], S[0]);
#pragma unroll
      for (int q4 = 0; q4 < 4; ++q4) {
        fA[q4] = ld_frag(rk0 + 32 * 144, q4 * 32);
        fA[4 + q4] = ld_frag(rk0 + 64 * 144, q4 * 32);
      }
      SCAN_MIX(10, 8, 0)
      __builtin_amdgcn_sched_barrier(0);
#pragma unroll
      for (int q4 = 0; q4 < 4; ++q4) {
        S[1] = MFMA32(fA[q4], vb[q4 >> 1][q4 & 1], S[1]);
        S[2] = MFMA32(fA[4 + q4], vb[q4 >> 1][q4 & 1], S[2]);
      }
#pragma unroll
      for (int q4 = 0; q4 < 4; ++q4) fB[q4] = ld_frag(rk0 + 96 * 144, q4 * 32);
      SCAN_MIX(8, 4, 0)
      __builtin_amdgcn_sched_barrier(0);
#pragma unroll
      for (int q4 = 0; q4 < 4; ++q4) S[3] = MFMA32(fB[q4], vb[q4 >> 1][q4 & 1], S[3]);
#undef SCAN_MIX
      {
#pragma unroll
        for (int tn = 0; tn < 2; ++tn) {
          const int pos = 32 * tn + r;
          const int tok = dir ? (b * T + T - 1 - n * 64 - pos) : (b * T + n * 64 + pos);
          unsigned pk[4][2];
#pragma unroll
          for (int g = 0; g < 4; ++g) {
            pk[g][0] = pack2(o[tn][4 * g + 0], o[tn][4 * g + 1]);
            pk[g][1] = pack2(o[tn][4 * g + 2], o[tn][4 * g + 3]);
          }
          uint4 st0, st1;
          {
            auto s0 = __builtin_amdgcn_permlane32_swap(pk[0][0], pk[2][0], false, false);
            auto s1 = __builtin_amdgcn_permlane32_swap(pk[0][1], pk[2][1], false, false);
            st0.x = s0[0]; st0.y = s1[0]; st0.z = s0[1]; st0.w = s1[1];
            auto s2 = __builtin_amdgcn_permlane32_swap(pk[1][0], pk[3][0], false, false);
            auto s3 = __builtin_amdgcn_permlane32_swap(pk[1][1], pk[3][1], false, false);
            st1.x = s2[0]; st1.y = s3[0]; st1.z = s2[1]; st1.w = s3[1];
          }
          bf16_t* op = p.obuf + ((size_t)dir * NTOK + tok) * 512 + hh * 128 + 32 * w + 16 * hf;
          *(uint4*)(op) = st0;
          *(uint4*)(op + 8) = st1;
        }
      }
      __syncthreads();
    }
    __builtin_amdgcn_s_setprio(0);
  }
}

DEV void phase_scan_helper(const Params& p, int ep, int c, int j, char* smem) {
  const int tid = fresh_tid(), lane = tid & 63, wid = tid >> 6;
  volatile unsigned* lprog = (volatile unsigned*)smem;
  const unsigned epoch = (unsigned)ep;
  const int dir = c & 1, bh = c >> 1;
  constexpr unsigned AHEAD = 8u;
  if (tid == 0) lprog[0] = 0u;
  __syncthreads();
  if (wid == 0) {
    unsigned v = 0u, spins = 0u;
    for (;;) {
      v = xb_ld(&p.bar[XB_CXCC(c)]);
      if ((v >> 4) == epoch || ++spins > 200000u) break;
      __builtin_amdgcn_s_sleep(8);
    }
    const bool mine = ((v >> 4) == epoch) && ((v & 15u) == xb_xcc_id());
    if (!mine) {
      if (lane == 0) lprog[0] = 0xffffffffu;
    } else {
      unsigned idle = 0u;
      for (;;) {
        const unsigned g = xb_ld(&p.bar[XB_PROG(c)]);
        const unsigned cur = (g >= epoch * 1024u) ? (g - epoch * 1024u + 1u) : 0u;
        if (lane == 0) lprog[0] = cur + 1u;
        if (cur >= 128u || ++idle > 400000u) break;
        __builtin_amdgcn_s_sleep(16);
      }
      if (lane == 0) lprog[0] = 0xffffffffu;
    }
  } else {
    u32x4 sink = {0u, 0u, 0u, 0u};
    unsigned spins = 0u;
    for (int n = 0; n < 128;) {
      const unsigned s = lprog[0];
      if (s == 0xffffffffu) break;
      if (s == 0u) {
        if (++spins > 4000000u) break;
        __builtin_amdgcn_s_sleep(4);
        continue;
      }
      const unsigned started = s - 1u;
      if ((unsigned)n < started) n = (int)started;
      if (n >= 128) break;
      if ((unsigned)n >= started + AHEAD) {
        if (++spins > 4000000u) break;
        __builtin_amdgcn_s_sleep(4);
        continue;
      }
      const int item = bh * 128 + (dir ? 127 - n : n);
      const char* rec = p.gdn_rec + ((size_t)item * 2 + dir) * REC_BYTES;
      const char* uu = (const char*)(p.gdn_u + ((size_t)(item * 2 + dir) * 32) * 128);
#pragma unroll
      for (int q = 0; q < 4; ++q) {
        const int pc = wid - 1 + 7 * q;
        if (pc < 24) {
          const int piece = 24 * j + pc;
          const char* ptr = (piece < 56 ? rec + piece * 1024 : uu + (piece - 56) * 1024) + lane * 16;
          asm volatile("global_load_dwordx4 %0, %1, off" : "+v"(sink) : "v"(ptr) : "memory");
        }
      }
      ++n;
    }
    asm volatile("s_waitcnt vmcnt(0)" ::: "memory");
    asm volatile("" :: "v"(sink));
  }
  __syncthreads();
}

DEV void phase_gdn_fin(const Params& p, int l, int bid, int nb) {
  const int tid_ = fresh_tid(), lane = tid_ & 63, wid = tid_ >> 6;
  const float* gnw = p.gdn_norm_w + l * 128 + (lane & 15) * 8;
  for (int t = bid * NWAVE + wid; t < NTOK; t += nb * NWAVE) {
    float of[8], ob[8], z[8], o[8];
    unpack8(*(const uint4*)(p.obuf + (size_t)t * 512 + lane * 8), of);
    unpack8(*(const uint4*)(p.obuf + ((size_t)NTOK + t) * 512 + lane * 8), ob);
    unpack8(*(const uint4*)(p.proj + (size_t)t * PROJW + OFF_GZ + lane * 8), z);
    float ss = 0.f;
#pragma unroll
    for (int e = 0; e < 8; ++e) {
      o[e] = of[e] + ob[e];
      ss += o[e] * o[e];
    }
    ss += shx(ss, 1, lane);
    ss += shx(ss, 2, lane);
    ss += shx(ss, 4, lane);
    ss += shx(ss, 8, lane);
    const float rr = rsqrtf(ss * (1.f / 128.f) + EPS);
    const float4 g0 = *(const float4*)(gnw), g1 = *(const float4*)(gnw + 4);
    const float gw[8] = {g0.x, g0.y, g0.z, g0.w, g1.x, g1.y, g1.z, g1.w};
    float res[8];
#pragma unroll
    for (int e = 0; e < 8; ++e) res[e] = o[e] * rr * gw[e] * silu_f(z[e]);
    *(uint4*)(p.y + (size_t)t * DM + 512 + lane * 8) = pack8(res);
  }
}

struct EpiWout {
  static constexpr bool PERM = false;
  const float* xin; float* xout; const float* mod_l;
  DEV void operator()(const f32x4 (&acc)[2][2][4][2], const GUnit& u, int wr, int wc, int fr, int fq) const {
    const int row0 = u.pm * 256 + wr * 64 + fr, col0 = u.pn * 256 + wc * 32 + 4 * fq;
    const float* gate = mod_l + ((u.pm * 256) / T) * 6144 + MOD_GATE1;
    f32x4 gv[2][2];
#pragma unroll
    for (int bj = 0; bj < 2; ++bj)
#pragma unroll
      for (int n = 0; n < 2; ++n) gv[bj][n] = *(const f32x4*)(gate + col0 + bj * G_HALF + n * 16);
#pragma unroll
    for (int ai = 0; ai < 2; ++ai)
#pragma unroll
      for (int m = 0; m < 4; ++m) {
        const size_t ro = (size_t)(row0 + ai * G_HALF + m * 16) * DM + col0;
#pragma unroll
        for (int bj = 0; bj < 2; ++bj)
#pragma unroll
          for (int n = 0; n < 2; ++n) {
            const f32x4 xi = *(const f32x4*)(xin + ro + bj * G_HALF + n * 16);
            *(f32x4*)(xout + ro + bj * G_HALF + n * 16) = xi + gv[bj][n] * acc[ai][bj][m][n];
          }
      }
  }
};

DEV void phase_gemm_wout(const Params& p, int l, const float* xin, int bid, int nb, char* smem) {
  DenseSched S;
  S.A = p.y; S.Bt = p.btout; S.K = DM; S.nM = NTOK / 256; S.nN = DM / 256; S.nwg = S.nM * S.nN; S.G = nb; S.c = bid; S.wv = p.wv;
  EpiWout E;
  E.xin = xin; E.xout = p.xbuf; E.mod_l = p.mod + l * 2 * 6144;
  gemm_phase((LAS unsigned char*)smem, S, E);
}

DEV void phase_consts(const Params& p, int bid, int nb) {
  const int tid = fresh_tid(), lane = tid & 63, wid = tid >> 6;
  for (int g = bid * NTHR + tid; g < DEPTH * DM * 48; g += nb * NTHR) {
    const int n = g % 48, lk = g / 48;
    float v = 0.f;
    if (n < 4) v = p.rg_w[(size_t)lk * 4 + n];
    else if (n < 36) v = p.re_w[(size_t)lk * 32 + (n - 4)];
    p.wcat[g] = v;
  }
  for (int g = bid * NTHR + tid; g < DEPTH * NB * DM; g += nb * NTHR) {
    const int k = g & (DM - 1), lb = g >> 10, l = lb >> 1;
    p.wsc2[g] = p.norm_ffn_w[l * DM + k] * (1.f + p.mod[lb * 6144 + MOD_SCALE2 + k]);
  }
  for (int o = bid * NWAVE + wid; o < DEPTH * NB * 48; o += nb * NWAVE) {
    const int n = o % 48, lb = o / 48, l = lb >> 1;
    float s = 0.f;
    if (n < 36) {
#pragma unroll
      for (int k16 = 0; k16 < DM / 64; ++k16) {
        const int k = lane + 64 * k16;
        const float w = (n < 4) ? p.rg_w[((size_t)l * DM + k) * 4 + n] : p.re_w[((size_t)l * DM + k) * 32 + (n - 4)];
        s += p.mod[lb * 6144 + MOD_SHIFT2 + k] * w;
      }
      s = wave_sum(s, lane);
      s += (n < 4) ? p.rg_b[l * 4 + n] : p.re_b[l * 32 + (n - 4)];
    }
    if (lane == 0) p.c0[o] = s;
  }
}

DEV void phase_router(const Params& p, int l, int bid, int nb, char* smem) {
  float* accb = (float*)smem;
  float* ssqb = accb + 2 * 64 * 49;
  float* rsl = ssqb + 128;
  int* lcnt = (int*)(rsl + 64);
  int* lbase = lcnt + NEXP;
  const int tid = fresh_tid(), lane = tid & 63, wid = tid >> 6, fr = lane & 15, fq = lane >> 4;
  const int tg = wid & 3, kh = wid >> 2;
  int sel_e0 = 0, sel_e1 = 0, sel_r0 = 0, sel_r1 = 0;
  if (tid < NEXP) lcnt[tid] = 0;
  __syncthreads();
  for (int tb = bid; tb < NTOK / 64; tb += nb) {
    const int tok0 = tb * 64;
    const int b = tok0 / T;
    const float* wsc = p.wsc2 + (l * 2 + b) * DM;
    {
      float* Bs = (float*)(smem + 32768);
      const float* xr = p.xbuf + (size_t)(tok0 + tg * 16 + fr) * DM + kh * 512 + fq * 4;
      const float* wv = wsc + kh * 512 + fq * 4;
      const float* wl = p.wcat + (size_t)l * DM * 48;
      f32x4 acc[3];
#pragma unroll
      for (int nt = 0; nt < 3; ++nt) acc[nt] = f32x4{0.f, 0.f, 0.f, 0.f};
      float ssq = 0.f;
      float4 rbv[3], xa[4], wa[4], xn[4], wn[4];
      auto gloadB = [&](int s) {
#pragma unroll
        for (int i = 0; i < 3; ++i) {
          const int idx = tid + NTHR * i, half = idx / 768, r = idx - half * 768, krow = r / 12, c4 = r - krow * 12;
          rbv[i] = *(const float4*)(wl + (size_t)(half * 512 + 64 * s + krow) * 48 + c4 * 4);
        }
      };
      auto storeB = [&](int buf) {
#pragma unroll
        for (int i = 0; i < 3; ++i) {
          const int idx = tid + NTHR * i, half = idx / 768, r = idx - half * 768, krow = r / 12, c4 = r - krow * 12;
          *(float4*)(Bs + ((buf * 2 + half) * 64 + krow) * 48 + c4 * 4) = rbv[i];
        }
      };
      auto gloadA = [&](float4 (&xd)[4], float4 (&wd)[4], int s) {
#pragma unroll
        for (int c = 0; c < 4; ++c) {
          xd[c] = *(const float4*)(xr + 64 * s + c * 16);
          wd[c] = *(const float4*)(wv + 64 * s + c * 16);
        }
      };
      gloadB(0);
      gloadA(xa, wa, 0);
      storeB(0);
      __syncthreads();
#pragma unroll 1
      for (int s = 0; s < 8; ++s) {
        const int sn = min(s + 1, 7);
        gloadB(sn);
        gloadA(xn, wn, sn);
        const float* bt = Bs + (((s & 1) * 2 + kh) * 64 + fq) * 48 + fr;
#pragma unroll
        for (int c = 0; c < 4; ++c) {
          const float4 xv = xa[c], ww = wa[c];
          ssq += xv.x * xv.x + xv.y * xv.y + xv.z * xv.z + xv.w * xv.w;
          const float a0 = xv.x * ww.x, a1 = xv.y * ww.y, a2 = xv.z * ww.z, a3 = xv.w * ww.w;
          const float* bp = bt + (16 * c + 3 * fq) * 48;
#pragma unroll
          for (int nt = 0; nt < 3; ++nt) {
            acc[nt] = __builtin_amdgcn_mfma_f32_16x16x4f32(a0, bp[0 * 48 + nt * 16], acc[nt], 0, 0, 0);
            acc[nt] = __builtin_amdgcn_mfma_f32_16x16x4f32(a1, bp[1 * 48 + nt * 16], acc[nt], 0, 0, 0);
            acc[nt] = __builtin_amdgcn_mfma_f32_16x16x4f32(a2, bp[2 * 48 + nt * 16], acc[nt], 0, 0, 0);
            acc[nt] = __builtin_amdgcn_mfma_f32_16x16x4f32(a3, bp[3 * 48 + nt * 16], acc[nt], 0, 0, 0);
          }
        }
        storeB((s + 1) & 1);
        __syncthreads();
#pragma unroll
        for (int c = 0; c < 4; ++c) { xa[c] = xn[c]; wa[c] = wn[c]; }
      }
      ssq += shx(ssq, 16, lane);
      ssq += shx(ssq, 32, lane);
#pragma unroll
      for (int nt = 0; nt < 3; ++nt)
#pragma unroll
        for (int j = 0; j < 4; ++j) accb[(kh * 64 + tg * 16 + fq * 4 + j) * 49 + nt * 16 + fr] = acc[nt][j];
      if (fq == 0) ssqb[kh * 64 + tg * 16 + fr] = ssq;
    }
    __syncthreads();
    if (tid < 64) {
      const int t = tok0 + tid;
      const float rstd = rsqrtf((ssqb[tid] + ssqb[64 + tid]) * (1.f / DM) + EPS);
      rsl[tid] = rstd;
      const float* c0 = p.c0 + (l * 2 + b) * 48;
      float acc[36];
#pragma unroll
      for (int o = 0; o < 36; ++o) acc[o] = rstd * (accb[tid * 49 + o] + accb[(64 + tid) * 49 + o]) + c0[o];
      int grp = 0;
      float mx = acc[0];
#pragma unroll
      for (int g = 1; g < 4; ++g)
        if (acc[g] > mx) { mx = acc[g]; grp = g; }
      float den = 0.f;
#pragma unroll
      for (int g = 0; g < 4; ++g) den += __expf(acc[g] - mx);
      const float pg_top = 1.f / den;
      float el[8];
#pragma unroll
      for (int j = 0; j < 8; ++j) {
        const float a0 = acc[4 + j], a1 = acc[12 + j], a2 = acc[20 + j], a3 = acc[28 + j];
        el[j] = (grp == 0) ? a0 : (grp == 1) ? a1 : (grp == 2) ? a2 : a3;
      }
      float b0 = -3.0e38f, b1 = -3.0e38f;
      int i0 = 0, i1 = 0;
#pragma unroll
      for (int j = 0; j < 8; ++j)
        if (el[j] > b0) { b0 = el[j]; i0 = j; }
#pragma unroll
      for (int j = 0; j < 8; ++j)
        if (j != i0 && el[j] > b1) { b1 = el[j]; i1 = j; }
      const float ex = __expf(b1 - b0);
      const float g0 = pg_top / (1.f + ex), g1 = pg_top * ex / (1.f + ex);
      const int e0 = grp * 8 + i0, e1 = grp * 8 + i1;
      sel_e0 = e0; sel_e1 = e1;
      sel_r0 = atomicAdd(&lcnt[e0], 1);
      sel_r1 = atomicAdd(&lcnt[e1], 1);
      p.sgate[2 * t] = g0;
      p.sgate[2 * t + 1] = g1;
    }
    __syncthreads();
    if (tid < NEXP) {
      const int c = lcnt[tid];
      lbase[tid] = (c > 0) ? atomicAdd(&p.cnt[l * NEXP + tid], c) : 0;
      lcnt[tid] = 0;
    }
    __syncthreads();
    if (tid < 64) {
      const int t = tok0 + tid;
      p.list[sel_e0 * CAP + lbase[sel_e0] + sel_r0] = 2 * t;
      p.list[sel_e1 * CAP + lbase[sel_e1] + sel_r1] = 2 * t + 1;
    }
    {
      const float* sh = p.mod + (l * 2 + b) * 6144 + MOD_SHIFT2;
#pragma unroll 2
      for (int q = 0; q < 8; ++q) {
        const int tl = wid * 8 + q;
        const float rstd = rsl[tl];
        const float4* xr = (const float4*)(p.xbuf + (size_t)(tok0 + tl) * DM);
#pragma unroll
        for (int i = 0; i < 4; ++i) {
          const int idx = (lane + 64 * i) * 4;
          const float4 xv = xr[lane + 64 * i];
          const float4 w = *(const float4*)(wsc + idx);
          const float4 h = *(const float4*)(sh + idx);
          uint2 pk;
          pk.x = pack2(xv.x * w.x * rstd + h.x, xv.y * w.y * rstd + h.y);
          pk.y = pack2(xv.z * w.z * rstd + h.z, xv.w * w.w * rstd + h.w);
          *(uint2*)(p.act + (size_t)(tok0 + tl) * DM + idx) = pk;
        }
      }
    }
    __syncthreads();
  }
}

struct EpiMoe {
  static constexpr bool PERM = true;
  bf16_t* H; bf16_t* Y; const int* list; const float* sgate;
  DEV void operator()(const f32x4 (&acc)[2][2][4][2], const GUnit& u, int wr, int wc, int fr_, int fq) const {
    int fr = fr_;
    asm volatile("" : "+v"(fr));
    if (!u.ph) {
      const __amdgpu_buffer_rsrc_t rh = __builtin_amdgcn_make_buffer_rsrc((void*)H, 0, 2 * 32768 * DEXP, 0x00020000);
      const int hcol = u.pn * 128 + wc * 32 + 8 * fq;
#pragma unroll
      for (int ai = 0; ai < 2; ++ai)
#pragma unroll
        for (int m = 0; m < 4; ++m) {
          const int rl = ai * G_HALF + wr * 64 + m * 16 + fr;
          if (rl < u.valid) {
            const int slot = list[u.e * CAP + u.pm * 256 + rl];
            float h[8];
#pragma unroll
            for (int n = 0; n < 2; ++n)
#pragma unroll
              for (int j = 0; j < 4; ++j) h[n * 4 + j] = silu_f(acc[ai][0][m][n][j]) * acc[ai][1][m][n][j];
            const uint4 pk = pack8(h);
            const u32x4 pv = {pk.x, pk.y, pk.z, pk.w};
            __builtin_amdgcn_raw_buffer_store_b128(pv, rh, (slot * DEXP + hcol) * 2, 0, 16  );
          }
        }
    } else {
      const int col0 = u.pn * 256 + wc * 32 + 8 * fq;
#pragma unroll
      for (int ai = 0; ai < 2; ++ai)
#pragma unroll
        for (int m = 0; m < 4; ++m) {
          const int rl = ai * G_HALF + wr * 64 + m * 16 + fr;
          if (rl < u.valid) {
            const int slot = list[u.e * CAP + u.pm * 256 + rl];
            const float g = sgate[slot];
#pragma unroll
            for (int bj = 0; bj < 2; ++bj) {
              float yv[8];
#pragma unroll
              for (int n = 0; n < 2; ++n)
#pragma unroll
                for (int j = 0; j < 4; ++j) yv[n * 4 + j] = g * acc[ai][bj][m][n][j];
              *(uint4*)(Y + (size_t)slot * DM + col0 + bj * G_HALF) = pack8(yv);
            }
          }
        }
    }
  }
};

DEV void phase_moe(const Params& p, int l, int bid, int nb, char* smem) {
  MoeSched S;
  S.act = p.act; S.hbuf = p.hbuf; S.bt1 = p.bt1; S.bt2 = p.bt2; S.cnt = p.cnt + l * NEXP; S.list = p.list;
  S.rdy = p.bar + XB_RDY + l * 192; S.tmo = p.bar + XB_TMO; S.G = nb; S.c = bid; S.wv = p.wv;
  EpiMoe E;
  E.H = p.hbuf; E.Y = p.ybuf; E.list = p.list; E.sgate = p.sgate;
  gemm_phase((LAS unsigned char*)smem, S, E);
}

DEV void phase_combine(const Params& p, int l, int bid, int nb) {
  const int tid_ = fresh_tid(), lane = tid_ & 63, wid = tid_ >> 6;
  for (int t = bid * NWAVE + wid; t < NTOK; t += nb * NWAVE) {
    float4* xr = (float4*)(p.xbuf + (size_t)t * DM);
    const int b = t / T;
    const float* md = p.mod + (l * 2 + b) * 6144;
    float4 v[4];
    float ss = 0.f;
#pragma unroll
    for (int i = 0; i < 4; ++i) {
      const int idx = (lane + 64 * i) * 4;
      v[i] = xr[lane + 64 * i];
      const float4 g = *(const float4*)(md + MOD_GATE2 + idx);
      const uint2 ya = *(const uint2*)(p.ybuf + (size_t)(2 * t) * DM + idx);
      const uint2 yb = *(const uint2*)(p.ybuf + (size_t)(2 * t + 1) * DM + idx);
      v[i].x += g.x * (__uint_as_float(ya.x << 16) + __uint_as_float(yb.x << 16));
      v[i].y += g.y * (__uint_as_float(ya.x & 0xffff0000u) + __uint_as_float(yb.x & 0xffff0000u));
      v[i].z += g.z * (__uint_as_float(ya.y << 16) + __uint_as_float(yb.y << 16));
      v[i].w += g.w * (__uint_as_float(ya.y & 0xffff0000u) + __uint_as_float(yb.y & 0xffff0000u));
      ss += v[i].x * v[i].x + v[i].y * v[i].y + v[i].z * v[i].z + v[i].w * v[i].w;
    }
    ss = wave_sum(ss, lane);
    const float rstd = rsqrtf(ss * (1.f / DM) + EPS);
    if (l + 1 < DEPTH) {
#pragma unroll
      for (int i = 0; i < 4; ++i) xr[lane + 64 * i] = v[i];
      const float* md2 = p.mod + ((l + 1) * 2 + b) * 6144;
      norm_mod_store(v, rstd, p.norm_mix_w + (l + 1) * DM, md2 + MOD_SCALE1, md2 + MOD_SHIFT1,
                     p.act + (size_t)t * DM, lane);
    } else {
      float4* orow = (float4*)(p.out + (size_t)t * DM);
#pragma unroll
      for (int i = 0; i < 4; ++i) {
        const float4 w = *(const float4*)(p.final_w + (lane + 64 * i) * 4);
        float4 r;
        r.x = v[i].x * rstd * w.x;
        r.y = v[i].y * rstd * w.y;
        r.z = v[i].z * rstd * w.z;
        r.w = v[i].w * rstd * w.w;
        orow[lane + 64 * i] = r;
      }
    }
  }
}

constexpr size_t ws_align(size_t b) { return (b + 255) & ~(size_t)255; }
constexpr size_t WS_bar = 0;
constexpr size_t WS_mod = WS_bar + ws_align(sizeof(unsigned) * BAR_WORDS_TOTAL);
constexpr size_t WS_btin = WS_mod + ws_align(sizeof(float) * DEPTH * NB * 6144);
constexpr size_t WS_btg = WS_btin + ws_align(2 * (size_t)PROJW * DM);
constexpr size_t WS_btout = WS_btg + ws_align(2 * (size_t)16 * DM);
constexpr size_t WS_bt1 = WS_btout + ws_align(2 * (size_t)DM * DM);
constexpr size_t WS_bt2 = WS_bt1 + ws_align(2 * (size_t)NEXP * 1024 * DM);
constexpr size_t WS_wcat = WS_bt2 + ws_align(2 * (size_t)NEXP * DM * DEXP);
constexpr size_t WS_wsc2 = WS_wcat + ws_align(sizeof(float) * DEPTH * DM * 48);
constexpr size_t WS_c0 = WS_wsc2 + ws_align(sizeof(float) * DEPTH * NB * DM);
constexpr size_t WS_cnt = WS_c0 + ws_align(sizeof(float) * DEPTH * NB * 48);
constexpr size_t WS_xbuf = WS_cnt + ws_align(sizeof(int) * DEPTH * NEXP);
constexpr size_t WS_act = WS_xbuf + ws_align(sizeof(float) * (size_t)NTOK * DM);
constexpr size_t WS_proj = WS_act + ws_align(2 * (size_t)NTOK * DM);
constexpr size_t WS_gates = WS_proj + ws_align(2 * (size_t)NTOK * PROJW);
constexpr size_t WS_y = WS_gates + ws_align(sizeof(float) * (size_t)NTOK * 16);
constexpr size_t WS_list = WS_y + ws_align(2 * (size_t)NTOK * DM);
constexpr size_t WS_sgate = WS_list + ws_align(sizeof(int) * NEXP * CAP);
constexpr size_t WS_egl = WS_sgate + ws_align(sizeof(float) * 2 * NTOK);
constexpr size_t WS_obuf = WS_egl + ws_align(sizeof(float) * 2048);
constexpr size_t WS_gdn_rec = WS_obuf + ws_align(2 * 2 * (size_t)NTOK * 512);
constexpr size_t WS_gdn_u = WS_gdn_rec + ws_align((size_t)2048 * REC_BYTES);
constexpr size_t WS_TOTAL = WS_gdn_u + ws_align(sizeof(unsigned) * (size_t)2048 * 32 * 128);

struct KArgs {
  const float *x, *c, *norm_mix_w, *norm_ffn_w, *w_ada, *b_ada, *w_in, *conv_a_w, *na_rpb, *gdn_conv_w,
      *gdn_a_log, *gdn_dt_bias, *gdn_norm_w, *w_out, *rg_w, *rg_b, *re_w, *re_b, *ew1, *ew3, *ew2, *final_w;
  float* out;
  char* ws;
  int rep[12];
};
DEV Params make_params(const KArgs& a) {
  Params p;
  p.x = a.x; p.c = a.c; p.norm_mix_w = a.norm_mix_w; p.norm_ffn_w = a.norm_ffn_w; p.w_ada = a.w_ada; p.b_ada = a.b_ada;
  p.w_in = a.w_in; p.conv_a_w = a.conv_a_w; p.na_rpb = a.na_rpb; p.gdn_conv_w = a.gdn_conv_w; p.gdn_a_log = a.gdn_a_log;
  p.gdn_dt_bias = a.gdn_dt_bias; p.gdn_norm_w = a.gdn_norm_w; p.w_out = a.w_out; p.rg_w = a.rg_w; p.rg_b = a.rg_b;
  p.re_w = a.re_w; p.re_b = a.re_b; p.ew1 = a.ew1; p.ew3 = a.ew3; p.ew2 = a.ew2; p.final_w = a.final_w;
  p.out = a.out;
  p.bar = (unsigned*)(a.ws + WS_bar);
  p.mod = (float*)(a.ws + WS_mod);
  p.btin = (bf16_t*)(a.ws + WS_btin);
  p.btg = (bf16_t*)(a.ws + WS_btg);
  p.btout = (bf16_t*)(a.ws + WS_btout);
  p.bt1 = (bf16_t*)(a.ws + WS_bt1);
  p.bt2 = (bf16_t*)(a.ws + WS_bt2);
  p.wcat = (float*)(a.ws + WS_wcat);
  p.wsc2 = (float*)(a.ws + WS_wsc2);
  p.c0 = (float*)(a.ws + WS_c0);
  p.cnt = (int*)(a.ws + WS_cnt);
  p.xbuf = (float*)(a.ws + WS_xbuf);
  p.act = (bf16_t*)(a.ws + WS_act);
  p.proj = (bf16_t*)(a.ws + WS_proj);
  p.gates = (float*)(a.ws + WS_gates);
  p.y = (bf16_t*)(a.ws + WS_y);
  p.list = (int*)(a.ws + WS_list);
  p.sgate = (float*)(a.ws + WS_sgate);
  p.egl = (float*)(a.ws + WS_egl);
  p.obuf = (bf16_t*)(a.ws + WS_obuf);
  p.gdn_rec = (char*)(a.ws + WS_gdn_rec);
  p.gdn_u = (unsigned*)(a.ws + WS_gdn_u);
  p.hbuf = (bf16_t*)p.obuf;
  p.ybuf = (bf16_t*)p.gdn_rec;
#pragma unroll
  for (int i = 0; i < 12; ++i) p.rep[i] = a.rep[i];
  p.wv = __builtin_amdgcn_readfirstlane((int)(threadIdx.x >> 6));
  return p;
}

__global__ void __launch_bounds__(NTHR) mega_kernel(KArgs ka) {
  const Params p = make_params(ka);
  __shared__ __attribute__((aligned(16))) char smem[SMEM_BYTES + 16];
  const int bid0 = blockIdx.x, nb = gridDim.x;
  if (fresh_tid() == 0) *(uint4*)(smem + SMEM_BYTES) = make_uint4(0u, 0u, 0u, 0u);
  __syncthreads();
  xcd_barrier_post(p.bar, fresh_tid());
#pragma unroll 1
  for (int rp = 0; rp < p.rep[7]; ++rp) {
    phase_ada(p, bid0, nb, smem);
    convert_win(p, 0, bid0, nb, smem);
  }
  xcd_barrier(p.bar, (volatile LAS unsigned*)(smem + SMEM_BYTES), fresh_tid());
#pragma unroll 1
  for (int rp = 0; rp < p.rep[8]; ++rp) {
    phase_hmix(p, 0, p.x, bid0, nb);
    phase_consts(p, bid0, nb);
  }
  xcd_barrier(p.bar, (volatile LAS unsigned*)(smem + SMEM_BYTES), fresh_tid());
#pragma unroll 1
  for (int l = 0; l < DEPTH; ++l) {
    int lz = l;
    asm volatile("" : "+s"(lz));
    const int bid = bid0 + (lz - l);
#pragma unroll 1
    for (int rp = 0; rp < p.rep[0]; ++rp) phase_gemm_proj(p, l, bid, nb, smem);
    xcd_barrier(p.bar, (volatile LAS unsigned*)(smem + SMEM_BYTES), fresh_tid());
#pragma unroll 1
    for (int rp = 0; rp < p.rep[1]; ++rp) phase_gdn_prep(p, l, bid, nb, smem);
    xcd_barrier(p.bar, (volatile LAS unsigned*)(smem + SMEM_BYTES), fresh_tid());
#pragma unroll 1
    for (int rp = 0; rp < p.rep[2]; ++rp) {
      if (bid < 16) {
        phase_gdn_scan(p, l * 4 + rp + 1, bid, smem);
      } else if (bid < 64) {
        phase_scan_helper(p, l * 4 + rp + 1, (bid - 16) & 15, (bid - 16) >> 4, smem);
      } else {
#pragma unroll 1
        for (int rq = 0; rq < p.rep[6]; ++rq) {
          phase_conv(p, l, bid - 64, nb - 64);
          phase_na(p, l, (bid - 64) * NWAVE + (fresh_tid() >> 6), (nb - 64) * NWAVE);
        }
#pragma unroll 1
        for (int rq = 0; rq < p.rep[10]; ++rq) convert_layer(p, l, bid - 64, nb - 64, smem);
      }
    }
    xcd_barrier(p.bar, (volatile LAS unsigned*)(smem + SMEM_BYTES), fresh_tid());
#pragma unroll 1
    for (int rp = 0; rp < p.rep[5]; ++rp) phase_gdn_fin(p, l, bid, nb);
    xcd_barrier(p.bar, (volatile LAS unsigned*)(smem + SMEM_BYTES), fresh_tid());
#pragma unroll 1
    for (int rp = 0; rp < (l == 0 ? p.rep[9] : 1); ++rp) phase_gemm_wout(p, l, l == 0 ? p.x : p.xbuf, bid, nb, smem);
    xcd_barrier(p.bar, (volatile LAS unsigned*)(smem + SMEM_BYTES), fresh_tid());
    phase_router(p, l, bid, nb, smem);
    xcd_barrier(p.bar, (volatile LAS unsigned*)(smem + SMEM_BYTES), fresh_tid());
    phase_moe(p, l, bid, nb, smem);
    xcd_barrier(p.bar, (volatile LAS unsigned*)(smem + SMEM_BYTES), fresh_tid());
    phase_combine(p, l, bid, nb);
#pragma unroll 1
    for (int rp = 1; rp < p.rep[11]; ++rp) xcd_barrier(p.bar, (volatile LAS unsigned*)(smem + SMEM_BYTES), fresh_tid());
    if (l + 1 < DEPTH) xcd_barrier(p.bar, (volatile LAS unsigned*)(smem + SMEM_BYTES), fresh_tid());
  }
}

extern "C" void kernel_launch(void* const* d_in, const int* in_sizes, int n_in, void* d_out, int out_size,
                              void* d_ws, size_t ws_size, hipStream_t stream) {
  KArgs p{};
  p.x = (const float*)d_in[0];
  p.c = (const float*)d_in[1];
  p.norm_mix_w = (const float*)d_in[2];
  p.norm_ffn_w = (const float*)d_in[3];
  p.w_ada = (const float*)d_in[4];
  p.b_ada = (const float*)d_in[5];
  p.w_in = (const float*)d_in[6];
  p.conv_a_w = (const float*)d_in[7];
  p.na_rpb = (const float*)d_in[8];
  p.gdn_conv_w = (const float*)d_in[9];
  p.gdn_a_log = (const float*)d_in[10];
  p.gdn_dt_bias = (const float*)d_in[11];
  p.gdn_norm_w = (const float*)d_in[12];
  p.w_out = (const float*)d_in[13];
  p.rg_w = (const float*)d_in[14];
  p.rg_b = (const float*)d_in[15];
  p.re_w = (const float*)d_in[16];
  p.re_b = (const float*)d_in[17];
  p.ew1 = (const float*)d_in[18];
  p.ew3 = (const float*)d_in[19];
  p.ew2 = (const float*)d_in[20];
  p.final_w = (const float*)d_in[21];
  p.out = (float*)d_out;
  p.ws = (char*)d_ws;
  if (WS_TOTAL > ws_size) fprintf(stderr, "workspace too small: need %zu have %zu\n", (size_t)WS_TOTAL, ws_size);

  static int grid_blocks = 0;
  if (!grid_blocks) {
    int dev = 0, cus = 0, per_cu = 0;
    (void)hipGetDevice(&dev);
    (void)hipDeviceGetAttribute(&cus, hipDeviceAttributeMultiprocessorCount, dev);
    (void)hipOccupancyMaxActiveBlocksPerMultiprocessor(&per_cu, mega_kernel, NTHR, 0);
    if (per_cu > 1) per_cu = 1;
    if (per_cu < 1) per_cu = 1;
    grid_blocks = cus * per_cu;
  }
  (void)hipMemsetAsync((char*)d_ws + WS_bar, 0, sizeof(unsigned) * BAR_WORDS_TOTAL, stream);
  for (int i = 0; i < 12; ++i) p.rep[i] = 1;
  void* args[] = {&p};
  hipError_t e = hipLaunchCooperativeKernel((void*)mega_kernel, dim3(grid_blocks), dim3(NTHR), args, 0, stream);
  if (e != hipSuccess) fprintf(stderr, "cooperative launch failed: %s (grid %d)\n", hipGetErrorString(e), grid_blocks);
}
```

```cpp
#include <hip/hip_runtime.h>
#include <hip/hip_cooperative_groups.h>
#include <stdint.h>
#include <stdio.h>

#define DEV __device__ __forceinline__
namespace cg = cooperative_groups;

typedef __attribute__((ext_vector_type(8))) short bf16x8;
typedef __attribute__((ext_vector_type(4))) float f32x4;
typedef __attribute__((ext_vector_type(16))) float f32x16;
typedef float f32x2_t __attribute__((ext_vector_type(2)));
typedef __bf16 bf16x2_t __attribute__((ext_vector_type(2)));
typedef unsigned short bf16_t;
typedef unsigned u32x4 __attribute__((ext_vector_type(4)));

constexpr int NTHR = 512;
constexpr int NWAVE = 8;
constexpr int DM = 1024;
constexpr int NB = 2;
constexpr int T = 8192;
constexpr int NTOK = NB * T;
constexpr int DEPTH = 2;
constexpr int DIN = 3600;
constexpr int PROJW = 3584;
constexpr int NEXP = 32;
constexpr int DEXP = 512;
constexpr int CAP = 16384;
constexpr float EPS = 1e-6f;
constexpr int OFF_CB = 0, OFF_CC = 256, OFF_CX = 512, OFF_NQ = 768, OFF_NK = 1024, OFF_NV = 1280,
              OFF_GQKV = 1536, OFF_GZ = 3072;
constexpr int MOD_SHIFT1 = 0, MOD_SCALE1 = 1024, MOD_GATE1 = 2048, MOD_SHIFT2 = 3072, MOD_SCALE2 = 4096,
              MOD_GATE2 = 5120;

constexpr int REC_WN = 0, REC_QD = 16384, REC_IN = 32768, REC_KT = 40960, REC_BYTES = 57344;
constexpr int SC_WN = 0, SC_QD = 17408, SC_IN = 34816, SC_KT = 44032, SC_U = 62464, SC_BUF = 78848;
constexpr int PL_Q = 0, PL_K = 17408, PL_V = 34816, PL_L = 52224, PL_GC = 87040, PL_BETA = 87552, PL_BG = 88064,
              PL_GL = 88576, PL_FQ = 88592  , PL_FK = 89104  ,
              PL_CW = 89616  ;
constexpr int SMEM_BYTES = 2 * SC_BUF;

struct Params {
  const float *x, *c, *norm_mix_w, *norm_ffn_w, *w_ada, *b_ada, *w_in, *conv_a_w, *na_rpb, *gdn_conv_w,
      *gdn_a_log, *gdn_dt_bias, *gdn_norm_w, *w_out, *rg_w, *rg_b, *re_w, *re_b, *ew1, *ew3, *ew2, *final_w;
  float* out;
  float* mod;
  int* cnt;
  float* xbuf;
  bf16_t* act;
  bf16_t* proj;
  float* gates;
  bf16_t* y;
  bf16_t* obuf;
  char* gdn_rec;
  unsigned* gdn_u;
  float* egl;
  bf16_t* hbuf;
  bf16_t* ybuf;
  int* list;
  float* sgate;
  bf16_t* btin;
  bf16_t* btg;
  bf16_t* btout;
  bf16_t* bt1;
  bf16_t* bt2;
  float* wcat;
  float* wsc2;
  float* c0;
  unsigned* bar;
  int rep[12];
  int wv;
};

DEV unsigned pack2(float a, float b) {
  f32x2_t v = {a, b};
  return __builtin_bit_cast(unsigned, __builtin_convertvector(v, bf16x2_t));
}
DEV bf16_t f2bf(float f) { return (bf16_t)(pack2(f, 0.f) & 0xffffu); }
DEV float bf2f(bf16_t h) { return __uint_as_float(((unsigned)h) << 16); }
DEV float silu_f(float x) { return x * __builtin_amdgcn_rcpf(1.f + __expf(-x)); }
DEV float sigmoid_f(float x) { return __builtin_amdgcn_rcpf(1.f + __expf(-x)); }
DEV float softplus_f(float x) { return fmaxf(x, 0.f) + log1pf(__expf(-fabsf(x))); }
DEV float shx(float v, int k, int lane) {
  return __int_as_float(__builtin_amdgcn_ds_bpermute((lane ^ k) << 2, __float_as_int(v)));
}
DEV float wave_sum(float v, int lane) {
#pragma unroll
  for (int o = 32; o > 0; o >>= 1) v += shx(v, o, lane);
  return v;
}
DEV int fresh_tid_w(int wv) {
  unsigned z = 0u;
  asm volatile("" : "+s"(wv), "+v"(z));
  int t = (wv << 6) | (int)__builtin_amdgcn_mbcnt_hi(~0u, __builtin_amdgcn_mbcnt_lo(~0u, z));
  asm volatile("" : "+v"(t));
  return t;
}
#define fresh_tid() fresh_tid_w(p.wv)
DEV void unpack8(uint4 u, float* f) {
  f[0] = __uint_as_float(u.x << 16);
  f[1] = __uint_as_float(u.x & 0xffff0000u);
  f[2] = __uint_as_float(u.y << 16);
  f[3] = __uint_as_float(u.y & 0xffff0000u);
  f[4] = __uint_as_float(u.z << 16);
  f[5] = __uint_as_float(u.z & 0xffff0000u);
  f[6] = __uint_as_float(u.w << 16);
  f[7] = __uint_as_float(u.w & 0xffff0000u);
}
DEV uint4 pack8(const float* f) {
  uint4 r;
  r.x = pack2(f[0], f[1]);
  r.y = pack2(f[2], f[3]);
  r.z = pack2(f[4], f[5]);
  r.w = pack2(f[6], f[7]);
  return r;
}
#define MFMA16(a, b, c) __builtin_amdgcn_mfma_f32_16x16x32_bf16((a), (b), (c), 0, 0, 0)
#define MFMA32(a, b, c) __builtin_amdgcn_mfma_f32_32x32x16_bf16((a), (b), (c), 0, 0, 0)

#define LAS __attribute__((address_space(3)))
#define XB_TMO      128
#define XB_XCNT(j)  (256  + 64 * (j))
#define XB_XSUB(j)  (1280 + 64 * (j))
#define XB_XGEN(j)  (2304 + 64 * (j))
#define XB_TOP      3328
#define XB_TOPGEN   3392
#define XCD_BAR_WORDS 3456
#define XB_PROG(c)   (3456 + 64 * (c))
#define XB_CXCC(c)   (3456 + 1024 + 64 * (c))
#define XB_RDY       (3456 + 2048)
#define XB_MQ        (3456 + 2048 + 384)
#define BAR_WORDS_TOTAL (3456 + 2048 + 384 + 128)
#define XB_SPIN_CAP (1u << 22)

DEV unsigned xb_ld(unsigned* p) { return __hip_atomic_load(p, __ATOMIC_RELAXED, __HIP_MEMORY_SCOPE_AGENT); }
DEV unsigned xb_add(unsigned* p, unsigned v) { return __hip_atomic_fetch_add(p, v, __ATOMIC_RELAXED, __HIP_MEMORY_SCOPE_AGENT); }
DEV unsigned xb_xcc_id() { return (unsigned)__builtin_amdgcn_s_getreg((3 << 11) | 20) & 0xFu; }
#define XB_SPIN(cond, bar) do { unsigned _sp = 0; while (cond) { __builtin_amdgcn_s_sleep(1); \
    if ((++_sp & 255u) == 0u) { if (xb_ld(&(bar)[XB_TMO])) break; if (_sp > XB_SPIN_CAP) { atomicAdd(&(bar)[XB_TMO], 1u); break; } } } } while (0)

DEV void xcd_barrier_post(unsigned* bar, int tid) {
  if (tid == 0) (void)xb_add(&bar[XB_XCNT(xb_xcc_id())], 1u);
}
DEV void xcd_barrier_complete(unsigned* bar, unsigned x, unsigned& nloc, unsigned& nx) {
  const unsigned G = gridDim.x * gridDim.y * gridDim.z;
  unsigned sum, cnt, mine, sp = 0u;
  for (;;) {
    sum = 0u; cnt = 0u; mine = 0u;
#pragma unroll
    for (unsigned j = 0; j < 16; ++j) {
      const unsigned c = xb_ld(&bar[XB_XCNT(j)]);
      sum += c;
      cnt += (c > 0u) ? 1u : 0u;
      mine = (j == x) ? c : mine;
    }
    if (sum == G) break;
    __builtin_amdgcn_s_sleep(1);
    if ((++sp & 255u) == 0u) {
      if (xb_ld(&bar[XB_TMO])) break;
      if (sp > XB_SPIN_CAP) { atomicAdd(&bar[XB_TMO], 1u); break; }
    }
  }
  nloc = mine > 0u ? mine : 1u;
  nx = cnt > 0u ? cnt : 1u;
}
DEV void xcd_barrier(unsigned* bar, volatile LAS unsigned* st, int tid) {
  asm volatile("s_waitcnt vmcnt(0)" ::: "memory");
  __syncthreads();
  if (tid == 0) {
    const unsigned bx = xb_xcc_id();
    __builtin_amdgcn_s_waitcnt(0);
    unsigned nloc = st[0], nx = st[1];
    const unsigned gen = st[2];
    st[2] = gen + 1u;
    if (nloc == 0u) {
      xcd_barrier_complete(bar, bx, nloc, nx);
      st[0] = nloc;
      st[1] = nx;
    }
    const unsigned old = xb_add(&bar[XB_XSUB(bx)], 1u);
    if (old + 1u == (gen + 1u) * nloc) {
      __builtin_amdgcn_fence(__ATOMIC_RELEASE, "agent");
      asm volatile("s_waitcnt vmcnt(0)" ::: "memory");
      const unsigned og = xb_add(&bar[XB_TOP], 1u);
      if (og + 1u == (gen + 1u) * nx) xb_add(&bar[XB_TOPGEN], 1u);
      else XB_SPIN(xb_ld(&bar[XB_TOPGEN]) == gen, bar);
      __builtin_amdgcn_fence(__ATOMIC_ACQUIRE, "agent");
      xb_add(&bar[XB_XGEN(bx)], 1u);
      asm volatile("s_waitcnt vmcnt(0)" ::: "memory");
    } else {
      XB_SPIN(xb_ld(&bar[XB_XGEN(bx)]) == gen, bar);
      __builtin_amdgcn_fence(__ATOMIC_ACQUIRE, "agent");
      asm volatile("s_waitcnt vmcnt(0)" ::: "memory");
    }
  }
  __syncthreads();
}

constexpr int G_BK = 64, G_HALF = 128, G_HTB = G_HALF * G_BK * 2, G_STAGE_BYTES = 8 * G_HTB;
DEV int g_lds_byte(int r, int c) {
  const int st = (r >> 4) * 2 + (c >> 5), rr = r & 15, cc = c & 31, ob = rr * 64 + cc * 2;
  return st * 1024 + (ob ^ (((ob >> 9) & 1) << 5));
}
DEV void g_stage_rc(int b, int& R, int& C) {
  const int st = b / 1024, sb = b % 1024, swz = sb ^ (((sb >> 9) & 1) << 5);
  R = (st >> 1) * 16 + swz / 64;
  C = (st & 1) * 32 + (swz % 64) / 2;
}
DEV int g_perm32(int rho) { const int n = rho >> 4, i = rho & 15; return 8 * (i >> 2) + 4 * n + (i & 3); }

struct GUnit { int pm, pn, e, valid, ph, ridx; };

template <class Epi, class Sched>
DEV void gemm_phase(LAS unsigned char* lds, const Sched& S, const Epi& E) {
  const int tid = fresh_tid_w(S.wv), wid = S.wv, lane = tid & 63, wr = wid >> 2, wc = wid & 3, fr = lane & 15,
            fq = lane >> 4;
  GUnit cur, nxt;
  int ui = 0;
  if (!S.next(0, cur)) return;
  int K = S.kof(cur), nt = K / G_BK;
  unsigned voffB[2];
  auto b_offsets = [&](int Ku) {
    const int tl_ = fresh_tid_w(S.wv);
#pragma unroll
    for (int i = 0; i < 2; ++i) {
      int R, C;
      g_stage_rc(tl_ * 16 + i * 8192, R, C);
      const int Rb = Epi::PERM ? ((R & ~31) + g_perm32(R & 31)) : R;
      voffB[i] = (unsigned)(Rb * Ku + C) * 2u;
    }
  };
  b_offsets(K);
  unsigned vA[2][2];
  auto a_offsets = [&](const GUnit& u) {
    const int tl_ = fresh_tid_w(S.wv);
#pragma unroll
    for (int h = 0; h < 2; ++h)
#pragma unroll
      for (int i = 0; i < 2; ++i) {
        int R, C;
        g_stage_rc(tl_ * 16 + i * 8192, R, C);
        vA[h][i] = S.rowoff(u, h * G_HALF + R) + (unsigned)C * 2u;
      }
  };
  const size_t kstep = (size_t)(G_BK * 2);
  size_t hstep = (size_t)G_HALF * K * 2;
  const unsigned ldsw = (unsigned)wid * 1024u;
  const int aoff = g_lds_byte(wr * 64 + fr, fq * 8), boff = g_lds_byte(wc * 32 + fr, fq * 8);
#define PG8_SA(b, h) (((b) * 2 + (h)) * G_HTB)
#define PG8_SB(b, h) ((4 + (b) * 2 + (h)) * G_HTB)
#define PG8_STAGE(bufoff, gbase, voff) do { _Pragma("unroll") for (int _i = 0; _i < 2; ++_i) \
    __builtin_amdgcn_global_load_lds((const unsigned*)((const char*)(gbase) + (voff)[_i]), (LAS unsigned*)(lds + (bufoff) + ldsw + _i * 8192), 16, 0, 0); } while (0)
#define PG8_LDA(dst, b, h) do { _Pragma("unroll") for (int m = 0; m < 4; ++m) _Pragma("unroll") for (int k = 0; k < 2; ++k) dst[m][k] = *(const LAS bf16x8*)(lds + PG8_SA(b, h) + aoff + m * 2048 + k * 1024); } while (0)
#define PG8_LDB(dst, b, h) do { _Pragma("unroll") for (int n = 0; n < 2; ++n) _Pragma("unroll") for (int k = 0; k < 2; ++k) dst[n][k] = *(const LAS bf16x8*)(lds + PG8_SB(b, h) + boff + n * 2048 + k * 1024); } while (0)
#define PG8_MMA(ai, bj, At, Bt) do { __builtin_amdgcn_s_setprio(1); _Pragma("unroll") for (int m = 0; m < 4; ++m) _Pragma("unroll") for (int n = 0; n < 2; ++n) _Pragma("unroll") for (int k = 0; k < 2; ++k) \
    acc[ai][bj][m][n] = __builtin_amdgcn_mfma_f32_16x16x32_bf16(Bt[n][k], At[m][k], acc[ai][bj][m][n], 0, 0, 0); __builtin_amdgcn_s_setprio(0); } while (0)
#define PG8_WAIT_V(n) asm volatile("s_waitcnt vmcnt(" #n ")" ::: "memory")
#define PG8_WAIT_L(n) asm volatile("s_waitcnt lgkmcnt(" #n ")" ::: "memory")
#define PG8_BAR __builtin_amdgcn_s_barrier()
#define PG8_SCHED __builtin_amdgcn_sched_barrier(0)
  f32x4 acc[2][2][4][2];
#pragma unroll
  for (int a = 0; a < 2; ++a)
#pragma unroll
    for (int b = 0; b < 2; ++b)
#pragma unroll
      for (int m = 0; m < 4; ++m)
#pragma unroll
        for (int n = 0; n < 2; ++n) acc[a][b][m][n] = (f32x4){0.f, 0.f, 0.f, 0.f};
  bf16x8 At[4][2], B0[2][2], B1[2][2];
  const char* gA = S.aptr(cur);
  const char* cB = S.bptr(cur);
  S.a_ready(cur);
  a_offsets(cur);
  PG8_STAGE(PG8_SB(0, 0), cB, voffB); PG8_STAGE(PG8_SA(0, 0), gA, vA[0]); PG8_STAGE(PG8_SB(0, 1), cB + hstep, voffB); PG8_STAGE(PG8_SA(0, 1), gA, vA[1]);
  if (wr == 1) PG8_BAR;
  PG8_WAIT_V(4); PG8_BAR;
  PG8_STAGE(PG8_SB(1, 0), cB + kstep, voffB); PG8_STAGE(PG8_SA(1, 0), gA + kstep, vA[0]); PG8_STAGE(PG8_SB(1, 1), cB + hstep + kstep, voffB);
  PG8_WAIT_V(6); PG8_BAR;
  for (;;) {
    bool has_next = false;
    const char* nB = cB;
    if (!Sched::LATE) {
      has_next = S.next(ui + 1, nxt);
      nB = has_next ? S.bptr(nxt) : cB;
    }
    for (int t = 0; t < nt; t += 2) {
      const bool last = (t == nt - 2);
      if (Sched::LATE && last) {
        has_next = S.next(ui + 1, nxt);
        nB = has_next ? S.bptr(nxt) : cB;
      }
      const char* a1 = gA + (size_t)(t + 1) * kstep;
      const char* b2 = last ? nB : cB + (size_t)(t + 2) * kstep;
      const char* b3 = b2 + kstep;
      PG8_LDB(B0, 0, 0); PG8_SCHED; PG8_LDA(At, 0, 0); PG8_STAGE(PG8_SA(1, 1), a1, vA[1]);
      PG8_WAIT_L(8); PG8_BAR; PG8_WAIT_L(0); PG8_MMA(0, 0, At, B0); PG8_BAR; PG8_SCHED;
      if (last && has_next) {
        S.a_ready(nxt);
        a_offsets(nxt);
        gA = S.aptr(nxt);
        const int Kn = S.kof(nxt);
        b_offsets(Kn);
        hstep = (size_t)G_HALF * Kn * 2;
      }
      const char* a2 = last ? gA : gA + (size_t)(t + 2) * kstep;
      const char* a3 = a2 + kstep;
      PG8_LDB(B1, 0, 1); PG8_STAGE(PG8_SB(0, 0), b2, voffB);
      PG8_BAR; PG8_WAIT_L(0); PG8_MMA(0, 1, At, B1); PG8_BAR;
      PG8_LDA(At, 0, 1); PG8_STAGE(PG8_SA(0, 0), a2, vA[0]);
      PG8_BAR; PG8_WAIT_L(0); PG8_MMA(1, 0, At, B0); PG8_BAR; PG8_SCHED;
      PG8_STAGE(PG8_SB(0, 1), b2 + hstep, voffB);
      PG8_WAIT_V(6); PG8_BAR; PG8_MMA(1, 1, At, B1); PG8_BAR;
      PG8_LDB(B0, 1, 0); PG8_SCHED; PG8_LDA(At, 1, 0); PG8_STAGE(PG8_SA(0, 1), a2, vA[1]);
      PG8_WAIT_L(8); PG8_BAR; PG8_WAIT_L(0); PG8_MMA(0, 0, At, B0); PG8_BAR; PG8_SCHED;
      PG8_LDB(B1, 1, 1); PG8_STAGE(PG8_SB(1, 0), b3, voffB);
      PG8_BAR; PG8_WAIT_L(0); PG8_MMA(0, 1, At, B1); PG8_BAR;
      PG8_LDA(At, 1, 1); PG8_STAGE(PG8_SA(1, 0), a3, vA[0]);
      PG8_BAR; PG8_WAIT_L(0); PG8_MMA(1, 0, At, B0); PG8_BAR; PG8_SCHED;
      PG8_STAGE(PG8_SB(1, 1), b3 + hstep, voffB);
      PG8_WAIT_V(6); PG8_BAR; PG8_MMA(1, 1, At, B1); PG8_BAR;
    }
    {
      const int te_ = fresh_tid_w(S.wv), le_ = te_ & 63;
      const unsigned tk_ = S.claim_begin(le_);
      E(acc, cur, wr, wc, le_ & 15, le_ >> 4);
      S.done(cur, le_);
      S.claim_end(ui + 2, le_, tk_);
    }
    if (!has_next) break;
#pragma unroll
    for (int a = 0; a < 2; ++a)
#pragma unroll
      for (int b = 0; b < 2; ++b)
#pragma unroll
        for (int m = 0; m < 4; ++m)
#pragma unroll
          for (int n = 0; n < 2; ++n) acc[a][b][m][n] = (f32x4){0.f, 0.f, 0.f, 0.f};
    cur = nxt; cB = nB; ++ui;
    K = S.kof(cur); nt = K / G_BK;
  }
  PG8_WAIT_V(0);
  if (wr == 0) PG8_BAR;
  PG8_BAR;
#undef PG8_SA
#undef PG8_SB
#undef PG8_STAGE
#undef PG8_LDA
#undef PG8_LDB
#undef PG8_MMA
#undef PG8_WAIT_V
#undef PG8_WAIT_L
#undef PG8_BAR
#undef PG8_SCHED
}

struct DenseSched {
  const bf16_t* A; const bf16_t* Bt; int K, nM, nN, nwg, G, c, wv;
  DEV bool next(int i, GUnit& u) const {
    const long L = (long)i * G + c;
    if (L >= nwg) return false;
    int wgid = (int)L;
    { const int q = nwg / 8, r = nwg % 8, xcd = wgid % 8, off = wgid / 8; wgid = (xcd < r ? xcd * (q + 1) : r * (q + 1) + (xcd - r) * q) + off; }
    const int nig = 8 * nN, gid = wgid / nig, fm = gid * 8;
    u.pm = fm + ((wgid % nig) & 7);
    u.pn = (wgid % nig) >> 3;
    u.e = 0;
    u.valid = 256;
    return true;
  }
  DEV unsigned rowoff(const GUnit& u, int row) const { return (unsigned)((u.pm * 256 + row) * K) * 2u; }
  DEV const char* bptr(const GUnit& u) const { return (const char*)Bt + (size_t)u.pn * 256 * K * 2; }
  DEV const char* aptr(const GUnit&) const { return (const char*)A; }
  DEV int kof(const GUnit&) const { return K; }
  DEV void a_ready(const GUnit&) const {}
  DEV void done(const GUnit&, int) const {}
  static constexpr bool LATE = false;
  DEV unsigned claim_begin(int) const { return 0u; }
  DEV void claim_end(int, int, unsigned) const {}
};
struct MoeSched {
  const bf16_t* act; const bf16_t* hbuf; const bf16_t* bt1; const bf16_t* bt2; const int* cnt; const int* list;
  unsigned* rdy; unsigned* tmo; unsigned* q; LAS int* tb; int G, c, wv, stage;
  static constexpr bool LATE = true;
  DEV bool next(int i, GUnit& u) const {
    const int L0 = __builtin_amdgcn_readfirstlane(tb[40 + (i & 1)]);
    const int U1 = __builtin_amdgcn_readfirstlane(tb[32]) * 4;
    if (L0 >= (stage ? 2 * U1 : U1)) return false;
    u.ph = (L0 >= U1) ? 1 : 0;
    const int L = L0 - u.ph * U1;
    const int qt = L >> 2;
    const int ln = __builtin_amdgcn_mbcnt_hi(~0u, __builtin_amdgcn_mbcnt_lo(~0u, 0u));
    const int pe = tb[1 + (ln & 31)];
    const unsigned long long bal = __builtin_amdgcn_ballot_w64(pe <= qt);
    const int e = __builtin_popcount((unsigned)bal);
    const int base = __builtin_amdgcn_readfirstlane(tb[e]);
    const int cn = __builtin_amdgcn_readfirstlane(tb[48 + e]);
    u.e = e; u.pm = qt - base; u.pn = L & 3; u.valid = min(256, cn - u.pm * 256); u.ridx = qt;
    return true;
  }
  DEV unsigned claim_begin(int lane) const {
    unsigned tk = 0u;
    if (wv == 0 && lane == 0) tk = atomicAdd(q, 1u);
    return tk;
  }
  DEV void claim_end(int i, int lane, unsigned tk) const {
    if (wv == 0 && lane == 0) { tb[40 + (i & 1)] = (int)tk; tb[44] = i; }
  }
  DEV unsigned rowoff(const GUnit& u, int row) const {
    const int slot = list[u.e * CAP + u.pm * 256 + min(row, u.valid - 1)];
    return u.ph ? (unsigned)(slot * DEXP) * 2u : (unsigned)((slot >> 1) * DM) * 2u;
  }
  DEV const char* bptr(const GUnit& u) const {
    return (const char*)bt1 + (ptrdiff_t)u.ph * ((const char*)bt2 - (const char*)bt1) +
           (((size_t)u.e * 1024 + u.pn * 256) * (size_t)(DM * 2 >> u.ph));
  }
  DEV const char* aptr(const GUnit& u) const {
    return (const char*)act + (ptrdiff_t)u.ph * ((const char*)hbuf - (const char*)act);
  }
  DEV int kof(const GUnit& u) const { return u.ph ? DEXP : DM; }
  DEV void a_ready(const GUnit& u) const {
    if (u.ph) {
      if (wv == 0) {
        unsigned spins = 0u;
        while (xb_ld(rdy + u.ridx) < 32u) {
          if (++spins > 4000000u) { atomicAdd(tmo, 1u); break; }
          __builtin_amdgcn_s_sleep(2);
        }
        __builtin_amdgcn_fence(__ATOMIC_ACQUIRE, "agent");
        asm volatile("s_waitcnt vmcnt(0)" ::: "memory");
      }
      asm volatile("" ::: "memory");
      __builtin_amdgcn_s_barrier();
      asm volatile("" ::: "memory");
    }
  }
  DEV void done(const GUnit& u, int lane) const {
    if (!u.ph) {
      asm volatile("s_waitcnt vmcnt(0)" ::: "memory");
      if (lane == 0) xb_add(rdy + u.ridx, 1u);
    }
  }
};

DEV void convert_tile(const float* src, int ld, int k0, int n0, bf16_t* dst, int drow0, int dK, float* tl, int tid) {
  {
    const int kk = tid >> 4, n4 = tid & 15;
    const float4 a = *(const float4*)(src + (size_t)(k0 + kk) * ld + n0 + n4 * 4);
    const float4 b = *(const float4*)(src + (size_t)(k0 + kk + 32) * ld + n0 + n4 * 4);
    float* r0 = tl + kk * 65 + n4 * 4;
    r0[0] = a.x; r0[1] = a.y; r0[2] = a.z; r0[3] = a.w;
    float* r1 = tl + (kk + 32) * 65 + n4 * 4;
    r1[0] = b.x; r1[1] = b.y; r1[2] = b.z; r1[3] = b.w;
  }
  __syncthreads();
  {
    const int n = tid >> 3, k8 = tid & 7;
    float v[8];
#pragma unroll
    for (int j = 0; j < 8; ++j) v[j] = tl[(k8 * 8 + j) * 65 + n];
    *(uint4*)(dst + (size_t)(drow0 + n) * dK + k0 + k8 * 8) = pack8(v);
  }
  __syncthreads();
}
DEV void convert_gates(const Params& p, int l, int bid, int nb, int tid) {
  const int bs = bid;
  const int g = bs * NTHR + tid;
  if (g < 16 * DM) {
    const int j = g >> 10, k = g & (DM - 1);
    p.btg[g] = f2bf(p.w_in[((size_t)l * DM + k) * DIN + PROJW + j]);
  }
}
DEV void convert_win(const Params& p, int l, int bid, int nb, char* smem) {
  const int tid = fresh_tid();
  for (int t = bid; t < 16 * 56; t += nb) {
    const int kt = t / 56, ntile = t - kt * 56;
    convert_tile(p.w_in + (size_t)l * DM * DIN, DIN, kt * 64, ntile * 64, p.btin, ntile * 64, DM, (float*)smem, tid);
  }
  convert_gates(p, l, bid, nb, tid);
}
struct CvtDesc { const float* src; bf16_t* dst; int ld, dK, k0, n0, drow0; };
DEV CvtDesc cvt_desc(const Params& p, int l, int t) {
  constexpr int NT_W1 = NEXP * 16 * 8, NT_W2 = NEXP * 8 * 16, NT_WO = 256;
  CvtDesc d;
  if (t < 2 * NT_W1) {
    const int which = t / NT_W1, r = t - which * NT_W1;
    const int e = r >> 7, kt = (r >> 3) & 15, ntile = r & 7;
    d.src = (which ? p.ew3 : p.ew1) + (size_t)(l * NEXP + e) * DM * DEXP;
    d.ld = DEXP; d.k0 = kt * 64; d.n0 = ntile * 64;
    d.dst = p.bt1; d.dK = DM;
    d.drow0 = e * 1024 + 256 * (d.n0 >> 7) + which * 128 + (d.n0 & 127);
  } else if (t < 2 * NT_W1 + NT_W2) {
    const int r = t - 2 * NT_W1;
    const int e = r >> 7, kt = (r >> 4) & 7, ntile = r & 15;
    d.src = p.ew2 + (size_t)(l * NEXP + e) * DEXP * DM;
    d.ld = DM; d.k0 = kt * 64; d.n0 = ntile * 64;
    d.dst = p.bt2; d.dK = DEXP; d.drow0 = e * 1024 + ntile * 64;
  } else {
    const int r = t - 2 * NT_W1 - NT_W2;
    const int kt = r >> 4, ntile = r & 15;
    d.src = p.w_out + (size_t)l * DM * DM;
    d.ld = DM; d.k0 = kt * 64; d.n0 = ntile * 64;
    d.dst = p.btout; d.dK = DM; d.drow0 = ntile * 64;
  }
  return d;
}
DEV void convert_layer(const Params& p, int l, int bid_, int nb, char* smem) {
  const int bid = bid_;
  const int tid = fresh_tid();
  float* tl = (float*)smem;
  constexpr int NT = 2 * (NEXP * 16 * 8) + NEXP * 8 * 16 + 256;
  const int kk = tid >> 4, n4 = tid & 15;
  auto fetch = [&](int t, float4& a, float4& b) {
    const CvtDesc d = cvt_desc(p, l, min(t, NT - 1));
    const float* s = d.src + (size_t)(d.k0 + kk) * d.ld + d.n0 + n4 * 4;
    {
      const f32x4 av = __builtin_nontemporal_load((const f32x4*)(s));
      const f32x4 bv = __builtin_nontemporal_load((const f32x4*)(s + (size_t)32 * d.ld));
      a = make_float4(av[0], av[1], av[2], av[3]);
      b = make_float4(bv[0], bv[1], bv[2], bv[3]);
    }
  };
  float4 a0, b0, a1, b1, a2, b2;
  fetch(bid, a0, b0);
  fetch(bid + nb, a1, b1);
#pragma unroll 1
  for (int t = bid; t < NT; t += nb) {
    fetch(t + 2 * nb, a2, b2);
    const CvtDesc d = cvt_desc(p, l, t);
    {
      float* r0 = tl + kk * 65 + n4 * 4;
      r0[0] = a0.x; r0[1] = a0.y; r0[2] = a0.z; r0[3] = a0.w;
      float* r1 = tl + (kk + 32) * 65 + n4 * 4;
      r1[0] = b0.x; r1[1] = b0.y; r1[2] = b0.z; r1[3] = b0.w;
    }
    __syncthreads();
    {
      const int n = tid >> 3, k8 = tid & 7;
      float v[8];
#pragma unroll
      for (int j = 0; j < 8; ++j) v[j] = tl[(k8 * 8 + j) * 65 + n];
      const uint4 pk = pack8(v);
      const u32x4 pkv = {pk.x, pk.y, pk.z, pk.w};
      __builtin_nontemporal_store(pkv, (u32x4*)(d.dst + (size_t)(d.drow0 + n) * d.dK + d.k0 + k8 * 8));
    }
    __syncthreads();
    a0 = a1; b0 = b1; a1 = a2; b1 = b2;
  }
  if (l + 1 < DEPTH) convert_win(p, l + 1, bid, nb, smem);
}

DEV void phase_ada(const Params& p, int bid, int nb, char* smem) {
  float* cond = (float*)smem;
  float* red = cond + 2 * DM;
  const int tid = fresh_tid(), lane = tid & 63, wid = tid >> 6;
  for (int i = tid; i < 2 * DM; i += NTHR) cond[i] = silu_f(p.c[i]);
  __syncthreads();
  for (int item = bid; item < DEPTH * 96; item += nb) {
    const int l = item / 96, j = (item - l * 96) * 64 + lane;
    const float* w = p.w_ada + ((size_t)l * DM + wid * 128) * 6144 + j;
    float a0 = 0.f, a1 = 0.f;
#pragma unroll 16
    for (int k = 0; k < 128; ++k) {
      const float wv = w[(size_t)k * 6144];
      a0 += cond[wid * 128 + k] * wv;
      a1 += cond[DM + wid * 128 + k] * wv;
    }
    red[(wid * 2 + 0) * 64 + lane] = a0;
    red[(wid * 2 + 1) * 64 + lane] = a1;
    __syncthreads();
    if (wid < 2) {
      float s = p.b_ada[l * 6144 + j];
#pragma unroll
      for (int w8 = 0; w8 < 8; ++w8) s += red[(w8 * 2 + wid) * 64 + lane];
      p.mod[(l * 2 + wid) * 6144 + j] = s;
    }
    __syncthreads();
  }
  if (bid == 0 && tid < DEPTH * NEXP) p.cnt[tid] = 0;
}

DEV void norm_mod_store(const float4 (&v)[4], float rstd, const float* nw, const float* sc, const float* sh,
                        bf16_t* dst, int lane) {
#pragma unroll
  for (int i = 0; i < 4; ++i) {
    const int idx = (lane + 64 * i) * 4;
    const float4 w = *(const float4*)(nw + idx);
    const float4 s = *(const float4*)(sc + idx);
    const float4 h = *(const float4*)(sh + idx);
    const float r0 = v[i].x * rstd * w.x * (1.f + s.x) + h.x;
    const float r1 = v[i].y * rstd * w.y * (1.f + s.y) + h.y;
    const float r2 = v[i].z * rstd * w.z * (1.f + s.z) + h.z;
    const float r3 = v[i].w * rstd * w.w * (1.f + s.w) + h.w;
    uint2 pk;
    pk.x = pack2(r0, r1);
    pk.y = pack2(r2, r3);
    *(uint2*)(dst + idx) = pk;
  }
}

DEV void phase_hmix(const Params& p, int l, const float* xin, int bid, int nb) {
  const int tid_ = fresh_tid(), lane = tid_ & 63, wid = tid_ >> 6;
  for (int t = bid * NWAVE + wid; t < NTOK; t += nb * NWAVE) {
    const float4* xr = (const float4*)(xin + (size_t)t * DM);
    float4 v[4];
    float ss = 0.f;
#pragma unroll
    for (int i = 0; i < 4; ++i) {
      v[i] = xr[lane + 64 * i];
      ss += v[i].x * v[i].x + v[i].y * v[i].y + v[i].z * v[i].z + v[i].w * v[i].w;
    }
    ss = wave_sum(ss, lane);
    const float rstd = rsqrtf(ss * (1.f / DM) + EPS);
    const int b = t / T;
    const float* md = p.mod + (l * 2 + b) * 6144;
    norm_mod_store(v, rstd, p.norm_mix_w + l * DM, md + MOD_SCALE1, md + MOD_SHIFT1, p.act + (size_t)t * DM, lane);
  }
}

struct EpiProj {
  static constexpr bool PERM = true;
  bf16_t* O;
  DEV void operator()(const f32x4 (&acc)[2][2][4][2], const GUnit& u, int wr, int wc, int fr, int fq) const {
    const int row0 = u.pm * 256 + wr * 64 + fr, col0 = u.pn * 256 + wc * 32 + 8 * fq;
#pragma unroll
    for (int ai = 0; ai < 2; ++ai)
#pragma unroll
      for (int m = 0; m < 4; ++m) {
        bf16_t* rowp = O + (size_t)(row0 + ai * G_HALF + m * 16) * PROJW + col0;
#pragma unroll
        for (int bj = 0; bj < 2; ++bj) {
          const f32x4 v0 = acc[ai][bj][m][0], v1 = acc[ai][bj][m][1];
          uint4 w;
          w.x = pack2(v0[0], v0[1]); w.y = pack2(v0[2], v0[3]); w.z = pack2(v1[0], v1[1]); w.w = pack2(v1[2], v1[3]);
          *(uint4*)(rowp + bj * G_HALF) = w;
        }
      }
  }
};

DEV void phase_gemm_proj(const Params& p, int l, int bid, int nb, char* smem) {
  DenseSched S;
  S.A = p.act; S.Bt = p.btin; S.K = DM; S.nM = NTOK / 256; S.nN = PROJW / 256; S.nwg = S.nM * S.nN; S.G = nb; S.c = bid; S.wv = p.wv;
  EpiProj E;
  E.O = p.proj;
  gemm_phase((LAS unsigned char*)smem, S, E);
  const int tid = fresh_tid(), lane = tid & 63, wid = tid >> 6, fr = lane & 15, fq = lane >> 4;
  for (int tb = bid; tb < NTOK / 64; tb += nb) {
    if (wid < 4) {
      const int tok0 = tb * 64 + wid * 16;
      const bf16_t* ap = p.act + (size_t)(tok0 + fr) * DM + fq * 8;
      const bf16_t* bp = p.btg + (size_t)fr * DM + fq * 8;
      f32x4 acc = {0.f, 0.f, 0.f, 0.f};
#pragma unroll 8
      for (int ks = 0; ks < DM / 32; ++ks)
        acc = MFMA16(*(const bf16x8*)(ap + ks * 32), *(const bf16x8*)(bp + ks * 32), acc);
#pragma unroll
      for (int j = 0; j < 4; ++j) p.gates[(size_t)(tok0 + fq * 4 + j) * 16 + fr] = acc[j];
    }
  }
}

DEV void phase_conv(const Params& p, int l, int bid, int nb) {
  const float* w = p.conv_a_w + l * 768;
  const int bs = bid;
  for (int g = bs * NTHR + fresh_tid(); g < NTOK * 32; g += nb * NTHR) {
    const int t = g >> 5, c = (g & 31) * 8;
    const int tl = t & (T - 1);
    const bf16_t* r = p.proj + (size_t)t * PROJW + c;
    float cb[8], cc[8], cx[8], s[8], wk[8];
    unpack8(*(const uint4*)(r + OFF_CB), cb);
    unpack8(*(const uint4*)(r + OFF_CC), cc);
    unpack8(*(const uint4*)(r + OFF_CX), cx);
    {
      const float4 w0 = *(const float4*)(w + 256 + c), w1 = *(const float4*)(w + 256 + c + 4);
      wk[0] = w0.x; wk[1] = w0.y; wk[2] = w0.z; wk[3] = w0.w; wk[4] = w1.x; wk[5] = w1.y; wk[6] = w1.z; wk[7] = w1.w;
    }
#pragma unroll
    for (int e = 0; e < 8; ++e) s[e] = wk[e] * cc[e] * cx[e];
    if (tl > 0) {
      unpack8(*(const uint4*)(r + OFF_CC - PROJW), cc);
      unpack8(*(const uint4*)(r + OFF_CX - PROJW), cx);
      const float4 w0 = *(const float4*)(w + c), w1 = *(const float4*)(w + c + 4);
      wk[0] = w0.x; wk[1] = w0.y; wk[2] = w0.z; wk[3] = w0.w; wk[4] = w1.x; wk[5] = w1.y; wk[6] = w1.z; wk[7] = w1.w;
#pragma unroll
      for (int e = 0; e < 8; ++e) s[e] += wk[e] * cc[e] * cx[e];
    }
    if (tl < T - 1) {
      unpack8(*(const uint4*)(r + OFF_CC + PROJW), cc);
      unpack8(*(const uint4*)(r + OFF_CX + PROJW), cx);
      const float4 w0 = *(const float4*)(w + 512 + c), w1 = *(const float4*)(w + 512 + c + 4);
      wk[0] = w0.x; wk[1] = w0.y; wk[2] = w0.z; wk[3] = w0.w; wk[4] = w1.x; wk[5] = w1.y; wk[6] = w1.z; wk[7] = w1.w;
#pragma unroll
      for (int e = 0; e < 8; ++e) s[e] += wk[e] * cc[e] * cx[e];
    }
#pragma unroll
    for (int e = 0; e < 8; ++e) s[e] *= cb[e];
    *(uint4*)(p.y + (size_t)t * DM + c) = pack8(s);
  }
}

DEV void phase_na(const Params& p, int l, int wgid, int nwg) {
  const int tid_ = fresh_tid(), lane = tid_ & 63, fr = lane & 15, fq = lane >> 4;
  for (int item = wgid; item < NB * 128 * 4 * 4; item += nwg) {
    const int qg = item & 3, h = (item >> 2) & 3, r = (item >> 4) & 127, b = item >> 11;
    const int rs = min(max(r - 4, 0), 120);
    const int kc0 = (qg == 0) ? 0 : (qg == 1) ? 8 : (qg == 2) ? 24 : 32;
    const int c = qg * 16 + fr;
    const int cs = min(max(c - 8, 0), 48);
    const size_t tq = (size_t)b * T + r * 64 + c;
    bf16x8 bq[2];
#pragma unroll
    for (int ks = 0; ks < 2; ++ks)
      bq[ks] = *(const bf16x8*)(p.proj + tq * PROJW + OFF_NQ + h * 64 + ks * 32 + fq * 8);
    f32x4 sc[16];
#pragma unroll
    for (int tt = 0; tt < 16; ++tt) {
      const int i = tt >> 1, half = tt & 1;
      const size_t kt = (size_t)b * T + (rs + i) * 64 + kc0 + half * 16 + fr;
      const bf16_t* kp = p.proj + kt * PROJW + OFF_NK + h * 64 + fq * 8;
      const bf16x8 a0 = *(const bf16x8*)(kp);
      const bf16x8 a1 = *(const bf16x8*)(kp + 32);
      f32x4 z = {0.f, 0.f, 0.f, 0.f};
      z = MFMA16(a0, bq[0], z);
      sc[tt] = MFMA16(a1, bq[1], z);
    }
    const float* rpb = p.na_rpb + (size_t)(l * 4 + h) * 465;
    float mx = -3.0e38f;
#pragma unroll
    for (int tt = 0; tt < 16; ++tt) {
      const int i = tt >> 1, half = tt & 1;
      const int dr = rs + i - r + 7;
#pragma unroll
      for (int j = 0; j < 4; ++j) {
        const int kcol = kc0 + half * 16 + fq * 4 + j;
        const bool valid = (kcol >= cs) && (kcol < cs + 16);
        const int dc = valid ? (kcol - c + 15) : 0;
        const float s = valid ? (sc[tt][j] * 0.125f + rpb[dr * 31 + dc]) : -3.0e38f;
        sc[tt][j] = s;
        mx = fmaxf(mx, s);
      }
    }
    mx = fmaxf(mx, shx(mx, 16, lane));
    mx = fmaxf(mx, shx(mx, 32, lane));
    float sum = 0.f;
#pragma unroll
    for (int tt = 0; tt < 16; ++tt)
#pragma unroll
      for (int j = 0; j < 4; ++j) {
        const float s = sc[tt][j];
        const float e = (s > -1.0e38f) ? __expf(s - mx) : 0.f;
        sc[tt][j] = e;
        sum += e;
      }
    sum += shx(sum, 16, lane);
    sum += shx(sum, 32, lane);
    const float inv = 1.f / sum;
    f32x4 oacc[4];
#pragma unroll
    for (int nt = 0; nt < 4; ++nt) oacc[nt] = f32x4{0.f, 0.f, 0.f, 0.f};
#pragma unroll
    for (int i = 0; i < 8; ++i) {
      uint4 pu;
      pu.x = pack2(sc[2 * i][0] * inv, sc[2 * i][1] * inv);
      pu.y = pack2(sc[2 * i][2] * inv, sc[2 * i][3] * inv);
      pu.z = pack2(sc[2 * i + 1][0] * inv, sc[2 * i + 1][1] * inv);
      pu.w = pack2(sc[2 * i + 1][2] * inv, sc[2 * i + 1][3] * inv);
      const bf16x8 pa = __builtin_bit_cast(bf16x8, pu);
      const bf16_t* vb = p.proj + ((size_t)b * T + (rs + i) * 64 + kc0 + fq * 4) * PROJW + OFF_NV + h * 64 + fr * 4;
      uint2 wv[8];
#pragma unroll
      for (int j = 0; j < 8; ++j) wv[j] = *(const uint2*)(vb + (size_t)(j < 4 ? j : 12 + j) * PROJW);
#pragma unroll
      for (int t = 0; t < 4; ++t) {
        uint4 bu;
        const unsigned sel = (t & 1) ? 0x07060302u : 0x05040100u;
#define NA_E(j) ((t & 2) ? wv[j].y : wv[j].x)
        bu.x = __builtin_amdgcn_perm(NA_E(1), NA_E(0), sel);
        bu.y = __builtin_amdgcn_perm(NA_E(3), NA_E(2), sel);
        bu.z = __builtin_amdgcn_perm(NA_E(5), NA_E(4), sel);
        bu.w = __builtin_amdgcn_perm(NA_E(7), NA_E(6), sel);
#undef NA_E
        oacc[t] = MFMA16(pa, __builtin_bit_cast(bf16x8, bu), oacc[t]);
      }
    }
#pragma unroll
    for (int j = 0; j < 4; ++j) {
      uint2 st;
      st.x = pack2(oacc[0][j], oacc[1][j]);
      st.y = pack2(oacc[2][j], oacc[3][j]);
      *(uint2*)(p.y + ((size_t)b * T + r * 64 + qg * 16 + fq * 4 + j) * DM + 256 + h * 64 + fr * 4) = st;
    }
  }
}

DEV void fmac1(float& acc, float a, float b) { asm("v_fmac_f32 %0, %1, %2" : "+v"(acc) : "v"(a), "v"(b)); }
struct LRow { float4 v[8]; };
template <int POS>
struct SolveStep {
  static DEV void run(float (&x)[64], LRow& row, const float* Ld, const float* sclv, const bf16_t* srcq, int sstep,
                      bool isu, unsigned* up, bf16_t* wp) {
    float s0 = 0.f, s1 = 0.f, s2 = 0.f, s3 = 0.f;
    float4 hi[8];
#pragma unroll
    for (int j4 = 8; j4 < (POS + 3) / 4; ++j4) hi[j4 - 8] = *(const float4*)(Ld + POS * 68 + j4 * 4);
#pragma unroll
    for (int j4 = 0; j4 < 8; ++j4) {
      if (j4 < (POS + 3) / 4) {
        const float4 lv = row.v[j4];
        fmac1(s0, lv.x, x[j4 * 4]);
        if (j4 * 4 + 1 < POS) fmac1(s1, lv.y, x[j4 * 4 + 1]);
        if (j4 * 4 + 2 < POS) fmac1(s2, lv.z, x[j4 * 4 + 2]);
        if (j4 * 4 + 3 < POS) fmac1(s3, lv.w, x[j4 * 4 + 3]);
      }
      if (POS + 1 < 64 && j4 < (POS + 4) / 4) row.v[j4] = *(const float4*)(Ld + (POS + 1) * 68 + j4 * 4);
    }
#pragma unroll
    for (int j4 = 8; j4 < (POS + 3) / 4; ++j4) {
      const float4 lv = hi[j4 - 8];
      fmac1(s0, lv.x, x[j4 * 4]);
      if (j4 * 4 + 1 < POS) fmac1(s1, lv.y, x[j4 * 4 + 1]);
      if (j4 * 4 + 2 < POS) fmac1(s2, lv.z, x[j4 * 4 + 2]);
      if (j4 * 4 + 3 < POS) fmac1(s3, lv.w, x[j4 * 4 + 3]);
    }
    const float a = sclv[POS] * bf2f(srcq[0]) - ((s0 + s1) + (s2 + s3));
    x[POS] = a;
    if (isu) {
      if (POS & 1) up[(POS >> 1) * 128] = pack2(x[POS - 1], a);
    } else {
      wp[POS * 128] = f2bf(-a);
    }
    asm volatile("" ::: "memory");
    SolveStep<POS + 1>::run(x, row, Ld, sclv, srcq + sstep, sstep, isu, up, wp);
  }
};
template <>
struct SolveStep<64> {
  static DEV void run(float (&)[64], LRow&, const float*, const float*, const bf16_t*, int, bool, unsigned*, bf16_t*) {}
};

DEV int kperm16(int k) { const int s = (k >> 2) & 3; return (k & ~15) | ((((s & 1) << 1) | (s >> 1)) << 2) | (k & 3); }

DEV void phase_gdn_prep(const Params& p, int l, int bid, int nb, char* smem) {
  const int tid = fresh_tid(), lane = tid & 63;
  bf16_t* q_bf = (bf16_t*)(smem + PL_Q);
  bf16_t* k_bf = (bf16_t*)(smem + PL_K);
  bf16_t* v_bf = (bf16_t*)(smem + PL_V);
  float* Lm = (float*)(smem + PL_L);
  float* gcl = (float*)(smem + PL_GC);
  float* bl = (float*)(smem + PL_BETA);
  float* bgl = (float*)(smem + PL_BG);
  float* fql = (float*)(smem + PL_FQ);
  float* fkl = (float*)(smem + PL_FK);
  float* cwl = (float*)(smem + PL_CW);
  {
    const float* cw = p.gdn_conv_w + l * 4608;
    for (int i = tid; i < 1152; i += NTHR) *(float4*)(cwl + i * 4) = *(const float4*)(cw + i * 4);
  }
  __syncthreads();
  for (int item = bid; item < 1024; item += nb) {
    const int b = item >> 9, h = (item >> 7) & 3, n = item & 127;
    const int t0 = b * T + n * 64;
    char* rec0 = p.gdn_rec + (size_t)item * 2 * REC_BYTES;
    float ga = 0.f, gb = 0.f, galog = 0.f, gdt = 0.f;
    if (tid < 128) {
      const int dir = tid >> 6;
      const int i = dir ? 63 - lane : lane;
      const size_t t = (size_t)t0 + i;
      ga = p.gates[t * 16 + dir * 4 + h];
      gb = p.gates[t * 16 + 8 + dir * 4 + h];
      galog = p.gdn_a_log[l * 8 + dir * 4 + h];
      gdt = p.gdn_dt_bias[l * 8 + dir * 4 + h];
    }
    uint4 raw[3][3][2];
    {
      const int i = tid >> 3, oc = tid & 7, d0 = oc * 16;
      const int tl = n * 64 + i;
      const bf16_t* rowp = p.proj + (size_t)(t0 + i) * PROJW + OFF_GQKV + h * 128 + d0;
      const int dm = (tl > 0) ? -PROJW : 0, dp = (tl < T - 1) ? PROJW : 0;
#pragma unroll
      for (int m = 0; m < 3; ++m) {
        const bf16_t* rp = rowp + m * 512;
        raw[m][0][0] = *(const uint4*)(rp + dm);
        raw[m][0][1] = *(const uint4*)(rp + dm + 8);
        raw[m][1][0] = *(const uint4*)(rp);
        raw[m][1][1] = *(const uint4*)(rp + 8);
        raw[m][2][0] = *(const uint4*)(rp + dp);
        raw[m][2][1] = *(const uint4*)(rp + dp + 8);
      }
    }
    if (tid < 128) {
      const int dir = tid >> 6;
      const float g = -__expf(galog) * softplus_f(ga + gdt);
      const float beta = sigmoid_f(gb);
      float cs = g;
#pragma unroll
      for (int o = 1; o < 64; o <<= 1) {
        const float v = __int_as_float(__builtin_amdgcn_ds_bpermute((lane - o) << 2, __float_as_int(cs)));
        if (lane >= o) cs += v;
      }
      const float last = __uint_as_float(__builtin_amdgcn_readlane(__float_as_uint(cs), 63));
      const float ec = __expf(cs);
      gcl[dir * 64 + lane] = cs;
      bl[dir * 64 + lane] = beta;
      bgl[dir * 64 + lane] = beta * ec;
      fql[dir * 64 + lane] = ec;
      fkl[dir * 64 + lane] = __expf(last - cs);
      if (lane == 0) p.egl[item * 2 + dir] = __expf(last);
    }
    float valq[16], valk[16];
    {
      int tA = tid;
      asm volatile("" : "+v"(tA));
      const int i = tA >> 3, oc = tA & 7, d0 = oc * 16;
      const int tl = n * 64 + i;
      const float zm = (tl > 0) ? 1.f : 0.f, zp = (tl < T - 1) ? 1.f : 0.f;
#pragma unroll
      for (int m = 0; m < 3; ++m) {
        float x0[16], x1[16], x2[16], val[16];
        unpack8(raw[m][0][0], x0);
        unpack8(raw[m][0][1], x0 + 8);
        unpack8(raw[m][1][0], x1);
        unpack8(raw[m][1][1], x1 + 8);
        unpack8(raw[m][2][0], x2);
        unpack8(raw[m][2][1], x2 + 8);
        const float* cwm = cwl + m * 512 + h * 128 + d0;
        float ss = 0.f;
#pragma unroll
        for (int e4 = 0; e4 < 4; ++e4) {
          const float4 w0 = *(const float4*)(cwm + e4 * 4), w1 = *(const float4*)(cwm + 1536 + e4 * 4),
                       w2 = *(const float4*)(cwm + 3072 + e4 * 4);
          const float w0a[4] = {w0.x * zm, w0.y * zm, w0.z * zm, w0.w * zm};
          const float w1a[4] = {w1.x, w1.y, w1.z, w1.w};
          const float w2a[4] = {w2.x * zp, w2.y * zp, w2.z * zp, w2.w * zp};
#pragma unroll
          for (int j = 0; j < 4; ++j) {
            const int e = e4 * 4 + j;
            val[e] = silu_f(w0a[j] * x0[e] + w1a[j] * x1[e] + w2a[j] * x2[e]);
            ss += val[e] * val[e];
          }
        }
        if (m < 2) {
          ss += shx(ss, 1, lane);
          ss += shx(ss, 2, lane);
          ss += shx(ss, 4, lane);
          float sc = rsqrtf(ss + EPS);
          if (m == 0) sc *= 0.08838834764831845f;
#pragma unroll
          for (int e = 0; e < 16; ++e) val[e] *= sc;
        }
        bf16_t* dst = (m == 0 ? q_bf : (m == 1 ? k_bf : v_bf)) + i * 136 + d0;
        *(uint4*)(dst) = pack8(val);
        *(uint4*)(dst + 8) = pack8(val + 8);
        if (m == 0) {
#pragma unroll
          for (int e = 0; e < 16; ++e) valq[e] = val[e];
        }
        if (m == 1) {
#pragma unroll
          for (int e = 0; e < 16; ++e) valk[e] = val[e];
        }
      }
    }
    __syncthreads();
    {
      int tA = tid;
      asm volatile("" : "+v"(tA));
      const int i = tA >> 3, oc = tA & 7, d0 = oc * 16;
#pragma unroll
      for (int dir = 0; dir < 2; ++dir) {
        const int pos = dir ? 63 - i : i;
        const float f = fql[dir * 64 + pos];
        float tmp[16];
#pragma unroll
        for (int e = 0; e < 16; ++e) tmp[kperm16(e)] = valq[e] * f;
        bf16_t* qd = (bf16_t*)(rec0 + dir * REC_BYTES + REC_QD) + pos * 128 + d0;
        *(uint4*)(qd) = pack8(tmp);
        *(uint4*)(qd + 8) = pack8(tmp + 8);
      }
      const int d = tA & 127;
#pragma unroll
      for (int k = 0; k < 4; ++k) {
        const int du = (tA >> 7) + 4 * k, dir = du >> 3, U = du & 7;
        const int p0 = 16 * (U >> 1) + 4 * (U & 1);
        const float4 fa = *(const float4*)(fkl + dir * 64 + p0), fb = *(const float4*)(fkl + dir * 64 + p0 + 8);
        const float ff[8] = {fa.x, fa.y, fa.z, fa.w, fb.x, fb.y, fb.z, fb.w};
        float o[8];
#pragma unroll
        for (int e = 0; e < 8; ++e) {
          const int pp = p0 + (e & 3) + 8 * (e >> 2);
          const int tok = dir ? 63 - pp : pp;
          o[e] = bf2f(k_bf[tok * 136 + d]) * ff[e];
        }
        *(uint4*)((bf16_t*)(rec0 + dir * REC_BYTES + REC_KT) + d * 64 + U * 8) = pack8(o);
      }
    }
    {
      int tB = tid;
      asm volatile("" : "+v"(tB));
      const int laneB = tB & 63, widB = tB >> 6, fr = laneB & 15, fq = laneB >> 4;
      const int mat = __builtin_amdgcn_readfirstlane(widB >> 2), rtile = widB & 3;
      const bf16_t* bsrc = mat ? q_bf : k_bf;
      const int i = rtile * 16 + fr;
      bf16x8 bf_[4];
#pragma unroll
      for (int ks = 0; ks < 4; ++ks) bf_[ks] = *(const bf16x8*)(bsrc + i * 136 + ks * 32 + fq * 8);
      const float gi0 = gcl[i], gi1 = gcl[64 + 63 - i];
      float4 gj0[4], gj1[4];
#pragma unroll
      for (int nt = 0; nt < 4; ++nt) {
        gj0[nt] = *(const float4*)(gcl + nt * 16 + fq * 4);
        gj1[nt] = *(const float4*)(gcl + 64 + 60 - (nt * 16 + fq * 4));
      }
      const float be0 = bl[i], be1 = bl[64 + 63 - i];
      f32x4 acc[4];
#pragma unroll
      for (int nt = 0; nt < 4; ++nt) {
        acc[nt] = f32x4{0.f, 0.f, 0.f, 0.f};
#pragma unroll
        for (int ks = 0; ks < 4; ++ks) {
          const bf16x8 afrag = *(const bf16x8*)(k_bf + (nt * 16 + fr) * 136 + ks * 32 + fq * 8);
          acc[nt] = MFMA16(afrag, bf_[ks], acc[nt]);
        }
      }
#pragma unroll
      for (int nt = 0; nt < 4; ++nt) {
        const int jj = nt * 16 + fq * 4;
        const float g0[4] = {gj0[nt].x, gj0[nt].y, gj0[nt].z, gj0[nt].w};
        const float g1[4] = {gj1[nt].x, gj1[nt].y, gj1[nt].z, gj1[nt].w};
        float v0[4], v1[4];
#pragma unroll
        for (int j = 0; j < 4; ++j) {
          const float G0 = acc[nt][j], G1 = acc[nt][3 - j];
          const float d0v = __expf(fminf(gi0 - g0[j], 0.f)), d1v = __expf(fminf(gi1 - g1[j], 0.f));
          if (mat == 0) {
            v0[j] = (i > jj + j) ? be0 * G0 * d0v : 0.f;
            v1[j] = (63 - i > 60 - jj + j) ? be1 * G1 * d1v : 0.f;
          } else {
            v0[j] = (i >= jj + j) ? G0 * d0v : 0.f;
            v1[j] = (63 - i >= 60 - jj + j) ? G1 * d1v : 0.f;
          }
        }
        if (mat == 0) {
          *(float4*)(Lm + i * 68 + jj) = make_float4(v0[0], v0[1], v0[2], v0[3]);
          *(float4*)(Lm + (64 + 63 - i) * 68 + 60 - jj) = make_float4(v1[0], v1[1], v1[2], v1[3]);
        } else {
          uint2 s0, s1;
          s0.x = pack2(v0[0], v0[1]); s0.y = pack2(v0[2], v0[3]);
          s1.x = pack2(v1[0], v1[1]); s1.y = pack2(v1[2], v1[3]);
          *(uint2*)((bf16_t*)(rec0 + REC_IN) + i * 64 + kperm16(jj)) = s0;
          *(uint2*)((bf16_t*)(rec0 + REC_BYTES + REC_IN) + (63 - i) * 64 + kperm16(60 - jj)) = s1;
        }
      }
    }
    __syncthreads();
    {
      int tC = tid;
      asm volatile("" : "+v"(tC));
      const int dir = tC >> 8, c = tC & 255;
      const float* Ld = Lm + dir * 64 * 68;
      const bool isu = __builtin_amdgcn_readfirstlane((int)(c < 128)) != 0;
      unsigned* up = p.gdn_u + ((size_t)(item * 2 + dir) * 32) * 128 + (c & 127);
      bf16_t* wp = (bf16_t*)(rec0 + dir * REC_BYTES + REC_WN) + kperm16(c & 127);
      const bf16_t* src = (isu ? v_bf : k_bf) + (c & 127);
      const float* sclv = (isu ? bl : bgl) + dir * 64;
      float x[64];
      LRow row0;
      SolveStep<0>::run(x, row0, Ld, sclv, src + (dir ? 63 * 136 : 0), dir ? -136 : 136, isu, up, wp);
    }
    __syncthreads();
  }
}

DEV int crow(int reg, int hf) { return (reg & 3) + 8 * (reg >> 2) + 4 * hf; }
DEV bf16x8 pack_acc8(const f32x16& x, int s) {
  uint4 v;
  v.x = pack2(x[8 * s + 0], x[8 * s + 1]);
  v.y = pack2(x[8 * s + 2], x[8 * s + 3]);
  v.z = pack2(x[8 * s + 4], x[8 * s + 5]);
  v.w = pack2(x[8 * s + 6], x[8 * s + 7]);
  return __builtin_bit_cast(bf16x8, v);
}
DEV bf16x8 ld_frag(const char* rowp, int kb) { return *(const bf16x8*)(rowp + kb); }

DEV void phase_gdn_scan(const Params& p, int ep, int chain, char* smem) {
  const int tid = fresh_tid(), lane = tid & 63, wid = tid >> 6;
  const int dir = chain & 1, bh = chain >> 1;
  const int b = bh >> 2, hh = bh & 3;
  if (wid >= 4) {
    const int lt = tid - 256;
    uint4 rA[18], rB[18];
    auto gl = [&](uint4 (&rg)[18], int n) {
      const int item = bh * 128 + (dir ? 127 - n : n);
      const __amdgpu_buffer_rsrc_t rr = __builtin_amdgcn_make_buffer_rsrc(
          (void*)(p.gdn_rec + ((size_t)item * 2 + dir) * REC_BYTES), 0, REC_BYTES, 0x00020000);
      const __amdgpu_buffer_rsrc_t ru = __builtin_amdgcn_make_buffer_rsrc(
          (void*)(p.gdn_u + ((size_t)(item * 2 + dir) * 32) * 128), 0, 16384, 0x00020000);
#pragma unroll
      for (int k = 0; k < 14; ++k) {
        const u32x4 v = __builtin_amdgcn_raw_buffer_load_b128(rr, lt * 16, k * 4096, 0);
        rg[k] = make_uint4(v.x, v.y, v.z, v.w);
      }
#pragma unroll
      for (int k = 0; k < 4; ++k) {
        const u32x4 v = __builtin_amdgcn_raw_buffer_load_b128(ru, lt * 16, k * 4096, 0);
        rg[14 + k] = make_uint4(v.x, v.y, v.z, v.w);
      }
    };
    auto st = [&](const uint4 (&rg)[18], int buf) {
      char* base = smem + buf * SC_BUF;
#pragma unroll
      for (int k = 0; k < 14; ++k) {
        const int u = lt + 256 * k;
        int row, c16, off;
        if (k < 4) { row = u >> 4; c16 = u & 15; off = SC_WN + row * 272; }
        else if (k < 8) { row = (u - 1024) >> 4; c16 = (u - 1024) & 15; off = SC_QD + row * 272; }
        else if (k < 10) { row = (u - 2048) >> 3; c16 = (u - 2048) & 7; off = SC_IN + row * 144; }
        else { row = (u - 2560) >> 3; c16 = (u - 2560) & 7; off = SC_KT + row * 144; }
        *(uint4*)(base + off + c16 * 16) = rg[k];
      }
#pragma unroll
      for (int k = 0; k < 4; ++k) *(uint4*)(base + SC_U + (lt + 256 * k) * 16) = rg[14 + k];
    };
    gl(rA, 0);
    st(rA, 0);
    gl(rB, 1);
    gl(rA, 2);
    __syncthreads();
#pragma unroll 1
    for (int n = 0; n < 128; n += 2) {
      st(rB, 1);
      gl(rB, min(n + 3, 127));
      __syncthreads();
      st(rA, 0);
      gl(rA, min(n + 4, 127));
      __syncthreads();
    }
  } else {
    const int w = wid, r = lane & 31, hf = lane >> 5;
    f32x16 S[4];
#pragma unroll
    for (int t4 = 0; t4 < 4; ++t4)
#pragma unroll
      for (int e = 0; e < 16; ++e) S[t4][e] = 0.f;
    __builtin_amdgcn_s_setprio(3);
    const float dlo = p.egl[(bh * 128 + (dir ? 127 - lane : lane)) * 2 + dir];
    const float dhi = p.egl[(bh * 128 + (dir ? 63 - lane : 64 + lane)) * 2 + dir];
    if (tid == 0) __hip_atomic_store(&p.bar[XB_CXCC(chain)], ((unsigned)ep << 4) | xb_xcc_id(), __ATOMIC_RELAXED, __HIP_MEMORY_SCOPE_AGENT);
    __syncthreads();
#pragma unroll 1
    for (int n = 0; n < 128; ++n) {
      if (tid == 0) __hip_atomic_store(&p.bar[XB_PROG(chain)], (unsigned)ep * 1024u + (unsigned)n, __ATOMIC_RELAXED, __HIP_MEMORY_SCOPE_AGENT);
      const char* buf = smem + (n & 1) * SC_BUF;
      const float decay = __uint_as_float(__builtin_amdgcn_readlane(__float_as_uint(n < 64 ? dlo : dhi), n & 63));
      f32x16 vn[2], o[2];
      {
        const unsigned* ul = (const unsigned*)(buf + SC_U) + 32 * w + r;
#pragma unroll
        for (int tm = 0; tm < 2; ++tm)
#pragma unroll
          for (int e2 = 0; e2 < 8; ++e2) {
            const unsigned uu = ul[((32 * tm + crow(2 * e2, hf)) >> 1) * 128];
            vn[tm][2 * e2] = __uint_as_float(uu << 16);
            vn[tm][2 * e2 + 1] = __uint_as_float(uu & 0xffff0000u);
          }
      }
#pragma unroll
      for (int e = 0; e < 16; ++e) { o[0][e] = 0.f; o[1][e] = 0.f; }
      const char* rw0 = buf + SC_WN + r * 272 + hf * 16;
      const char* rq0 = buf + SC_QD + r * 272 + hf * 16;
      const char* ri0 = buf + SC_IN + r * 144 + hf * 16;
      const char* rk0 = buf + SC_KT + r * 144 + hf * 16;
      bf16x8 fA[8], fB[8], sb[4][2];
#define SCAN_LOAD(dst, base, t4a)                                                                        \
  _Pragma("unroll") for (int dt = 0; dt < 2; ++dt) _Pragma("unroll") for (int s = 0; s < 2; ++s)         \
      _Pragma("unroll") for (int tm = 0; tm < 2; ++tm)                                                   \
          dst[dt * 4 + s * 2 + tm] = ld_frag(base + tm * 32 * 272, (32 * ((t4a) + dt) + 16 * s) * 2);
#define SCAN_MMA(acc, f, t4a)                                                                            \
  _Pragma("unroll") for (int dt = 0; dt < 2; ++dt) _Pragma("unroll") for (int s = 0; s < 2; ++s)         \
      _Pragma("unroll") for (int tm = 0; tm < 2; ++tm)                                                   \
          acc[tm] = MFMA32(f[dt * 4 + s * 2 + tm], sb[(t4a) + dt][s], acc[tm]);
#define SCAN_MMA_T(acc, f, t4a)                                                                          \
  _Pragma("unroll") for (int dt = 0; dt < 2; ++dt) _Pragma("unroll") for (int s = 0; s < 2; ++s)         \
      _Pragma("unroll") for (int tm = 0; tm < 2; ++tm)                                                   \
          acc[tm] = MFMA32(sb[(t4a) + dt][s], f[dt * 4 + s * 2 + tm], acc[tm]);
#define SCAN_MIX(nmfma, nds, nvalu)                                                                      \
  _Pragma("unroll") for (int _g = 0; _g < (nmfma); ++_g) {                                               \
    __builtin_amdgcn_sched_group_barrier(0x008, 1, 0);                                                   \
    if (_g < (nds)) __builtin_amdgcn_sched_group_barrier(0x100, 1, 0);                                   \
    __builtin_amdgcn_sched_group_barrier(0x002, (nvalu), 0);                                             \
  }
      SCAN_LOAD(fA, rw0, 0)
      sb[0][0] = pack_acc8(S[0], 0); sb[0][1] = pack_acc8(S[0], 1);
      sb[1][0] = pack_acc8(S[1], 0); sb[1][1] = pack_acc8(S[1], 1);
      __builtin_amdgcn_sched_barrier(0);
      SCAN_MMA(vn, fA, 0)
      SCAN_LOAD(fB, rw0, 2)
      sb[2][0] = pack_acc8(S[2], 0); sb[2][1] = pack_acc8(S[2], 1);
      sb[3][0] = pack_acc8(S[3], 0); sb[3][1] = pack_acc8(S[3], 1);
      SCAN_MIX(8, 8, 2)
      __builtin_amdgcn_sched_barrier(0);
      SCAN_MMA(vn, fB, 2)
      SCAN_LOAD(fA, rq0, 0)
#pragma unroll
      for (int e = 0; e < 16; ++e) S[0][e] *= decay;
      SCAN_MIX(8, 8, 2)
      __builtin_amdgcn_sched_barrier(0);
      SCAN_MMA_T(o, fA, 0)
      SCAN_LOAD(fB, rq0, 2)
#pragma unroll
      for (int e = 0; e < 16; ++e) { S[1][e] *= decay; S[2][e] *= decay; }
      SCAN_MIX(8, 8, 3)
      __builtin_amdgcn_sched_barrier(0);
      bf16x8 fi[6], fk0[4];
      SCAN_MMA_T(o, fB, 2)
      fi[0] = ld_frag(ri0, 0);
      fi[1] = ld_frag(ri0, 32);
#pragma unroll
      for (int q4 = 0; q4 < 4; ++q4) fi[2 + q4] = ld_frag(ri0 + 32 * 144, q4 * 32);
#pragma unroll
      for (int q4 = 0; q4 < 4; ++q4) fk0[q4] = ld_frag(rk0, q4 * 32);
      bf16x8 vb[2][2];
#pragma unroll
      for (int tk = 0; tk < 2; ++tk) {
        vb[tk][0] = pack_acc8(vn[tk], 0);
        vb[tk][1] = pack_acc8(vn[tk], 1);
      }
#pragma unroll
      for (int e = 0; e < 16; ++e) S[3][e] *= decay;
      SCAN_MIX(8, 8, 4)
      __builtin_amdgcn_sched_barrier(0);
#undef SCAN_LOAD
#undef SCAN_MMA
#undef SCAN_MMA_T
      o[0] = MFMA32(vb[0][0], fi[0], o[0]);
      o[1] = MFMA32(vb[0][0], fi[2], o[1]);
      o[0] = MFMA32(vb[0][1], fi[1], o[0]);
      o[1] = MFMA32(vb[0][1], fi[3], o[1]);
      S[0] = MFMA32(fk0[0], vb[0][0], S[0]);
      o[1] = MFMA32(vb[1][0], fi[4], o[1]);
      S[0] = MFMA32(fk0[1], vb[0][1], S[0]);
      o[1] = MFMA32(vb[1][1], fi[5], o[1]);
      S[0] = MFMA32(fk0[2], vb[1][0], S[0]);
      S[0] = MFMA32(fk0[3], vb[1][1], S[0]);
#pragma unroll
      for (int q4 = 0; q4 < 4; ++q4) {
        fA[q4] = ld_frag(rk0 + 32 * 144, q4 * 32);
        fA[4 + q4] = ld_frag(rk0 + 64 * 144, q4 * 32);
      }
      SCAN_MIX(10, 8, 0)
      __builtin_amdgcn_sched_barrier(0);
#pragma unroll
      for (int q4 = 0; q4 < 4; ++q4) {
        S[1] = MFMA32(fA[q4], vb[q4 >> 1][q4 & 1], S[1]);
        S[2] = MFMA32(fA[4 + q4], vb[q4 >> 1][q4 & 1], S[2]);
      }
#pragma unroll
      for (int q4 = 0; q4 < 4; ++q4) fB[q4] = ld_frag(rk0 + 96 * 144, q4 * 32);
      SCAN_MIX(8, 4, 0)
      __builtin_amdgcn_sched_barrier(0);
#pragma unroll
      for (int q4 = 0; q4 < 4; ++q4) S[3] = MFMA32(fB[q4], vb[q4 >> 1][q4 & 1], S[3]);
#undef SCAN_MIX
      {
#pragma unroll
        for (int tn = 0; tn < 2; ++tn) {
          const int pos = 32 * tn + r;
          const int tok = dir ? (b * T + T - 1 - n * 64 - pos) : (b * T + n * 64 + pos);
          unsigned pk[4][2];
#pragma unroll
          for (int g = 0; g < 4; ++g) {
            pk[g][0] = pack2(o[tn][4 * g + 0], o[tn][4 * g + 1]);
            pk[g][1] = pack2(o[tn][4 * g + 2], o[tn][4 * g + 3]);
          }
          uint4 st0, st1;
          {
            auto s0 = __builtin_amdgcn_permlane32_swap(pk[0][0], pk[2][0], false, false);
            auto s1 = __builtin_amdgcn_permlane32_swap(pk[0][1], pk[2][1], false, false);
            st0.x = s0[0]; st0.y = s1[0]; st0.z = s0[1]; st0.w = s1[1];
            auto s2 = __builtin_amdgcn_permlane32_swap(pk[1][0], pk[3][0], false, false);
            auto s3 = __builtin_amdgcn_permlane32_swap(pk[1][1], pk[3][1], false, false);
            st1.x = s2[0]; st1.y = s3[0]; st1.z = s2[1]; st1.w = s3[1];
          }
          bf16_t* op = p.obuf + ((size_t)dir * NTOK + tok) * 512 + hh * 128 + 32 * w + 16 * hf;
          *(uint4*)(op) = st0;
          *(uint4*)(op + 8) = st1;
        }
      }
      __syncthreads();
    }
    __builtin_amdgcn_s_setprio(0);
  }
}

DEV void phase_scan_helper(const Params& p, int ep, int c, int j, char* smem) {
  const int tid = fresh_tid(), lane = tid & 63, wid = tid >> 6;
  volatile unsigned* lprog = (volatile unsigned*)smem;
  const unsigned epoch = (unsigned)ep;
  const int dir = c & 1, bh = c >> 1;
  constexpr unsigned AHEAD = 8u;
  if (tid == 0) lprog[0] = 0u;
  __syncthreads();
  if (wid == 0) {
    unsigned v = 0u, spins = 0u;
    for (;;) {
      v = xb_ld(&p.bar[XB_CXCC(c)]);
      if ((v >> 4) == epoch || ++spins > 200000u) break;
      __builtin_amdgcn_s_sleep(8);
    }
    const bool mine = ((v >> 4) == epoch) && ((v & 15u) == xb_xcc_id());
    if (!mine) {
      if (lane == 0) lprog[0] = 0xffffffffu;
    } else {
      unsigned idle = 0u;
      for (;;) {
        const unsigned g = xb_ld(&p.bar[XB_PROG(c)]);
        const unsigned cur = (g >= epoch * 1024u) ? (g - epoch * 1024u + 1u) : 0u;
        if (lane == 0) lprog[0] = cur + 1u;
        if (cur >= 128u || ++idle > 400000u) break;
        __builtin_amdgcn_s_sleep(16);
      }
      if (lane == 0) lprog[0] = 0xffffffffu;
    }
  } else {
    u32x4 sink = {0u, 0u, 0u, 0u};
    unsigned spins = 0u;
    for (int n = 0; n < 128;) {
      const unsigned s = lprog[0];
      if (s == 0xffffffffu) break;
      if (s == 0u) {
        if (++spins > 4000000u) break;
        __builtin_amdgcn_s_sleep(4);
        continue;
      }
      const unsigned started = s - 1u;
      if ((unsigned)n < started) n = (int)started;
      if (n >= 128) break;
      if ((unsigned)n >= started + AHEAD) {
        if (++spins > 4000000u) break;
        __builtin_amdgcn_s_sleep(4);
        continue;
      }
      const int item = bh * 128 + (dir ? 127 - n : n);
      const char* rec = p.gdn_rec + ((size_t)item * 2 + dir) * REC_BYTES;
      const char* uu = (const char*)(p.gdn_u + ((size_t)(item * 2 + dir) * 32) * 128);
#pragma unroll
      for (int q = 0; q < 4; ++q) {
        const int pc = wid - 1 + 7 * q;
        if (pc < 24) {
          const int piece = 24 * j + pc;
          const char* ptr = (piece < 56 ? rec + piece * 1024 : uu + (piece - 56) * 1024) + lane * 16;
          asm volatile("global_load_dwordx4 %0, %1, off" : "+v"(sink) : "v"(ptr) : "memory");
        }
      }
      ++n;
    }
    asm volatile("s_waitcnt vmcnt(0)" ::: "memory");
    asm volatile("" :: "v"(sink));
  }
  __syncthreads();
}

DEV void phase_gdn_fin(const Params& p, int l, int bid, int nb) {
  const int tid_ = fresh_tid(), lane = tid_ & 63, wid = tid_ >> 6;
  const float* gnw = p.gdn_norm_w + l * 128 + (lane & 15) * 8;
  for (int t = bid * NWAVE + wid; t < NTOK; t += nb * NWAVE) {
    float of[8], ob[8], z[8], o[8];
    unpack8(*(const uint4*)(p.obuf + (size_t)t * 512 + lane * 8), of);
    unpack8(*(const uint4*)(p.obuf + ((size_t)NTOK + t) * 512 + lane * 8), ob);
    unpack8(*(const uint4*)(p.proj + (size_t)t * PROJW + OFF_GZ + lane * 8), z);
    float ss = 0.f;
#pragma unroll
    for (int e = 0; e < 8; ++e) {
      o[e] = of[e] + ob[e];
      ss += o[e] * o[e];
    }
    ss += shx(ss, 1, lane);
    ss += shx(ss, 2, lane);
    ss += shx(ss, 4, lane);
    ss += shx(ss, 8, lane);
    const float rr = rsqrtf(ss * (1.f / 128.f) + EPS);
    const float4 g0 = *(const float4*)(gnw), g1 = *(const float4*)(gnw + 4);
    const float gw[8] = {g0.x, g0.y, g0.z, g0.w, g1.x, g1.y, g1.z, g1.w};
    float res[8];
#pragma unroll
    for (int e = 0; e < 8; ++e) res[e] = o[e] * rr * gw[e] * silu_f(z[e]);
    *(uint4*)(p.y + (size_t)t * DM + 512 + lane * 8) = pack8(res);
  }
}

struct EpiWout {
  static constexpr bool PERM = false;
  const float* xin; float* xout; const float* mod_l;
  DEV void operator()(const f32x4 (&acc)[2][2][4][2], const GUnit& u, int wr, int wc, int fr, int fq) const {
    const int row0 = u.pm * 256 + wr * 64 + fr, col0 = u.pn * 256 + wc * 32 + 4 * fq;
    const float* gate = mod_l + ((u.pm * 256) / T) * 6144 + MOD_GATE1;
    f32x4 gv[2][2];
#pragma unroll
    for (int bj = 0; bj < 2; ++bj)
#pragma unroll
      for (int n = 0; n < 2; ++n) gv[bj][n] = *(const f32x4*)(gate + col0 + bj * G_HALF + n * 16);
#pragma unroll
    for (int ai = 0; ai < 2; ++ai)
#pragma unroll
      for (int m = 0; m < 4; ++m) {
        const size_t ro = (size_t)(row0 + ai * G_HALF + m * 16) * DM + col0;
#pragma unroll
        for (int bj = 0; bj < 2; ++bj)
#pragma unroll
          for (int n = 0; n < 2; ++n) {
            const f32x4 xi = *(const f32x4*)(xin + ro + bj * G_HALF + n * 16);
            *(f32x4*)(xout + ro + bj * G_HALF + n * 16) = xi + gv[bj][n] * acc[ai][bj][m][n];
          }
      }
  }
};

DEV void phase_gemm_wout(const Params& p, int l, const float* xin, int bid, int nb, char* smem) {
  DenseSched S;
  S.A = p.y; S.Bt = p.btout; S.K = DM; S.nM = NTOK / 256; S.nN = DM / 256; S.nwg = S.nM * S.nN; S.G = nb; S.c = bid; S.wv = p.wv;
  EpiWout E;
  E.xin = xin; E.xout = p.xbuf; E.mod_l = p.mod + l * 2 * 6144;
  gemm_phase((LAS unsigned char*)smem, S, E);
}

DEV void phase_consts(const Params& p, int bid, int nb) {
  const int tid = fresh_tid(), lane = tid & 63, wid = tid >> 6;
  for (int g = bid * NTHR + tid; g < DEPTH * DM * 48; g += nb * NTHR) {
    const int n = g % 48, lk = g / 48;
    float v = 0.f;
    if (n < 4) v = p.rg_w[(size_t)lk * 4 + n];
    else if (n < 36) v = p.re_w[(size_t)lk * 32 + (n - 4)];
    p.wcat[g] = v;
  }
  for (int g = bid * NTHR + tid; g < DEPTH * NB * DM; g += nb * NTHR) {
    const int k = g & (DM - 1), lb = g >> 10, l = lb >> 1;
    p.wsc2[g] = p.norm_ffn_w[l * DM + k] * (1.f + p.mod[lb * 6144 + MOD_SCALE2 + k]);
  }
  for (int o = bid * NWAVE + wid; o < DEPTH * NB * 48; o += nb * NWAVE) {
    const int n = o % 48, lb = o / 48, l = lb >> 1;
    float s = 0.f;
    if (n < 36) {
#pragma unroll
      for (int k16 = 0; k16 < DM / 64; ++k16) {
        const int k = lane + 64 * k16;
        const float w = (n < 4) ? p.rg_w[((size_t)l * DM + k) * 4 + n] : p.re_w[((size_t)l * DM + k) * 32 + (n - 4)];
        s += p.mod[lb * 6144 + MOD_SHIFT2 + k] * w;
      }
      s = wave_sum(s, lane);
      s += (n < 4) ? p.rg_b[l * 4 + n] : p.re_b[l * 32 + (n - 4)];
    }
    if (lane == 0) p.c0[o] = s;
  }
}

DEV void phase_router(const Params& p, int l, int bid, int nb, char* smem) {
  float* accb = (float*)smem;
  float* ssqb = accb + 2 * 64 * 49;
  float* rsl = ssqb + 128;
  int* lcnt = (int*)(rsl + 64);
  int* lbase = lcnt + NEXP;
  const int tid = fresh_tid(), lane = tid & 63, wid = tid >> 6, fr = lane & 15, fq = lane >> 4;
  const int tg = wid & 3, kh = wid >> 2;
  int sel_e0 = 0, sel_e1 = 0, sel_r0 = 0, sel_r1 = 0;
  if (tid < NEXP) lcnt[tid] = 0;
  __syncthreads();
  for (int tb = bid; tb < NTOK / 64; tb += nb) {
    const int tok0 = tb * 64;
    const int b = tok0 / T;
    const float* wsc = p.wsc2 + (l * 2 + b) * DM;
    {
      float* Bs = (float*)(smem + 32768);
      const float* xr = p.xbuf + (size_t)(tok0 + tg * 16 + fr) * DM + kh * 512 + fq * 4;
      const float* wv = wsc + kh * 512 + fq * 4;
      const float* wl = p.wcat + (size_t)l * DM * 48;
      f32x4 acc[3];
#pragma unroll
      for (int nt = 0; nt < 3; ++nt) acc[nt] = f32x4{0.f, 0.f, 0.f, 0.f};
      float ssq = 0.f;
      float4 rbv[3], xa[4], wa[4], xn[4], wn[4];
      auto gloadB = [&](int s) {
#pragma unroll
        for (int i = 0; i < 3; ++i) {
          const int idx = tid + NTHR * i, half = idx / 768, r = idx - half * 768, krow = r / 12, c4 = r - krow * 12;
          rbv[i] = *(const float4*)(wl + (size_t)(half * 512 + 64 * s + krow) * 48 + c4 * 4);
        }
      };
      auto storeB = [&](int buf) {
#pragma unroll
        for (int i = 0; i < 3; ++i) {
          const int idx = tid + NTHR * i, half = idx / 768, r = idx - half * 768, krow = r / 12, c4 = r - krow * 12;
          *(float4*)(Bs + ((buf * 2 + half) * 64 + krow) * 48 + c4 * 4) = rbv[i];
        }
      };
      auto gloadA = [&](float4 (&xd)[4], float4 (&wd)[4], int s) {
#pragma unroll
        for (int c = 0; c < 4; ++c) {
          xd[c] = *(const float4*)(xr + 64 * s + c * 16);
          wd[c] = *(const float4*)(wv + 64 * s + c * 16);
        }
      };
      gloadB(0);
      gloadA(xa, wa, 0);
      storeB(0);
      __syncthreads();
#pragma unroll 1
      for (int s = 0; s < 8; ++s) {
        const int sn = min(s + 1, 7);
        gloadB(sn);
        gloadA(xn, wn, sn);
        const float* bt = Bs + (((s & 1) * 2 + kh) * 64 + fq) * 48 + fr;
#pragma unroll
        for (int c = 0; c < 4; ++c) {
          const float4 xv = xa[c], ww = wa[c];
          ssq += xv.x * xv.x + xv.y * xv.y + xv.z * xv.z + xv.w * xv.w;
          const float a0 = xv.x * ww.x, a1 = xv.y * ww.y, a2 = xv.z * ww.z, a3 = xv.w * ww.w;
          const float* bp = bt + (16 * c + 3 * fq) * 48;
#pragma unroll
          for (int nt = 0; nt < 3; ++nt) {
            acc[nt] = __builtin_amdgcn_mfma_f32_16x16x4f32(a0, bp[0 * 48 + nt * 16], acc[nt], 0, 0, 0);
            acc[nt] = __builtin_amdgcn_mfma_f32_16x16x4f32(a1, bp[1 * 48 + nt * 16], acc[nt], 0, 0, 0);
            acc[nt] = __builtin_amdgcn_mfma_f32_16x16x4f32(a2, bp[2 * 48 + nt * 16], acc[nt], 0, 0, 0);
            acc[nt] = __builtin_amdgcn_mfma_f32_16x16x4f32(a3, bp[3 * 48 + nt * 16], acc[nt], 0, 0, 0);
          }
        }
        storeB((s + 1) & 1);
        __syncthreads();
#pragma unroll
        for (int c = 0; c < 4; ++c) { xa[c] = xn[c]; wa[c] = wn[c]; }
      }
      ssq += shx(ssq, 16, lane);
      ssq += shx(ssq, 32, lane);
#pragma unroll
      for (int nt = 0; nt < 3; ++nt)
#pragma unroll
        for (int j = 0; j < 4; ++j) accb[(kh * 64 + tg * 16 + fq * 4 + j) * 49 + nt * 16 + fr] = acc[nt][j];
      if (fq == 0) ssqb[kh * 64 + tg * 16 + fr] = ssq;
    }
    __syncthreads();
    if (tid < 64) {
      const int t = tok0 + tid;
      const float rstd = rsqrtf((ssqb[tid] + ssqb[64 + tid]) * (1.f / DM) + EPS);
      rsl[tid] = rstd;
      const float* c0 = p.c0 + (l * 2 + b) * 48;
      float acc[36];
#pragma unroll
      for (int o = 0; o < 36; ++o) acc[o] = rstd * (accb[tid * 49 + o] + accb[(64 + tid) * 49 + o]) + c0[o];
      int grp = 0;
      float mx = acc[0];
#pragma unroll
      for (int g = 1; g < 4; ++g)
        if (acc[g] > mx) { mx = acc[g]; grp = g; }
      float den = 0.f;
#pragma unroll
      for (int g = 0; g < 4; ++g) den += __expf(acc[g] - mx);
      const float pg_top = 1.f / den;
      float el[8];
#pragma unroll
      for (int j = 0; j < 8; ++j) {
        const float a0 = acc[4 + j], a1 = acc[12 + j], a2 = acc[20 + j], a3 = acc[28 + j];
        el[j] = (grp == 0) ? a0 : (grp == 1) ? a1 : (grp == 2) ? a2 : a3;
      }
      float b0 = -3.0e38f, b1 = -3.0e38f;
      int i0 = 0, i1 = 0;
#pragma unroll
      for (int j = 0; j < 8; ++j)
        if (el[j] > b0) { b0 = el[j]; i0 = j; }
#pragma unroll
      for (int j = 0; j < 8; ++j)
        if (j != i0 && el[j] > b1) { b1 = el[j]; i1 = j; }
      const float ex = __expf(b1 - b0);
      const float g0 = pg_top / (1.f + ex), g1 = pg_top * ex / (1.f + ex);
      const int e0 = grp * 8 + i0, e1 = grp * 8 + i1;
      sel_e0 = e0; sel_e1 = e1;
      sel_r0 = atomicAdd(&lcnt[e0], 1);
      sel_r1 = atomicAdd(&lcnt[e1], 1);
      p.sgate[2 * t] = g0;
      p.sgate[2 * t + 1] = g1;
    }
    __syncthreads();
    if (tid < NEXP) {
      const int c = lcnt[tid];
      lbase[tid] = (c > 0) ? atomicAdd(&p.cnt[l * NEXP + tid], c) : 0;
      lcnt[tid] = 0;
    }
    __syncthreads();
    if (tid < 64) {
      const int t = tok0 + tid;
      p.list[sel_e0 * CAP + lbase[sel_e0] + sel_r0] = 2 * t;
      p.list[sel_e1 * CAP + lbase[sel_e1] + sel_r1] = 2 * t + 1;
    }
    {
      const float* sh = p.mod + (l * 2 + b) * 6144 + MOD_SHIFT2;
#pragma unroll 2
      for (int q = 0; q < 8; ++q) {
        const int tl = wid * 8 + q;
        const float rstd = rsl[tl];
        const float4* xr = (const float4*)(p.xbuf + (size_t)(tok0 + tl) * DM);
#pragma unroll
        for (int i = 0; i < 4; ++i) {
          const int idx = (lane + 64 * i) * 4;
          const float4 xv = xr[lane + 64 * i];
          const float4 w = *(const float4*)(wsc + idx);
          const float4 h = *(const float4*)(sh + idx);
          uint2 pk;
          pk.x = pack2(xv.x * w.x * rstd + h.x, xv.y * w.y * rstd + h.y);
          pk.y = pack2(xv.z * w.z * rstd + h.z, xv.w * w.w * rstd + h.w);
          *(uint2*)(p.act + (size_t)(tok0 + tl) * DM + idx) = pk;
        }
      }
    }
    __syncthreads();
  }
}

struct EpiMoe {
  static constexpr bool PERM = true;
  bf16_t* H; bf16_t* Y; const int* list; const float* sgate;
  DEV void operator()(const f32x4 (&acc)[2][2][4][2], const GUnit& u, int wr, int wc, int fr_, int fq) const {
    int fr = fr_;
    asm volatile("" : "+v"(fr));
    if (!u.ph) {
      const __amdgpu_buffer_rsrc_t rh = __builtin_amdgcn_make_buffer_rsrc((void*)H, 0, 2 * 32768 * DEXP, 0x00020000);
      const int hcol = u.pn * 128 + wc * 32 + 8 * fq;
#pragma unroll
      for (int ai = 0; ai < 2; ++ai)
#pragma unroll
        for (int m = 0; m < 4; ++m) {
          const int rl = ai * G_HALF + wr * 64 + m * 16 + fr;
          if (rl < u.valid) {
            const int slot = list[u.e * CAP + u.pm * 256 + rl];
            float h[8];
#pragma unroll
            for (int n = 0; n < 2; ++n)
#pragma unroll
              for (int j = 0; j < 4; ++j) h[n * 4 + j] = silu_f(acc[ai][0][m][n][j]) * acc[ai][1][m][n][j];
            const uint4 pk = pack8(h);
            const u32x4 pv = {pk.x, pk.y, pk.z, pk.w};
            __builtin_amdgcn_raw_buffer_store_b128(pv, rh, (slot * DEXP + hcol) * 2, 0, 16  );
          }
        }
    } else {
      const int col0 = u.pn * 256 + wc * 32 + 8 * fq;
#pragma unroll
      for (int ai = 0; ai < 2; ++ai)
#pragma unroll
        for (int m = 0; m < 4; ++m) {
          const int rl = ai * G_HALF + wr * 64 + m * 16 + fr;
          if (rl < u.valid) {
            const int slot = list[u.e * CAP + u.pm * 256 + rl];
            const float g = sgate[slot];
#pragma unroll
            for (int bj = 0; bj < 2; ++bj) {
              float yv[8];
#pragma unroll
              for (int n = 0; n < 2; ++n)
#pragma unroll
                for (int j = 0; j < 4; ++j) yv[n * 4 + j] = g * acc[ai][bj][m][n][j];
              *(uint4*)(Y + (size_t)slot * DM + col0 + bj * G_HALF) = pack8(yv);
            }
          }
        }
    }
  }
};

DEV void phase_moe(const Params& p, int l, int bid, int nb, char* smem) {
  MoeSched S;
  S.act = p.act; S.hbuf = p.hbuf; S.bt1 = p.bt1; S.bt2 = p.bt2; S.cnt = p.cnt + l * NEXP; S.list = p.list;
  S.rdy = p.bar + XB_RDY + l * 192; S.tmo = p.bar + XB_TMO; S.G = nb; S.c = bid; S.wv = p.wv;
  S.q = p.bar + XB_MQ + l * 64;
  S.tb = (LAS int*)(smem + 131072);
  {
    const int tq = fresh_tid();
    if (tq < 64) {
      const int cn = (tq < NEXP) ? S.cnt[tq] : 0;
      int ps = (cn + 255) >> 8;
#pragma unroll
      for (int o = 1; o < 64; o <<= 1) {
        const int v = __builtin_amdgcn_ds_bpermute((tq - o) << 2, ps);
        if (tq >= o) ps += v;
      }
      if (tq < NEXP) { S.tb[1 + tq] = ps; S.tb[48 + tq] = cn; }
      if (tq == 0) {
        S.tb[0] = 0;
        const unsigned t0 = atomicAdd(S.q, 2u);
        S.tb[40] = (int)t0;
        S.tb[41] = (int)t0 + 1;
        S.tb[44] = 1;
      }
    }
    __syncthreads();
  }
  EpiMoe E;
  E.H = p.hbuf; E.Y = p.ybuf; E.list = p.list; E.sgate = p.sgate;
#pragma unroll 1
  for (int stage = 0; stage < 2; ++stage) {
    S.stage = stage;
    if (stage) {
      __syncthreads();
      if (fresh_tid() == 0) {
        const int m = S.tb[44];
        const int ta = S.tb[40 + ((m - 1) & 1)], tb_ = S.tb[40 + (m & 1)];
        S.tb[40] = ta; S.tb[41] = tb_; S.tb[44] = 1;
      }
      __syncthreads();
    }
    gemm_phase((LAS unsigned char*)smem, S, E);
  }
}

DEV void phase_combine(const Params& p, int l, int bid, int nb) {
  const int tid_ = fresh_tid(), lane = tid_ & 63, wid = tid_ >> 6;
  for (int t = bid * NWAVE + wid; t < NTOK; t += nb * NWAVE) {
    float4* xr = (float4*)(p.xbuf + (size_t)t * DM);
    const int b = t / T;
    const float* md = p.mod + (l * 2 + b) * 6144;
    float4 v[4];
    float ss = 0.f;
#pragma unroll
    for (int i = 0; i < 4; ++i) {
      const int idx = (lane + 64 * i) * 4;
      v[i] = xr[lane + 64 * i];
      const float4 g = *(const float4*)(md + MOD_GATE2 + idx);
      const uint2 ya = *(const uint2*)(p.ybuf + (size_t)(2 * t) * DM + idx);
      const uint2 yb = *(const uint2*)(p.ybuf + (size_t)(2 * t + 1) * DM + idx);
      v[i].x += g.x * (__uint_as_float(ya.x << 16) + __uint_as_float(yb.x << 16));
      v[i].y += g.y * (__uint_as_float(ya.x & 0xffff0000u) + __uint_as_float(yb.x & 0xffff0000u));
      v[i].z += g.z * (__uint_as_float(ya.y << 16) + __uint_as_float(yb.y << 16));
      v[i].w += g.w * (__uint_as_float(ya.y & 0xffff0000u) + __uint_as_float(yb.y & 0xffff0000u));
      ss += v[i].x * v[i].x + v[i].y * v[i].y + v[i].z * v[i].z + v[i].w * v[i].w;
    }
    ss = wave_sum(ss, lane);
    const float rstd = rsqrtf(ss * (1.f / DM) + EPS);
    if (l + 1 < DEPTH) {
#pragma unroll
      for (int i = 0; i < 4; ++i) xr[lane + 64 * i] = v[i];
      const float* md2 = p.mod + ((l + 1) * 2 + b) * 6144;
      norm_mod_store(v, rstd, p.norm_mix_w + (l + 1) * DM, md2 + MOD_SCALE1, md2 + MOD_SHIFT1,
                     p.act + (size_t)t * DM, lane);
    } else {
      float4* orow = (float4*)(p.out + (size_t)t * DM);
#pragma unroll
      for (int i = 0; i < 4; ++i) {
        const float4 w = *(const float4*)(p.final_w + (lane + 64 * i) * 4);
        float4 r;
        r.x = v[i].x * rstd * w.x;
        r.y = v[i].y * rstd * w.y;
        r.z = v[i].z * rstd * w.z;
        r.w = v[i].w * rstd * w.w;
        orow[lane + 64 * i] = r;
      }
    }
  }
}

constexpr size_t ws_align(size_t b) { return (b + 255) & ~(size_t)255; }
constexpr size_t WS_bar = 0;
constexpr size_t WS_mod = WS_bar + ws_align(sizeof(unsigned) * BAR_WORDS_TOTAL);
constexpr size_t WS_btin = WS_mod + ws_align(sizeof(float) * DEPTH * NB * 6144);
constexpr size_t WS_btg = WS_btin + ws_align(2 * (size_t)PROJW * DM);
constexpr size_t WS_btout = WS_btg + ws_align(2 * (size_t)16 * DM);
constexpr size_t WS_bt1 = WS_btout + ws_align(2 * (size_t)DM * DM);
constexpr size_t WS_bt2 = WS_bt1 + ws_align(2 * (size_t)NEXP * 1024 * DM);
constexpr size_t WS_wcat = WS_bt2 + ws_align(2 * (size_t)NEXP * DM * DEXP);
constexpr size_t WS_wsc2 = WS_wcat + ws_align(sizeof(float) * DEPTH * DM * 48);
constexpr size_t WS_c0 = WS_wsc2 + ws_align(sizeof(float) * DEPTH * NB * DM);
constexpr size_t WS_cnt = WS_c0 + ws_align(sizeof(float) * DEPTH * NB * 48);
constexpr size_t WS_xbuf = WS_cnt + ws_align(sizeof(int) * DEPTH * NEXP);
constexpr size_t WS_act = WS_xbuf + ws_align(sizeof(float) * (size_t)NTOK * DM);
constexpr size_t WS_proj = WS_act + ws_align(2 * (size_t)NTOK * DM);
constexpr size_t WS_gates = WS_proj + ws_align(2 * (size_t)NTOK * PROJW);
constexpr size_t WS_y = WS_gates + ws_align(sizeof(float) * (size_t)NTOK * 16);
constexpr size_t WS_list = WS_y + ws_align(2 * (size_t)NTOK * DM);
constexpr size_t WS_sgate = WS_list + ws_align(sizeof(int) * NEXP * CAP);
constexpr size_t WS_egl = WS_sgate + ws_align(sizeof(float) * 2 * NTOK);
constexpr size_t WS_obuf = WS_egl + ws_align(sizeof(float) * 2048);
constexpr size_t WS_gdn_rec = WS_obuf + ws_align(2 * 2 * (size_t)NTOK * 512);
constexpr size_t WS_gdn_u = WS_gdn_rec + ws_align((size_t)2048 * REC_BYTES);
constexpr size_t WS_TOTAL = WS_gdn_u + ws_align(sizeof(unsigned) * (size_t)2048 * 32 * 128);

struct KArgs {
  const float *x, *c, *norm_mix_w, *norm_ffn_w, *w_ada, *b_ada, *w_in, *conv_a_w, *na_rpb, *gdn_conv_w,
      *gdn_a_log, *gdn_dt_bias, *gdn_norm_w, *w_out, *rg_w, *rg_b, *re_w, *re_b, *ew1, *ew3, *ew2, *final_w;
  float* out;
  char* ws;
  int rep[12];
};
DEV Params make_params(const KArgs& a) {
  Params p;
  p.x = a.x; p.c = a.c; p.norm_mix_w = a.norm_mix_w; p.norm_ffn_w = a.norm_ffn_w; p.w_ada = a.w_ada; p.b_ada = a.b_ada;
  p.w_in = a.w_in; p.conv_a_w = a.conv_a_w; p.na_rpb = a.na_rpb; p.gdn_conv_w = a.gdn_conv_w; p.gdn_a_log = a.gdn_a_log;
  p.gdn_dt_bias = a.gdn_dt_bias; p.gdn_norm_w = a.gdn_norm_w; p.w_out = a.w_out; p.rg_w = a.rg_w; p.rg_b = a.rg_b;
  p.re_w = a.re_w; p.re_b = a.re_b; p.ew1 = a.ew1; p.ew3 = a.ew3; p.ew2 = a.ew2; p.final_w = a.final_w;
  p.out = a.out;
  p.bar = (unsigned*)(a.ws + WS_bar);
  p.mod = (float*)(a.ws + WS_mod);
  p.btin = (bf16_t*)(a.ws + WS_btin);
  p.btg = (bf16_t*)(a.ws + WS_btg);
  p.btout = (bf16_t*)(a.ws + WS_btout);
  p.bt1 = (bf16_t*)(a.ws + WS_bt1);
  p.bt2 = (bf16_t*)(a.ws + WS_bt2);
  p.wcat = (float*)(a.ws + WS_wcat);
  p.wsc2 = (float*)(a.ws + WS_wsc2);
  p.c0 = (float*)(a.ws + WS_c0);
  p.cnt = (int*)(a.ws + WS_cnt);
  p.xbuf = (float*)(a.ws + WS_xbuf);
  p.act = (bf16_t*)(a.ws + WS_act);
  p.proj = (bf16_t*)(a.ws + WS_proj);
  p.gates = (float*)(a.ws + WS_gates);
  p.y = (bf16_t*)(a.ws + WS_y);
  p.list = (int*)(a.ws + WS_list);
  p.sgate = (float*)(a.ws + WS_sgate);
  p.egl = (float*)(a.ws + WS_egl);
  p.obuf = (bf16_t*)(a.ws + WS_obuf);
  p.gdn_rec = (char*)(a.ws + WS_gdn_rec);
  p.gdn_u = (unsigned*)(a.ws + WS_gdn_u);
  p.hbuf = (bf16_t*)p.obuf;
  p.ybuf = (bf16_t*)p.gdn_rec;
#pragma unroll
  for (int i = 0; i < 12; ++i) p.rep[i] = a.rep[i];
  p.wv = __builtin_amdgcn_readfirstlane((int)(threadIdx.x >> 6));
  return p;
}

__global__ void __launch_bounds__(NTHR) mega_kernel(KArgs ka) {
  const Params p = make_params(ka);
  __shared__ __attribute__((aligned(16))) char smem[SMEM_BYTES + 16];
  const int bid0 = blockIdx.x, nb = gridDim.x;
  if (fresh_tid() == 0) *(uint4*)(smem + SMEM_BYTES) = make_uint4(0u, 0u, 0u, 0u);
  __syncthreads();
  xcd_barrier_post(p.bar, fresh_tid());
#pragma unroll 1
  for (int rp = 0; rp < p.rep[7]; ++rp) {
    phase_ada(p, bid0, nb, smem);
    convert_win(p, 0, bid0, nb, smem);
  }
  xcd_barrier(p.bar, (volatile LAS unsigned*)(smem + SMEM_BYTES), fresh_tid());
#pragma unroll 1
  for (int rp = 0; rp < p.rep[8]; ++rp) {
    phase_hmix(p, 0, p.x, bid0, nb);
    phase_consts(p, bid0, nb);
  }
  xcd_barrier(p.bar, (volatile LAS unsigned*)(smem + SMEM_BYTES), fresh_tid());
#pragma unroll 1
  for (int l = 0; l < DEPTH; ++l) {
    int lz = l;
    asm volatile("" : "+s"(lz));
    const int bid = bid0 + (lz - l);
#pragma unroll 1
    for (int rp = 0; rp < p.rep[0]; ++rp) phase_gemm_proj(p, l, bid, nb, smem);
    xcd_barrier(p.bar, (volatile LAS unsigned*)(smem + SMEM_BYTES), fresh_tid());
#pragma unroll 1
    for (int rp = 0; rp < p.rep[1]; ++rp) phase_gdn_prep(p, l, bid, nb, smem);
    xcd_barrier(p.bar, (volatile LAS unsigned*)(smem + SMEM_BYTES), fresh_tid());
#pragma unroll 1
    for (int rp = 0; rp < p.rep[2]; ++rp) {
      if (bid < 16) {
        phase_gdn_scan(p, l * 4 + rp + 1, bid, smem);
      } else if (bid < 64) {
        phase_scan_helper(p, l * 4 + rp + 1, (bid - 16) & 15, (bid - 16) >> 4, smem);
      } else {
#pragma unroll 1
        for (int rq = 0; rq < p.rep[6]; ++rq) {
          phase_conv(p, l, bid - 64, nb - 64);
          phase_na(p, l, (bid - 64) * NWAVE + (fresh_tid() >> 6), (nb - 64) * NWAVE);
        }
#pragma unroll 1
        for (int rq = 0; rq < p.rep[10]; ++rq) convert_layer(p, l, bid - 64, nb - 64, smem);
      }
    }
    xcd_barrier(p.bar, (volatile LAS unsigned*)(smem + SMEM_BYTES), fresh_tid());
#pragma unroll 1
    for (int rp = 0; rp < p.rep[5]; ++rp) phase_gdn_fin(p, l, bid, nb);
    xcd_barrier(p.bar, (volatile LAS unsigned*)(smem + SMEM_BYTES), fresh_tid());
#pragma unroll 1
    for (int rp = 0; rp < (l == 0 ? p.rep[9] : 1); ++rp) phase_gemm_wout(p, l, l == 0 ? p.x : p.xbuf, bid, nb, smem);
    xcd_barrier(p.bar, (volatile LAS unsigned*)(smem + SMEM_BYTES), fresh_tid());
    phase_router(p, l, bid, nb, smem);
    xcd_barrier(p.bar, (volatile LAS unsigned*)(smem + SMEM_BYTES), fresh_tid());
    phase_moe(p, l, bid, nb, smem);
    xcd_barrier(p.bar, (volatile LAS unsigned*)(smem + SMEM_BYTES), fresh_tid());
    phase_combine(p, l, bid, nb);
#pragma unroll 1
    for (int rp = 1; rp < p.rep[11]; ++rp) xcd_barrier(p.bar, (volatile LAS unsigned*)(smem + SMEM_BYTES), fresh_tid());
    if (l + 1 < DEPTH) xcd_barrier(p.bar, (volatile LAS unsigned*)(smem + SMEM_BYTES), fresh_tid());
  }
}

extern "C" void kernel_launch(void* const* d_in, const int* in_sizes, int n_in, void* d_out, int out_size,
                              void* d_ws, size_t ws_size, hipStream_t stream) {
  KArgs p{};
  p.x = (const float*)d_in[0];
  p.c = (const float*)d_in[1];
  p.norm_mix_w = (const float*)d_in[2];
  p.norm_ffn_w = (const float*)d_in[3];
  p.w_ada = (const float*)d_in[4];
  p.b_ada = (const float*)d_in[5];
  p.w_in = (const float*)d_in[6];
  p.conv_a_w = (const float*)d_in[7];
  p.na_rpb = (const float*)d_in[8];
  p.gdn_conv_w = (const float*)d_in[9];
  p.gdn_a_log = (const float*)d_in[10];
  p.gdn_dt_bias = (const float*)d_in[11];
  p.gdn_norm_w = (const float*)d_in[12];
  p.w_out = (const float*)d_in[13];
  p.rg_w = (const float*)d_in[14];
  p.rg_b = (const float*)d_in[15];
  p.re_w = (const float*)d_in[16];
  p.re_b = (const float*)d_in[17];
  p.ew1 = (const float*)d_in[18];
  p.ew3 = (const float*)d_in[19];
  p.ew2 = (const float*)d_in[20];
  p.final_w = (const float*)d_in[21];
  p.out = (float*)d_out;
  p.ws = (char*)d_ws;
  if (WS_TOTAL > ws_size) fprintf(stderr, "workspace too small: need %zu have %zu\n", (size_t)WS_TOTAL, ws_size);

  static int grid_blocks = 0;
  if (!grid_blocks) {
    int dev = 0, cus = 0, per_cu = 0;
    (void)hipGetDevice(&dev);
    (void)hipDeviceGetAttribute(&cus, hipDeviceAttributeMultiprocessorCount, dev);
    (void)hipOccupancyMaxActiveBlocksPerMultiprocessor(&per_cu, mega_kernel, NTHR, 0);
    if (per_cu > 1) per_cu = 1;
    if (per_cu < 1) per_cu = 1;
    grid_blocks = cus * per_cu;
  }
  (void)hipMemsetAsync((char*)d_ws + WS_bar, 0, sizeof(unsigned) * BAR_WORDS_TOTAL, stream);
  for (int i = 0; i < 12; ++i) p.rep[i] = 1;
  void* args[] = {&p};
  hipError_t e = hipLaunchCooperativeKernel((void*)mega_kernel, dim3(grid_blocks), dim3(NTHR), args, 0, stream);
  if (e != hipSuccess) fprintf(stderr, "cooperative launch failed: %s (grid %d)\n", hipGetErrorString(e), grid_blocks);
}
```

```cpp
#include <hip/hip_runtime.h>
#include <hip/hip_cooperative_groups.h>
#include <stdint.h>
#include <stdio.h>

#define DEV __device__ __forceinline__
namespace cg = cooperative_groups;

typedef __attribute__((ext_vector_type(8))) short bf16x8;
typedef __attribute__((ext_vector_type(4))) float f32x4;
typedef __attribute__((ext_vector_type(16))) float f32x16;
typedef float f32x2_t __attribute__((ext_vector_type(2)));
typedef __bf16 bf16x2_t __attribute__((ext_vector_type(2)));
typedef unsigned short bf16_t;
typedef unsigned u32x4 __attribute__((ext_vector_type(4)));

constexpr int NTHR = 512;
constexpr int NWAVE = 8;
constexpr int DM = 1024;
constexpr int NB = 2;
constexpr int T = 8192;
constexpr int NTOK = NB * T;
constexpr int DEPTH = 2;
constexpr int DIN = 3600;
constexpr int PROJW = 3584;
constexpr int NEXP = 32;
constexpr int DEXP = 512;
constexpr int CAP = 16384;
constexpr float EPS = 1e-6f;
constexpr int OFF_CB = 0, OFF_CC = 256, OFF_CX = 512, OFF_NQ = 768, OFF_NK = 1024, OFF_NV = 1280,
              OFF_GQKV = 1536, OFF_GZ = 3072;
constexpr int MOD_SHIFT1 = 0, MOD_SCALE1 = 1024, MOD_GATE1 = 2048, MOD_SHIFT2 = 3072, MOD_SCALE2 = 4096,
              MOD_GATE2 = 5120;

constexpr int REC_WN = 0, REC_QD = 16384, REC_IN = 32768, REC_KT = 40960, REC_BYTES = 57344;
constexpr int SC_WN = 0, SC_QD = 17408, SC_IN = 34816, SC_KT = 44032, SC_U = 62464, SC_BUF = 78848;
constexpr int PL_Q = 0, PL_K = 17408, PL_V = 34816, PL_L = 52224, PL_GC = 87040, PL_BETA = 87552, PL_BG = 88064,
              PL_GL = 88576, PL_FQ = 88592  , PL_FK = 89104  ,
              PL_CW = 89616  ;
constexpr int SMEM_BYTES = 2 * SC_BUF;

struct Params {
  const float *x, *c, *norm_mix_w, *norm_ffn_w, *w_ada, *b_ada, *w_in, *conv_a_w, *na_rpb, *gdn_conv_w,
      *gdn_a_log, *gdn_dt_bias, *gdn_norm_w, *w_out, *rg_w, *rg_b, *re_w, *re_b, *ew1, *ew3, *ew2, *final_w;
  float* out;
  float* mod;
  int* cnt;
  float* xbuf;
  bf16_t* act;
  bf16_t* proj;
  float* gates;
  bf16_t* y;
  bf16_t* obuf;
  char* gdn_rec;
  unsigned* gdn_u;
  float* egl;
  bf16_t* hbuf;
  bf16_t* ybuf;
  int* list;
  float* sgate;
  bf16_t* btin;
  bf16_t* btg;
  bf16_t* btout;
  bf16_t* bt1;
  bf16_t* bt2;
  float* wcat;
  float* wsc2;
  float* c0;
  unsigned* bar;
  int rep[12];
  int wv;
};

DEV unsigned pack2(float a, float b) {
  f32x2_t v = {a, b};
  return __builtin_bit_cast(unsigned, __builtin_convertvector(v, bf16x2_t));
}
DEV bf16_t f2bf(float f) { return (bf16_t)(pack2(f, 0.f) & 0xffffu); }
DEV float bf2f(bf16_t h) { return __uint_as_float(((unsigned)h) << 16); }
DEV float silu_f(float x) { return x * __builtin_amdgcn_rcpf(1.f + __expf(-x)); }
DEV float sigmoid_f(float x) { return __builtin_amdgcn_rcpf(1.f + __expf(-x)); }
DEV float softplus_f(float x) { return fmaxf(x, 0.f) + log1pf(__expf(-fabsf(x))); }
DEV float shx(float v, int k, int lane) {
  return __int_as_float(__builtin_amdgcn_ds_bpermute((lane ^ k) << 2, __float_as_int(v)));
}
DEV float wave_sum(float v, int lane) {
#pragma unroll
  for (int o = 32; o > 0; o >>= 1) v += shx(v, o, lane);
  return v;
}
DEV int fresh_tid_w(int wv) {
  unsigned z = 0u;
  asm volatile("" : "+s"(wv), "+v"(z));
  int t = (wv << 6) | (int)__builtin_amdgcn_mbcnt_hi(~0u, __builtin_amdgcn_mbcnt_lo(~0u, z));
  asm volatile("" : "+v"(t));
  return t;
}
#define fresh_tid() fresh_tid_w(p.wv)
DEV void unpack8(uint4 u, float* f) {
  f[0] = __uint_as_float(u.x << 16);
  f[1] = __uint_as_float(u.x & 0xffff0000u);
  f[2] = __uint_as_float(u.y << 16);
  f[3] = __uint_as_float(u.y & 0xffff0000u);
  f[4] = __uint_as_float(u.z << 16);
  f[5] = __uint_as_float(u.z & 0xffff0000u);
  f[6] = __uint_as_float(u.w << 16);
  f[7] = __uint_as_float(u.w & 0xffff0000u);
}
DEV uint4 pack8(const float* f) {
  uint4 r;
  r.x = pack2(f[0], f[1]);
  r.y = pack2(f[2], f[3]);
  r.z = pack2(f[4], f[5]);
  r.w = pack2(f[6], f[7]);
  return r;
}
#define MFMA16(a, b, c) __builtin_amdgcn_mfma_f32_16x16x32_bf16((a), (b), (c), 0, 0, 0)
#define MFMA32(a, b, c) __builtin_amdgcn_mfma_f32_32x32x16_bf16((a), (b), (c), 0, 0, 0)

#define LAS __attribute__((address_space(3)))
#define XB_TMO      128
#define XB_XCNT(j)  (256  + 64 * (j))
#define XB_XSUB(j)  (1280 + 64 * (j))
#define XB_XGEN(j)  (2304 + 64 * (j))
#define XB_TOP      3328
#define XB_TOPGEN   3392
#define XCD_BAR_WORDS 3456
#define XB_PROG(c)   (3456 + 64 * (c))
#define XB_CXCC(c)   (3456 + 1024 + 64 * (c))
#define XB_RDY       (3456 + 2048)
#define XB_MQ        (3456 + 2048 + 384)
#define BAR_WORDS_TOTAL (3456 + 2048 + 384 + 128)
#define XB_SPIN_CAP (1u << 22)

DEV unsigned xb_ld(unsigned* p) { return __hip_atomic_load(p, __ATOMIC_RELAXED, __HIP_MEMORY_SCOPE_AGENT); }
DEV unsigned xb_add(unsigned* p, unsigned v) { return __hip_atomic_fetch_add(p, v, __ATOMIC_RELAXED, __HIP_MEMORY_SCOPE_AGENT); }
DEV unsigned xb_xcc_id() { return (unsigned)__builtin_amdgcn_s_getreg((3 << 11) | 20) & 0xFu; }
#define XB_SPIN(cond, bar) do { unsigned _sp = 0; while (cond) { __builtin_amdgcn_s_sleep(1); \
    if ((++_sp & 255u) == 0u) { if (xb_ld(&(bar)[XB_TMO])) break; if (_sp > XB_SPIN_CAP) { atomicAdd(&(bar)[XB_TMO], 1u); break; } } } } while (0)

DEV void xcd_barrier_post(unsigned* bar, int tid) {
  if (tid == 0) (void)xb_add(&bar[XB_XCNT(xb_xcc_id())], 1u);
}
DEV void xcd_barrier_complete(unsigned* bar, unsigned x, unsigned& nloc, unsigned& nx) {
  const unsigned G = gridDim.x * gridDim.y * gridDim.z;
  unsigned sum, cnt, mine, sp = 0u;
  for (;;) {
    sum = 0u; cnt = 0u; mine = 0u;
#pragma unroll
    for (unsigned j = 0; j < 16; ++j) {
      const unsigned c = xb_ld(&bar[XB_XCNT(j)]);
      sum += c;
      cnt += (c > 0u) ? 1u : 0u;
      mine = (j == x) ? c : mine;
    }
    if (sum == G) break;
    __builtin_amdgcn_s_sleep(1);
    if ((++sp & 255u) == 0u) {
      if (xb_ld(&bar[XB_TMO])) break;
      if (sp > XB_SPIN_CAP) { atomicAdd(&bar[XB_TMO], 1u); break; }
    }
  }
  nloc = mine > 0u ? mine : 1u;
  nx = cnt > 0u ? cnt : 1u;
}
DEV void xcd_barrier(unsigned* bar, volatile LAS unsigned* st, int tid) {
  asm volatile("s_waitcnt vmcnt(0)" ::: "memory");
  __syncthreads();
  if (tid == 0) {
    const unsigned bx = xb_xcc_id();
    __builtin_amdgcn_s_waitcnt(0);
    unsigned nloc = st[0], nx = st[1];
    const unsigned gen = st[2];
    st[2] = gen + 1u;
    if (nloc == 0u) {
      xcd_barrier_complete(bar, bx, nloc, nx);
      st[0] = nloc;
      st[1] = nx;
    }
    const unsigned old = xb_add(&bar[XB_XSUB(bx)], 1u);
    if (old + 1u == (gen + 1u) * nloc) {
      __builtin_amdgcn_fence(__ATOMIC_RELEASE, "agent");
      asm volatile("s_waitcnt vmcnt(0)" ::: "memory");
      const unsigned og = xb_add(&bar[XB_TOP], 1u);
      if (og + 1u == (gen + 1u) * nx) xb_add(&bar[XB_TOPGEN], 1u);
      else XB_SPIN(xb_ld(&bar[XB_TOPGEN]) == gen, bar);
      __builtin_amdgcn_fence(__ATOMIC_ACQUIRE, "agent");
      xb_add(&bar[XB_XGEN(bx)], 1u);
      asm volatile("s_waitcnt vmcnt(0)" ::: "memory");
    } else {
      XB_SPIN(xb_ld(&bar[XB_XGEN(bx)]) == gen, bar);
      __builtin_amdgcn_fence(__ATOMIC_ACQUIRE, "agent");
      asm volatile("s_waitcnt vmcnt(0)" ::: "memory");
    }
  }
  __syncthreads();
}

constexpr int G_BK = 64, G_HALF = 128, G_HTB = G_HALF * G_BK * 2, G_STAGE_BYTES = 8 * G_HTB;
DEV int g_lds_byte(int r, int c) {
  const int st = (r >> 4) * 2 + (c >> 5), rr = r & 15, cc = c & 31, ob = rr * 64 + cc * 2;
  return st * 1024 + (ob ^ (((ob >> 9) & 1) << 5));
}
DEV void g_stage_rc(int b, int& R, int& C) {
  const int st = b / 1024, sb = b % 1024, swz = sb ^ (((sb >> 9) & 1) << 5);
  R = (st >> 1) * 16 + swz / 64;
  C = (st & 1) * 32 + (swz % 64) / 2;
}
DEV int g_perm32(int rho) { const int n = rho >> 4, i = rho & 15; return 8 * (i >> 2) + 4 * n + (i & 3); }

struct GUnit { int pm, pn, e, valid, ph, ridx; };

template <class Epi, class Sched>
DEV void gemm_phase(LAS unsigned char* lds, const Sched& S, const Epi& E) {
  const int tid = fresh_tid_w(S.wv), wid = S.wv, lane = tid & 63, wr = wid >> 2, wc = wid & 3, fr = lane & 15,
            fq = lane >> 4;
  GUnit cur, nxt;
  int ui = 0;
  if (!S.next(0, cur)) return;
  int K = S.kof(cur), nt = K / G_BK;
  unsigned voffB[2];
  auto b_offsets = [&](int Ku) {
    const int tl_ = fresh_tid_w(S.wv);
#pragma unroll
    for (int i = 0; i < 2; ++i) {
      int R, C;
      g_stage_rc(tl_ * 16 + i * 8192, R, C);
      const int Rb = Epi::PERM ? ((R & ~31) + g_perm32(R & 31)) : R;
      voffB[i] = (unsigned)(Rb * Ku + C) * 2u;
    }
  };
  b_offsets(K);
  unsigned vA[2][2];
  auto a_offsets = [&](const GUnit& u) {
    const int tl_ = fresh_tid_w(S.wv);
#pragma unroll
    for (int h = 0; h < 2; ++h)
#pragma unroll
      for (int i = 0; i < 2; ++i) {
        int R, C;
        g_stage_rc(tl_ * 16 + i * 8192, R, C);
        vA[h][i] = S.rowoff(u, h * G_HALF + R) + (unsigned)C * 2u;
      }
  };
  const size_t kstep = (size_t)(G_BK * 2);
  size_t hstep = (size_t)G_HALF * K * 2;
  const unsigned ldsw = (unsigned)wid * 1024u;
  const int aoff = g_lds_byte(wr * 64 + fr, fq * 8), boff = g_lds_byte(wc * 32 + fr, fq * 8);
#define PG8_SA(b, h) (((b) * 2 + (h)) * G_HTB)
#define PG8_SB(b, h) ((4 + (b) * 2 + (h)) * G_HTB)
#define PG8_STAGE(bufoff, gbase, voff) do { _Pragma("unroll") for (int _i = 0; _i < 2; ++_i) \
    __builtin_amdgcn_global_load_lds((const unsigned*)((const char*)(gbase) + (voff)[_i]), (LAS unsigned*)(lds + (bufoff) + ldsw + _i * 8192), 16, 0, 0); } while (0)
#define PG8_LDA(dst, b, h) do { _Pragma("unroll") for (int m = 0; m < 4; ++m) _Pragma("unroll") for (int k = 0; k < 2; ++k) dst[m][k] = *(const LAS bf16x8*)(lds + PG8_SA(b, h) + aoff + m * 2048 + k * 1024); } while (0)
#define PG8_LDB(dst, b, h) do { _Pragma("unroll") for (int n = 0; n < 2; ++n) _Pragma("unroll") for (int k = 0; k < 2; ++k) dst[n][k] = *(const LAS bf16x8*)(lds + PG8_SB(b, h) + boff + n * 2048 + k * 1024); } while (0)
#define PG8_MMA(ai, bj, At, Bt) do { __builtin_amdgcn_s_setprio(1); _Pragma("unroll") for (int m = 0; m < 4; ++m) _Pragma("unroll") for (int n = 0; n < 2; ++n) _Pragma("unroll") for (int k = 0; k < 2; ++k) \
    acc[ai][bj][m][n] = __builtin_amdgcn_mfma_f32_16x16x32_bf16(Bt[n][k], At[m][k], acc[ai][bj][m][n], 0, 0, 0); __builtin_amdgcn_s_setprio(0); } while (0)
#define PG8_WAIT_V(n) asm volatile("s_waitcnt vmcnt(" #n ")" ::: "memory")
#define PG8_WAIT_L(n) asm volatile("s_waitcnt lgkmcnt(" #n ")" ::: "memory")
#define PG8_BAR __builtin_amdgcn_s_barrier()
#define PG8_SCHED __builtin_amdgcn_sched_barrier(0)
  f32x4 acc[2][2][4][2];
#pragma unroll
  for (int a = 0; a < 2; ++a)
#pragma unroll
    for (int b = 0; b < 2; ++b)
#pragma unroll
      for (int m = 0; m < 4; ++m)
#pragma unroll
        for (int n = 0; n < 2; ++n) acc[a][b][m][n] = (f32x4){0.f, 0.f, 0.f, 0.f};
  bf16x8 At[4][2], B0[2][2], B1[2][2];
  const char* gA = S.aptr(cur);
  const char* cB = S.bptr(cur);
  S.a_ready(cur);
  a_offsets(cur);
  PG8_STAGE(PG8_SB(0, 0), cB, voffB); PG8_STAGE(PG8_SA(0, 0), gA, vA[0]); PG8_STAGE(PG8_SB(0, 1), cB + hstep, voffB); PG8_STAGE(PG8_SA(0, 1), gA, vA[1]);
  if (wr == 1) PG8_BAR;
  PG8_WAIT_V(4); PG8_BAR;
  PG8_STAGE(PG8_SB(1, 0), cB + kstep, voffB); PG8_STAGE(PG8_SA(1, 0), gA + kstep, vA[0]); PG8_STAGE(PG8_SB(1, 1), cB + hstep + kstep, voffB);
  PG8_WAIT_V(6); PG8_BAR;
  for (;;) {
    bool has_next = false;
    const char* nB = cB;
    if (!Sched::LATE) {
      has_next = S.next(ui + 1, nxt);
      nB = has_next ? S.bptr(nxt) : cB;
    }
    for (int t = 0; t < nt; t += 2) {
      const bool last = (t == nt - 2);
      if (Sched::LATE && last) {
        has_next = S.next(ui + 1, nxt);
        nB = has_next ? S.bptr(nxt) : cB;
      }
      const char* a1 = gA + (size_t)(t + 1) * kstep;
      const char* b2 = last ? nB : cB + (size_t)(t + 2) * kstep;
      const char* b3 = b2 + kstep;
      PG8_LDB(B0, 0, 0); PG8_SCHED; PG8_LDA(At, 0, 0); PG8_STAGE(PG8_SA(1, 1), a1, vA[1]);
      PG8_WAIT_L(8); PG8_BAR; PG8_WAIT_L(0); PG8_MMA(0, 0, At, B0); PG8_BAR; PG8_SCHED;
      if (last && has_next) {
        S.a_ready(nxt);
        a_offsets(nxt);
        gA = S.aptr(nxt);
        const int Kn = S.kof(nxt);
        b_offsets(Kn);
        hstep = (size_t)G_HALF * Kn * 2;
      }
      const char* a2 = last ? gA : gA + (size_t)(t + 2) * kstep;
      const char* a3 = a2 + kstep;
      PG8_LDB(B1, 0, 1); PG8_STAGE(PG8_SB(0, 0), b2, voffB);
      PG8_BAR; PG8_WAIT_L(0); PG8_MMA(0, 1, At, B1); PG8_BAR;
      PG8_LDA(At, 0, 1); PG8_STAGE(PG8_SA(0, 0), a2, vA[0]);
      PG8_BAR; PG8_WAIT_L(0); PG8_MMA(1, 0, At, B0); PG8_BAR; PG8_SCHED;
      PG8_STAGE(PG8_SB(0, 1), b2 + hstep, voffB);
      PG8_WAIT_V(6); PG8_BAR; PG8_MMA(1, 1, At, B1); PG8_BAR;
      PG8_LDB(B0, 1, 0); PG8_SCHED; PG8_LDA(At, 1, 0); PG8_STAGE(PG8_SA(0, 1), a2, vA[1]);
      PG8_WAIT_L(8); PG8_BAR; PG8_WAIT_L(0); PG8_MMA(0, 0, At, B0); PG8_BAR; PG8_SCHED;
      PG8_LDB(B1, 1, 1); PG8_STAGE(PG8_SB(1, 0), b3, voffB);
      PG8_BAR; PG8_WAIT_L(0); PG8_MMA(0, 1, At, B1); PG8_BAR;
      PG8_LDA(At, 1, 1); PG8_STAGE(PG8_SA(1, 0), a3, vA[0]);
      PG8_BAR; PG8_WAIT_L(0); PG8_MMA(1, 0, At, B0); PG8_BAR; PG8_SCHED;
      PG8_STAGE(PG8_SB(1, 1), b3 + hstep, voffB);
      PG8_WAIT_V(6); PG8_BAR; PG8_MMA(1, 1, At, B1); PG8_BAR;
    }
    {
      const int te_ = fresh_tid_w(S.wv), le_ = te_ & 63;
      const unsigned tk_ = S.claim_begin(le_);
      E(acc, cur, wr, wc, le_ & 15, le_ >> 4);
      S.done(cur, le_);
      S.claim_end(ui + 2, le_, tk_);
    }
    if (!has_next) break;
#pragma unroll
    for (int a = 0; a < 2; ++a)
#pragma unroll
      for (int b = 0; b < 2; ++b)
#pragma unroll
        for (int m = 0; m < 4; ++m)
#pragma unroll
          for (int n = 0; n < 2; ++n) acc[a][b][m][n] = (f32x4){0.f, 0.f, 0.f, 0.f};
    cur = nxt; cB = nB; ++ui;
    K = S.kof(cur); nt = K / G_BK;
  }
  PG8_WAIT_V(0);
  if (wr == 0) PG8_BAR;
  PG8_BAR;
#undef PG8_SA
#undef PG8_SB
#undef PG8_STAGE
#undef PG8_LDA
#undef PG8_LDB
#undef PG8_MMA
#undef PG8_WAIT_V
#undef PG8_WAIT_L
#undef PG8_BAR
#undef PG8_SCHED
}

struct DenseSched {
  const bf16_t* A; const bf16_t* Bt; int K, nM, nN, nwg, G, c, wv;
  DEV bool next(int i, GUnit& u) const {
    const long L = (long)i * G + c;
    if (L >= nwg) return false;
    int wgid = (int)L;
    { const int q = nwg / 8, r = nwg % 8, xcd = wgid % 8, off = wgid / 8; wgid = (xcd < r ? xcd * (q + 1) : r * (q + 1) + (xcd - r) * q) + off; }
    const int nig = 8 * nN, gid = wgid / nig, fm = gid * 8;
    u.pm = fm + ((wgid % nig) & 7);
    u.pn = (wgid % nig) >> 3;
    u.e = 0;
    u.valid = 256;
    return true;
  }
  DEV unsigned rowoff(const GUnit& u, int row) const { return (unsigned)((u.pm * 256 + row) * K) * 2u; }
  DEV const char* bptr(const GUnit& u) const { return (const char*)Bt + (size_t)u.pn * 256 * K * 2; }
  DEV const char* aptr(const GUnit&) const { return (const char*)A; }
  DEV int kof(const GUnit&) const { return K; }
  DEV void a_ready(const GUnit&) const {}
  DEV void done(const GUnit&, int) const {}
  static constexpr bool LATE = false;
  DEV unsigned claim_begin(int) const { return 0u; }
  DEV void claim_end(int, int, unsigned) const {}
};
struct MoeSched {
  const bf16_t* act; const bf16_t* hbuf; const bf16_t* bt1; const bf16_t* bt2; const int* cnt; const int* list;
  unsigned* rdy; unsigned* tmo; unsigned* q; LAS int* tb; int G, c, wv, stage;
  static constexpr bool LATE = true;
  DEV bool next(int i, GUnit& u) const {
    const int L0 = __builtin_amdgcn_readfirstlane(tb[40 + (i & 1)]);
    const int U1 = __builtin_amdgcn_readfirstlane(tb[32]) * 4;
    if (L0 >= (stage ? 2 * U1 : U1)) return false;
    u.ph = (L0 >= U1) ? 1 : 0;
    const int L = L0 - u.ph * U1;
    const int qt = L >> 2;
    const int ln = __builtin_amdgcn_mbcnt_hi(~0u, __builtin_amdgcn_mbcnt_lo(~0u, 0u));
    const int pe = tb[1 + (ln & 31)];
    const unsigned long long bal = __builtin_amdgcn_ballot_w64(pe <= qt);
    const int e = __builtin_popcount((unsigned)bal);
    const int base = __builtin_amdgcn_readfirstlane(tb[e]);
    const int cn = __builtin_amdgcn_readfirstlane(tb[48 + e]);
    u.e = e; u.pm = qt - base; u.pn = L & 3; u.valid = min(256, cn - u.pm * 256); u.ridx = qt;
    return true;
  }
  DEV unsigned claim_begin(int lane) const {
    unsigned tk = 0u;
    if (wv == 0 && lane == 0) tk = atomicInc(q, 0xffffffffu);
    return tk;
  }
  DEV void claim_end(int i, int lane, unsigned tk) const {
    if (wv == 0 && lane == 0) { tb[40 + (i & 1)] = (int)tk; tb[44] = i; }
  }
  DEV unsigned rowoff(const GUnit& u, int row) const {
    const int slot = list[u.e * CAP + u.pm * 256 + min(row, u.valid - 1)];
    return u.ph ? (unsigned)(slot * DEXP) * 2u : (unsigned)((slot >> 1) * DM) * 2u;
  }
  DEV const char* bptr(const GUnit& u) const {
    return (const char*)bt1 + (ptrdiff_t)u.ph * ((const char*)bt2 - (const char*)bt1) +
           (((size_t)u.e * 1024 + u.pn * 256) * (size_t)(DM * 2 >> u.ph));
  }
  DEV const char* aptr(const GUnit& u) const {
    return (const char*)act + (ptrdiff_t)u.ph * ((const char*)hbuf - (const char*)act);
  }
  DEV int kof(const GUnit& u) const { return u.ph ? DEXP : DM; }
  DEV void a_ready(const GUnit& u) const {
    if (u.ph) {
      if (wv == 0) {
        unsigned spins = 0u;
        while (xb_ld(rdy + u.ridx) < 32u) {
          if (++spins > 4000000u) { atomicAdd(tmo, 1u); break; }
          __builtin_amdgcn_s_sleep(2);
        }
        __builtin_amdgcn_fence(__ATOMIC_ACQUIRE, "agent");
        asm volatile("s_waitcnt vmcnt(0)" ::: "memory");
      }
      asm volatile("" ::: "memory");
      __builtin_amdgcn_s_barrier();
      asm volatile("" ::: "memory");
    }
  }
  DEV void done(const GUnit& u, int lane) const {
    if (!u.ph) {
      asm volatile("s_waitcnt vmcnt(0)" ::: "memory");
      if (lane == 0) xb_add(rdy + u.ridx, 1u);
    }
  }
};

DEV void convert_tile(const float* src, int ld, int k0, int n0, bf16_t* dst, int drow0, int dK, float* tl, int tid) {
  {
    const int kk = tid >> 4, n4 = tid & 15;
    const float4 a = *(const float4*)(src + (size_t)(k0 + kk) * ld + n0 + n4 * 4);
    const float4 b = *(const float4*)(src + (size_t)(k0 + kk + 32) * ld + n0 + n4 * 4);
    float* r0 = tl + kk * 65 + n4 * 4;
    r0[0] = a.x; r0[1] = a.y; r0[2] = a.z; r0[3] = a.w;
    float* r1 = tl + (kk + 32) * 65 + n4 * 4;
    r1[0] = b.x; r1[1] = b.y; r1[2] = b.z; r1[3] = b.w;
  }
  __syncthreads();
  {
    const int n = tid >> 3, k8 = tid & 7;
    float v[8];
#pragma unroll
    for (int j = 0; j < 8; ++j) v[j] = tl[(k8 * 8 + j) * 65 + n];
    *(uint4*)(dst + (size_t)(drow0 + n) * dK + k0 + k8 * 8) = pack8(v);
  }
  __syncthreads();
}
DEV void convert_gates(const Params& p, int l, int bid, int nb, int tid) {
  const int bs = bid;
  const int g = bs * NTHR + tid;
  if (g < 16 * DM) {
    const int j = g >> 10, k = g & (DM - 1);
    p.btg[g] = f2bf(p.w_in[((size_t)l * DM + k) * DIN + PROJW + j]);
  }
}
DEV void convert_win(const Params& p, int l, int bid, int nb, char* smem) {
  const int tid = fresh_tid();
  for (int t = bid; t < 16 * 56; t += nb) {
    const int kt = t / 56, ntile = t - kt * 56;
    convert_tile(p.w_in + (size_t)l * DM * DIN, DIN, kt * 64, ntile * 64, p.btin, ntile * 64, DM, (float*)smem, tid);
  }
  convert_gates(p, l, bid, nb, tid);
}
struct CvtDesc { const float* src; bf16_t* dst; int ld, dK, k0, n0, drow0; };
DEV CvtDesc cvt_desc(const Params& p, int l, int t) {
  constexpr int NT_W1 = NEXP * 16 * 8, NT_W2 = NEXP * 8 * 16, NT_WO = 256;
  CvtDesc d;
  if (t < 2 * NT_W1) {
    const int which = t / NT_W1, r = t - which * NT_W1;
    const int e = r >> 7, kt = (r >> 3) & 15, ntile = r & 7;
    d.src = (which ? p.ew3 : p.ew1) + (size_t)(l * NEXP + e) * DM * DEXP;
    d.ld = DEXP; d.k0 = kt * 64; d.n0 = ntile * 64;
    d.dst = p.bt1; d.dK = DM;
    d.drow0 = e * 1024 + 256 * (d.n0 >> 7) + which * 128 + (d.n0 & 127);
  } else if (t < 2 * NT_W1 + NT_W2) {
    const int r = t - 2 * NT_W1;
    const int e = r >> 7, kt = (r >> 4) & 7, ntile = r & 15;
    d.src = p.ew2 + (size_t)(l * NEXP + e) * DEXP * DM;
    d.ld = DM; d.k0 = kt * 64; d.n0 = ntile * 64;
    d.dst = p.bt2; d.dK = DEXP; d.drow0 = e * 1024 + ntile * 64;
  } else {
    const int r = t - 2 * NT_W1 - NT_W2;
    const int kt = r >> 4, ntile = r & 15;
    d.src = p.w_out + (size_t)l * DM * DM;
    d.ld = DM; d.k0 = kt * 64; d.n0 = ntile * 64;
    d.dst = p.btout; d.dK = DM; d.drow0 = ntile * 64;
  }
  return d;
}
DEV void convert_layer(const Params& p, int l, int bid_, int nb, char* smem) {
  const int bid = bid_;
  const int tid = fresh_tid();
  float* tl = (float*)smem;
  constexpr int NT = 2 * (NEXP * 16 * 8) + NEXP * 8 * 16 + 256;
  const int kk = tid >> 4, n4 = tid & 15;
  auto fetch = [&](int t, float4& a, float4& b) {
    const CvtDesc d = cvt_desc(p, l, min(t, NT - 1));
    const float* s = d.src + (size_t)(d.k0 + kk) * d.ld + d.n0 + n4 * 4;
    {
      const f32x4 av = __builtin_nontemporal_load((const f32x4*)(s));
      const f32x4 bv = __builtin_nontemporal_load((const f32x4*)(s + (size_t)32 * d.ld));
      a = make_float4(av[0], av[1], av[2], av[3]);
      b = make_float4(bv[0], bv[1], bv[2], bv[3]);
    }
  };
  float4 a0, b0, a1, b1, a2, b2;
  fetch(bid, a0, b0);
  fetch(bid + nb, a1, b1);
#pragma unroll 1
  for (int t = bid; t < NT; t += nb) {
    fetch(t + 2 * nb, a2, b2);
    const CvtDesc d = cvt_desc(p, l, t);
    {
      float* r0 = tl + kk * 65 + n4 * 4;
      r0[0] = a0.x; r0[1] = a0.y; r0[2] = a0.z; r0[3] = a0.w;
      float* r1 = tl + (kk + 32) * 65 + n4 * 4;
      r1[0] = b0.x; r1[1] = b0.y; r1[2] = b0.z; r1[3] = b0.w;
    }
    __syncthreads();
    {
      const int n = tid >> 3, k8 = tid & 7;
      float v[8];
#pragma unroll
      for (int j = 0; j < 8; ++j) v[j] = tl[(k8 * 8 + j) * 65 + n];
      const uint4 pk = pack8(v);
      const u32x4 pkv = {pk.x, pk.y, pk.z, pk.w};
      __builtin_nontemporal_store(pkv, (u32x4*)(d.dst + (size_t)(d.drow0 + n) * d.dK + d.k0 + k8 * 8));
    }
    __syncthreads();
    a0 = a1; b0 = b1; a1 = a2; b1 = b2;
  }
  if (l + 1 < DEPTH) convert_win(p, l + 1, bid, nb, smem);
}

DEV void phase_ada(const Params& p, int bid, int nb, char* smem) {
  float* cond = (float*)smem;
  float* red = cond + 2 * DM;
  const int tid = fresh_tid(), lane = tid & 63, wid = tid >> 6;
  for (int i = tid; i < 2 * DM; i += NTHR) cond[i] = silu_f(p.c[i]);
  __syncthreads();
  for (int item = bid; item < DEPTH * 96; item += nb) {
    const int l = item / 96, j = (item - l * 96) * 64 + lane;
    const float* w = p.w_ada + ((size_t)l * DM + wid * 128) * 6144 + j;
    float a0 = 0.f, a1 = 0.f;
#pragma unroll
    for (int kb = 0; kb < 2; ++kb) {
      float wreg[64];
#pragma unroll
      for (int k = 0; k < 64; ++k) wreg[k] = __builtin_nontemporal_load(w + (size_t)(kb * 64 + k) * 6144);
#pragma unroll
      for (int k = 0; k < 64; ++k) {
        a0 += cond[wid * 128 + kb * 64 + k] * wreg[k];
        a1 += cond[DM + wid * 128 + kb * 64 + k] * wreg[k];
      }
    }
    red[(wid * 2 + 0) * 64 + lane] = a0;
    red[(wid * 2 + 1) * 64 + lane] = a1;
    __syncthreads();
    if (wid < 2) {
      float s = p.b_ada[l * 6144 + j];
#pragma unroll
      for (int w8 = 0; w8 < 8; ++w8) s += red[(w8 * 2 + wid) * 64 + lane];
      p.mod[(l * 2 + wid) * 6144 + j] = s;
    }
    __syncthreads();
  }
  if (bid == 0 && tid < DEPTH * NEXP) p.cnt[tid] = 0;
}

DEV void norm_mod_store(const float4 (&v)[4], float rstd, const float* nw, const float* sc, const float* sh,
                        bf16_t* dst, int lane) {
#pragma unroll
  for (int i = 0; i < 4; ++i) {
    const int idx = (lane + 64 * i) * 4;
    const float4 w = *(const float4*)(nw + idx);
    const float4 s = *(const float4*)(sc + idx);
    const float4 h = *(const float4*)(sh + idx);
    const float r0 = v[i].x * rstd * w.x * (1.f + s.x) + h.x;
    const float r1 = v[i].y * rstd * w.y * (1.f + s.y) + h.y;
    const float r2 = v[i].z * rstd * w.z * (1.f + s.z) + h.z;
    const float r3 = v[i].w * rstd * w.w * (1.f + s.w) + h.w;
    uint2 pk;
    pk.x = pack2(r0, r1);
    pk.y = pack2(r2, r3);
    *(uint2*)(dst + idx) = pk;
  }
}

DEV void phase_hmix(const Params& p, int l, const float* xin, int bid, int nb) {
  const int tid_ = fresh_tid(), lane = tid_ & 63, wid = tid_ >> 6;
  for (int t = bid * NWAVE + wid; t < NTOK; t += nb * NWAVE) {
    const float4* xr = (const float4*)(xin + (size_t)t * DM);
    float4 v[4];
    float ss = 0.f;
#pragma unroll
    for (int i = 0; i < 4; ++i) {
      v[i] = xr[lane + 64 * i];
      ss += v[i].x * v[i].x + v[i].y * v[i].y + v[i].z * v[i].z + v[i].w * v[i].w;
    }
    ss = wave_sum(ss, lane);
    const float rstd = rsqrtf(ss * (1.f / DM) + EPS);
    const int b = t / T;
    const float* md = p.mod + (l * 2 + b) * 6144;
    norm_mod_store(v, rstd, p.norm_mix_w + l * DM, md + MOD_SCALE1, md + MOD_SHIFT1, p.act + (size_t)t * DM, lane);
  }
}

struct EpiProj {
  static constexpr bool PERM = true;
  bf16_t* O;
  DEV void operator()(const f32x4 (&acc)[2][2][4][2], const GUnit& u, int wr, int wc, int fr, int fq) const {
    const int row0 = u.pm * 256 + wr * 64 + fr, col0 = u.pn * 256 + wc * 32 + 8 * fq;
#pragma unroll
    for (int ai = 0; ai < 2; ++ai)
#pragma unroll
      for (int m = 0; m < 4; ++m) {
        bf16_t* rowp = O + (size_t)(row0 + ai * G_HALF + m * 16) * PROJW + col0;
#pragma unroll
        for (int bj = 0; bj < 2; ++bj) {
          const f32x4 v0 = acc[ai][bj][m][0], v1 = acc[ai][bj][m][1];
          uint4 w;
          w.x = pack2(v0[0], v0[1]); w.y = pack2(v0[2], v0[3]); w.z = pack2(v1[0], v1[1]); w.w = pack2(v1[2], v1[3]);
          *(uint4*)(rowp + bj * G_HALF) = w;
        }
      }
  }
};

DEV void phase_gemm_proj(const Params& p, int l, int bid, int nb, char* smem) {
  DenseSched S;
  S.A = p.act; S.Bt = p.btin; S.K = DM; S.nM = NTOK / 256; S.nN = PROJW / 256; S.nwg = S.nM * S.nN; S.G = nb; S.c = bid; S.wv = p.wv;
  EpiProj E;
  E.O = p.proj;
  gemm_phase((LAS unsigned char*)smem, S, E);
  const int tid = fresh_tid(), lane = tid & 63, wid = tid >> 6, fr = lane & 15, fq = lane >> 4;
  for (int tb = bid; tb < NTOK / 64; tb += nb) {
    if (wid < 4) {
      const int tok0 = tb * 64 + wid * 16;
      const bf16_t* ap = p.act + (size_t)(tok0 + fr) * DM + fq * 8;
      const bf16_t* bp = p.btg + (size_t)fr * DM + fq * 8;
      f32x4 acc = {0.f, 0.f, 0.f, 0.f};
#pragma unroll 8
      for (int ks = 0; ks < DM / 32; ++ks)
        acc = MFMA16(*(const bf16x8*)(ap + ks * 32), *(const bf16x8*)(bp + ks * 32), acc);
#pragma unroll
      for (int j = 0; j < 4; ++j) p.gates[(size_t)(tok0 + fq * 4 + j) * 16 + fr] = acc[j];
    }
  }
}

DEV void phase_conv(const Params& p, int l, int bid, int nb) {
  const float* w = p.conv_a_w + l * 768;
  const int bs = bid;
  for (int g = bs * NTHR + fresh_tid(); g < NTOK * 32; g += nb * NTHR) {
    const int t = g >> 5, c = (g & 31) * 8;
    const int tl = t & (T - 1);
    const bf16_t* r = p.proj + (size_t)t * PROJW + c;
    float cb[8], cc[8], cx[8], s[8], wk[8];
    unpack8(*(const uint4*)(r + OFF_CB), cb);
    unpack8(*(const uint4*)(r + OFF_CC), cc);
    unpack8(*(const uint4*)(r + OFF_CX), cx);
    {
      const float4 w0 = *(const float4*)(w + 256 + c), w1 = *(const float4*)(w + 256 + c + 4);
      wk[0] = w0.x; wk[1] = w0.y; wk[2] = w0.z; wk[3] = w0.w; wk[4] = w1.x; wk[5] = w1.y; wk[6] = w1.z; wk[7] = w1.w;
    }
#pragma unroll
    for (int e = 0; e < 8; ++e) s[e] = wk[e] * cc[e] * cx[e];
    if (tl > 0) {
      unpack8(*(const uint4*)(r + OFF_CC - PROJW), cc);
      unpack8(*(const uint4*)(r + OFF_CX - PROJW), cx);
      const float4 w0 = *(const float4*)(w + c), w1 = *(const float4*)(w + c + 4);
      wk[0] = w0.x; wk[1] = w0.y; wk[2] = w0.z; wk[3] = w0.w; wk[4] = w1.x; wk[5] = w1.y; wk[6] = w1.z; wk[7] = w1.w;
#pragma unroll
      for (int e = 0; e < 8; ++e) s[e] += wk[e] * cc[e] * cx[e];
    }
    if (tl < T - 1) {
      unpack8(*(const uint4*)(r + OFF_CC + PROJW), cc);
      unpack8(*(const uint4*)(r + OFF_CX + PROJW), cx);
      const float4 w0 = *(const float4*)(w + 512 + c), w1 = *(const float4*)(w + 512 + c + 4);
      wk[0] = w0.x; wk[1] = w0.y; wk[2] = w0.z; wk[3] = w0.w; wk[4] = w1.x; wk[5] = w1.y; wk[6] = w1.z; wk[7] = w1.w;
#pragma unroll
      for (int e = 0; e < 8; ++e) s[e] += wk[e] * cc[e] * cx[e];
    }
#pragma unroll
    for (int e = 0; e < 8; ++e) s[e] *= cb[e];
    *(uint4*)(p.y + (size_t)t * DM + c) = pack8(s);
  }
}

DEV void phase_na(const Params& p, int l, int wgid, int nwg) {
  const int tid_ = fresh_tid(), lane = tid_ & 63, fr = lane & 15, fq = lane >> 4;
  for (int item = wgid; item < NB * 128 * 4 * 4; item += nwg) {
    const int qg = item & 3, h = (item >> 2) & 3, r = (item >> 4) & 127, b = item >> 11;
    const int rs = min(max(r - 4, 0), 120);
    const int kc0 = (qg == 0) ? 0 : (qg == 1) ? 8 : (qg == 2) ? 24 : 32;
    const int c = qg * 16 + fr;
    const int cs = min(max(c - 8, 0), 48);
    const size_t tq = (size_t)b * T + r * 64 + c;
    bf16x8 bq[2];
#pragma unroll
    for (int ks = 0; ks < 2; ++ks)
      bq[ks] = *(const bf16x8*)(p.proj + tq * PROJW + OFF_NQ + h * 64 + ks * 32 + fq * 8);
    f32x4 sc[16];
#pragma unroll
    for (int tt = 0; tt < 16; ++tt) {
      const int i = tt >> 1, half = tt & 1;
      const size_t kt = (size_t)b * T + (rs + i) * 64 + kc0 + half * 16 + fr;
      const bf16_t* kp = p.proj + kt * PROJW + OFF_NK + h * 64 + fq * 8;
      const bf16x8 a0 = *(const bf16x8*)(kp);
      const bf16x8 a1 = *(const bf16x8*)(kp + 32);
      f32x4 z = {0.f, 0.f, 0.f, 0.f};
      z = MFMA16(a0, bq[0], z);
      sc[tt] = MFMA16(a1, bq[1], z);
    }
    const float* rpb = p.na_rpb + (size_t)(l * 4 + h) * 465;
    float mx = -3.0e38f;
#pragma unroll
    for (int tt = 0; tt < 16; ++tt) {
      const int i = tt >> 1, half = tt & 1;
      const int dr = rs + i - r + 7;
#pragma unroll
      for (int j = 0; j < 4; ++j) {
        const int kcol = kc0 + half * 16 + fq * 4 + j;
        const bool valid = (kcol >= cs) && (kcol < cs + 16);
        const int dc = valid ? (kcol - c + 15) : 0;
        const float s = valid ? (sc[tt][j] * 0.125f + rpb[dr * 31 + dc]) : -3.0e38f;
        sc[tt][j] = s;
        mx = fmaxf(mx, s);
      }
    }
    mx = fmaxf(mx, shx(mx, 16, lane));
    mx = fmaxf(mx, shx(mx, 32, lane));
    float sum = 0.f;
#pragma unroll
    for (int tt = 0; tt < 16; ++tt)
#pragma unroll
      for (int j = 0; j < 4; ++j) {
        const float s = sc[tt][j];
        const float e = (s > -1.0e38f) ? __expf(s - mx) : 0.f;
        sc[tt][j] = e;
        sum += e;
      }
    sum += shx(sum, 16, lane);
    sum += shx(sum, 32, lane);
    const float inv = 1.f / sum;
    f32x4 oacc[4];
#pragma unroll
    for (int nt = 0; nt < 4; ++nt) oacc[nt] = f32x4{0.f, 0.f, 0.f, 0.f};
#pragma unroll
    for (int i = 0; i < 8; ++i) {
      uint4 pu;
      pu.x = pack2(sc[2 * i][0] * inv, sc[2 * i][1] * inv);
      pu.y = pack2(sc[2 * i][2] * inv, sc[2 * i][3] * inv);
      pu.z = pack2(sc[2 * i + 1][0] * inv, sc[2 * i + 1][1] * inv);
      pu.w = pack2(sc[2 * i + 1][2] * inv, sc[2 * i + 1][3] * inv);
      const bf16x8 pa = __builtin_bit_cast(bf16x8, pu);
      const bf16_t* vb = p.proj + ((size_t)b * T + (rs + i) * 64 + kc0 + fq * 4) * PROJW + OFF_NV + h * 64 + fr * 4;
      uint2 wv[8];
#pragma unroll
      for (int j = 0; j < 8; ++j) wv[j] = *(const uint2*)(vb + (size_t)(j < 4 ? j : 12 + j) * PROJW);
#pragma unroll
      for (int t = 0; t < 4; ++t) {
        uint4 bu;
        const unsigned sel = (t & 1) ? 0x07060302u : 0x05040100u;
#define NA_E(j) ((t & 2) ? wv[j].y : wv[j].x)
        bu.x = __builtin_amdgcn_perm(NA_E(1), NA_E(0), sel);
        bu.y = __builtin_amdgcn_perm(NA_E(3), NA_E(2), sel);
        bu.z = __builtin_amdgcn_perm(NA_E(5), NA_E(4), sel);
        bu.w = __builtin_amdgcn_perm(NA_E(7), NA_E(6), sel);
#undef NA_E
        oacc[t] = MFMA16(pa, __builtin_bit_cast(bf16x8, bu), oacc[t]);
      }
    }
#pragma unroll
    for (int j = 0; j < 4; ++j) {
      uint2 st;
      st.x = pack2(oacc[0][j], oacc[1][j]);
      st.y = pack2(oacc[2][j], oacc[3][j]);
      *(uint2*)(p.y + ((size_t)b * T + r * 64 + qg * 16 + fq * 4 + j) * DM + 256 + h * 64 + fr * 4) = st;
    }
  }
}

DEV void fmac1(float& acc, float a, float b) { asm("v_fmac_f32 %0, %1, %2" : "+v"(acc) : "v"(a), "v"(b)); }
struct LRow { float4 v[8]; };
template <int POS>
struct SolveStep {
  static DEV void run(float (&x)[64], LRow& row, const float* Ld, const float* sclv, const bf16_t* srcq, int sstep,
                      bool isu, unsigned* up, bf16_t* wp) {
    float s0 = 0.f, s1 = 0.f, s2 = 0.f, s3 = 0.f;
    float4 hi[8];
#pragma unroll
    for (int j4 = 8; j4 < (POS + 3) / 4; ++j4) hi[j4 - 8] = *(const float4*)(Ld + POS * 68 + j4 * 4);
#pragma unroll
    for (int j4 = 0; j4 < 8; ++j4) {
      if (j4 < (POS + 3) / 4) {
        const float4 lv = row.v[j4];
        fmac1(s0, lv.x, x[j4 * 4]);
        if (j4 * 4 + 1 < POS) fmac1(s1, lv.y, x[j4 * 4 + 1]);
        if (j4 * 4 + 2 < POS) fmac1(s2, lv.z, x[j4 * 4 + 2]);
        if (j4 * 4 + 3 < POS) fmac1(s3, lv.w, x[j4 * 4 + 3]);
      }
      if (POS + 1 < 64 && j4 < (POS + 4) / 4) row.v[j4] = *(const float4*)(Ld + (POS + 1) * 68 + j4 * 4);
    }
#pragma unroll
    for (int j4 = 8; j4 < (POS + 3) / 4; ++j4) {
      const float4 lv = hi[j4 - 8];
      fmac1(s0, lv.x, x[j4 * 4]);
      if (j4 * 4 + 1 < POS) fmac1(s1, lv.y, x[j4 * 4 + 1]);
      if (j4 * 4 + 2 < POS) fmac1(s2, lv.z, x[j4 * 4 + 2]);
      if (j4 * 4 + 3 < POS) fmac1(s3, lv.w, x[j4 * 4 + 3]);
    }
    const float a = sclv[POS] * bf2f(srcq[0]) - ((s0 + s1) + (s2 + s3));
    x[POS] = a;
    if (isu) {
      if (POS & 1) up[(POS >> 1) * 128] = pack2(x[POS - 1], a);
    } else {
      wp[POS * 128] = f2bf(-a);
    }
    asm volatile("" ::: "memory");
    SolveStep<POS + 1>::run(x, row, Ld, sclv, srcq + sstep, sstep, isu, up, wp);
  }
};
template <>
struct SolveStep<64> {
  static DEV void run(float (&)[64], LRow&, const float*, const float*, const bf16_t*, int, bool, unsigned*, bf16_t*) {}
};

DEV int kperm16(int k) { const int s = (k >> 2) & 3; return (k & ~15) | ((((s & 1) << 1) | (s >> 1)) << 2) | (k & 3); }

DEV void phase_gdn_prep(const Params& p, int l, int bid, int nb, char* smem) {
  const int tid = fresh_tid(), lane = tid & 63;
  bf16_t* q_bf = (bf16_t*)(smem + PL_Q);
  bf16_t* k_bf = (bf16_t*)(smem + PL_K);
  bf16_t* v_bf = (bf16_t*)(smem + PL_V);
  float* Lm = (float*)(smem + PL_L);
  float* gcl = (float*)(smem + PL_GC);
  float* bl = (float*)(smem + PL_BETA);
  float* bgl = (float*)(smem + PL_BG);
  float* fql = (float*)(smem + PL_FQ);
  float* fkl = (float*)(smem + PL_FK);
  float* cwl = (float*)(smem + PL_CW);
  {
    const float* cw = p.gdn_conv_w + l * 4608;
    for (int i = tid; i < 1152; i += NTHR) *(float4*)(cwl + i * 4) = *(const float4*)(cw + i * 4);
  }
  __syncthreads();
  for (int item = bid; item < 1024; item += nb) {
    const int b = item >> 9, h = (item >> 7) & 3, n = item & 127;
    const int t0 = b * T + n * 64;
    char* rec0 = p.gdn_rec + (size_t)item * 2 * REC_BYTES;
    float ga = 0.f, gb = 0.f, galog = 0.f, gdt = 0.f;
    if (tid < 128) {
      const int dir = tid >> 6;
      const int i = dir ? 63 - lane : lane;
      const size_t t = (size_t)t0 + i;
      ga = p.gates[t * 16 + dir * 4 + h];
      gb = p.gates[t * 16 + 8 + dir * 4 + h];
      galog = p.gdn_a_log[l * 8 + dir * 4 + h];
      gdt = p.gdn_dt_bias[l * 8 + dir * 4 + h];
    }
    uint4 raw[3][3][2];
    {
      const int i = tid >> 3, oc = tid & 7, d0 = oc * 16;
      const int tl = n * 64 + i;
      const bf16_t* rowp = p.proj + (size_t)(t0 + i) * PROJW + OFF_GQKV + h * 128 + d0;
      const int dm = (tl > 0) ? -PROJW : 0, dp = (tl < T - 1) ? PROJW : 0;
#pragma unroll
      for (int m = 0; m < 3; ++m) {
        const bf16_t* rp = rowp + m * 512;
        raw[m][0][0] = *(const uint4*)(rp + dm);
        raw[m][0][1] = *(const uint4*)(rp + dm + 8);
        raw[m][1][0] = *(const uint4*)(rp);
        raw[m][1][1] = *(const uint4*)(rp + 8);
        raw[m][2][0] = *(const uint4*)(rp + dp);
        raw[m][2][1] = *(const uint4*)(rp + dp + 8);
      }
    }
    if (tid < 128) {
      const int dir = tid >> 6;
      const float g = -__expf(galog) * softplus_f(ga + gdt);
      const float beta = sigmoid_f(gb);
      float cs = g;
#pragma unroll
      for (int o = 1; o < 64; o <<= 1) {
        const float v = __int_as_float(__builtin_amdgcn_ds_bpermute((lane - o) << 2, __float_as_int(cs)));
        if (lane >= o) cs += v;
      }
      const float last = __uint_as_float(__builtin_amdgcn_readlane(__float_as_uint(cs), 63));
      const float ec = __expf(cs);
      gcl[dir * 64 + lane] = cs;
      bl[dir * 64 + lane] = beta;
      bgl[dir * 64 + lane] = beta * ec;
      fql[dir * 64 + lane] = ec;
      fkl[dir * 64 + lane] = __expf(last - cs);
      if (lane == 0) p.egl[item * 2 + dir] = __expf(last);
    }
    float valq[16], valk[16];
    {
      int tA = tid;
      asm volatile("" : "+v"(tA));
      const int i = tA >> 3, oc = tA & 7, d0 = oc * 16;
      const int tl = n * 64 + i;
      const float zm = (tl > 0) ? 1.f : 0.f, zp = (tl < T - 1) ? 1.f : 0.f;
#pragma unroll
      for (int m = 0; m < 3; ++m) {
        float x0[16], x1[16], x2[16], val[16];
        unpack8(raw[m][0][0], x0);
        unpack8(raw[m][0][1], x0 + 8);
        unpack8(raw[m][1][0], x1);
        unpack8(raw[m][1][1], x1 + 8);
        unpack8(raw[m][2][0], x2);
        unpack8(raw[m][2][1], x2 + 8);
        const float* cwm = cwl + m * 512 + h * 128 + d0;
        float ss = 0.f;
#pragma unroll
        for (int e4 = 0; e4 < 4; ++e4) {
          const float4 w0 = *(const float4*)(cwm + e4 * 4), w1 = *(const float4*)(cwm + 1536 + e4 * 4),
                       w2 = *(const float4*)(cwm + 3072 + e4 * 4);
          const float w0a[4] = {w0.x * zm, w0.y * zm, w0.z * zm, w0.w * zm};
          const float w1a[4] = {w1.x, w1.y, w1.z, w1.w};
          const float w2a[4] = {w2.x * zp, w2.y * zp, w2.z * zp, w2.w * zp};
#pragma unroll
          for (int j = 0; j < 4; ++j) {
            const int e = e4 * 4 + j;
            val[e] = silu_f(w0a[j] * x0[e] + w1a[j] * x1[e] + w2a[j] * x2[e]);
            ss += val[e] * val[e];
          }
        }
        if (m < 2) {
          ss += shx(ss, 1, lane);
          ss += shx(ss, 2, lane);
          ss += shx(ss, 4, lane);
          float sc = rsqrtf(ss + EPS);
          if (m == 0) sc *= 0.08838834764831845f;
#pragma unroll
          for (int e = 0; e < 16; ++e) val[e] *= sc;
        }
        bf16_t* dst = (m == 0 ? q_bf : (m == 1 ? k_bf : v_bf)) + i * 136 + d0;
        *(uint4*)(dst) = pack8(val);
        *(uint4*)(dst + 8) = pack8(val + 8);
        if (m == 0) {
#pragma unroll
          for (int e = 0; e < 16; ++e) valq[e] = val[e];
        }
        if (m == 1) {
#pragma unroll
          for (int e = 0; e < 16; ++e) valk[e] = val[e];
        }
      }
    }
    __syncthreads();
    {
      int tA = tid;
      asm volatile("" : "+v"(tA));
      const int i = tA >> 3, oc = tA & 7, d0 = oc * 16;
#pragma unroll
      for (int dir = 0; dir < 2; ++dir) {
        const int pos = dir ? 63 - i : i;
        const float f = fql[dir * 64 + pos];
        float tmp[16];
#pragma unroll
        for (int e = 0; e < 16; ++e) tmp[kperm16(e)] = valq[e] * f;
        bf16_t* qd = (bf16_t*)(rec0 + dir * REC_BYTES + REC_QD) + pos * 128 + d0;
        *(uint4*)(qd) = pack8(tmp);
        *(uint4*)(qd + 8) = pack8(tmp + 8);
      }
      const int d = tA & 127;
#pragma unroll
      for (int k = 0; k < 4; ++k) {
        const int du = (tA >> 7) + 4 * k, dir = du >> 3, U = du & 7;
        const int p0 = 16 * (U >> 1) + 4 * (U & 1);
        const float4 fa = *(const float4*)(fkl + dir * 64 + p0), fb = *(const float4*)(fkl + dir * 64 + p0 + 8);
        const float ff[8] = {fa.x, fa.y, fa.z, fa.w, fb.x, fb.y, fb.z, fb.w};
        float o[8];
#pragma unroll
        for (int e = 0; e < 8; ++e) {
          const int pp = p0 + (e & 3) + 8 * (e >> 2);
          const int tok = dir ? 63 - pp : pp;
          o[e] = bf2f(k_bf[tok * 136 + d]) * ff[e];
        }
        *(uint4*)((bf16_t*)(rec0 + dir * REC_BYTES + REC_KT) + d * 64 + U * 8) = pack8(o);
      }
    }
    {
      int tB = tid;
      asm volatile("" : "+v"(tB));
      const int laneB = tB & 63, widB = tB >> 6, fr = laneB & 15, fq = laneB >> 4;
      const int mat = __builtin_amdgcn_readfirstlane(widB >> 2), rtile = widB & 3;
      const bf16_t* bsrc = mat ? q_bf : k_bf;
      const int i = rtile * 16 + fr;
      bf16x8 bf_[4];
#pragma unroll
      for (int ks = 0; ks < 4; ++ks) bf_[ks] = *(const bf16x8*)(bsrc + i * 136 + ks * 32 + fq * 8);
      const float gi0 = gcl[i], gi1 = gcl[64 + 63 - i];
      float4 gj0[4], gj1[4];
#pragma unroll
      for (int nt = 0; nt < 4; ++nt) {
        gj0[nt] = *(const float4*)(gcl + nt * 16 + fq * 4);
        gj1[nt] = *(const float4*)(gcl + 64 + 60 - (nt * 16 + fq * 4));
      }
      const float be0 = bl[i], be1 = bl[64 + 63 - i];
      f32x4 acc[4];
#pragma unroll
      for (int nt = 0; nt < 4; ++nt) {
        acc[nt] = f32x4{0.f, 0.f, 0.f, 0.f};
#pragma unroll
        for (int ks = 0; ks < 4; ++ks) {
          const bf16x8 afrag = *(const bf16x8*)(k_bf + (nt * 16 + fr) * 136 + ks * 32 + fq * 8);
          acc[nt] = MFMA16(afrag, bf_[ks], acc[nt]);
        }
      }
#pragma unroll
      for (int nt = 0; nt < 4; ++nt) {
        const int jj = nt * 16 + fq * 4;
        const float g0[4] = {gj0[nt].x, gj0[nt].y, gj0[nt].z, gj0[nt].w};
        const float g1[4] = {gj1[nt].x, gj1[nt].y, gj1[nt].z, gj1[nt].w};
        float v0[4], v1[4];
#pragma unroll
        for (int j = 0; j < 4; ++j) {
          const float G0 = acc[nt][j], G1 = acc[nt][3 - j];
          const float d0v = __expf(fminf(gi0 - g0[j], 0.f)), d1v = __expf(fminf(gi1 - g1[j], 0.f));
          if (mat == 0) {
            v0[j] = (i > jj + j) ? be0 * G0 * d0v : 0.f;
            v1[j] = (63 - i > 60 - jj + j) ? be1 * G1 * d1v : 0.f;
          } else {
            v0[j] = (i >= jj + j) ? G0 * d0v : 0.f;
            v1[j] = (63 - i >= 60 - jj + j) ? G1 * d1v : 0.f;
          }
        }
        if (mat == 0) {
          *(float4*)(Lm + i * 68 + jj) = make_float4(v0[0], v0[1], v0[2], v0[3]);
          *(float4*)(Lm + (64 + 63 - i) * 68 + 60 - jj) = make_float4(v1[0], v1[1], v1[2], v1[3]);
        } else {
          uint2 s0, s1;
          s0.x = pack2(v0[0], v0[1]); s0.y = pack2(v0[2], v0[3]);
          s1.x = pack2(v1[0], v1[1]); s1.y = pack2(v1[2], v1[3]);
          *(uint2*)((bf16_t*)(rec0 + REC_IN) + i * 64 + kperm16(jj)) = s0;
          *(uint2*)((bf16_t*)(rec0 + REC_BYTES + REC_IN) + (63 - i) * 64 + kperm16(60 - jj)) = s1;
        }
      }
    }
    __syncthreads();
    {
      int tC = tid;
      asm volatile("" : "+v"(tC));
      const int dir = tC >> 8, c = tC & 255;
      const float* Ld = Lm + dir * 64 * 68;
      const bool isu = __builtin_amdgcn_readfirstlane((int)(c < 128)) != 0;
      unsigned* up = p.gdn_u + ((size_t)(item * 2 + dir) * 32) * 128 + (c & 127);
      bf16_t* wp = (bf16_t*)(rec0 + dir * REC_BYTES + REC_WN) + kperm16(c & 127);
      const bf16_t* src = (isu ? v_bf : k_bf) + (c & 127);
      const float* sclv = (isu ? bl : bgl) + dir * 64;
      float x[64];
      LRow row0;
      SolveStep<0>::run(x, row0, Ld, sclv, src + (dir ? 63 * 136 : 0), dir ? -136 : 136, isu, up, wp);
    }
    __syncthreads();
  }
}

DEV int crow(int reg, int hf) { return (reg & 3) + 8 * (reg >> 2) + 4 * hf; }
DEV bf16x8 pack_acc8(const f32x16& x, int s) {
  uint4 v;
  v.x = pack2(x[8 * s + 0], x[8 * s + 1]);
  v.y = pack2(x[8 * s + 2], x[8 * s + 3]);
  v.z = pack2(x[8 * s + 4], x[8 * s + 5]);
  v.w = pack2(x[8 * s + 6], x[8 * s + 7]);
  return __builtin_bit_cast(bf16x8, v);
}
DEV bf16x8 ld_frag(const char* rowp, int kb) { return *(const bf16x8*)(rowp + kb); }

DEV void phase_gdn_scan(const Params& p, int ep, int chain, char* smem) {
  const int tid = fresh_tid(), lane = tid & 63, wid = tid >> 6;
  const int dir = chain & 1, bh = chain >> 1;
  const int b = bh >> 2, hh = bh & 3;
  if (wid >= 4) {
    const int lt = tid - 256;
    uint4 rA[18], rB[18];
    auto gl = [&](uint4 (&rg)[18], int n) {
      const int item = bh * 128 + (dir ? 127 - n : n);
      const __amdgpu_buffer_rsrc_t rr = __builtin_amdgcn_make_buffer_rsrc(
          (void*)(p.gdn_rec + ((size_t)item * 2 + dir) * REC_BYTES), 0, REC_BYTES, 0x00020000);
      const __amdgpu_buffer_rsrc_t ru = __builtin_amdgcn_make_buffer_rsrc(
          (void*)(p.gdn_u + ((size_t)(item * 2 + dir) * 32) * 128), 0, 16384, 0x00020000);
#pragma unroll
      for (int k = 0; k < 14; ++k) {
        const u32x4 v = __builtin_amdgcn_raw_buffer_load_b128(rr, lt * 16, k * 4096, 0);
        rg[k] = make_uint4(v.x, v.y, v.z, v.w);
      }
#pragma unroll
      for (int k = 0; k < 4; ++k) {
        const u32x4 v = __builtin_amdgcn_raw_buffer_load_b128(ru, lt * 16, k * 4096, 0);
        rg[14 + k] = make_uint4(v.x, v.y, v.z, v.w);
      }
    };
    auto st = [&](const uint4 (&rg)[18], int buf) {
      char* base = smem + buf * SC_BUF;
#pragma unroll
      for (int k = 0; k < 14; ++k) {
        const int u = lt + 256 * k;
        int row, c16, off;
        if (k < 4) { row = u >> 4; c16 = u & 15; off = SC_WN + row * 272; }
        else if (k < 8) { row = (u - 1024) >> 4; c16 = (u - 1024) & 15; off = SC_QD + row * 272; }
        else if (k < 10) { row = (u - 2048) >> 3; c16 = (u - 2048) & 7; off = SC_IN + row * 144; }
        else { row = (u - 2560) >> 3; c16 = (u - 2560) & 7; off = SC_KT + row * 144; }
        *(uint4*)(base + off + c16 * 16) = rg[k];
      }
#pragma unroll
      for (int k = 0; k < 4; ++k) *(uint4*)(base + SC_U + (lt + 256 * k) * 16) = rg[14 + k];
    };
    gl(rA, 0);
    st(rA, 0);
    gl(rB, 1);
    gl(rA, 2);
    __syncthreads();
#pragma unroll 1
    for (int n = 0; n < 128; n += 2) {
      st(rB, 1);
      gl(rB, min(n + 3, 127));
      __syncthreads();
      st(rA, 0);
      gl(rA, min(n + 4, 127));
      __syncthreads();
    }
  } else {
    const int w = wid, r = lane & 31, hf = lane >> 5;
    f32x16 S[4];
#pragma unroll
    for (int t4 = 0; t4 < 4; ++t4)
#pragma unroll
      for (int e = 0; e < 16; ++e) S[t4][e] = 0.f;
    __builtin_amdgcn_s_setprio(3);
    const float dlo = p.egl[(bh * 128 + (dir ? 127 - lane : lane)) * 2 + dir];
    const float dhi = p.egl[(bh * 128 + (dir ? 63 - lane : 64 + lane)) * 2 + dir];
    if (tid == 0) __hip_atomic_store(&p.bar[XB_CXCC(chain)], ((unsigned)ep << 4) | xb_xcc_id(), __ATOMIC_RELAXED, __HIP_MEMORY_SCOPE_AGENT);
    __syncthreads();
#pragma unroll 1
    for (int n = 0; n < 128; ++n) {
      if (tid == 0) __hip_atomic_store(&p.bar[XB_PROG(chain)], (unsigned)ep * 1024u + (unsigned)n, __ATOMIC_RELAXED, __HIP_MEMORY_SCOPE_AGENT);
      const char* buf = smem + (n & 1) * SC_BUF;
      const float decay = __uint_as_float(__builtin_amdgcn_readlane(__float_as_uint(n < 64 ? dlo : dhi), n & 63));
      f32x16 vn[2], o[2];
      {
        const unsigned* ul = (const unsigned*)(buf + SC_U) + 32 * w + r;
#pragma unroll
        for (int tm = 0; tm < 2; ++tm)
#pragma unroll
          for (int e2 = 0; e2 < 8; ++e2) {
            const unsigned uu = ul[((32 * tm + crow(2 * e2, hf)) >> 1) * 128];
            vn[tm][2 * e2] = __uint_as_float(uu << 16);
            vn[tm][2 * e2 + 1] = __uint_as_float(uu & 0xffff0000u);
          }
      }
#pragma unroll
      for (int e = 0; e < 16; ++e) { o[0][e] = 0.f; o[1][e] = 0.f; }
      const char* rw0 = buf + SC_WN + r * 272 + hf * 16;
      const char* rq0 = buf + SC_QD + r * 272 + hf * 16;
      const char* ri0 = buf + SC_IN + r * 144 + hf * 16;
      const char* rk0 = buf + SC_KT + r * 144 + hf * 16;
      bf16x8 fA[8], fB[8], sb[4][2];
#define SCAN_LOAD(dst, base, t4a)                                                                        \
  _Pragma("unroll") for (int dt = 0; dt < 2; ++dt) _Pragma("unroll") for (int s = 0; s < 2; ++s)         \
      _Pragma("unroll") for (int tm = 0; tm < 2; ++tm)                                                   \
          dst[dt * 4 + s * 2 + tm] = ld_frag(base + tm * 32 * 272, (32 * ((t4a) + dt) + 16 * s) * 2);
#define SCAN_MMA(acc, f, t4a)                                                                            \
  _Pragma("unroll") for (int dt = 0; dt < 2; ++dt) _Pragma("unroll") for (int s = 0; s < 2; ++s)         \
      _Pragma("unroll") for (int tm = 0; tm < 2; ++tm)                                                   \
          acc[tm] = MFMA32(f[dt * 4 + s * 2 + tm], sb[(t4a) + dt][s], acc[tm]);
#define SCAN_MMA_T(acc, f, t4a)                                                                          \
  _Pragma("unroll") for (int dt = 0; dt < 2; ++dt) _Pragma("unroll") for (int s = 0; s < 2; ++s)         \
      _Pragma("unroll") for (int tm = 0; tm < 2; ++tm)                                                   \
          acc[tm] = MFMA32(sb[(t4a) + dt][s], f[dt * 4 + s * 2 + tm], acc[tm]);
#define SCAN_MIX(nmfma, nds, nvalu)                                                                      \
  _Pragma("unroll") for (int _g = 0; _g < (nmfma); ++_g) {                                               \
    __builtin_amdgcn_sched_group_barrier(0x008, 1, 0);                                                   \
    if (_g < (nds)) __builtin_amdgcn_sched_group_barrier(0x100, 1, 0);                                   \
    __builtin_amdgcn_sched_group_barrier(0x002, (nvalu), 0);                                             \
  }
      SCAN_LOAD(fA, rw0, 0)
      sb[0][0] = pack_acc8(S[0], 0); sb[0][1] = pack_acc8(S[0], 1);
      sb[1][0] = pack_acc8(S[1], 0); sb[1][1] = pack_acc8(S[1], 1);
      __builtin_amdgcn_sched_barrier(0);
      SCAN_MMA(vn, fA, 0)
      SCAN_LOAD(fB, rw0, 2)
      sb[2][0] = pack_acc8(S[2], 0); sb[2][1] = pack_acc8(S[2], 1);
      sb[3][0] = pack_acc8(S[3], 0); sb[3][1] = pack_acc8(S[3], 1);
      SCAN_MIX(8, 8, 2)
      __builtin_amdgcn_sched_barrier(0);
      SCAN_MMA(vn, fB, 2)
      SCAN_LOAD(fA, rq0, 0)
#pragma unroll
      for (int e = 0; e < 16; ++e) S[0][e] *= decay;
      SCAN_MIX(8, 8, 2)
      __builtin_amdgcn_sched_barrier(0);
      SCAN_MMA_T(o, fA, 0)
      SCAN_LOAD(fB, rq0, 2)
#pragma unroll
      for (int e = 0; e < 16; ++e) { S[1][e] *= decay; S[2][e] *= decay; }
      SCAN_MIX(8, 8, 3)
      __builtin_amdgcn_sched_barrier(0);
      bf16x8 fi[6], fk0[4];
      SCAN_MMA_T(o, fB, 2)
      fi[0] = ld_frag(ri0, 0);
      fi[1] = ld_frag(ri0, 32);
#pragma unroll
      for (int q4 = 0; q4 < 4; ++q4) fi[2 + q4] = ld_frag(ri0 + 32 * 144, q4 * 32);
#pragma unroll
      for (int q4 = 0; q4 < 4; ++q4) fk0[q4] = ld_frag(rk0, q4 * 32);
      bf16x8 vb[2][2];
#pragma unroll
      for (int tk = 0; tk < 2; ++tk) {
        vb[tk][0] = pack_acc8(vn[tk], 0);
        vb[tk][1] = pack_acc8(vn[tk], 1);
      }
#pragma unroll
      for (int e = 0; e < 16; ++e) S[3][e] *= decay;
      SCAN_MIX(8, 8, 4)
      __builtin_amdgcn_sched_barrier(0);
#undef SCAN_LOAD
#undef SCAN_MMA
#undef SCAN_MMA_T
      o[0] = MFMA32(vb[0][0], fi[0], o[0]);
      o[1] = MFMA32(vb[0][0], fi[2], o[1]);
      o[0] = MFMA32(vb[0][1], fi[1], o[0]);
      o[1] = MFMA32(vb[0][1], fi[3], o[1]);
      S[0] = MFMA32(fk0[0], vb[0][0], S[0]);
      o[1] = MFMA32(vb[1][0], fi[4], o[1]);
      S[0] = MFMA32(fk0[1], vb[0][1], S[0]);
      o[1] = MFMA32(vb[1][1], fi[5], o[1]);
      S[0] = MFMA32(fk0[2], vb[1][0], S[0]);
      S[0] = MFMA32(fk0[3], vb[1][1], S[0]);
#pragma unroll
      for (int q4 = 0; q4 < 4; ++q4) {
        fA[q4] = ld_frag(rk0 + 32 * 144, q4 * 32);
        fA[4 + q4] = ld_frag(rk0 + 64 * 144, q4 * 32);
      }
      SCAN_MIX(10, 8, 0)
      __builtin_amdgcn_sched_barrier(0);
#pragma unroll
      for (int q4 = 0; q4 < 4; ++q4) {
        S[1] = MFMA32(fA[q4], vb[q4 >> 1][q4 & 1], S[1]);
        S[2] = MFMA32(fA[4 + q4], vb[q4 >> 1][q4 & 1], S[2]);
      }
#pragma unroll
      for (int q4 = 0; q4 < 4; ++q4) fB[q4] = ld_frag(rk0 + 96 * 144, q4 * 32);
      SCAN_MIX(8, 4, 0)
      __builtin_amdgcn_sched_barrier(0);
#pragma unroll
      for (int q4 = 0; q4 < 4; ++q4) S[3] = MFMA32(fB[q4], vb[q4 >> 1][q4 & 1], S[3]);
#undef SCAN_MIX
      {
#pragma unroll
        for (int tn = 0; tn < 2; ++tn) {
          const int pos = 32 * tn + r;
          const int tok = dir ? (b * T + T - 1 - n * 64 - pos) : (b * T + n * 64 + pos);
          unsigned pk[4][2];
#pragma unroll
          for (int g = 0; g < 4; ++g) {
            pk[g][0] = pack2(o[tn][4 * g + 0], o[tn][4 * g + 1]);
            pk[g][1] = pack2(o[tn][4 * g + 2], o[tn][4 * g + 3]);
          }
          uint4 st0, st1;
          {
            auto s0 = __builtin_amdgcn_permlane32_swap(pk[0][0], pk[2][0], false, false);
            auto s1 = __builtin_amdgcn_permlane32_swap(pk[0][1], pk[2][1], false, false);
            st0.x = s0[0]; st0.y = s1[0]; st0.z = s0[1]; st0.w = s1[1];
            auto s2 = __builtin_amdgcn_permlane32_swap(pk[1][0], pk[3][0], false, false);
            auto s3 = __builtin_amdgcn_permlane32_swap(pk[1][1], pk[3][1], false, false);
            st1.x = s2[0]; st1.y = s3[0]; st1.z = s2[1]; st1.w = s3[1];
          }
          bf16_t* op = p.obuf + ((size_t)dir * NTOK + tok) * 512 + hh * 128 + 32 * w + 16 * hf;
          *(uint4*)(op) = st0;
          *(uint4*)(op + 8) = st1;
        }
      }
      __syncthreads();
    }
    __builtin_amdgcn_s_setprio(0);
  }
}

DEV void phase_scan_helper(const Params& p, int ep, int c, int j, char* smem) {
  const int tid = fresh_tid(), lane = tid & 63, wid = tid >> 6;
  volatile unsigned* lprog = (volatile unsigned*)smem;
  const unsigned epoch = (unsigned)ep;
  const int dir = c & 1, bh = c >> 1;
  constexpr unsigned AHEAD = 8u;
  if (tid == 0) lprog[0] = 0u;
  __syncthreads();
  if (wid == 0) {
    unsigned v = 0u, spins = 0u;
    for (;;) {
      v = xb_ld(&p.bar[XB_CXCC(c)]);
      if ((v >> 4) == epoch || ++spins > 200000u) break;
      __builtin_amdgcn_s_sleep(8);
    }
    const bool mine = ((v >> 4) == epoch) && ((v & 15u) == xb_xcc_id());
    if (!mine) {
      if (lane == 0) lprog[0] = 0xffffffffu;
    } else {
      unsigned idle = 0u;
      for (;;) {
        const unsigned g = xb_ld(&p.bar[XB_PROG(c)]);
        const unsigned cur = (g >= epoch * 1024u) ? (g - epoch * 1024u + 1u) : 0u;
        if (lane == 0) lprog[0] = cur + 1u;
        if (cur >= 128u || ++idle > 400000u) break;
        __builtin_amdgcn_s_sleep(16);
      }
      if (lane == 0) lprog[0] = 0xffffffffu;
    }
  } else {
    u32x4 sink = {0u, 0u, 0u, 0u};
    unsigned spins = 0u;
    for (int n = 0; n < 128;) {
      const unsigned s = lprog[0];
      if (s == 0xffffffffu) break;
      if (s == 0u) {
        if (++spins > 4000000u) break;
        __builtin_amdgcn_s_sleep(4);
        continue;
      }
      const unsigned started = s - 1u;
      if ((unsigned)n < started) n = (int)started;
      if (n >= 128) break;
      if ((unsigned)n >= started + AHEAD) {
        if (++spins > 4000000u) break;
        __builtin_amdgcn_s_sleep(4);
        continue;
      }
      const int item = bh * 128 + (dir ? 127 - n : n);
      const char* rec = p.gdn_rec + ((size_t)item * 2 + dir) * REC_BYTES;
      const char* uu = (const char*)(p.gdn_u + ((size_t)(item * 2 + dir) * 32) * 128);
#pragma unroll
      for (int q = 0; q < 4; ++q) {
        const int pc = wid - 1 + 7 * q;
        if (pc < 24) {
          const int piece = 24 * j + pc;
          const char* ptr = (piece < 56 ? rec + piece * 1024 : uu + (piece - 56) * 1024) + lane * 16;
          asm volatile("global_load_dwordx4 %0, %1, off" : "+v"(sink) : "v"(ptr) : "memory");
        }
      }
      ++n;
    }
    asm volatile("s_waitcnt vmcnt(0)" ::: "memory");
    asm volatile("" :: "v"(sink));
  }
  __syncthreads();
}

DEV void phase_gdn_fin(const Params& p, int l, int bid, int nb) {
  const int tid_ = fresh_tid(), lane = tid_ & 63, wid = tid_ >> 6;
  const float* gnw = p.gdn_norm_w + l * 128 + (lane & 15) * 8;
  for (int t = bid * NWAVE + wid; t < NTOK; t += nb * NWAVE) {
    float of[8], ob[8], z[8], o[8];
    unpack8(*(const uint4*)(p.obuf + (size_t)t * 512 + lane * 8), of);
    unpack8(*(const uint4*)(p.obuf + ((size_t)NTOK + t) * 512 + lane * 8), ob);
    unpack8(*(const uint4*)(p.proj + (size_t)t * PROJW + OFF_GZ + lane * 8), z);
    float ss = 0.f;
#pragma unroll
    for (int e = 0; e < 8; ++e) {
      o[e] = of[e] + ob[e];
      ss += o[e] * o[e];
    }
    ss += shx(ss, 1, lane);
    ss += shx(ss, 2, lane);
    ss += shx(ss, 4, lane);
    ss += shx(ss, 8, lane);
    const float rr = rsqrtf(ss * (1.f / 128.f) + EPS);
    const float4 g0 = *(const float4*)(gnw), g1 = *(const float4*)(gnw + 4);
    const float gw[8] = {g0.x, g0.y, g0.z, g0.w, g1.x, g1.y, g1.z, g1.w};
    float res[8];
#pragma unroll
    for (int e = 0; e < 8; ++e) res[e] = o[e] * rr * gw[e] * silu_f(z[e]);
    *(uint4*)(p.y + (size_t)t * DM + 512 + lane * 8) = pack8(res);
  }
}

struct EpiWout {
  static constexpr bool PERM = false;
  const float* xin; float* xout; const float* mod_l;
  DEV void operator()(const f32x4 (&acc)[2][2][4][2], const GUnit& u, int wr, int wc, int fr, int fq) const {
    const int row0 = u.pm * 256 + wr * 64 + fr, col0 = u.pn * 256 + wc * 32 + 4 * fq;
    const float* gate = mod_l + ((u.pm * 256) / T) * 6144 + MOD_GATE1;
    f32x4 gv[2][2];
#pragma unroll
    for (int bj = 0; bj < 2; ++bj)
#pragma unroll
      for (int n = 0; n < 2; ++n) gv[bj][n] = *(const f32x4*)(gate + col0 + bj * G_HALF + n * 16);
#pragma unroll
    for (int ai = 0; ai < 2; ++ai)
#pragma unroll
      for (int m = 0; m < 4; ++m) {
        const size_t ro = (size_t)(row0 + ai * G_HALF + m * 16) * DM + col0;
#pragma unroll
        for (int bj = 0; bj < 2; ++bj)
#pragma unroll
          for (int n = 0; n < 2; ++n) {
            const f32x4 xi = *(const f32x4*)(xin + ro + bj * G_HALF + n * 16);
            *(f32x4*)(xout + ro + bj * G_HALF + n * 16) = xi + gv[bj][n] * acc[ai][bj][m][n];
          }
      }
  }
};

DEV void phase_gemm_wout(const Params& p, int l, const float* xin, int bid, int nb, char* smem) {
  DenseSched S;
  S.A = p.y; S.Bt = p.btout; S.K = DM; S.nM = NTOK / 256; S.nN = DM / 256; S.nwg = S.nM * S.nN; S.G = nb; S.c = bid; S.wv = p.wv;
  EpiWout E;
  E.xin = xin; E.xout = p.xbuf; E.mod_l = p.mod + l * 2 * 6144;
  gemm_phase((LAS unsigned char*)smem, S, E);
}

DEV void phase_consts(const Params& p, int bid, int nb) {
  const int tid = fresh_tid(), lane = tid & 63, wid = tid >> 6;
  for (int g = bid * NTHR + tid; g < DEPTH * DM * 48; g += nb * NTHR) {
    const int n = g % 48, lk = g / 48;
    float v = 0.f;
    if (n < 4) v = p.rg_w[(size_t)lk * 4 + n];
    else if (n < 36) v = p.re_w[(size_t)lk * 32 + (n - 4)];
    p.wcat[g] = v;
  }
  for (int g = bid * NTHR + tid; g < DEPTH * NB * DM; g += nb * NTHR) {
    const int k = g & (DM - 1), lb = g >> 10, l = lb >> 1;
    p.wsc2[g] = p.norm_ffn_w[l * DM + k] * (1.f + p.mod[lb * 6144 + MOD_SCALE2 + k]);
  }
  for (int o = bid * NWAVE + wid; o < DEPTH * NB * 48; o += nb * NWAVE) {
    const int n = o % 48, lb = o / 48, l = lb >> 1;
    float s = 0.f;
    if (n < 36) {
#pragma unroll
      for (int k16 = 0; k16 < DM / 64; ++k16) {
        const int k = lane + 64 * k16;
        const float w = (n < 4) ? p.rg_w[((size_t)l * DM + k) * 4 + n] : p.re_w[((size_t)l * DM + k) * 32 + (n - 4)];
        s += p.mod[lb * 6144 + MOD_SHIFT2 + k] * w;
      }
      s = wave_sum(s, lane);
      s += (n < 4) ? p.rg_b[l * 4 + n] : p.re_b[l * 32 + (n - 4)];
    }
    if (lane == 0) p.c0[o] = s;
  }
}

DEV void phase_router(const Params& p, int l, int bid, int nb, char* smem) {
  float* accb = (float*)smem;
  float* ssqb = accb + 2 * 64 * 49;
  float* rsl = ssqb + 128;
  int* lcnt = (int*)(rsl + 64);
  int* lbase = lcnt + NEXP;
  const int tid = fresh_tid(), lane = tid & 63, wid = tid >> 6, fr = lane & 15, fq = lane >> 4;
  const int tg = wid & 3, kh = wid >> 2;
  int sel_e0 = 0, sel_e1 = 0, sel_r0 = 0, sel_r1 = 0;
  if (tid < NEXP) lcnt[tid] = 0;
  __syncthreads();
  for (int tb = bid; tb < NTOK / 64; tb += nb) {
    const int tok0 = tb * 64;
    const int b = tok0 / T;
    const float* wsc = p.wsc2 + (l * 2 + b) * DM;
    {
      float* Bs = (float*)(smem + 32768);
      const float* xr = p.xbuf + (size_t)(tok0 + tg * 16 + fr) * DM + kh * 512 + fq * 4;
      const float* wv = wsc + kh * 512 + fq * 4;
      const float* wl = p.wcat + (size_t)l * DM * 48;
      f32x4 acc[3];
#pragma unroll
      for (int nt = 0; nt < 3; ++nt) acc[nt] = f32x4{0.f, 0.f, 0.f, 0.f};
      float ssq = 0.f;
      float4 rbv[3], xa[4], wa[4], xn[4], wn[4];
      auto gloadB = [&](int s) {
#pragma unroll
        for (int i = 0; i < 3; ++i) {
          const int idx = tid + NTHR * i, half = idx / 768, r = idx - half * 768, krow = r / 12, c4 = r - krow * 12;
          rbv[i] = *(const float4*)(wl + (size_t)(half * 512 + 64 * s + krow) * 48 + c4 * 4);
        }
      };
      auto storeB = [&](int buf) {
#pragma unroll
        for (int i = 0; i < 3; ++i) {
          const int idx = tid + NTHR * i, half = idx / 768, r = idx - half * 768, krow = r / 12, c4 = r - krow * 12;
          *(float4*)(Bs + ((buf * 2 + half) * 64 + krow) * 48 + c4 * 4) = rbv[i];
        }
      };
      auto gloadA = [&](float4 (&xd)[4], float4 (&wd)[4], int s) {
#pragma unroll
        for (int c = 0; c < 4; ++c) {
          xd[c] = *(const float4*)(xr + 64 * s + c * 16);
          wd[c] = *(const float4*)(wv + 64 * s + c * 16);
        }
      };
      gloadB(0);
      gloadA(xa, wa, 0);
      storeB(0);
      __syncthreads();
#pragma unroll 1
      for (int s = 0; s < 8; ++s) {
        const int sn = min(s + 1, 7);
        gloadB(sn);
        gloadA(xn, wn, sn);
        const float* bt = Bs + (((s & 1) * 2 + kh) * 64 + fq) * 48 + fr;
#pragma unroll
        for (int c = 0; c < 4; ++c) {
          const float4 xv = xa[c], ww = wa[c];
          ssq += xv.x * xv.x + xv.y * xv.y + xv.z * xv.z + xv.w * xv.w;
          const float a0 = xv.x * ww.x, a1 = xv.y * ww.y, a2 = xv.z * ww.z, a3 = xv.w * ww.w;
          const float* bp = bt + (16 * c + 3 * fq) * 48;
#pragma unroll
          for (int nt = 0; nt < 3; ++nt) {
            acc[nt] = __builtin_amdgcn_mfma_f32_16x16x4f32(a0, bp[0 * 48 + nt * 16], acc[nt], 0, 0, 0);
            acc[nt] = __builtin_amdgcn_mfma_f32_16x16x4f32(a1, bp[1 * 48 + nt * 16], acc[nt], 0, 0, 0);
            acc[nt] = __builtin_amdgcn_mfma_f32_16x16x4f32(a2, bp[2 * 48 + nt * 16], acc[nt], 0, 0, 0);
            acc[nt] = __builtin_amdgcn_mfma_f32_16x16x4f32(a3, bp[3 * 48 + nt * 16], acc[nt], 0, 0, 0);
          }
        }
        storeB((s + 1) & 1);
        __syncthreads();
#pragma unroll
        for (int c = 0; c < 4; ++c) { xa[c] = xn[c]; wa[c] = wn[c]; }
      }
      ssq += shx(ssq, 16, lane);
      ssq += shx(ssq, 32, lane);
#pragma unroll
      for (int nt = 0; nt < 3; ++nt)
#pragma unroll
        for (int j = 0; j < 4; ++j) accb[(kh * 64 + tg * 16 + fq * 4 + j) * 49 + nt * 16 + fr] = acc[nt][j];
      if (fq == 0) ssqb[kh * 64 + tg * 16 + fr] = ssq;
    }
    __syncthreads();
    if (tid < 64) {
      const int t = tok0 + tid;
      const float rstd = rsqrtf((ssqb[tid] + ssqb[64 + tid]) * (1.f / DM) + EPS);
      rsl[tid] = rstd;
      const float* c0 = p.c0 + (l * 2 + b) * 48;
      float acc[36];
#pragma unroll
      for (int o = 0; o < 36; ++o) acc[o] = rstd * (accb[tid * 49 + o] + accb[(64 + tid) * 49 + o]) + c0[o];
      int grp = 0;
      float mx = acc[0];
#pragma unroll
      for (int g = 1; g < 4; ++g)
        if (acc[g] > mx) { mx = acc[g]; grp = g; }
      float den = 0.f;
#pragma unroll
      for (int g = 0; g < 4; ++g) den += __expf(acc[g] - mx);
      const float pg_top = 1.f / den;
      float el[8];
#pragma unroll
      for (int j = 0; j < 8; ++j) {
        const float a0 = acc[4 + j], a1 = acc[12 + j], a2 = acc[20 + j], a3 = acc[28 + j];
        el[j] = (grp == 0) ? a0 : (grp == 1) ? a1 : (grp == 2) ? a2 : a3;
      }
      float b0 = -3.0e38f, b1 = -3.0e38f;
      int i0 = 0, i1 = 0;
#pragma unroll
      for (int j = 0; j < 8; ++j)
        if (el[j] > b0) { b0 = el[j]; i0 = j; }
#pragma unroll
      for (int j = 0; j < 8; ++j)
        if (j != i0 && el[j] > b1) { b1 = el[j]; i1 = j; }
      const float ex = __expf(b1 - b0);
      const float g0 = pg_top / (1.f + ex), g1 = pg_top * ex / (1.f + ex);
      const int e0 = grp * 8 + i0, e1 = grp * 8 + i1;
      sel_e0 = e0; sel_e1 = e1;
      sel_r0 = atomicAdd(&lcnt[e0], 1);
      sel_r1 = atomicAdd(&lcnt[e1], 1);
      p.sgate[2 * t] = g0;
      p.sgate[2 * t + 1] = g1;
    }
    __syncthreads();
    if (tid < NEXP) {
      const int c = lcnt[tid];
      lbase[tid] = (c > 0) ? atomicAdd(&p.cnt[l * NEXP + tid], c) : 0;
      lcnt[tid] = 0;
    }
    __syncthreads();
    if (tid < 64) {
      const int t = tok0 + tid;
      p.list[sel_e0 * CAP + lbase[sel_e0] + sel_r0] = 2 * t;
      p.list[sel_e1 * CAP + lbase[sel_e1] + sel_r1] = 2 * t + 1;
    }
    {
      const float* sh = p.mod + (l * 2 + b) * 6144 + MOD_SHIFT2;
#pragma unroll 2
      for (int q = 0; q < 8; ++q) {
        const int tl = wid * 8 + q;
        const float rstd = rsl[tl];
        const float4* xr = (const float4*)(p.xbuf + (size_t)(tok0 + tl) * DM);
#pragma unroll
        for (int i = 0; i < 4; ++i) {
          const int idx = (lane + 64 * i) * 4;
          const float4 xv = xr[lane + 64 * i];
          const float4 w = *(const float4*)(wsc + idx);
          const float4 h = *(const float4*)(sh + idx);
          uint2 pk;
          pk.x = pack2(xv.x * w.x * rstd + h.x, xv.y * w.y * rstd + h.y);
          pk.y = pack2(xv.z * w.z * rstd + h.z, xv.w * w.w * rstd + h.w);
          *(uint2*)(p.act + (size_t)(tok0 + tl) * DM + idx) = pk;
        }
      }
    }
    __syncthreads();
  }
}

struct EpiMoe {
  static constexpr bool PERM = true;
  bf16_t* H; bf16_t* Y; const int* list; const float* sgate;
  DEV void operator()(const f32x4 (&acc)[2][2][4][2], const GUnit& u, int wr, int wc, int fr_, int fq) const {
    int fr = fr_;
    asm volatile("" : "+v"(fr));
    if (!u.ph) {
      const __amdgpu_buffer_rsrc_t rh = __builtin_amdgcn_make_buffer_rsrc((void*)H, 0, 2 * 32768 * DEXP, 0x00020000);
      const int hcol = u.pn * 128 + wc * 32 + 8 * fq;
#pragma unroll
      for (int ai = 0; ai < 2; ++ai)
#pragma unroll
        for (int m = 0; m < 4; ++m) {
          const int rl = ai * G_HALF + wr * 64 + m * 16 + fr;
          if (rl < u.valid) {
            const int slot = list[u.e * CAP + u.pm * 256 + rl];
            float h[8];
#pragma unroll
            for (int n = 0; n < 2; ++n)
#pragma unroll
              for (int j = 0; j < 4; ++j) h[n * 4 + j] = silu_f(acc[ai][0][m][n][j]) * acc[ai][1][m][n][j];
            const uint4 pk = pack8(h);
            const u32x4 pv = {pk.x, pk.y, pk.z, pk.w};
            __builtin_amdgcn_raw_buffer_store_b128(pv, rh, (slot * DEXP + hcol) * 2, 0, 16  );
          }
        }
    } else {
      const int col0 = u.pn * 256 + wc * 32 + 8 * fq;
#pragma unroll
      for (int ai = 0; ai < 2; ++ai)
#pragma unroll
        for (int m = 0; m < 4; ++m) {
          const int rl = ai * G_HALF + wr * 64 + m * 16 + fr;
          if (rl < u.valid) {
            const int slot = list[u.e * CAP + u.pm * 256 + rl];
            const float g = sgate[slot];
#pragma unroll
            for (int bj = 0; bj < 2; ++bj) {
              float yv[8];
#pragma unroll
              for (int n = 0; n < 2; ++n)
#pragma unroll
                for (int j = 0; j < 4; ++j) yv[n * 4 + j] = g * acc[ai][bj][m][n][j];
              *(uint4*)(Y + (size_t)slot * DM + col0 + bj * G_HALF) = pack8(yv);
            }
          }
        }
    }
  }
};

DEV void phase_moe(const Params& p, int l, int bid, int nb, char* smem) {
  MoeSched S;
  S.act = p.act; S.hbuf = p.hbuf; S.bt1 = p.bt1; S.bt2 = p.bt2; S.cnt = p.cnt + l * NEXP; S.list = p.list;
  S.rdy = p.bar + XB_RDY + l * 192; S.tmo = p.bar + XB_TMO; S.G = nb; S.c = bid; S.wv = p.wv;
  S.q = p.bar + XB_MQ + l * 64;
  S.tb = (LAS int*)(smem + 131072);
  {
    const int tq = fresh_tid();
    if (tq < 64) {
      const int cn = (tq < NEXP) ? S.cnt[tq] : 0;
      int ps = (cn + 255) >> 8;
#pragma unroll
      for (int o = 1; o < 64; o <<= 1) {
        const int v = __builtin_amdgcn_ds_bpermute((tq - o) << 2, ps);
        if (tq >= o) ps += v;
      }
      if (tq < NEXP) { S.tb[1 + tq] = ps; S.tb[48 + tq] = cn; }
      if (tq == 0) {
        S.tb[0] = 0;
        const unsigned t0 = atomicAdd(S.q, 2u);
        S.tb[40] = (int)t0;
        S.tb[41] = (int)t0 + 1;
        S.tb[44] = 1;
      }
    }
    __syncthreads();
  }
  EpiMoe E;
  E.H = p.hbuf; E.Y = p.ybuf; E.list = p.list; E.sgate = p.sgate;
#pragma unroll 1
  for (int stage = 0; stage < 2; ++stage) {
    S.stage = stage;
    if (stage) {
      __syncthreads();
      if (fresh_tid() == 0) {
        const int m = S.tb[44];
        const int ta = S.tb[40 + ((m - 1) & 1)], tb_ = S.tb[40 + (m & 1)];
        S.tb[40] = ta; S.tb[41] = tb_; S.tb[44] = 1;
      }
      __syncthreads();
    }
    gemm_phase((LAS unsigned char*)smem, S, E);
  }
}

DEV void phase_combine(const Params& p, int l, int bid, int nb) {
  const int tid_ = fresh_tid(), lane = tid_ & 63, wid = tid_ >> 6;
  for (int t = bid * NWAVE + wid; t < NTOK; t += nb * NWAVE) {
    float4* xr = (float4*)(p.xbuf + (size_t)t * DM);
    const int b = t / T;
    const float* md = p.mod + (l * 2 + b) * 6144;
    float4 v[4];
    float ss = 0.f;
#pragma unroll
    for (int i = 0; i < 4; ++i) {
      const int idx = (lane + 64 * i) * 4;
      v[i] = xr[lane + 64 * i];
      const float4 g = *(const float4*)(md + MOD_GATE2 + idx);
      const uint2 ya = *(const uint2*)(p.ybuf + (size_t)(2 * t) * DM + idx);
      const uint2 yb = *(const uint2*)(p.ybuf + (size_t)(2 * t + 1) * DM + idx);
      v[i].x += g.x * (__uint_as_float(ya.x << 16) + __uint_as_float(yb.x << 16));
      v[i].y += g.y * (__uint_as_float(ya.x & 0xffff0000u) + __uint_as_float(yb.x & 0xffff0000u));
      v[i].z += g.z * (__uint_as_float(ya.y << 16) + __uint_as_float(yb.y << 16));
      v[i].w += g.w * (__uint_as_float(ya.y & 0xffff0000u) + __uint_as_float(yb.y & 0xffff0000u));
      ss += v[i].x * v[i].x + v[i].y * v[i].y + v[i].z * v[i].z + v[i].w * v[i].w;
    }
    ss = wave_sum(ss, lane);
    const float rstd = rsqrtf(ss * (1.f / DM) + EPS);
    if (l + 1 < DEPTH) {
#pragma unroll
      for (int i = 0; i < 4; ++i) xr[lane + 64 * i] = v[i];
      const float* md2 = p.mod + ((l + 1) * 2 + b) * 6144;
      norm_mod_store(v, rstd, p.norm_mix_w + (l + 1) * DM, md2 + MOD_SCALE1, md2 + MOD_SHIFT1,
                     p.act + (size_t)t * DM, lane);
    } else {
      float4* orow = (float4*)(p.out + (size_t)t * DM);
#pragma unroll
      for (int i = 0; i < 4; ++i) {
        const float4 w = *(const float4*)(p.final_w + (lane + 64 * i) * 4);
        float4 r;
        r.x = v[i].x * rstd * w.x;
        r.y = v[i].y * rstd * w.y;
        r.z = v[i].z * rstd * w.z;
        r.w = v[i].w * rstd * w.w;
        orow[lane + 64 * i] = r;
      }
    }
  }
}

constexpr size_t ws_align(size_t b) { return (b + 255) & ~(size_t)255; }
constexpr size_t WS_bar = 0;
constexpr size_t WS_mod = WS_bar + ws_align(sizeof(unsigned) * BAR_WORDS_TOTAL);
constexpr size_t WS_btin = WS_mod + ws_align(sizeof(float) * DEPTH * NB * 6144);
constexpr size_t WS_btg = WS_btin + ws_align(2 * (size_t)PROJW * DM);
constexpr size_t WS_btout = WS_btg + ws_align(2 * (size_t)16 * DM);
constexpr size_t WS_bt1 = WS_btout + ws_align(2 * (size_t)DM * DM);
constexpr size_t WS_bt2 = WS_bt1 + ws_align(2 * (size_t)NEXP * 1024 * DM);
constexpr size_t WS_wcat = WS_bt2 + ws_align(2 * (size_t)NEXP * DM * DEXP);
constexpr size_t WS_wsc2 = WS_wcat + ws_align(sizeof(float) * DEPTH * DM * 48);
constexpr size_t WS_c0 = WS_wsc2 + ws_align(sizeof(float) * DEPTH * NB * DM);
constexpr size_t WS_cnt = WS_c0 + ws_align(sizeof(float) * DEPTH * NB * 48);
constexpr size_t WS_xbuf = WS_cnt + ws_align(sizeof(int) * DEPTH * NEXP);
constexpr size_t WS_act = WS_xbuf + ws_align(sizeof(float) * (size_t)NTOK * DM);
constexpr size_t WS_proj = WS_act + ws_align(2 * (size_t)NTOK * DM);
constexpr size_t WS_gates = WS_proj + ws_align(2 * (size_t)NTOK * PROJW);
constexpr size_t WS_y = WS_gates + ws_align(sizeof(float) * (size_t)NTOK * 16);
constexpr size_t WS_list = WS_y + ws_align(2 * (size_t)NTOK * DM);
constexpr size_t WS_sgate = WS_list + ws_align(sizeof(int) * NEXP * CAP);
constexpr size_t WS_egl = WS_sgate + ws_align(sizeof(float) * 2 * NTOK);
constexpr size_t WS_obuf = WS_egl + ws_align(sizeof(float) * 2048);
constexpr size_t WS_gdn_rec = WS_obuf + ws_align(2 * 2 * (size_t)NTOK * 512);
constexpr size_t WS_gdn_u = WS_gdn_rec + ws_align((size_t)2048 * REC_BYTES);
constexpr size_t WS_TOTAL = WS_gdn_u + ws_align(sizeof(unsigned) * (size_t)2048 * 32 * 128);

struct KArgs {
  const float *x, *c, *norm_mix_w, *norm_ffn_w, *w_ada, *b_ada, *w_in, *conv_a_w, *na_rpb, *gdn_conv_w,
      *gdn_a_log, *gdn_dt_bias, *gdn_norm_w, *w_out, *rg_w, *rg_b, *re_w, *re_b, *ew1, *ew3, *ew2, *final_w;
  float* out;
  char* ws;
  int rep[12];
};
DEV Params make_params(const KArgs& a) {
  Params p;
  p.x = a.x; p.c = a.c; p.norm_mix_w = a.norm_mix_w; p.norm_ffn_w = a.norm_ffn_w; p.w_ada = a.w_ada; p.b_ada = a.b_ada;
  p.w_in = a.w_in; p.conv_a_w = a.conv_a_w; p.na_rpb = a.na_rpb; p.gdn_conv_w = a.gdn_conv_w; p.gdn_a_log = a.gdn_a_log;
  p.gdn_dt_bias = a.gdn_dt_bias; p.gdn_norm_w = a.gdn_norm_w; p.w_out = a.w_out; p.rg_w = a.rg_w; p.rg_b = a.rg_b;
  p.re_w = a.re_w; p.re_b = a.re_b; p.ew1 = a.ew1; p.ew3 = a.ew3; p.ew2 = a.ew2; p.final_w = a.final_w;
  p.out = a.out;
  p.bar = (unsigned*)(a.ws + WS_bar);
  p.mod = (float*)(a.ws + WS_mod);
  p.btin = (bf16_t*)(a.ws + WS_btin);
  p.btg = (bf16_t*)(a.ws + WS_btg);
  p.btout = (bf16_t*)(a.ws + WS_btout);
  p.bt1 = (bf16_t*)(a.ws + WS_bt1);
  p.bt2 = (bf16_t*)(a.ws + WS_bt2);
  p.wcat = (float*)(a.ws + WS_wcat);
  p.wsc2 = (float*)(a.ws + WS_wsc2);
  p.c0 = (float*)(a.ws + WS_c0);
  p.cnt = (int*)(a.ws + WS_cnt);
  p.xbuf = (float*)(a.ws + WS_xbuf);
  p.act = (bf16_t*)(a.ws + WS_act);
  p.proj = (bf16_t*)(a.ws + WS_proj);
  p.gates = (float*)(a.ws + WS_gates);
  p.y = (bf16_t*)(a.ws + WS_y);
  p.list = (int*)(a.ws + WS_list);
  p.sgate = (float*)(a.ws + WS_sgate);
  p.egl = (float*)(a.ws + WS_egl);
  p.obuf = (bf16_t*)(a.ws + WS_obuf);
  p.gdn_rec = (char*)(a.ws + WS_gdn_rec);
  p.gdn_u = (unsigned*)(a.ws + WS_gdn_u);
  p.hbuf = (bf16_t*)p.obuf;
  p.ybuf = (bf16_t*)p.gdn_rec;
#pragma unroll
  for (int i = 0; i < 12; ++i) p.rep[i] = a.rep[i];
  p.wv = __builtin_amdgcn_readfirstlane((int)(threadIdx.x >> 6));
  return p;
}

__global__ void __launch_bounds__(NTHR) mega_kernel(KArgs ka) {
  const Params p = make_params(ka);
  __shared__ __attribute__((aligned(16))) char smem[SMEM_BYTES + 16];
  const int bid0 = blockIdx.x, nb = gridDim.x;
  if (fresh_tid() == 0) *(uint4*)(smem + SMEM_BYTES) = make_uint4(0u, 0u, 0u, 0u);
  __syncthreads();
  xcd_barrier_post(p.bar, fresh_tid());
#pragma unroll 1
  for (int rp = 0; rp < p.rep[7]; ++rp) {
    phase_ada(p, bid0, nb, smem);
    convert_win(p, 0, bid0, nb, smem);
  }
  xcd_barrier(p.bar, (volatile LAS unsigned*)(smem + SMEM_BYTES), fresh_tid());
#pragma unroll 1
  for (int rp = 0; rp < p.rep[8]; ++rp) {
    phase_hmix(p, 0, p.x, bid0, nb);
    phase_consts(p, bid0, nb);
  }
  xcd_barrier(p.bar, (volatile LAS unsigned*)(smem + SMEM_BYTES), fresh_tid());
#pragma unroll 1
  for (int l = 0; l < DEPTH; ++l) {
    int lz = l;
    asm volatile("" : "+s"(lz));
    const int bid = bid0 + (lz - l);
#pragma unroll 1
    for (int rp = 0; rp < p.rep[0]; ++rp) phase_gemm_proj(p, l, bid, nb, smem);
    xcd_barrier(p.bar, (volatile LAS unsigned*)(smem + SMEM_BYTES), fresh_tid());
#pragma unroll 1
    for (int rp = 0; rp < p.rep[1]; ++rp) phase_gdn_prep(p, l, bid, nb, smem);
    xcd_barrier(p.bar, (volatile LAS unsigned*)(smem + SMEM_BYTES), fresh_tid());
#pragma unroll 1
    for (int rp = 0; rp < p.rep[2]; ++rp) {
      if (bid < 16) {
        phase_gdn_scan(p, l * 4 + rp + 1, bid, smem);
      } else if (bid < 64) {
        phase_scan_helper(p, l * 4 + rp + 1, (bid - 16) & 15, (bid - 16) >> 4, smem);
      } else {
#pragma unroll 1
        for (int rq = 0; rq < p.rep[6]; ++rq) {
          phase_conv(p, l, bid - 64, nb - 64);
          phase_na(p, l, (bid - 64) * NWAVE + (fresh_tid() >> 6), (nb - 64) * NWAVE);
        }
#pragma unroll 1
        for (int rq = 0; rq < p.rep[10]; ++rq) convert_layer(p, l, bid - 64, nb - 64, smem);
      }
    }
    xcd_barrier(p.bar, (volatile LAS unsigned*)(smem + SMEM_BYTES), fresh_tid());
#pragma unroll 1
    for (int rp = 0; rp < p.rep[5]; ++rp) phase_gdn_fin(p, l, bid, nb);
    xcd_barrier(p.bar, (volatile LAS unsigned*)(smem + SMEM_BYTES), fresh_tid());
#pragma unroll 1
    for (int rp = 0; rp < (l == 0 ? p.rep[9] : 1); ++rp) phase_gemm_wout(p, l, l == 0 ? p.x : p.xbuf, bid, nb, smem);
    xcd_barrier(p.bar, (volatile LAS unsigned*)(smem + SMEM_BYTES), fresh_tid());
    phase_router(p, l, bid, nb, smem);
    xcd_barrier(p.bar, (volatile LAS unsigned*)(smem + SMEM_BYTES), fresh_tid());
    phase_moe(p, l, bid, nb, smem);
    xcd_barrier(p.bar, (volatile LAS unsigned*)(smem + SMEM_BYTES), fresh_tid());
    phase_combine(p, l, bid, nb);
#pragma unroll 1
    for (int rp = 1; rp < p.rep[11]; ++rp) xcd_barrier(p.bar, (volatile LAS unsigned*)(smem + SMEM_BYTES), fresh_tid());
    if (l + 1 < DEPTH) xcd_barrier(p.bar, (volatile LAS unsigned*)(smem + SMEM_BYTES), fresh_tid());
  }
}

extern "C" void kernel_launch(void* const* d_in, const int* in_sizes, int n_in, void* d_out, int out_size,
                              void* d_ws, size_t ws_size, hipStream_t stream) {
  KArgs p{};
  p.x = (const float*)d_in[0];
  p.c = (const float*)d_in[1];
  p.norm_mix_w = (const float*)d_in[2];
  p.norm_ffn_w = (const float*)d_in[3];
  p.w_ada = (const float*)d_in[4];
  p.b_ada = (const float*)d_in[5];
  p.w_in = (const float*)d_in[6];
  p.conv_a_w = (const float*)d_in[7];
  p.na_rpb = (const float*)d_in[8];
  p.gdn_conv_w = (const float*)d_in[9];
  p.gdn_a_log = (const float*)d_in[10];
  p.gdn_dt_bias = (const float*)d_in[11];
  p.gdn_norm_w = (const float*)d_in[12];
  p.w_out = (const float*)d_in[13];
  p.rg_w = (const float*)d_in[14];
  p.rg_b = (const float*)d_in[15];
  p.re_w = (const float*)d_in[16];
  p.re_b = (const float*)d_in[17];
  p.ew1 = (const float*)d_in[18];
  p.ew3 = (const float*)d_in[19];
  p.ew2 = (const float*)d_in[20];
  p.final_w = (const float*)d_in[21];
  p.out = (float*)d_out;
  p.ws = (char*)d_ws;
  if (WS_TOTAL > ws_size) fprintf(stderr, "workspace too small: need %zu have %zu\n", (size_t)WS_TOTAL, ws_size);

  static int grid_blocks = 0;
  if (!grid_blocks) {
    int dev = 0, cus = 0, per_cu = 0;
    (void)hipGetDevice(&dev);
    (void)hipDeviceGetAttribute(&cus, hipDeviceAttributeMultiprocessorCount, dev);
    (void)hipOccupancyMaxActiveBlocksPerMultiprocessor(&per_cu, mega_kernel, NTHR, 0);
    if (per_cu > 1) per_cu = 1;
    if (per_cu < 1) per_cu = 1;
    grid_blocks = cus * per_cu;
  }
  (void)hipMemsetAsync((char*)d_ws + WS_bar, 0, sizeof(unsigned) * BAR_WORDS_TOTAL, stream);
  for (int i = 0; i < 12; ++i) p.rep[i] = 1;
  void* args[] = {&p};
  hipError_t e = hipLaunchCooperativeKernel((void*)mega_kernel, dim3(grid_blocks), dim3(NTHR), args, 0, stream);
  if (e != hipSuccess) fprintf(stderr, "cooperative launch failed: %s (grid %d)\n", hipGetErrorString(e), grid_blocks);
}
```
